# Optimizing an MI355X kernel written in HIP

```python
import numpy as np
import jax
import jax.numpy as jnp
from jax import lax

D_MODEL = 1024
BATCH = 8
SEQ = 8192
DEPTH = 1

RET_HEADS = 4
RET_QK_DIM = 128
RET_V_DIM = 256
MLSTM_HEADS = 4
MLSTM_QK_DIM = 128
MLSTM_V_DIM = 256
CONV_WIDTH = 4
CHUNK = 128
ROPE_BASE = 10000.0
N_GROUPS = 4
EXPERTS_PER_GROUP = 8
N_EXPERTS = N_GROUPS * EXPERTS_PER_GROUP
TOP_K = 2
D_EXPERT = 512
MOE_BLOCK = 128
NORM_EPS = 1e-6

RET_QK = RET_HEADS * RET_QK_DIM
RET_V = RET_HEADS * RET_V_DIM
M_QK = MLSTM_HEADS * MLSTM_QK_DIM
M_V = MLSTM_HEADS * MLSTM_V_DIM
IN_SPLITS = (RET_QK, RET_QK, RET_V, RET_V, M_QK, M_QK, M_V, M_V, MLSTM_HEADS, MLSTM_HEADS, D_MODEL, D_MODEL)
D_IN = RET_QK * 2 + RET_V * 2 + M_QK * 2 + M_V * 2 + MLSTM_HEADS * 2 + D_MODEL * 2

kernel_name = "hybrid_retention_mlstm_hmoe"


def split_points(widths):
    pts, acc = [], 0
    for w in widths[:-1]:
        acc += w
        pts.append(acc)
    return pts


def rms_norm(x, w):
    xf = x.astype(jnp.float32)
    y = xf * lax.rsqrt(jnp.mean(xf * xf, axis=-1, keepdims=True) + NORM_EPS)
    return (y * w.astype(jnp.float32)).astype(x.dtype)


def head_rms_norm(xh):
    B, S, H, d = xh.shape
    y = xh * lax.rsqrt(jnp.mean(xh * xh, axis=-1, keepdims=True) + NORM_EPS)
    return y.reshape(B, S, H * d)


def rotary(x, positions):
    d = x.shape[-1]
    inv_freq = 1.0 / (ROPE_BASE ** (jnp.arange(0, d, 2, dtype=jnp.float32) / d))
    ang = positions.astype(jnp.float32)[:, None] * inv_freq[None, :]
    cos = jnp.cos(ang)[None, :, None, :]
    sin = jnp.sin(ang)[None, :, None, :]
    x1, x2 = jnp.split(x, 2, axis=-1)
    return jnp.concatenate([x1 * cos - x2 * sin, x2 * cos + x1 * sin], axis=-1)


def to_chunks(t):
    B, S, H, d = t.shape
    return t.reshape(B, S // CHUNK, CHUNK, H, d).transpose(1, 0, 3, 2, 4)


def from_chunks(t):
    nc, B, H, L, d = t.shape
    return t.transpose(1, 0, 3, 2, 4).reshape(B, nc * L, H, d)


def retention_chunkwise(q, k, v, log_gamma):
    B, S, H, dk = q.shape
    dv = v.shape[-1]
    idx = jnp.arange(CHUNK, dtype=jnp.float32)
    rel = idx[:, None] - idx[None, :]
    causal = rel >= 0
    decay_mask = jnp.where(causal[None], jnp.exp(log_gamma[:, None, None] * jnp.where(causal, rel, 0.0)[None]), 0.0)
    q_decay = jnp.exp(log_gamma[:, None] * (idx + 1.0)[None, :])
    k_decay = jnp.exp(log_gamma[:, None] * (CHUNK - 1.0 - idx)[None, :])
    chunk_decay = jnp.exp(log_gamma * CHUNK)

    def step(R, inp):
        qi, ki, vi = inp
        s = jnp.einsum('bhld,bhmd->bhlm', qi, ki) * decay_mask[None]
        o = (jnp.einsum('bhlm,bhme->bhle', s, vi)
             + jnp.einsum('bhld,bhde->bhle', qi, R) * q_decay[None, :, :, None])
        R = (R * chunk_decay[None, :, None, None]
             + jnp.einsum('bhld,bhle->bhde', ki * k_decay[None, :, :, None], vi))
        return R, o

    R0 = jnp.zeros((B, H, dk, dv), jnp.float32)
    _, o = lax.scan(step, R0, (to_chunks(q), to_chunks(k), to_chunks(v)))
    return from_chunks(o)


def mlstm_chunkwise(q, k, v, i_pre, f_pre):
    B, S, H, dk = q.shape
    dv = v.shape[-1]
    nc = S // CHUNK
    log_f = jax.nn.log_sigmoid(f_pre)
    gate_chunks = lambda g: g.reshape(B, nc, CHUNK, H).transpose(1, 0, 3, 2)
    causal = jnp.tril(jnp.ones((CHUNK, CHUNK), dtype=bool))

    def step(carry, inp):
        C, n, m = carry
        qi, ki, vi, ii, lfi = inp
        b = jnp.cumsum(lfi, axis=-1)
        a = b + m[..., None]
        dmat = jnp.where(causal, b[..., :, None] - b[..., None, :] + ii[..., None, :], -jnp.inf)
        m_t = jnp.maximum(a, jnp.max(dmat, axis=-1))
        w_inter = jnp.exp(a - m_t)
        s = jnp.einsum('bhld,bhmd->bhlm', qi, ki) * jnp.exp(dmat - m_t[..., None])
        num = jnp.einsum('bhlm,bhme->bhle', s, vi) + jnp.einsum('bhld,bhde->bhle', qi, C) * w_inter[..., None]
        den = jnp.sum(s, axis=-1) + jnp.einsum('bhld,bhd->bhl', qi, n) * w_inter
        h = num / jnp.maximum(jnp.abs(den), jnp.exp(-m_t))[..., None]
        b_last = b[..., -1]
        g = b_last[..., None] - b + ii
        m_new = jnp.maximum(b_last + m, jnp.max(g, axis=-1))
        keep = jnp.exp(b_last + m - m_new)
        wk = ki * jnp.exp(g - m_new[..., None])[..., None]
        C = C * keep[..., None, None] + jnp.einsum('bhld,bhle->bhde', wk, vi)
        n = n * keep[..., None] + jnp.sum(wk, axis=-2)
        return (C, n, m_new), h

    carry0 = (jnp.zeros((B, H, dk, dv), jnp.float32), jnp.zeros((B, H, dk), jnp.float32),
              jnp.zeros((B, H), jnp.float32))
    _, h = lax.scan(step, carry0, (to_chunks(q), to_chunks(k), to_chunks(v), gate_chunks(i_pre), gate_chunks(log_f)))
    return from_chunks(h)


def causal_depthwise_conv(u, w, b):
    y = lax.conv_general_dilated(u, w.astype(u.dtype), window_strides=(1,), padding=[(w.shape[0] - 1, 0)],
                                 dimension_numbers=('NWC', 'WIO', 'NWC'), feature_group_count=u.shape[-1])
    return y + b.astype(u.dtype)


def hybrid_mixer(h, positions, w_in, ret_gn_w, w_ret_branch, conv_w, conv_b, b_i, b_f, mlstm_gn_w,
                 w_mlstm_branch, w_out):
    B, S, _ = h.shape
    f32 = jnp.float32
    proj = h @ w_in
    (r_q, r_k, r_v, r_g, m_q, m_k, m_v, m_o, m_i, m_f, gate_r, gate_m) = jnp.split(proj, split_points(IN_SPLITS), axis=-1)

    log_gamma = jnp.log(1.0 - 2.0 ** (-5.0 - jnp.arange(RET_HEADS, dtype=f32)))
    rq = rotary(r_q.reshape(B, S, RET_HEADS, RET_QK_DIM).astype(f32), positions)
    rk = rotary(r_k.reshape(B, S, RET_HEADS, RET_QK_DIM).astype(f32), positions) * (RET_QK_DIM ** -0.5)
    rv = r_v.reshape(B, S, RET_HEADS, RET_V_DIM).astype(f32)
    ret = head_rms_norm(retention_chunkwise(rq, rk, rv, log_gamma))
    ret = ret * ret_gn_w.astype(f32) * jax.nn.silu(r_g.astype(f32))
    y_ret = ret.astype(h.dtype) @ w_ret_branch

    qk = jax.nn.silu(causal_depthwise_conv(jnp.concatenate([m_q, m_k], axis=-1), conv_w, conv_b))
    mq, mk = jnp.split(qk, 2, axis=-1)
    mq = mq.reshape(B, S, MLSTM_HEADS, MLSTM_QK_DIM).astype(f32)
    mk = mk.reshape(B, S, MLSTM_HEADS, MLSTM_QK_DIM).astype(f32) * (MLSTM_QK_DIM ** -0.5)
    mv = m_v.reshape(B, S, MLSTM_HEADS, MLSTM_V_DIM).astype(f32)
    i_pre = m_i.astype(f32) + b_i.astype(f32)
    f_pre = m_f.astype(f32) + b_f.astype(f32)
    hm = mlstm_chunkwise(mq, mk, mv, i_pre, f_pre).reshape(B, S, M_V) * jax.nn.sigmoid(m_o.astype(f32))
    hm = head_rms_norm(hm.reshape(B, S, MLSTM_HEADS, MLSTM_V_DIM)) * mlstm_gn_w.astype(f32)
    y_m = hm.astype(h.dtype) @ w_mlstm_branch

    merged = jax.nn.sigmoid(gate_r) * y_ret + jax.nn.sigmoid(gate_m) * y_m
    return merged @ w_out


def hierarchical_moe(h, w_group, b_group, w_expert_router, b_expert_router, w_gate, w_up, w_down):
    B, S, D = h.shape
    T = B * S
    xt = h.reshape(T, D)
    xf = xt.astype(jnp.float32)
    group_prob = jax.nn.softmax(xf @ w_group.astype(jnp.float32) + b_group.astype(jnp.float32), axis=-1)
    g_w, g_idx = lax.top_k(group_prob, 1)
    e_logits = (xf @ w_expert_router.astype(jnp.float32) + b_expert_router.astype(jnp.float32)).reshape(T, N_GROUPS, EXPERTS_PER_GROUP)
    sel_logits = e_logits[jnp.arange(T), g_idx[:, 0]]
    top_logits, e_idx = lax.top_k(sel_logits, TOP_K)
    e_w = jax.nn.softmax(top_logits, axis=-1)
    weights = g_w * e_w
    expert_id = g_idx * EXPERTS_PER_GROUP + e_idx

    A = T * TOP_K
    P = A + N_EXPERTS * MOE_BLOCK
    n_blocks = P // MOE_BLOCK
    flat_e = expert_id.reshape(A).astype(jnp.int32)
    flat_tok = jnp.repeat(jnp.arange(T, dtype=jnp.int32), TOP_K)
    flat_w = weights.reshape(A)
    order = jnp.argsort(flat_e)
    se = flat_e[order]
    counts = jnp.bincount(flat_e, length=N_EXPERTS)
    padded = ((counts + MOE_BLOCK - 1) // MOE_BLOCK) * MOE_BLOCK
    start = jnp.cumsum(counts) - counts
    pend = jnp.cumsum(padded)
    pstart = pend - padded
    dest = pstart[se] + (jnp.arange(A, dtype=jnp.int32) - start[se])
    slot_tok = jnp.full((P,), T, dtype=jnp.int32).at[dest].set(flat_tok[order])
    slot_w = jnp.zeros((P,), jnp.float32).at[dest].set(flat_w[order])
    blk_start = jnp.arange(n_blocks, dtype=jnp.int32) * MOE_BLOCK
    blk_e = jnp.minimum(jnp.sum(blk_start[:, None] >= pend[None, :], axis=-1), N_EXPERTS - 1)
    x_pad = jnp.concatenate([xt, jnp.zeros((1, D), xt.dtype)], axis=0)
    xs = x_pad[slot_tok].reshape(n_blocks, MOE_BLOCK, D)

    def expert_block(args):
        xb, e = args
        return (jax.nn.silu(xb @ w_gate[e]) * (xb @ w_up[e])) @ w_down[e]

    ys = lax.map(expert_block, (xs, blk_e)).reshape(P, D)
    ys = ys * slot_w[:, None].astype(ys.dtype)
    out = jax.ops.segment_sum(ys, slot_tok, num_segments=T + 1)[:T]
    return out.reshape(B, S, D)


def setup_inputs(seed: int = 0) -> dict:
    key = jax.random.key(seed)
    ks = jax.random.split(key, 24)
    L, D = DEPTH, D_MODEL

    def nrm(k, shape, scale):
        return jax.random.normal(k, shape, jnp.float32) * scale

    return {
        "x": nrm(ks[0], (BATCH, SEQ, D), 1.0),
        "norm_mix_w": 1.0 + nrm(ks[1], (L, D), 0.02),
        "w_in": nrm(ks[2], (L, D, D_IN), D ** -0.5),
        "ret_gn_w": 1.0 + nrm(ks[3], (L, RET_V), 0.02),
        "w_ret_branch": nrm(ks[4], (L, RET_V, D), RET_V ** -0.5),
        "mlstm_conv_w": nrm(ks[5], (L, CONV_WIDTH, 1, 2 * M_QK), CONV_WIDTH ** -0.5),
        "mlstm_conv_b": nrm(ks[6], (L, 2 * M_QK), 0.01),
        "b_igate": nrm(ks[7], (L, MLSTM_HEADS), 0.1),
        "b_fgate": jnp.linspace(3.0, 6.0, MLSTM_HEADS, dtype=jnp.float32)[None, :] + nrm(ks[8], (L, MLSTM_HEADS), 0.1),
        "mlstm_gn_w": 1.0 + nrm(ks[9], (L, M_V), 0.02),
        "w_mlstm_branch": nrm(ks[10], (L, M_V, D), M_V ** -0.5),
        "w_out": nrm(ks[11], (L, D, D), D ** -0.5),
        "norm_ffn_w": 1.0 + nrm(ks[12], (L, D), 0.02),
        "w_group": nrm(ks[13], (L, D, N_GROUPS), D ** -0.5),
        "b_group": nrm(ks[14], (L, N_GROUPS), 0.01),
        "w_expert_router": nrm(ks[15], (L, D, N_EXPERTS), D ** -0.5),
        "b_expert_router": nrm(ks[16], (L, N_EXPERTS), 0.01),
        "w_gate": nrm(ks[17], (L, N_EXPERTS, D, D_EXPERT), D ** -0.5),
        "w_up": nrm(ks[18], (L, N_EXPERTS, D, D_EXPERT), D ** -0.5),
        "w_down": nrm(ks[19], (L, N_EXPERTS, D_EXPERT, D), D_EXPERT ** -0.5),
        "norm_final_w": 1.0 + nrm(ks[20], (D,), 0.02),
    }


def reference(x, norm_mix_w, w_in, ret_gn_w, w_ret_branch, mlstm_conv_w, mlstm_conv_b, b_igate, b_fgate,
              mlstm_gn_w, w_mlstm_branch, w_out, norm_ffn_w, w_group, b_group, w_expert_router,
              b_expert_router, w_gate, w_up, w_down, norm_final_w):
    positions = jnp.arange(x.shape[1], dtype=jnp.int32)
    for layer in range(DEPTH):
        h = rms_norm(x, norm_mix_w[layer])
        x = x + hybrid_mixer(h, positions, w_in[layer], ret_gn_w[layer], w_ret_branch[layer], mlstm_conv_w[layer],
                             mlstm_conv_b[layer], b_igate[layer], b_fgate[layer], mlstm_gn_w[layer],
                             w_mlstm_branch[layer], w_out[layer])
        h = rms_norm(x, norm_ffn_w[layer])
        x = x + hierarchical_moe(h, w_group[layer], b_group[layer], w_expert_router[layer], b_expert_router[layer],
                                 w_gate[layer], w_up[layer], w_down[layer])
    return rms_norm(x, norm_final_w)
```

```cpp
#include <hip/hip_runtime.h>
#include <hip/hip_cooperative_groups.h>
#include <cstdio>
#include <cstdint>
namespace cg = cooperative_groups;
namespace pg8 {
#define PG8_LAS __attribute__((address_space(3)))
typedef unsigned short bf16_t;
typedef short bf16x8 __attribute__((ext_vector_type(8)));
typedef float f32x4 __attribute__((ext_vector_type(4)));
typedef unsigned u32x4 __attribute__((ext_vector_type(4)));
constexpr int BM = 256, BK = 64, HALF = 128, HTB = HALF * BK * 2  , STAGE_BYTES = 8 * HTB, NXCD = 8, WGM = 8;

__host__ __device__ __forceinline__ int lds_byte(int r, int c) { const int st = (r >> 4) * 2 + (c >> 5), rr = r & 15, cc = c & 31, ob = rr * 64 + cc * 2; return st * 1024 + (ob ^ (((ob >> 9) & 1) << 5)); }
__host__ __device__ __forceinline__ void stage_rc(int b, int& R, int& C) { const int st = b / 1024, sb = b % 1024, swz = sb ^ (((sb >> 9) & 1) << 5); R = (st >> 1) * 16 + swz / 64; C = (st & 1) * 32 + (swz % 64) / 2; }
__host__ __device__ __forceinline__ int perm32(int rho) { const int n = rho >> 4, i = rho & 15; return 8 * (i >> 2) + 4 * n + (i & 3); }

struct Unit { int pm, pn; };
struct Gemm { const bf16_t* A; const bf16_t* Bt; int M, N, K; };

struct StaticOrder {
    int nM, nN, nwg, G, c;
    __host__ __device__ void init(int M, int N, int G_, int c_) { nM = M / BM; nN = N / BM; nwg = nM * nN; G = G_; c = c_; }
    __host__ __device__ bool next(int i, Unit& u) const {
        const long L = (long)i * G + c; if (L >= nwg) return false;
        int wgid = (int)L; { const int q = nwg / NXCD, r = nwg % NXCD, xcd = wgid % NXCD, off = wgid / NXCD; wgid = (xcd < r ? xcd * (q + 1) : r * (q + 1) + (xcd - r) * q) + off; }
        const int nig = WGM * nN, gid = wgid / nig, fm = gid * WGM, gsz = (nM - fm) < WGM ? (nM - fm) : WGM;
        u.pm = fm + ((wgid % nig) % gsz); u.pn = (wgid % nig) / gsz; return true;
    }
    __device__ __forceinline__ void a_ready(const Unit&) const {}
    __device__ __forceinline__ void done(const Unit&) const {}
};

__device__ __forceinline__ unsigned cvt_pk_bf16(float lo, float hi) { unsigned r; asm volatile("v_cvt_pk_bf16_f32 %0, %1, %2" : "=v"(r) : "v"(lo), "v"(hi)); return r; }
typedef float f32x2 __attribute__((ext_vector_type(2)));
__device__ __forceinline__ f32x2 gelu_pk(f32x2 v) {
    const f32x2 av = __builtin_elementwise_abs(v), d = av * 0.2316418882f + 1.0f;
    f32x2 t; t.x = __builtin_amdgcn_rcpf(d.x); t.y = __builtin_amdgcn_rcpf(d.y);
    f32x2 q = t * 0.5307027145f + (-0.7265760135f); q = q * t + 0.7107068705f; q = q * t + (-0.142248368f); q = q * t + 0.127414796f; q = q * t;
    const f32x2 s = (v * v) * (-0.72134752044f);
    f32x2 e; e.x = __builtin_amdgcn_exp2f(s.x); e.y = __builtin_amdgcn_exp2f(s.y);
    const f32x2 m = v * (q * e), r = v - m;
    f32x2 o; o.x = v.x < 0.f ? m.x : r.x; o.y = v.y < 0.f ? m.y : r.y; return o;
}

template <int ACT  > struct EpiBf16 {
    static constexpr bool PERM = true, AFTER_DRAIN = false; static_assert(ACT == 0 || ACT == 1, "EpiBf16: ACT is 0 (none) or 1 (gelu_pk)");
    bf16_t* O; int ldc; const float* bias; int split_cols; size_t split_stride; float scale0;
    __device__ __forceinline__ void operator()(const f32x4 (&acc)[2][2][4][2], const Unit& u, int wr, int wc, int fr, int fq) const {
        const int row0 = u.pm * BM + wr * 64 + fr; int colt = u.pn * BM; bf16_t* base = O;
        float sc = 1.f; if (split_cols) { const int t = colt / split_cols; base += (size_t)t * split_stride; colt -= t * split_cols; if (t == 0) sc = scale0; }
        const int col0 = colt + wc * 32 + 8 * fq, bcol0 = u.pn * BM + wc * 32 + 8 * fq;
        f32x4 bv[2][2];
#pragma unroll
        for (int bj = 0; bj < 2; ++bj)
#pragma unroll
            for (int n = 0; n < 2; ++n) bv[bj][n] = bias ? *(const f32x4*)(bias + bcol0 + bj * HALF + 4 * n) : (f32x4){0.f, 0.f, 0.f, 0.f};
#pragma unroll
        for (int ai = 0; ai < 2; ++ai)
#pragma unroll
            for (int m = 0; m < 4; ++m) { bf16_t* rowp = base + (size_t)(row0 + ai * HALF + m * 16) * ldc + col0;
#pragma unroll
                for (int bj = 0; bj < 2; ++bj) { f32x4 v0 = acc[ai][bj][m][0] + bv[bj][0], v1 = acc[ai][bj][m][1] + bv[bj][1];
                    if (ACT == 1) { f32x2 a = gelu_pk((f32x2){v0[0], v0[1]}), b = gelu_pk((f32x2){v0[2], v0[3]}), c = gelu_pk((f32x2){v1[0], v1[1]}), d = gelu_pk((f32x2){v1[2], v1[3]});
                        v0 = (f32x4){a.x, a.y, b.x, b.y}; v1 = (f32x4){c.x, c.y, d.x, d.y}; }
                    v0 = v0 * sc; v1 = v1 * sc; u32x4 w; w.x = cvt_pk_bf16(v0[0], v0[1]); w.y = cvt_pk_bf16(v0[2], v0[3]); w.z = cvt_pk_bf16(v1[0], v1[1]); w.w = cvt_pk_bf16(v1[2], v1[3]);
                    *(u32x4*)(rowp + bj * HALF) = w; } }
    }
};
template <class Epi, class Sched, bool ALIGN_EPI = false, bool SP2 = false>
__device__ __forceinline__ void gemm_phase(PG8_LAS unsigned char* lds, const Gemm g, const Sched& S, const Epi& E) {
    const int tid = threadIdx.x, wid = __builtin_amdgcn_readfirstlane(tid >> 6), lane = tid & 63, wr = wid >> 2, wc = wid & 3, fr = lane & 15, fq = lane >> 4;
    const int K = g.K, nt = K / BK;
    unsigned voffA[2], voffB[2];
#pragma unroll
    for (int i = 0; i < 2; ++i) { int R, C; stage_rc(tid * 16 + i * 8192, R, C); const int Rb = Epi::PERM ? ((R & ~31) + perm32(R & 31)) : R;
        voffA[i] = (unsigned)(R * K + C) * 2u; voffB[i] = (unsigned)(Rb * K + C) * 2u; }
    const size_t kstep = (size_t)(BK * 2);
    const size_t hstep = (size_t)HALF * K * 2;
    const size_t tstep = 2 * hstep;
    const unsigned ldsw = (unsigned)wid * 1024u;
    const int aoff = lds_byte(wr * 64 + fr, fq * 8), boff = lds_byte(wc * 32 + fr, fq * 8);
#define PG8_SA(b, h) (((b) * 2 + (h)) * HTB)
#define PG8_SB(b, h) ((4 + (b) * 2 + (h)) * HTB)
#define PG8_STAGE(bufoff, gbase, voff) do { _Pragma("unroll") for (int _i = 0; _i < 2; ++_i) \
        __builtin_amdgcn_global_load_lds((const unsigned*)((const char*)(gbase) + (voff)[_i]), (PG8_LAS unsigned*)(lds + (bufoff) + ldsw + _i * 8192), 16, 0, 0); } while (0)
#define PG8_LDA(dst, b, h) do { _Pragma("unroll") for (int m = 0; m < 4; ++m) _Pragma("unroll") for (int k = 0; k < 2; ++k) dst[m][k] = *(const PG8_LAS bf16x8*)(lds + PG8_SA(b, h) + aoff + m * 2048 + k * 1024); } while (0)
#define PG8_LDB(dst, b, h) do { _Pragma("unroll") for (int n = 0; n < 2; ++n) _Pragma("unroll") for (int k = 0; k < 2; ++k) dst[n][k] = *(const PG8_LAS bf16x8*)(lds + PG8_SB(b, h) + boff + n * 2048 + k * 1024); } while (0)
#define PG8_MMA(ai, bj, At, Bt) do { __builtin_amdgcn_s_setprio(1); _Pragma("unroll") for (int m = 0; m < 4; ++m) _Pragma("unroll") for (int n = 0; n < 2; ++n) _Pragma("unroll") for (int k = 0; k < 2; ++k) \
        acc[ai][bj][m][n] = __builtin_amdgcn_mfma_f32_16x16x32_bf16(Bt[n][k], At[m][k], acc[ai][bj][m][n], 0, 0, 0); __builtin_amdgcn_s_setprio(0); } while (0)
#define PG8_WAIT_V(n) asm volatile("s_waitcnt vmcnt(" #n ")" ::: "memory")
#define PG8_WAIT_L(n) asm volatile("s_waitcnt lgkmcnt(" #n ")" ::: "memory")
#define PG8_BAR __builtin_amdgcn_s_barrier()
#define PG8_SCHED __builtin_amdgcn_sched_barrier(0)
    Unit cur, nxt; int ui = 0;
    if (!S.next(0, cur)) return;
    f32x4 acc[2][2][4][2];
#pragma unroll
    for (int a = 0; a < 2; ++a)
#pragma unroll
        for (int b = 0; b < 2; ++b)
#pragma unroll
            for (int m = 0; m < 4; ++m)
#pragma unroll
                for (int n = 0; n < 2; ++n) acc[a][b][m][n] = (f32x4){0.f, 0.f, 0.f, 0.f};
    bf16x8 At[4][2], B0[2][2], B1[2][2];
    const char* cA = (const char*)g.A + (size_t)cur.pm * tstep; const char* cB = (const char*)g.Bt + (size_t)cur.pn * tstep;
    S.a_ready(cur);
    if constexpr (SP2) {
        PG8_STAGE(PG8_SB(0, 0), cB, voffB); PG8_STAGE(PG8_SB(0, 1), cB + hstep, voffB); PG8_STAGE(PG8_SA(0, 0), cA, voffA); PG8_STAGE(PG8_SA(0, 1), cA + hstep, voffA);
        if (wr == 1) PG8_BAR;
        PG8_WAIT_V(2); PG8_BAR;
        PG8_STAGE(PG8_SB(1, 0), cB + kstep, voffB); PG8_STAGE(PG8_SA(1, 0), cA + kstep, voffA); PG8_STAGE(PG8_SB(1, 1), cB + hstep + kstep, voffB);
        PG8_WAIT_V(6); PG8_BAR;
    } else {
        PG8_STAGE(PG8_SB(0, 0), cB, voffB); PG8_STAGE(PG8_SA(0, 0), cA, voffA); PG8_STAGE(PG8_SB(0, 1), cB + hstep, voffB); PG8_STAGE(PG8_SA(0, 1), cA + hstep, voffA);
        if (wr == 1) PG8_BAR;
        PG8_WAIT_V(4); PG8_BAR;
        PG8_STAGE(PG8_SB(1, 0), cB + kstep, voffB); PG8_STAGE(PG8_SA(1, 0), cA + kstep, voffA); PG8_STAGE(PG8_SB(1, 1), cB + hstep + kstep, voffB);
        PG8_WAIT_V(6); PG8_BAR;
    }
    for (;;) {
        const bool has_next = S.next(ui + 1, nxt);
        const char* nA = has_next ? (const char*)g.A + (size_t)nxt.pm * tstep : cA; const char* nB = has_next ? (const char*)g.Bt + (size_t)nxt.pn * tstep : cB;
        for (int t = 0; t < nt; t += 2) {
            const bool last = (t == nt - 2);
            const char* a1 = cA + (size_t)(t + 1) * kstep;
            const char* a2 = last ? nA : cA + (size_t)(t + 2) * kstep; const char* b2 = last ? nB : cB + (size_t)(t + 2) * kstep;
            const char* a3 = a2 + kstep; const char* b3 = b2 + kstep;
            if (last && has_next) S.a_ready(nxt);
            if constexpr (SP2) {
            PG8_LDB(B0, 0, 0); PG8_LDB(B1, 0, 1); PG8_SCHED; PG8_LDA(At, 0, 0); PG8_STAGE(PG8_SA(1, 1), a1 + hstep, voffA);
            PG8_WAIT_V(8); PG8_WAIT_L(0); PG8_BAR; PG8_MMA(0, 0, At, B0); PG8_MMA(0, 1, At, B1); PG8_BAR; PG8_SCHED;
            PG8_LDA(At, 0, 1); PG8_STAGE(PG8_SB(0, 0), b2, voffB); PG8_STAGE(PG8_SB(0, 1), b2 + hstep, voffB); PG8_STAGE(PG8_SA(0, 0), a2, voffA);
            PG8_WAIT_V(8); PG8_WAIT_L(0); PG8_BAR; PG8_MMA(1, 0, At, B0); PG8_MMA(1, 1, At, B1); PG8_BAR; PG8_SCHED;
            PG8_LDB(B0, 1, 0); PG8_LDB(B1, 1, 1); PG8_SCHED; PG8_LDA(At, 1, 0); PG8_STAGE(PG8_SA(0, 1), a2 + hstep, voffA);
            PG8_WAIT_V(8); PG8_WAIT_L(0); PG8_BAR; PG8_MMA(0, 0, At, B0); PG8_MMA(0, 1, At, B1); PG8_BAR; PG8_SCHED;
            PG8_LDA(At, 1, 1); PG8_STAGE(PG8_SB(1, 0), b3, voffB); PG8_STAGE(PG8_SB(1, 1), b3 + hstep, voffB); PG8_STAGE(PG8_SA(1, 0), a3, voffA);
            PG8_WAIT_V(8); PG8_WAIT_L(0); PG8_BAR; PG8_MMA(1, 0, At, B0); PG8_MMA(1, 1, At, B1); PG8_BAR; PG8_SCHED;
            } else {
            PG8_LDB(B0, 0, 0); PG8_SCHED; PG8_LDA(At, 0, 0); PG8_STAGE(PG8_SA(1, 1), a1 + hstep, voffA);
            PG8_WAIT_L(8); PG8_BAR; PG8_WAIT_L(0); PG8_MMA(0, 0, At, B0); PG8_BAR; PG8_SCHED;
            PG8_LDB(B1, 0, 1); PG8_STAGE(PG8_SB(0, 0), b2, voffB);
            PG8_BAR; PG8_WAIT_L(0); PG8_MMA(0, 1, At, B1); PG8_BAR;
            PG8_LDA(At, 0, 1); PG8_STAGE(PG8_SA(0, 0), a2, voffA);
            PG8_BAR; PG8_WAIT_L(0); PG8_MMA(1, 0, At, B0); PG8_BAR; PG8_SCHED;
            PG8_STAGE(PG8_SB(0, 1), b2 + hstep, voffB);
            PG8_WAIT_V(6); PG8_BAR; PG8_MMA(1, 1, At, B1); PG8_BAR;
            PG8_LDB(B0, 1, 0); PG8_SCHED; PG8_LDA(At, 1, 0); PG8_STAGE(PG8_SA(0, 1), a2 + hstep, voffA);
            PG8_WAIT_L(8); PG8_BAR; PG8_WAIT_L(0); PG8_MMA(0, 0, At, B0); PG8_BAR; PG8_SCHED;
            PG8_LDB(B1, 1, 1); PG8_STAGE(PG8_SB(1, 0), b3, voffB);
            PG8_BAR; PG8_WAIT_L(0); PG8_MMA(0, 1, At, B1); PG8_BAR;
            PG8_LDA(At, 1, 1); PG8_STAGE(PG8_SA(1, 0), a3, voffA);
            PG8_BAR; PG8_WAIT_L(0); PG8_MMA(1, 0, At, B0); PG8_BAR; PG8_SCHED;
            PG8_STAGE(PG8_SB(1, 1), b3 + hstep, voffB);
            PG8_WAIT_V(6); PG8_BAR; PG8_MMA(1, 1, At, B1); PG8_BAR;
            }
        }
        if constexpr (ALIGN_EPI) { if (wr == 0) PG8_BAR; }
        if constexpr (!Epi::AFTER_DRAIN) { E(acc, cur, wr, wc, fr, fq); S.done(cur); }
        if (!has_next) break;
#pragma unroll
        for (int a = 0; a < 2; ++a)
#pragma unroll
            for (int b = 0; b < 2; ++b)
#pragma unroll
                for (int m = 0; m < 4; ++m)
#pragma unroll
                    for (int n = 0; n < 2; ++n) acc[a][b][m][n] = (f32x4){0.f, 0.f, 0.f, 0.f};
        cur = nxt; cA = nA; cB = nB; ++ui;
        if constexpr (ALIGN_EPI) { if (wr == 1) PG8_BAR; }
    }
    PG8_WAIT_V(0);
    if constexpr (!ALIGN_EPI) { if (wr == 0) PG8_BAR; }
    PG8_BAR;
    if constexpr (Epi::AFTER_DRAIN) { E.fused(acc, cur, wr, wc, fr, fq, lds, wid, lane); S.done(cur); }
#undef PG8_SA
#undef PG8_SB
#undef PG8_STAGE
#undef PG8_LDA
#undef PG8_LDB
#undef PG8_MMA
#undef PG8_WAIT_V
#undef PG8_WAIT_L
#undef PG8_BAR
#undef PG8_SCHED
}
}

#define GAS __attribute__((address_space(1)))
#define LAS __attribute__((address_space(3)))
typedef unsigned short bf16;
typedef unsigned U4 __attribute__((ext_vector_type(4)));
typedef unsigned U2 __attribute__((ext_vector_type(2)));
typedef float F4 __attribute__((ext_vector_type(4)));
typedef float F2 __attribute__((ext_vector_type(2)));
typedef float F16 __attribute__((ext_vector_type(16)));
typedef short B8 __attribute__((ext_vector_type(8)));
typedef short S4 __attribute__((ext_vector_type(4)));
typedef __bf16 bf16x2_t __attribute__((ext_vector_type(2)));

constexpr int NWAVES = 8, NTHR = 512;
constexpr int DM = 1024, BATCH = 8, SEQ = 8192, NTOK = BATCH * SEQ;
constexpr int DIN = 8200, NPROJ = 8192;
constexpr int CHUNK = 128, NCHUNK = SEQ / CHUNK;
constexpr int NEXP = 32, DEXP = 512;
constexpr int MAXTILES = 544, MAXROWS = MAXTILES * 256;
constexpr float EPS = 1e-6f;
constexpr int LDS_BYTES = 147456;
constexpr int LDS_MISC = 131072;

constexpr size_t MiB = 1u << 20;
constexpr size_t WS_CTL = 0, CTL_ZERO_BYTES = 4096;
constexpr size_t WS_IF = 1 * MiB;
constexpr size_t WS_THR = 3 * MiB;
constexpr size_t WS_CDEC = 4 * MiB;
constexpr size_t WS_ROUT = 4 * MiB + 65536;
constexpr size_t WS_ROPE = 5 * MiB;
constexpr size_t WS_TOK = 9 * MiB;
constexpr size_t WS_WIN = 12 * MiB;
constexpr size_t WS_WRB = 28 * MiB, WS_WMB = 30 * MiB, WS_WOUT = 32 * MiB;
constexpr size_t WS_H = 34 * MiB;
constexpr size_t WS_MQP = 34 * MiB, WS_MKP = 98 * MiB, WS_MERGED = 34 * MiB;
constexpr size_t WS_RQ = 162 * MiB, WS_RK = 226 * MiB, WS_MQ = 290 * MiB, WS_MK = 354 * MiB;
constexpr size_t WS_WGU = 162 * MiB, WS_WD = 226 * MiB, WS_TMP = 258 * MiB;
constexpr size_t WS_RV = 418 * MiB, WS_RG = 546 * MiB, WS_MV = 674 * MiB, WS_MO = 802 * MiB;
constexpr size_t WS_XS = 418 * MiB, WS_HMID = 690 * MiB, WS_Y = 418 * MiB;
constexpr size_t WS_END = 930 * MiB;
constexpr size_t OUT_GR = 0, OUT_GM = 128 * MiB;
static_assert(WS_XS + (size_t)MAXROWS * 1024 * 2 <= WS_HMID && WS_HMID + (size_t)MAXROWS * 512 * 2 <= WS_END, "ws map");

struct TokInfo { int e0, p0, e1, p1; float w0, w1, rstd, pad; };

__device__ __forceinline__ float bflo(unsigned u) { return __uint_as_float(u << 16); }
__device__ __forceinline__ float bfhi(unsigned u) { return __uint_as_float(u & 0xffff0000u); }
__device__ __forceinline__ float bf2f(short s) { return __uint_as_float(((unsigned)(unsigned short)s) << 16); }
__device__ __forceinline__ unsigned cvtpk(float lo, float hi) { F2 v = {lo, hi}; bf16x2_t b = __builtin_convertvector(v, bf16x2_t); return __builtin_bit_cast(unsigned, b); }
__device__ __forceinline__ float wave_sum(float v) {
#pragma unroll
    for (int o = 1; o < 64; o <<= 1) v += __shfl_xor(v, o);
    return v;
}
__device__ __forceinline__ float sigm(float x) { return 1.f / (1.f + __expf(-x)); }
__device__ __forceinline__ float silu(float x) { return x / (1.f + __expf(-x)); }
__device__ __forceinline__ int crow(int r, int hi) { return (r & 3) + 8 * (r >> 2) + 4 * hi; }
#define MFMA32(a, b, c) __builtin_amdgcn_mfma_f32_32x32x16_bf16((a), (b), (c), 0, 0, 0)
typedef short v4i16_t __attribute__((ext_vector_type(4)));
__device__ __forceinline__ S4 trrd(LAS const unsigned char* p) { return __builtin_bit_cast(S4, __builtin_amdgcn_ds_read_tr16_b64_v4i16((LAS v4i16_t*)p)); }
__device__ __forceinline__ unsigned offb(unsigned row, unsigned ch) { return 256u * row + 16u * (ch ^ (((row & 3) << 2) | ((row >> 2) & 3))); }
__device__ __forceinline__ unsigned offv(unsigned row, unsigned ch) { return 128u * row + 16u * (ch ^ (((row >> 1) & 1) << 2)); }

namespace pg8 {
struct EpiProj {
    static constexpr bool PERM = true, AFTER_DRAIN = false;
    unsigned char* ws; unsigned char* ob;
    __device__ __forceinline__ void operator()(const f32x4 (&acc)[2][2][4][2], const Unit& u, int wr, int wc, int fr, int fq) const {
        const int pn = u.pn; bf16_t* base; int ld, ct;
        if (pn < 2)       { base = (bf16_t*)(ws + WS_RQ); ld = 512;  ct = pn; }
        else if (pn < 4)  { base = (bf16_t*)(ws + WS_RK); ld = 512;  ct = pn - 2; }
        else if (pn < 8)  { base = (bf16_t*)(ws + WS_RV); ld = 1024; ct = pn - 4; }
        else if (pn < 12) { base = (bf16_t*)(ws + WS_RG); ld = 1024; ct = pn - 8; }
        else if (pn < 14) { base = (bf16_t*)(ws + WS_MQ); ld = 512;  ct = pn - 12; }
        else if (pn < 16) { base = (bf16_t*)(ws + WS_MK); ld = 512;  ct = pn - 14; }
        else if (pn < 20) { base = (bf16_t*)(ws + WS_MV); ld = 1024; ct = pn - 16; }
        else if (pn < 24) { base = (bf16_t*)(ws + WS_MO); ld = 1024; ct = pn - 20; }
        else if (pn < 28) { base = (bf16_t*)(ob + OUT_GR); ld = 1024; ct = pn - 24; }
        else              { base = (bf16_t*)(ob + OUT_GM); ld = 1024; ct = pn - 28; }
        const int row0 = u.pm * BM + wr * 64 + fr, col0 = ct * BM + wc * 32 + 8 * fq;
#pragma unroll
        for (int ai = 0; ai < 2; ++ai)
#pragma unroll
            for (int m = 0; m < 4; ++m) { bf16_t* rowp = base + (size_t)(row0 + ai * HALF + m * 16) * ld + col0;
#pragma unroll
                for (int bj = 0; bj < 2; ++bj) { const f32x4 v0 = acc[ai][bj][m][0], v1 = acc[ai][bj][m][1];
                    u32x4 w; w.x = cvt_pk_bf16(v0[0], v0[1]); w.y = cvt_pk_bf16(v0[2], v0[3]); w.z = cvt_pk_bf16(v1[0], v1[1]); w.w = cvt_pk_bf16(v1[2], v1[3]);
                    *(u32x4*)(rowp + bj * HALF) = w; } }
    }
};
template <int MODE> struct EpiGate {
    static constexpr bool PERM = true, AFTER_DRAIN = false;
    const bf16_t* G; const bf16_t* TI; bf16_t* O;
    __device__ __forceinline__ void operator()(const f32x4 (&acc)[2][2][4][2], const Unit& u, int wr, int wc, int fr, int fq) const {
        const int row0 = u.pm * BM + wr * 64 + fr, col0 = u.pn * BM + wc * 32 + 8 * fq;
#pragma unroll
        for (int ai = 0; ai < 2; ++ai)
#pragma unroll
            for (int m = 0; m < 4; ++m) { const size_t ro = (size_t)(row0 + ai * HALF + m * 16) * 1024 + col0;
#pragma unroll
                for (int bj = 0; bj < 2; ++bj) { const f32x4 v0 = acc[ai][bj][m][0], v1 = acc[ai][bj][m][1];
                    const u32x4 g = *(const u32x4*)(G + ro + bj * HALF);
                    float r[8];
                    r[0] = v0[0] * sigm(bflo(g.x)); r[1] = v0[1] * sigm(bfhi(g.x)); r[2] = v0[2] * sigm(bflo(g.y)); r[3] = v0[3] * sigm(bfhi(g.y));
                    r[4] = v1[0] * sigm(bflo(g.z)); r[5] = v1[1] * sigm(bfhi(g.z)); r[6] = v1[2] * sigm(bflo(g.w)); r[7] = v1[3] * sigm(bfhi(g.w));
                    if (MODE == 1) { const u32x4 t = *(const u32x4*)(TI + ro + bj * HALF);
                        r[0] += bflo(t.x); r[1] += bfhi(t.x); r[2] += bflo(t.y); r[3] += bfhi(t.y); r[4] += bflo(t.z); r[5] += bfhi(t.z); r[6] += bflo(t.w); r[7] += bfhi(t.w); }
                    u32x4 w; w.x = cvt_pk_bf16(r[0], r[1]); w.y = cvt_pk_bf16(r[2], r[3]); w.z = cvt_pk_bf16(r[4], r[5]); w.w = cvt_pk_bf16(r[6], r[7]);
                    *(u32x4*)(O + ro + bj * HALF) = w; } }
    }
};
struct EpiX1 {
    static constexpr bool PERM = true, AFTER_DRAIN = false;
    const float* X; float* O;
    __device__ __forceinline__ void operator()(const f32x4 (&acc)[2][2][4][2], const Unit& u, int wr, int wc, int fr, int fq) const {
        const int row0 = u.pm * BM + wr * 64 + fr, col0 = u.pn * BM + wc * 32 + 8 * fq;
#pragma unroll
        for (int ai = 0; ai < 2; ++ai)
#pragma unroll
            for (int m = 0; m < 4; ++m) { const size_t ro = (size_t)(row0 + ai * HALF + m * 16) * 1024 + col0;
#pragma unroll
                for (int bj = 0; bj < 2; ++bj) {
                    const f32x4 a = *(const f32x4*)(X + ro + bj * HALF), b = *(const f32x4*)(X + ro + bj * HALF + 4);
                    *(f32x4*)(O + ro + bj * HALF) = a + acc[ai][bj][m][0]; *(f32x4*)(O + ro + bj * HALF + 4) = b + acc[ai][bj][m][1]; } }
    }
};
struct EpiSwiglu {
    static constexpr bool PERM = true, AFTER_DRAIN = false;
    bf16_t* O;
    __device__ __forceinline__ void operator()(const f32x4 (&acc)[2][2][4][2], const Unit& u, int wr, int wc, int fr, int fq) const {
        const int row0 = u.pm * BM + wr * 64 + fr, col0 = (u.pn & 3) * HALF + wc * 32 + 8 * fq;
#pragma unroll
        for (int ai = 0; ai < 2; ++ai)
#pragma unroll
            for (int m = 0; m < 4; ++m) { bf16_t* rowp = O + (size_t)(row0 + ai * HALF + m * 16) * 512 + col0;
                const f32x4 g0 = acc[ai][0][m][0], g1 = acc[ai][0][m][1], u0 = acc[ai][1][m][0], u1 = acc[ai][1][m][1];
                u32x4 w; w.x = cvt_pk_bf16(silu(g0[0]) * u0[0], silu(g0[1]) * u0[1]); w.y = cvt_pk_bf16(silu(g0[2]) * u0[2], silu(g0[3]) * u0[3]);
                w.z = cvt_pk_bf16(silu(g1[0]) * u1[0], silu(g1[1]) * u1[1]); w.w = cvt_pk_bf16(silu(g1[2]) * u1[2], silu(g1[3]) * u1[3]);
                *(u32x4*)rowp = w; }
    }
};
struct EpiY {
    static constexpr bool PERM = true, AFTER_DRAIN = false;
    bf16_t* O;
    __device__ __forceinline__ void operator()(const f32x4 (&acc)[2][2][4][2], const Unit& u, int wr, int wc, int fr, int fq) const {
        const int row0 = u.pm * BM + wr * 64 + fr, col0 = (u.pn & 3) * BM + wc * 32 + 8 * fq;
#pragma unroll
        for (int ai = 0; ai < 2; ++ai)
#pragma unroll
            for (int m = 0; m < 4; ++m) { bf16_t* rowp = O + (size_t)(row0 + ai * HALF + m * 16) * 1024 + col0;
#pragma unroll
                for (int bj = 0; bj < 2; ++bj) { const f32x4 v0 = acc[ai][bj][m][0], v1 = acc[ai][bj][m][1];
                    u32x4 w; w.x = cvt_pk_bf16(v0[0], v0[1]); w.y = cvt_pk_bf16(v0[2], v0[3]); w.z = cvt_pk_bf16(v1[0], v1[1]); w.w = cvt_pk_bf16(v1[2], v1[3]);
                    *(u32x4*)(rowp + bj * HALF) = w; } }
    }
};
struct GroupedOrder {
    int ntiles, G, c; const PG8_LAS unsigned char* t2e;
    __device__ __forceinline__ bool next(int i, Unit& u) const {
        const int L = i * G + c; if (L >= ntiles * 4) return false;
        const int rt = L >> 2; u.pm = rt; u.pn = __builtin_amdgcn_readfirstlane((int)t2e[rt]) * 4 + (L & 3); return true;
    }
    __device__ __forceinline__ void a_ready(const Unit&) const {}
    __device__ __forceinline__ void done(const Unit&) const {}
};
}

struct Ctx { LAS unsigned char* lds; int tid, lane, wave, vcu, G; };

__device__ __forceinline__ void transpose_item(const float* W, int ld, int k0, int n0, bf16* WT, int K, int drow0, LAS float* scr, int lane) {
#pragma unroll 8
    for (int i = 0; i < 32; ++i) { const int kk = 2 * i + (lane >> 5); scr[kk * 33 + (lane & 31)] = W[(size_t)(k0 + kk) * ld + n0 + (lane & 31)]; }
    asm volatile("s_waitcnt lgkmcnt(0)" ::: "memory");
    const int c = lane & 7;
#pragma unroll
    for (int j = 0; j < 4; ++j) { const int n = (lane >> 3) + 8 * j; const LAS float* s = scr + (8 * c) * 33 + n;
        U4 o; o.x = cvtpk(s[0 * 33], s[1 * 33]); o.y = cvtpk(s[2 * 33], s[3 * 33]); o.z = cvtpk(s[4 * 33], s[5 * 33]); o.w = cvtpk(s[6 * 33], s[7 * 33]);
        *(U4*)(WT + (size_t)(drow0 + n) * K + k0 + 8 * c) = o; }
    asm volatile("s_waitcnt lgkmcnt(0)" ::: "memory");
}

__device__ __forceinline__ void phase0(const Ctx& C, const float* const* in, unsigned char* ws) {
    const float* x = in[0]; const float* nw = in[1]; const float* w_in = in[2];
    LAS float* scr = (LAS float*)(C.lds + C.wave * 8448);
    LAS float* wif = (LAS float*)(C.lds + 98304);
    LAS double* invf = (LAS double*)(C.lds + 98304 + 32768);
    for (int i = C.tid; i < 8192; i += NTHR) wif[i] = w_in[(size_t)(i >> 3) * DIN + 6144 + (i & 7)];
    if (C.tid < 64) { double r = 1.0; for (int j = 0; j < C.tid; ++j) r *= 0.8659643233600653; invf[C.tid] = r; }
    __syncthreads();
    const int gw = C.vcu * NWAVES + C.wave, NGW = C.G * NWAVES;
    {
        bf16* H = (bf16*)(ws + WS_H); float* IFP = (float*)(ws + WS_IF);
        F4 wv[4];
#pragma unroll
        for (int j = 0; j < 4; ++j) wv[j] = *(const F4*)(nw + 4 * C.lane + 256 * j);
        for (int m = gw; m < NTOK; m += NGW) {
            const F4* xr = (const F4*)(x + (size_t)m * DM) + C.lane;
            F4 v[4]; float s = 0.f;
#pragma unroll
            for (int j = 0; j < 4; ++j) { v[j] = xr[64 * j]; s += (v[j].x * v[j].x + v[j].y * v[j].y) + (v[j].z * v[j].z + v[j].w * v[j].w); }
            const float rstd = rsqrtf(wave_sum(s) * (1.f / DM) + EPS);
            float g[8];
#pragma unroll
            for (int c = 0; c < 8; ++c) g[c] = 0.f;
            unsigned long long* o8 = (unsigned long long*)(H + (size_t)m * DM) + C.lane;
#pragma unroll
            for (int j = 0; j < 4; ++j) { v[j] = v[j] * rstd * wv[j];
                o8[64 * j] = (unsigned long long)cvtpk(v[j].x, v[j].y) | ((unsigned long long)cvtpk(v[j].z, v[j].w) << 32);
#pragma unroll
                for (int i = 0; i < 4; ++i) { const LAS F4* wp = (const LAS F4*)(wif + (4 * C.lane + 256 * j + i) * 8); const F4 wa = wp[0], wb = wp[1]; const float hv = v[j][i];
                    g[0] += hv * wa.x; g[1] += hv * wa.y; g[2] += hv * wa.z; g[3] += hv * wa.w; g[4] += hv * wb.x; g[5] += hv * wb.y; g[6] += hv * wb.z; g[7] += hv * wb.w; } }
#pragma unroll
            for (int c = 0; c < 8; ++c) g[c] = wave_sum(g[c]);
            if (C.lane == 0) { F4* op = (F4*)(IFP + (size_t)m * 8); op[0] = (F4){g[0], g[1], g[2], g[3]}; op[1] = (F4){g[4], g[5], g[6], g[7]}; }
        }
    }
    for (int it = gw; it < 4096 + 3 * 512; it += NGW) {
        if (it < 4096) { const int kb = it >> 8, nb = it & 255; transpose_item(w_in, DIN, kb * 64, nb * 32 + (nb >= 192 ? 8 : 0), (bf16*)(ws + WS_WIN), 1024, nb * 32, scr, C.lane); }
        else { int r = it - 4096; const int mth = r >> 9; r &= 511; const int kb = r >> 5, nb = r & 31;
            const float* W = mth == 0 ? in[4] : (mth == 1 ? in[10] : in[11]); bf16* dst = (bf16*)(ws + (mth == 0 ? WS_WRB : (mth == 1 ? WS_WMB : WS_WOUT)));
            transpose_item(W, 1024, kb * 64, nb * 32, dst, 1024, nb * 32, scr, C.lane); }
    }
    { F2* RT = (F2*)(ws + WS_ROPE);
        for (int idx = C.vcu * NTHR + C.tid; idx < SEQ * 64; idx += C.G * NTHR) { const int pos = idx >> 6, j = idx & 63;
            const double rev = (double)pos * invf[j] * 0.15915494309189535; const float fr = (float)(rev - __builtin_floor(rev));
            RT[idx] = (F2){__builtin_amdgcn_cosf(fr), __builtin_amdgcn_sinf(fr)}; } }
    { F4* WR = (F4*)(ws + WS_ROUT); const float* nfw = in[12]; const float* wg = in[13]; const float* we = in[15];
        for (int idx = C.vcu * NTHR + C.tid; idx < 64 * 3 * 64; idx += C.G * NTHR) { const int l = idx & 63, nt = (idx >> 6) % 3, kb = idx / 192; const int n = 16 * nt + (l & 15);
            F4 o;
#pragma unroll
            for (int j = 0; j < 4; ++j) { const int k = 16 * kb + 4 * (l >> 4) + j; float wv = 0.f; if (n < 4) wv = wg[k * 4 + n]; else if (n < 36) wv = we[k * 32 + (n - 4)]; o[j] = wv * nfw[k]; }
            WR[idx] = o; } }
}

__device__ __forceinline__ float wscan_add(float v, int lane) {
#pragma unroll
    for (int o = 1; o < 64; o <<= 1) { const float t = __shfl_up(v, o); if (lane >= o) v += t; }
    return v;
}
__device__ __forceinline__ float wscan_max(float v, int lane) {
#pragma unroll
    for (int o = 1; o < 64; o <<= 1) { const float t = __shfl_up(v, o); if (lane >= o) v = fmaxf(v, t); }
    return v;
}
__device__ __forceinline__ void phase2(const Ctx& C, const float* const* in, unsigned char* ws) {
    const float* convw = in[5]; const float* convb = in[6]; const float* b_i = in[7]; const float* b_f = in[8];
    LAS float* sQ = (LAS float*)(C.lds);
    LAS float* sK = (LAS float*)(C.lds + 2048);
    const float* IFP = (const float*)(ws + WS_IF); float* THR = (float*)(ws + WS_THR); float* CDEC = (float*)(ws + WS_CDEC);
    const F2* RT = (const F2*)(ws + WS_ROPE);
    for (int it = C.vcu; it < BATCH * NCHUNK; it += C.G) {
        const int b = it >> 6, c = it & 63; const size_t t0 = (size_t)b * SEQ + (size_t)c * CHUNK;
        __syncthreads();
        if (C.wave < 4) { const int hd = C.wave, l = C.lane;
            const float i0 = IFP[(t0 + 2 * l) * 8 + hd] + b_i[hd], i1 = IFP[(t0 + 2 * l + 1) * 8 + hd] + b_i[hd];
            const float f0 = IFP[(t0 + 2 * l) * 8 + 4 + hd] + b_f[hd], f1 = IFP[(t0 + 2 * l + 1) * 8 + 4 + hd] + b_f[hd];
            const float lf0 = fminf(f0, 0.f) - log1pf(__expf(-fabsf(f0))), lf1 = fminf(f1, 0.f) - log1pf(__expf(-fabsf(f1)));
            const float s1 = lf0 + lf1, inc = wscan_add(s1, l), ex = inc - s1;
            const float b0 = ex + lf0, b1 = ex + s1;
            const float u0 = i0 - b0, u1 = i1 - b1, p1 = fmaxf(u0, u1);
            const float pin = wscan_max(p1, l); float pex = __shfl_up(pin, 1); if (l == 0) pex = -INFINITY;
            const float pm0 = fmaxf(pex, u0), pm1 = fmaxf(pex, p1);
            sQ[hd * 128 + 2 * l] = __expf(-pm0); sQ[hd * 128 + 2 * l + 1] = __expf(-pm1);
            sK[hd * 128 + 2 * l] = __expf(u0) * 0.08838834764831845f; sK[hd * 128 + 2 * l + 1] = __expf(u1) * 0.08838834764831845f;
            THR[(t0 + 2 * l) * 4 + hd] = __expf(-b0 - pm0); THR[(t0 + 2 * l + 1) * 4 + hd] = __expf(-b1 - pm1);
            if (l == 63) CDEC[(size_t)it * 4 + hd] = __expf(b1);
        }
        __syncthreads();
        for (int u = C.tid; u < 2 * 4096; u += NTHR) {
            const int arr = u >> 12, g = u & 7, row = (u >> 3) & 127, hd = (u >> 10) & 3;
            bf16* base = (bf16*)(ws + (arr ? WS_RK : WS_RQ)) + (t0 + row) * 512 + hd * 128 + 8 * g;
            const U4 a = *(const U4*)base, bb = *(const U4*)(base + 64);
            const float lg = hd == 0 ? -0.04580368961312479f : (hd == 1 ? -0.02272007650008353f : (hd == 2 ? -0.011315313227834146f : -0.005646563141142063f));
            const float sc = arr ? exp2f(-lg * (float)row) * 0.08838834764831845f : exp2f(lg * (float)row);
            const F2* rt = RT + (size_t)(c * CHUNK + row) * 64 + 8 * g;
            float x1[8], x2[8], y1[8], y2[8];
            x1[0] = bflo(a.x); x1[1] = bfhi(a.x); x1[2] = bflo(a.y); x1[3] = bfhi(a.y); x1[4] = bflo(a.z); x1[5] = bfhi(a.z); x1[6] = bflo(a.w); x1[7] = bfhi(a.w);
            x2[0] = bflo(bb.x); x2[1] = bfhi(bb.x); x2[2] = bflo(bb.y); x2[3] = bfhi(bb.y); x2[4] = bflo(bb.z); x2[5] = bfhi(bb.z); x2[6] = bflo(bb.w); x2[7] = bfhi(bb.w);
#pragma unroll
            for (int i = 0; i < 8; ++i) { const F2 cs = rt[i]; y1[i] = (x1[i] * cs.x - x2[i] * cs.y) * sc; y2[i] = (x2[i] * cs.x + x1[i] * cs.y) * sc; }
            U4 o1, o2; o1.x = cvtpk(y1[0], y1[1]); o1.y = cvtpk(y1[2], y1[3]); o1.z = cvtpk(y1[4], y1[5]); o1.w = cvtpk(y1[6], y1[7]);
            o2.x = cvtpk(y2[0], y2[1]); o2.y = cvtpk(y2[2], y2[3]); o2.z = cvtpk(y2[4], y2[5]); o2.w = cvtpk(y2[6], y2[7]);
            *(U4*)base = o1; *(U4*)(base + 64) = o2;
        }
        for (int u = C.tid; u < 2 * 8192; u += NTHR) {
            const int arr = u >> 13, g = u & 63, row = (u >> 6) & 127, hd = g >> 4;
            const bf16* src = (const bf16*)(ws + (arr ? WS_MK : WS_MQ)) + (t0 + row) * 512 + 8 * g;
            const int chn = arr * 512 + 8 * g;
            float y[8];
            { const F4 b0 = *(const F4*)(convb + chn), b1 = *(const F4*)(convb + chn + 4); y[0] = b0.x; y[1] = b0.y; y[2] = b0.z; y[3] = b0.w; y[4] = b1.x; y[5] = b1.y; y[6] = b1.z; y[7] = b1.w; }
#pragma unroll
            for (int w = 0; w < 4; ++w) { const int back = 3 - w;
                if (c * CHUNK + row - back >= 0) { const U4 a = *(const U4*)(src - (size_t)back * 512);
                    const F4 w0 = *(const F4*)(convw + w * 1024 + chn), w1 = *(const F4*)(convw + w * 1024 + chn + 4);
                    y[0] += bflo(a.x) * w0.x; y[1] += bfhi(a.x) * w0.y; y[2] += bflo(a.y) * w0.z; y[3] += bfhi(a.y) * w0.w;
                    y[4] += bflo(a.z) * w1.x; y[5] += bfhi(a.z) * w1.y; y[6] += bflo(a.w) * w1.z; y[7] += bfhi(a.w) * w1.w; } }
            const float sc = arr ? sK[hd * 128 + row] : sQ[hd * 128 + row];
#pragma unroll
            for (int i = 0; i < 8; ++i) y[i] = silu(y[i]) * sc;
            U4 o; o.x = cvtpk(y[0], y[1]); o.y = cvtpk(y[2], y[3]); o.z = cvtpk(y[4], y[5]); o.w = cvtpk(y[6], y[7]);
            *(U4*)((bf16*)(ws + (arr ? WS_MKP : WS_MQP)) + (t0 + row) * 512 + 8 * g) = o;
        }
    }
}

template <bool ML>
__device__ __forceinline__ void mixer_item(const Ctx& C, const bf16* Qp, const bf16* Kp, bf16* Vp, const float* thr, const float* cdec, int b, int hd, int sl) {
    LAS unsigned char* lds = C.lds;
    const int tid = C.tid, lane = C.lane, w = C.wave, l31 = lane & 31, hi = lane >> 5;
    const int lt = (w < 4) ? w : 7 - w, et = w >> 2, dt = w & 3;
    const int q_ = (lane & 15) >> 2, p_ = lane & 3, blk = (lane >> 4) & 1;
    constexpr unsigned KOFF = 0, VOFF = 32768, SOFF = 49152, NOFF = 81920;
    const size_t tok0 = (size_t)b * SEQ;
    const float rdec = hd == 0 ? 0.017183023570817902f : (hd == 1 ? 0.1332151628796484f : (hd == 2 ? 0.3664377159220373f : 0.6059370882290803f));
    __syncthreads();
    for (int i = tid; i < (2 * 16384 + 1024) / 16; i += NTHR) *(LAS U4*)(lds + SOFF + 16 * i) = (U4){0u, 0u, 0u, 0u};
    F16 St;
#pragma unroll
    for (int r = 0; r < 16; ++r) St[r] = 0.f;
    U4 kreg[4], vreg[2]; B8 qf[8];
#define MX_LOAD(cc) do { \
        const bf16* kp_ = Kp + (tok0 + (size_t)(cc) * CHUNK) * 512 + hd * 128; \
        _Pragma("unroll") for (int i = 0; i < 4; ++i) { const int q = tid + NTHR * i; kreg[i] = *(const U4*)(kp_ + (size_t)(q >> 4) * 512 + (q & 15) * 8); } \
        const bf16* vp_ = Vp + (tok0 + (size_t)(cc) * CHUNK) * 1024 + hd * 256 + sl * 64; \
        _Pragma("unroll") for (int i = 0; i < 2; ++i) { const int q = tid + NTHR * i; vreg[i] = *(const U4*)(vp_ + (size_t)(q >> 3) * 1024 + (q & 7) * 8); } \
        } while (0)
#define MX_LOADQ(cc) do { \
        const bf16* qp_ = Qp + (tok0 + (size_t)(cc) * CHUNK + 32 * lt + l31) * 512 + hd * 128 + 8 * hi; \
        _Pragma("unroll") for (int s = 0; s < 8; ++s) qf[s] = *(const B8*)(qp_ + 16 * s); } while (0)
#define MX_STORE() do { \
        _Pragma("unroll") for (int i = 0; i < 4; ++i) { const int q = tid + NTHR * i; *(LAS U4*)(lds + KOFF + offb(q >> 4, q & 15)) = kreg[i]; } \
        _Pragma("unroll") for (int i = 0; i < 2; ++i) { const int q = tid + NTHR * i; *(LAS U4*)(lds + VOFF + offv(q >> 3, q & 7)) = vreg[i]; } \
        } while (0)
    MX_LOAD(0);
    MX_LOADQ(0);
    MX_STORE();
    __syncthreads();
    for (int c = 0; c < NCHUNK; ++c) {
        if (c + 1 < NCHUNK) MX_LOAD(c + 1);
        const int cur = c & 1, nxt = cur ^ 1;
        const float decay = ML ? cdec[((size_t)b * NCHUNK + c) * 4 + hd] : rdec;
        F16 o;
#pragma unroll
        for (int r = 0; r < 16; ++r) o[r] = 0.f;
#pragma unroll
        for (int s = 0; s < 8; ++s) { const B8 a = *(const LAS B8*)(lds + SOFF + cur * 16384 + offb(32 * et + l31, 2 * s + hi)); o = MFMA32(a, qf[s], o); }
        float csum = 0.f;
        for (int jt = 0; jt <= lt; ++jt) {
            F16 st;
#pragma unroll
            for (int r = 0; r < 16; ++r) st[r] = 0.f;
#pragma unroll
            for (int s = 0; s < 8; ++s) { const B8 a = *(const LAS B8*)(lds + KOFF + offb(32 * jt + l31, 2 * s + hi)); st = MFMA32(a, qf[s], st); }
            if (jt == lt) {
#pragma unroll
                for (int r = 0; r < 16; ++r) if (crow(r, hi) > l31) st[r] = 0.f;
            }
            if (ML) {
#pragma unroll
                for (int r = 0; r < 16; ++r) csum += st[r];
            }
#pragma unroll
            for (int s2 = 0; s2 < 2; ++s2) {
                U4 pk; pk.x = cvtpk(st[8 * s2 + 0], st[8 * s2 + 1]); pk.y = cvtpk(st[8 * s2 + 2], st[8 * s2 + 3]); pk.z = cvtpk(st[8 * s2 + 4], st[8 * s2 + 5]); pk.w = cvtpk(st[8 * s2 + 6], st[8 * s2 + 7]);
                const B8 bfr = __builtin_bit_cast(B8, pk);
                const unsigned R0 = 32 * jt + 16 * s2 + 4 * hi + q_, chv = 4 * et + 2 * blk + (p_ >> 1);
                const S4 lo = trrd(lds + VOFF + offv(R0, chv) + 8 * (p_ & 1));
                const S4 h4 = trrd(lds + VOFF + offv(R0 + 8, chv) + 8 * (p_ & 1));
                const B8 afr = __builtin_shufflevector(lo, h4, 0, 1, 2, 3, 4, 5, 6, 7);
                o = MFMA32(afr, bfr, o);
            }
        }
        if (ML) {
            csum += __shfl_xor(csum, 32);
            const LAS float* nv = (const LAS float*)(lds + NOFF + cur * 512);
            float qd = 0.f;
#pragma unroll
            for (int s = 0; s < 8; ++s) { const F4 n0 = *(const LAS F4*)(nv + 16 * s + 8 * hi), n1 = *(const LAS F4*)(nv + 16 * s + 8 * hi + 4);
                qd += bf2f(qf[s][0]) * n0.x + bf2f(qf[s][1]) * n0.y + bf2f(qf[s][2]) * n0.z + bf2f(qf[s][3]) * n0.w
                    + bf2f(qf[s][4]) * n1.x + bf2f(qf[s][5]) * n1.y + bf2f(qf[s][6]) * n1.z + bf2f(qf[s][7]) * n1.w; }
            qd += __shfl_xor(qd, 32);
            const float den = csum + qd, th = thr[(tok0 + (size_t)c * CHUNK + 32 * lt + l31) * 4 + hd];
            const float sc = 1.f / fmaxf(fabsf(den), th);
#pragma unroll
            for (int r = 0; r < 16; ++r) o[r] *= sc;
        }
        { bf16* op = Vp + (tok0 + (size_t)c * CHUNK + 32 * lt + l31) * 1024 + hd * 256 + sl * 64 + 32 * et + 4 * hi;
#pragma unroll
            for (int g = 0; g < 4; ++g) { U2 pk; pk.x = cvtpk(o[4 * g], o[4 * g + 1]); pk.y = cvtpk(o[4 * g + 2], o[4 * g + 3]); *(U2*)(op + 8 * g) = pk; } }
        if (c + 1 < NCHUNK) MX_LOADQ(c + 1);
        float ksum = 0.f;
#pragma unroll
        for (int ks = 0; ks < 8; ++ks) {
            const unsigned R0 = 16 * ks + 8 * hi + q_, chk = 4 * dt + 2 * blk + (p_ >> 1), chv = 4 * et + 2 * blk + (p_ >> 1);
            const S4 alo = trrd(lds + KOFF + offb(R0, chk) + 8 * (p_ & 1)), ahi = trrd(lds + KOFF + offb(R0 + 4, chk) + 8 * (p_ & 1));
            const S4 blo = trrd(lds + VOFF + offv(R0, chv) + 8 * (p_ & 1)), bhi = trrd(lds + VOFF + offv(R0 + 4, chv) + 8 * (p_ & 1));
            const B8 afr = __builtin_shufflevector(alo, ahi, 0, 1, 2, 3, 4, 5, 6, 7), bfr = __builtin_shufflevector(blo, bhi, 0, 1, 2, 3, 4, 5, 6, 7);
            St = MFMA32(afr, bfr, St);
            if (ML) ksum += (bf2f(afr[0]) + bf2f(afr[1])) + (bf2f(afr[2]) + bf2f(afr[3])) + (bf2f(afr[4]) + bf2f(afr[5])) + (bf2f(afr[6]) + bf2f(afr[7]));
        }
#pragma unroll
        for (int r = 0; r < 16; ++r) St[r] *= decay;
#pragma unroll
        for (int g = 0; g < 4; ++g) { U2 pk; pk.x = cvtpk(St[4 * g], St[4 * g + 1]); pk.y = cvtpk(St[4 * g + 2], St[4 * g + 3]);
            *(LAS U2*)(lds + SOFF + nxt * 16384 + offb(32 * et + l31, 4 * dt + g) + 8 * hi) = pk; }
        if (ML) { ksum += __shfl_xor(ksum, 32);
            if (et == 0 && hi == 0) { const LAS float* nv = (const LAS float*)(lds + NOFF + cur * 512); LAS float* nn = (LAS float*)(lds + NOFF + nxt * 512);
                nn[32 * dt + l31] = decay * (nv[32 * dt + l31] + ksum); } }
        __syncthreads();
        if (c + 1 < NCHUNK) MX_STORE();
        __syncthreads();
    }
#undef MX_LOAD
#undef MX_LOADQ
#undef MX_STORE
}
__device__ __forceinline__ void phase3(const Ctx& C, unsigned char* ws) {
    for (int it = C.vcu; it < 256; it += C.G) {
        const int mix = it >> 7, b = (it >> 4) & 7, hd = (it >> 2) & 3, sl = it & 3;
        if (mix == 0) mixer_item<false>(C, (const bf16*)(ws + WS_RQ), (const bf16*)(ws + WS_RK), (bf16*)(ws + WS_RV), nullptr, nullptr, b, hd, sl);
        else mixer_item<true>(C, (const bf16*)(ws + WS_MQP), (const bf16*)(ws + WS_MKP), (bf16*)(ws + WS_MV), (const float*)(ws + WS_THR), (const float*)(ws + WS_CDEC), b, hd, sl);
    }
}

__device__ __forceinline__ void phase4(const Ctx& C, const float* const* in, unsigned char* ws) {
    const float* rgn = in[3]; const float* mgn = in[9];
    const int gw = C.vcu * NWAVES + C.wave, NGW = C.G * NWAVES;
    const int col = (C.lane >> 4) * 256 + (C.lane & 15) * 16;
    float gr[16], gm[16];
#pragma unroll
    for (int i = 0; i < 4; ++i) { const F4 a = *(const F4*)(rgn + col + 4 * i), bq = *(const F4*)(mgn + col + 4 * i);
        gr[4 * i] = a.x; gr[4 * i + 1] = a.y; gr[4 * i + 2] = a.z; gr[4 * i + 3] = a.w; gm[4 * i] = bq.x; gm[4 * i + 1] = bq.y; gm[4 * i + 2] = bq.z; gm[4 * i + 3] = bq.w; }
    for (int m = gw; m < NTOK; m += NGW) {
#pragma unroll
        for (int mx = 0; mx < 2; ++mx) {
            bf16* op = (bf16*)(ws + (mx ? WS_MV : WS_RV)) + (size_t)m * 1024 + col;
            const bf16* gp = (const bf16*)(ws + (mx ? WS_MO : WS_RG)) + (size_t)m * 1024 + col;
            const U4 o0 = *(const U4*)op, o1 = *(const U4*)(op + 8), g0 = *(const U4*)gp, g1 = *(const U4*)(gp + 8);
            float v[16], g[16];
            v[0] = bflo(o0.x); v[1] = bfhi(o0.x); v[2] = bflo(o0.y); v[3] = bfhi(o0.y); v[4] = bflo(o0.z); v[5] = bfhi(o0.z); v[6] = bflo(o0.w); v[7] = bfhi(o0.w);
            v[8] = bflo(o1.x); v[9] = bfhi(o1.x); v[10] = bflo(o1.y); v[11] = bfhi(o1.y); v[12] = bflo(o1.z); v[13] = bfhi(o1.z); v[14] = bflo(o1.w); v[15] = bfhi(o1.w);
            g[0] = bflo(g0.x); g[1] = bfhi(g0.x); g[2] = bflo(g0.y); g[3] = bfhi(g0.y); g[4] = bflo(g0.z); g[5] = bfhi(g0.z); g[6] = bflo(g0.w); g[7] = bfhi(g0.w);
            g[8] = bflo(g1.x); g[9] = bfhi(g1.x); g[10] = bflo(g1.y); g[11] = bfhi(g1.y); g[12] = bflo(g1.z); g[13] = bfhi(g1.z); g[14] = bflo(g1.w); g[15] = bfhi(g1.w);
            if (mx) {
#pragma unroll
                for (int i = 0; i < 16; ++i) v[i] *= sigm(g[i]);
            }
            float ss = 0.f;
#pragma unroll
            for (int i = 0; i < 16; ++i) ss += v[i] * v[i];
            ss += __shfl_xor(ss, 1); ss += __shfl_xor(ss, 2); ss += __shfl_xor(ss, 4); ss += __shfl_xor(ss, 8);
            const float r = rsqrtf(ss * (1.f / 256.f) + EPS);
            float y[16];
#pragma unroll
            for (int i = 0; i < 16; ++i) y[i] = mx ? v[i] * r * gm[i] : v[i] * r * gr[i] * silu(g[i]);
            U4 w0, w1; w0.x = cvtpk(y[0], y[1]); w0.y = cvtpk(y[2], y[3]); w0.z = cvtpk(y[4], y[5]); w0.w = cvtpk(y[6], y[7]);
            w1.x = cvtpk(y[8], y[9]); w1.y = cvtpk(y[10], y[11]); w1.z = cvtpk(y[12], y[13]); w1.w = cvtpk(y[14], y[15]);
            *(U4*)op = w0; *(U4*)(op + 8) = w1;
        }
    }
    LAS float* scr = (LAS float*)(C.lds + C.wave * 8448);
    const float* wgate = in[17]; const float* wup = in[18]; const float* wdn = in[19];
    for (int it = gw; it < 16384 + 8192; it += NGW) {
        if (it < 16384) { const int e = it >> 9, kb = (it >> 5) & 15, nb = it & 31; const int R0 = nb * 32, tile = R0 >> 8, within = R0 & 255;
            const float* W = (within < 128 ? wgate : wup) + (size_t)e * 1024 * 512;
            transpose_item(W, 512, kb * 64, tile * 128 + (within & 127), (bf16*)(ws + WS_WGU), 1024, e * 1024 + R0, scr, C.lane); }
        else { const int r = it - 16384; const int e = r >> 8, kb = (r >> 5) & 7, nb = r & 31;
            transpose_item(wdn + (size_t)e * 512 * 1024, 1024, kb * 64, nb * 32, (bf16*)(ws + WS_WD), 512, e * 1024 + nb * 32, scr, C.lane); }
    }
}

__device__ __forceinline__ void phase8(const Ctx& C, const float* const* in, const float* x1, unsigned char* ws) {
    const float* bg = in[14]; const float* be = in[16];
    const F4* WR = (const F4*)(ws + WS_ROUT); TokInfo* TI = (TokInfo*)(ws + WS_TOK); unsigned* gcnt = (unsigned*)(ws + WS_CTL);
    LAS float* scr = (LAS float*)(C.lds + C.wave * 4096);
    LAS unsigned* lcnt = (LAS unsigned*)(C.lds + 65536);
    LAS unsigned* lbase = (LAS unsigned*)(C.lds + 65536 + 128);
    const int l = C.lane, l15 = l & 15, kk = l >> 4;
    for (int blkid = C.vcu; blkid < NTOK / 256; blkid += C.G) {
        __syncthreads();
        if (C.tid < 32) lcnt[C.tid] = 0u;
        __syncthreads();
        int e0[2], e1[2]; float w0[2], w1[2], rs[2]; unsigned rk0[2], rk1[2];
#pragma unroll
        for (int tt = 0; tt < 2; ++tt) {
            const int row0 = blkid * 256 + C.wave * 32 + tt * 16;
            F4 acc[3]; for (int n = 0; n < 3; ++n) acc[n] = (F4){0.f, 0.f, 0.f, 0.f};
            float ss = 0.f;
            const float* xr = x1 + (size_t)(row0 + l15) * DM + 4 * kk;
#pragma unroll 4
            for (int kb = 0; kb < 64; ++kb) {
                const F4 a = *(const F4*)(xr + 16 * kb);
                const F4 b0 = WR[(kb * 3 + 0) * 64 + l], b1 = WR[(kb * 3 + 1) * 64 + l], b2 = WR[(kb * 3 + 2) * 64 + l];
                ss += (a.x * a.x + a.y * a.y) + (a.z * a.z + a.w * a.w);
#pragma unroll
                for (int j = 0; j < 4; ++j) {
                    acc[0] = __builtin_amdgcn_mfma_f32_16x16x4f32(a[j], b0[j], acc[0], 0, 0, 0);
                    acc[1] = __builtin_amdgcn_mfma_f32_16x16x4f32(a[j], b1[j], acc[1], 0, 0, 0);
                    acc[2] = __builtin_amdgcn_mfma_f32_16x16x4f32(a[j], b2[j], acc[2], 0, 0, 0); }
            }
            ss += __shfl_xor(ss, 16); ss += __shfl_xor(ss, 32);
            const float rstd = rsqrtf(ss * (1.f / DM) + EPS);
#pragma unroll
            for (int n = 0; n < 3; ++n)
#pragma unroll
                for (int r = 0; r < 4; ++r) scr[(4 * kk + r) * 49 + 16 * n + l15] = acc[n][r];
            if (kk == 0) scr[16 * 49 + l15] = rstd;
            asm volatile("s_waitcnt lgkmcnt(0)" ::: "memory");
            e0[tt] = 0; e1[tt] = 0; w0[tt] = 0.f; w1[tt] = 0.f; rs[tt] = 0.f; rk0[tt] = 0u; rk1[tt] = 0u;
            if (l < 16) {
                const LAS float* lr = scr + l * 49; const float rr = scr[16 * 49 + l];
                float g0 = lr[0] * rr + bg[0], g1 = lr[1] * rr + bg[1], g2 = lr[2] * rr + bg[2], g3 = lr[3] * rr + bg[3];
                int gi = 0; float gmx = g0; if (g1 > gmx) { gmx = g1; gi = 1; } if (g2 > gmx) { gmx = g2; gi = 2; } if (g3 > gmx) { gmx = g3; gi = 3; }
                const float gw = 1.f / (__expf(g0 - gmx) + __expf(g1 - gmx) + __expf(g2 - gmx) + __expf(g3 - gmx));
                float m1 = -INFINITY, m2 = -INFINITY; int i1 = 0, i2 = 0;
#pragma unroll
                for (int i = 0; i < 8; ++i) { const float v = lr[4 + gi * 8 + i] * rr + be[gi * 8 + i];
                    if (v > m1) { m2 = m1; i2 = i1; m1 = v; i1 = i; } else if (v > m2) { m2 = v; i2 = i; } }
                const float ex = __expf(m2 - m1), wa = 1.f / (1.f + ex);
                e0[tt] = gi * 8 + i1; e1[tt] = gi * 8 + i2; w0[tt] = gw * wa; w1[tt] = gw * ex * wa; rs[tt] = rr;
                rk0[tt] = atomicAdd((unsigned*)(lcnt + e0[tt]), 1u); rk1[tt] = atomicAdd((unsigned*)(lcnt + e1[tt]), 1u);
            }
            asm volatile("s_waitcnt lgkmcnt(0)" ::: "memory");
        }
        __syncthreads();
        if (C.tid < 32) lbase[C.tid] = atomicAdd(gcnt + C.tid, lcnt[C.tid]);
        __syncthreads();
#pragma unroll
        for (int tt = 0; tt < 2; ++tt) if (l < 16) {
            TokInfo ti; ti.e0 = e0[tt]; ti.p0 = (int)(lbase[e0[tt]] + rk0[tt]); ti.e1 = e1[tt]; ti.p1 = (int)(lbase[e1[tt]] + rk1[tt]); ti.w0 = w0[tt]; ti.w1 = w1[tt]; ti.rstd = rs[tt]; ti.pad = 0.f;
            TI[blkid * 256 + C.wave * 32 + tt * 16 + l] = ti; }
    }
}

__device__ __forceinline__ int build_rowbase(const Ctx& C, unsigned char* ws) {
    LAS int* rb = (LAS int*)(C.lds + LDS_MISC);
    LAS unsigned char* t2e = (LAS unsigned char*)(C.lds + LDS_MISC + 256);
    const unsigned* gcnt = (const unsigned*)(ws + WS_CTL);
    __syncthreads();
    if (C.tid == 0) { int acc = 0; for (int e = 0; e < NEXP; ++e) { rb[e] = acc; const int n = (int)__hip_atomic_load(gcnt + e, __ATOMIC_RELAXED, __HIP_MEMORY_SCOPE_AGENT); acc += (n + 255) & ~255; } rb[NEXP] = acc; }
    __syncthreads();
    for (int e = C.tid >> 4; e < NEXP; e += NTHR >> 4) for (int t = (rb[e] >> 8) + (C.tid & 15); t < (rb[e + 1] >> 8); t += 16) t2e[t] = (unsigned char)e;
    __syncthreads();
    return rb[NEXP] >> 8;
}

__device__ __forceinline__ void phase9(const Ctx& C, const float* const* in, const float* x1, unsigned char* ws) {
    (void)build_rowbase(C, ws);
    const LAS int* rb = (const LAS int*)(C.lds + LDS_MISC);
    const float* nfw = in[12]; const TokInfo* TI = (const TokInfo*)(ws + WS_TOK); bf16* XS = (bf16*)(ws + WS_XS);
    const int gw = C.vcu * NWAVES + C.wave, NGW = C.G * NWAVES;
    F4 wv[4];
#pragma unroll
    for (int j = 0; j < 4; ++j) wv[j] = *(const F4*)(nfw + 4 * C.lane + 256 * j);
    for (int m = gw; m < NTOK; m += NGW) {
        const TokInfo ti = TI[m];
        const F4* xr = (const F4*)(x1 + (size_t)m * DM) + C.lane;
        unsigned long long* d0 = (unsigned long long*)(XS + (size_t)(rb[ti.e0] + ti.p0) * DM) + C.lane;
        unsigned long long* d1 = (unsigned long long*)(XS + (size_t)(rb[ti.e1] + ti.p1) * DM) + C.lane;
#pragma unroll
        for (int j = 0; j < 4; ++j) { const F4 v = xr[64 * j] * ti.rstd * wv[j];
            const unsigned long long pk = (unsigned long long)cvtpk(v.x, v.y) | ((unsigned long long)cvtpk(v.z, v.w) << 32);
            d0[64 * j] = pk; d1[64 * j] = pk; }
    }
}

__device__ __forceinline__ void phase12(const Ctx& C, const float* const* in, float* xo, unsigned char* ws) {
    (void)build_rowbase(C, ws);
    const LAS int* rb = (const LAS int*)(C.lds + LDS_MISC);
    const float* fw = in[20]; const TokInfo* TI = (const TokInfo*)(ws + WS_TOK); const bf16* Y = (const bf16*)(ws + WS_Y);
    const int gw = C.vcu * NWAVES + C.wave, NGW = C.G * NWAVES;
    F4 wv[4];
#pragma unroll
    for (int j = 0; j < 4; ++j) wv[j] = *(const F4*)(fw + 4 * C.lane + 256 * j);
    for (int m = gw; m < NTOK; m += NGW) {
        const TokInfo ti = TI[m];
        F4* xr = (F4*)(xo + (size_t)m * DM) + C.lane;
        const U2* y0 = (const U2*)(Y + (size_t)(rb[ti.e0] + ti.p0) * DM) + C.lane;
        const U2* y1 = (const U2*)(Y + (size_t)(rb[ti.e1] + ti.p1) * DM) + C.lane;
        F4 v[4]; float s = 0.f;
#pragma unroll
        for (int j = 0; j < 4; ++j) { const U2 a = y0[64 * j], bq = y1[64 * j]; v[j] = xr[64 * j];
            v[j].x += ti.w0 * bflo(a.x) + ti.w1 * bflo(bq.x); v[j].y += ti.w0 * bfhi(a.x) + ti.w1 * bfhi(bq.x);
            v[j].z += ti.w0 * bflo(a.y) + ti.w1 * bflo(bq.y); v[j].w += ti.w0 * bfhi(a.y) + ti.w1 * bfhi(bq.y);
            s += (v[j].x * v[j].x + v[j].y * v[j].y) + (v[j].z * v[j].z + v[j].w * v[j].w); }
        const float rstd = rsqrtf(wave_sum(s) * (1.f / DM) + EPS);
#pragma unroll
        for (int j = 0; j < 4; ++j) xr[64 * j] = v[j] * rstd * wv[j];
    }
}

constexpr int NPHASE = 13;
struct Args { const float* in[21]; float* out; unsigned char* ws; int ph_lo, ph_hi; };
__global__ void __launch_bounds__(NTHR, 2) fwd_kernel(Args args) {
    extern __shared__ __attribute__((aligned(16))) unsigned char lds_raw[];
    cg::grid_group grid = cg::this_grid();
    Ctx C; C.lds = (LAS unsigned char*)lds_raw; C.tid = threadIdx.x; C.lane = C.tid & 63; C.wave = __builtin_amdgcn_readfirstlane(C.tid >> 6);
    C.G = gridDim.x; { const int bx = blockIdx.x; C.vcu = (C.G % 8 == 0) ? (bx % 8) * (C.G / 8) + bx / 8 : bx; }
    unsigned char* ws = args.ws; unsigned char* ob = (unsigned char*)args.out;
    const int lo = args.ph_lo, hi = args.ph_hi;
#ifndef PHMASK
#define PHMASK 0x1fff
#endif
#define IN(k) (((PHMASK >> (k)) & 1) && lo <= (k) && (k) < hi)
#define SEAM(k) do { if (IN(k) && IN((k) + 1)) grid.sync(); } while (0)
    if (IN(0)) { phase0(C, args.in, ws); } SEAM(0);
    if (IN(1)) { pg8::Gemm g{(const pg8::bf16_t*)(ws + WS_H), (const pg8::bf16_t*)(ws + WS_WIN), NTOK, NPROJ, DM}; pg8::StaticOrder S; S.init(NTOK, NPROJ, C.G, (int)blockIdx.x);
        pg8::EpiProj E{ws, ob}; pg8::gemm_phase<pg8::EpiProj, pg8::StaticOrder, true, true>(C.lds, g, S, E); } SEAM(1);
    if (IN(2)) { phase2(C, args.in, ws); } SEAM(2);
    if (IN(3)) { phase3(C, ws); } SEAM(3);
    if (IN(4)) { phase4(C, args.in, ws); } SEAM(4);
    if (IN(5)) { pg8::Gemm g{(const pg8::bf16_t*)(ws + WS_RV), (const pg8::bf16_t*)(ws + WS_WRB), NTOK, DM, DM}; pg8::StaticOrder S; S.init(NTOK, DM, C.G, (int)blockIdx.x);
        pg8::EpiGate<0> E{(const pg8::bf16_t*)(ob + OUT_GR), nullptr, (pg8::bf16_t*)(ws + WS_TMP)}; pg8::gemm_phase<pg8::EpiGate<0>, pg8::StaticOrder, true, true>(C.lds, g, S, E); } SEAM(5);
    if (IN(6)) { pg8::Gemm g{(const pg8::bf16_t*)(ws + WS_MV), (const pg8::bf16_t*)(ws + WS_WMB), NTOK, DM, DM}; pg8::StaticOrder S; S.init(NTOK, DM, C.G, (int)blockIdx.x);
        pg8::EpiGate<1> E{(const pg8::bf16_t*)(ob + OUT_GM), (const pg8::bf16_t*)(ws + WS_TMP), (pg8::bf16_t*)(ws + WS_MERGED)}; pg8::gemm_phase<pg8::EpiGate<1>, pg8::StaticOrder, true, true>(C.lds, g, S, E); } SEAM(6);
    if (IN(7)) { pg8::Gemm g{(const pg8::bf16_t*)(ws + WS_MERGED), (const pg8::bf16_t*)(ws + WS_WOUT), NTOK, DM, DM}; pg8::StaticOrder S; S.init(NTOK, DM, C.G, (int)blockIdx.x);
        pg8::EpiX1 E{args.in[0], args.out}; pg8::gemm_phase<pg8::EpiX1, pg8::StaticOrder, true, true>(C.lds, g, S, E); } SEAM(7);
    if (IN(8)) { phase8(C, args.in, args.out, ws); } SEAM(8);
    if (IN(9)) { phase9(C, args.in, args.out, ws); } SEAM(9);
    if (IN(10)) { const int nt = build_rowbase(C, ws);
        pg8::Gemm g{(const pg8::bf16_t*)(ws + WS_XS), (const pg8::bf16_t*)(ws + WS_WGU), MAXROWS, NEXP * 1024, DM};
        pg8::GroupedOrder S{nt, C.G, C.vcu, (const LAS unsigned char*)(C.lds + LDS_MISC + 256)};
        pg8::EpiSwiglu E{(pg8::bf16_t*)(ws + WS_HMID)}; pg8::gemm_phase<pg8::EpiSwiglu, pg8::GroupedOrder, true, true>(C.lds, g, S, E); } SEAM(10);
    if (IN(11)) { const int nt = build_rowbase(C, ws);
        pg8::Gemm g{(const pg8::bf16_t*)(ws + WS_HMID), (const pg8::bf16_t*)(ws + WS_WD), MAXROWS, NEXP * 1024, DEXP};
        pg8::GroupedOrder S{nt, C.G, C.vcu, (const LAS unsigned char*)(C.lds + LDS_MISC + 256)};
        pg8::EpiY E{(pg8::bf16_t*)(ws + WS_Y)}; pg8::gemm_phase<pg8::EpiY, pg8::GroupedOrder, true, true>(C.lds, g, S, E); } SEAM(11);
    if (IN(12)) { phase12(C, args.in, args.out, ws); }
#undef IN
#undef SEAM
}

#ifndef MK_SPLIT
#define MK_SPLIT 0
#endif
extern "C" void kernel_launch(void* const* d_in, const int* in_sizes, int n_in, void* d_out, int out_size, void* d_ws, size_t ws_size, hipStream_t stream) {
    static int grid = 0;
    if (grid == 0) {
        if (n_in != 21 || out_size != NTOK * DM || ws_size < WS_END) { fprintf(stderr, "kernel_launch: unexpected shapes (n_in %d out %d ws %zu)\n", n_in, out_size, ws_size); grid = -1; return; }
        int dev = 0, cus = 0, per_cu = 0;
        if (hipGetDevice(&dev) != hipSuccess || hipDeviceGetAttribute(&cus, hipDeviceAttributeMultiprocessorCount, dev) != hipSuccess) { grid = -1; return; }
        if (hipFuncSetAttribute((const void*)fwd_kernel, hipFuncAttributeMaxDynamicSharedMemorySize, LDS_BYTES) != hipSuccess) { fprintf(stderr, "kernel_launch: hipFuncSetAttribute failed\n"); grid = -1; return; }
        if (hipOccupancyMaxActiveBlocksPerMultiprocessor(&per_cu, (const void*)fwd_kernel, NTHR, LDS_BYTES) != hipSuccess || per_cu < 1) { fprintf(stderr, "kernel_launch: occupancy query says %d\n", per_cu); per_cu = 1; }
        (void)hipGetLastError();
        grid = cus;
    }
    if (grid < 0) return;
    (void)hipMemsetAsync((char*)d_ws + WS_CTL, 0, CTL_ZERO_BYTES, stream);
    Args a{};
    for (int i = 0; i < 21; ++i) a.in[i] = (const float*)d_in[i];
    a.out = (float*)d_out; a.ws = (unsigned char*)d_ws;
    void* kargs[] = {&a};
#if MK_SPLIT
    for (int p = 0; p < NPHASE; ++p) { a.ph_lo = p; a.ph_hi = p + 1;
        hipError_t e = hipLaunchCooperativeKernel((const void*)fwd_kernel, dim3(grid), dim3(NTHR), kargs, LDS_BYTES, stream);
        if (e != hipSuccess) { fprintf(stderr, "kernel_launch: launch %d failed: %s\n", p, hipGetErrorString(e)); break; } }
#else
    a.ph_lo = 0; a.ph_hi = NPHASE;
    hipError_t e = hipLaunchCooperativeKernel((const void*)fwd_kernel, dim3(grid), dim3(NTHR), kargs, LDS_BYTES, stream);
    if (e != hipSuccess) fprintf(stderr, "kernel_launch: cooperative launch failed: %s (grid %d)\n", hipGetErrorString(e), grid);
#endif
}
```

```cpp
#include <hip/hip_runtime.h>
#include <hip/hip_cooperative_groups.h>
#include <cstdio>
#include <cstdint>
namespace cg = cooperative_groups;
namespace pg8 {
#define PG8_LAS __attribute__((address_space(3)))
typedef unsigned short bf16_t;
typedef short bf16x8 __attribute__((ext_vector_type(8)));
typedef float f32x4 __attribute__((ext_vector_type(4)));
typedef unsigned u32x4 __attribute__((ext_vector_type(4)));
constexpr int BM = 256, BK = 64, HALF = 128, HTB = HALF * BK * 2  , STAGE_BYTES = 8 * HTB, NXCD = 8, WGM = 8;

__host__ __device__ __forceinline__ int lds_byte(int r, int c) { const int st = (r >> 4) * 2 + (c >> 5), rr = r & 15, cc = c & 31, ob = rr * 64 + cc * 2; return st * 1024 + (ob ^ (((ob >> 9) & 1) << 5)); }
__host__ __device__ __forceinline__ void stage_rc(int b, int& R, int& C) { const int st = b / 1024, sb = b % 1024, swz = sb ^ (((sb >> 9) & 1) << 5); R = (st >> 1) * 16 + swz / 64; C = (st & 1) * 32 + (swz % 64) / 2; }
__host__ __device__ __forceinline__ int perm32(int rho) { const int n = rho >> 4, i = rho & 15; return 8 * (i >> 2) + 4 * n + (i & 3); }

struct Unit { int pm, pn; };
struct Gemm { const bf16_t* A; const bf16_t* Bt; int M, N, K; };

struct StaticOrder {
    int nM, nN, nwg, G, c;
    __host__ __device__ void init(int M, int N, int G_, int c_) { nM = M / BM; nN = N / BM; nwg = nM * nN; G = G_; c = c_; }
    __host__ __device__ bool next(int i, Unit& u) const {
        const long L = (long)i * G + c; if (L >= nwg) return false;
        int wgid = (int)L; { const int q = nwg / NXCD, r = nwg % NXCD, xcd = wgid % NXCD, off = wgid / NXCD; wgid = (xcd < r ? xcd * (q + 1) : r * (q + 1) + (xcd - r) * q) + off; }
        const int nig = WGM * nN, gid = wgid / nig, fm = gid * WGM, gsz = (nM - fm) < WGM ? (nM - fm) : WGM;
        u.pm = fm + ((wgid % nig) % gsz); u.pn = (wgid % nig) / gsz; return true;
    }
    __device__ __forceinline__ void a_ready(const Unit&) const {}
    __device__ __forceinline__ void done(const Unit&) const {}
};

__device__ __forceinline__ unsigned cvt_pk_bf16(float lo, float hi) { unsigned r; asm volatile("v_cvt_pk_bf16_f32 %0, %1, %2" : "=v"(r) : "v"(lo), "v"(hi)); return r; }
typedef float f32x2 __attribute__((ext_vector_type(2)));
__device__ __forceinline__ f32x2 gelu_pk(f32x2 v) {
    const f32x2 av = __builtin_elementwise_abs(v), d = av * 0.2316418882f + 1.0f;
    f32x2 t; t.x = __builtin_amdgcn_rcpf(d.x); t.y = __builtin_amdgcn_rcpf(d.y);
    f32x2 q = t * 0.5307027145f + (-0.7265760135f); q = q * t + 0.7107068705f; q = q * t + (-0.142248368f); q = q * t + 0.127414796f; q = q * t;
    const f32x2 s = (v * v) * (-0.72134752044f);
    f32x2 e; e.x = __builtin_amdgcn_exp2f(s.x); e.y = __builtin_amdgcn_exp2f(s.y);
    const f32x2 m = v * (q * e), r = v - m;
    f32x2 o; o.x = v.x < 0.f ? m.x : r.x; o.y = v.y < 0.f ? m.y : r.y; return o;
}

template <int ACT  > struct EpiBf16 {
    static constexpr bool PERM = true, AFTER_DRAIN = false; static_assert(ACT == 0 || ACT == 1, "EpiBf16: ACT is 0 (none) or 1 (gelu_pk)");
    bf16_t* O; int ldc; const float* bias; int split_cols; size_t split_stride; float scale0;
    __device__ __forceinline__ void operator()(const f32x4 (&acc)[2][2][4][2], const Unit& u, int wr, int wc, int fr, int fq) const {
        const int row0 = u.pm * BM + wr * 64 + fr; int colt = u.pn * BM; bf16_t* base = O;
        float sc = 1.f; if (split_cols) { const int t = colt / split_cols; base += (size_t)t * split_stride; colt -= t * split_cols; if (t == 0) sc = scale0; }
        const int col0 = colt + wc * 32 + 8 * fq, bcol0 = u.pn * BM + wc * 32 + 8 * fq;
        f32x4 bv[2][2];
#pragma unroll
        for (int bj = 0; bj < 2; ++bj)
#pragma unroll
            for (int n = 0; n < 2; ++n) bv[bj][n] = bias ? *(const f32x4*)(bias + bcol0 + bj * HALF + 4 * n) : (f32x4){0.f, 0.f, 0.f, 0.f};
#pragma unroll
        for (int ai = 0; ai < 2; ++ai)
#pragma unroll
            for (int m = 0; m < 4; ++m) { bf16_t* rowp = base + (size_t)(row0 + ai * HALF + m * 16) * ldc + col0;
#pragma unroll
                for (int bj = 0; bj < 2; ++bj) { f32x4 v0 = acc[ai][bj][m][0] + bv[bj][0], v1 = acc[ai][bj][m][1] + bv[bj][1];
                    if (ACT == 1) { f32x2 a = gelu_pk((f32x2){v0[0], v0[1]}), b = gelu_pk((f32x2){v0[2], v0[3]}), c = gelu_pk((f32x2){v1[0], v1[1]}), d = gelu_pk((f32x2){v1[2], v1[3]});
                        v0 = (f32x4){a.x, a.y, b.x, b.y}; v1 = (f32x4){c.x, c.y, d.x, d.y}; }
                    v0 = v0 * sc; v1 = v1 * sc; u32x4 w; w.x = cvt_pk_bf16(v0[0], v0[1]); w.y = cvt_pk_bf16(v0[2], v0[3]); w.z = cvt_pk_bf16(v1[0], v1[1]); w.w = cvt_pk_bf16(v1[2], v1[3]);
                    *(u32x4*)(rowp + bj * HALF) = w; } }
    }
};
template <class Epi, class Sched, bool ALIGN_EPI = false, bool SP2 = false>
__device__ __forceinline__ void gemm_phase(PG8_LAS unsigned char* lds, const Gemm g, const Sched& S, const Epi& E) {
    const int tid = threadIdx.x, wid = __builtin_amdgcn_readfirstlane(tid >> 6), lane = tid & 63, wr = wid >> 2, wc = wid & 3, fr = lane & 15, fq = lane >> 4;
    const int K = g.K, nt = K / BK;
    unsigned voffA[2], voffB[2];
#pragma unroll
    for (int i = 0; i < 2; ++i) { int R, C; stage_rc(tid * 16 + i * 8192, R, C); const int Rb = Epi::PERM ? ((R & ~31) + perm32(R & 31)) : R;
        voffA[i] = (unsigned)(R * K + C) * 2u; voffB[i] = (unsigned)(Rb * K + C) * 2u; }
    const size_t kstep = (size_t)(BK * 2);
    const size_t hstep = (size_t)HALF * K * 2;
    const size_t tstep = 2 * hstep;
    const unsigned ldsw = (unsigned)wid * 1024u;
    const int aoff = lds_byte(wr * 64 + fr, fq * 8), boff = lds_byte(wc * 32 + fr, fq * 8);
#define PG8_SA(b, h) (((b) * 2 + (h)) * HTB)
#define PG8_SB(b, h) ((4 + (b) * 2 + (h)) * HTB)
#define PG8_STAGE(bufoff, gbase, voff) do { _Pragma("unroll") for (int _i = 0; _i < 2; ++_i) \
        __builtin_amdgcn_global_load_lds((const unsigned*)((const char*)(gbase) + (voff)[_i]), (PG8_LAS unsigned*)(lds + (bufoff) + ldsw + _i * 8192), 16, 0, 0); } while (0)
#define PG8_LDA(dst, b, h) do { _Pragma("unroll") for (int m = 0; m < 4; ++m) _Pragma("unroll") for (int k = 0; k < 2; ++k) dst[m][k] = *(const PG8_LAS bf16x8*)(lds + PG8_SA(b, h) + aoff + m * 2048 + k * 1024); } while (0)
#define PG8_LDB(dst, b, h) do { _Pragma("unroll") for (int n = 0; n < 2; ++n) _Pragma("unroll") for (int k = 0; k < 2; ++k) dst[n][k] = *(const PG8_LAS bf16x8*)(lds + PG8_SB(b, h) + boff + n * 2048 + k * 1024); } while (0)
#define PG8_MMA(ai, bj, At, Bt) do { __builtin_amdgcn_s_setprio(1); _Pragma("unroll") for (int m = 0; m < 4; ++m) _Pragma("unroll") for (int n = 0; n < 2; ++n) _Pragma("unroll") for (int k = 0; k < 2; ++k) \
        acc[ai][bj][m][n] = __builtin_amdgcn_mfma_f32_16x16x32_bf16(Bt[n][k], At[m][k], acc[ai][bj][m][n], 0, 0, 0); __builtin_amdgcn_s_setprio(0); } while (0)
#define PG8_WAIT_V(n) asm volatile("s_waitcnt vmcnt(" #n ")" ::: "memory")
#define PG8_WAIT_L(n) asm volatile("s_waitcnt lgkmcnt(" #n ")" ::: "memory")
#define PG8_BAR __builtin_amdgcn_s_barrier()
#define PG8_SCHED __builtin_amdgcn_sched_barrier(0)
    Unit cur, nxt; int ui = 0;
    if (!S.next(0, cur)) return;
    f32x4 acc[2][2][4][2];
#pragma unroll
    for (int a = 0; a < 2; ++a)
#pragma unroll
        for (int b = 0; b < 2; ++b)
#pragma unroll
            for (int m = 0; m < 4; ++m)
#pragma unroll
                for (int n = 0; n < 2; ++n) acc[a][b][m][n] = (f32x4){0.f, 0.f, 0.f, 0.f};
    bf16x8 At[4][2], B0[2][2], B1[2][2];
    const char* cA = (const char*)g.A + (size_t)cur.pm * tstep; const char* cB = (const char*)g.Bt + (size_t)cur.pn * tstep;
    S.a_ready(cur);
    if constexpr (SP2) {
        PG8_STAGE(PG8_SB(0, 0), cB, voffB); PG8_STAGE(PG8_SB(0, 1), cB + hstep, voffB); PG8_STAGE(PG8_SA(0, 0), cA, voffA); PG8_STAGE(PG8_SA(0, 1), cA + hstep, voffA);
        if (wr == 1) PG8_BAR;
        PG8_WAIT_V(2); PG8_BAR;
        PG8_STAGE(PG8_SB(1, 0), cB + kstep, voffB); PG8_STAGE(PG8_SA(1, 0), cA + kstep, voffA); PG8_STAGE(PG8_SB(1, 1), cB + hstep + kstep, voffB);
        PG8_WAIT_V(6); PG8_BAR;
    } else {
        PG8_STAGE(PG8_SB(0, 0), cB, voffB); PG8_STAGE(PG8_SA(0, 0), cA, voffA); PG8_STAGE(PG8_SB(0, 1), cB + hstep, voffB); PG8_STAGE(PG8_SA(0, 1), cA + hstep, voffA);
        if (wr == 1) PG8_BAR;
        PG8_WAIT_V(4); PG8_BAR;
        PG8_STAGE(PG8_SB(1, 0), cB + kstep, voffB); PG8_STAGE(PG8_SA(1, 0), cA + kstep, voffA); PG8_STAGE(PG8_SB(1, 1), cB + hstep + kstep, voffB);
        PG8_WAIT_V(6); PG8_BAR;
    }
    for (;;) {
        const bool has_next = S.next(ui + 1, nxt);
        const char* nA = has_next ? (const char*)g.A + (size_t)nxt.pm * tstep : cA; const char* nB = has_next ? (const char*)g.Bt + (size_t)nxt.pn * tstep : cB;
        for (int t = 0; t < nt; t += 2) {
            const bool last = (t == nt - 2);
            const char* a1 = cA + (size_t)(t + 1) * kstep;
            const char* a2 = last ? nA : cA + (size_t)(t + 2) * kstep; const char* b2 = last ? nB : cB + (size_t)(t + 2) * kstep;
            const char* a3 = a2 + kstep; const char* b3 = b2 + kstep;
            if (last && has_next) S.a_ready(nxt);
            if constexpr (SP2) {
            PG8_LDB(B0, 0, 0); PG8_LDB(B1, 0, 1); PG8_SCHED; PG8_LDA(At, 0, 0); PG8_STAGE(PG8_SA(1, 1), a1 + hstep, voffA);
            PG8_WAIT_V(8); PG8_WAIT_L(0); PG8_BAR; PG8_MMA(0, 0, At, B0); PG8_MMA(0, 1, At, B1); PG8_BAR; PG8_SCHED;
            PG8_LDA(At, 0, 1); PG8_STAGE(PG8_SB(0, 0), b2, voffB); PG8_STAGE(PG8_SB(0, 1), b2 + hstep, voffB); PG8_STAGE(PG8_SA(0, 0), a2, voffA);
            PG8_WAIT_V(8); PG8_WAIT_L(0); PG8_BAR; PG8_MMA(1, 0, At, B0); PG8_MMA(1, 1, At, B1); PG8_BAR; PG8_SCHED;
            PG8_LDB(B0, 1, 0); PG8_LDB(B1, 1, 1); PG8_SCHED; PG8_LDA(At, 1, 0); PG8_STAGE(PG8_SA(0, 1), a2 + hstep, voffA);
            PG8_WAIT_V(8); PG8_WAIT_L(0); PG8_BAR; PG8_MMA(0, 0, At, B0); PG8_MMA(0, 1, At, B1); PG8_BAR; PG8_SCHED;
            PG8_LDA(At, 1, 1); PG8_STAGE(PG8_SB(1, 0), b3, voffB); PG8_STAGE(PG8_SB(1, 1), b3 + hstep, voffB); PG8_STAGE(PG8_SA(1, 0), a3, voffA);
            PG8_WAIT_V(8); PG8_WAIT_L(0); PG8_BAR; PG8_MMA(1, 0, At, B0); PG8_MMA(1, 1, At, B1); PG8_BAR; PG8_SCHED;
            } else {
            PG8_LDB(B0, 0, 0); PG8_SCHED; PG8_LDA(At, 0, 0); PG8_STAGE(PG8_SA(1, 1), a1 + hstep, voffA);
            PG8_WAIT_L(8); PG8_BAR; PG8_WAIT_L(0); PG8_MMA(0, 0, At, B0); PG8_BAR; PG8_SCHED;
            PG8_LDB(B1, 0, 1); PG8_STAGE(PG8_SB(0, 0), b2, voffB);
            PG8_BAR; PG8_WAIT_L(0); PG8_MMA(0, 1, At, B1); PG8_BAR;
            PG8_LDA(At, 0, 1); PG8_STAGE(PG8_SA(0, 0), a2, voffA);
            PG8_BAR; PG8_WAIT_L(0); PG8_MMA(1, 0, At, B0); PG8_BAR; PG8_SCHED;
            PG8_STAGE(PG8_SB(0, 1), b2 + hstep, voffB);
            PG8_WAIT_V(6); PG8_BAR; PG8_MMA(1, 1, At, B1); PG8_BAR;
            PG8_LDB(B0, 1, 0); PG8_SCHED; PG8_LDA(At, 1, 0); PG8_STAGE(PG8_SA(0, 1), a2 + hstep, voffA);
            PG8_WAIT_L(8); PG8_BAR; PG8_WAIT_L(0); PG8_MMA(0, 0, At, B0); PG8_BAR; PG8_SCHED;
            PG8_LDB(B1, 1, 1); PG8_STAGE(PG8_SB(1, 0), b3, voffB);
            PG8_BAR; PG8_WAIT_L(0); PG8_MMA(0, 1, At, B1); PG8_BAR;
            PG8_LDA(At, 1, 1); PG8_STAGE(PG8_SA(1, 0), a3, voffA);
            PG8_BAR; PG8_WAIT_L(0); PG8_MMA(1, 0, At, B0); PG8_BAR; PG8_SCHED;
            PG8_STAGE(PG8_SB(1, 1), b3 + hstep, voffB);
            PG8_WAIT_V(6); PG8_BAR; PG8_MMA(1, 1, At, B1); PG8_BAR;
            }
        }
        if constexpr (ALIGN_EPI) { if (wr == 0) PG8_BAR; }
        if constexpr (!Epi::AFTER_DRAIN) { E(acc, cur, wr, wc, fr, fq); S.done(cur); }
        if (!has_next) break;
#pragma unroll
        for (int a = 0; a < 2; ++a)
#pragma unroll
            for (int b = 0; b < 2; ++b)
#pragma unroll
                for (int m = 0; m < 4; ++m)
#pragma unroll
                    for (int n = 0; n < 2; ++n) acc[a][b][m][n] = (f32x4){0.f, 0.f, 0.f, 0.f};
        cur = nxt; cA = nA; cB = nB; ++ui;
        if constexpr (ALIGN_EPI) { if (wr == 1) PG8_BAR; }
    }
    PG8_WAIT_V(0);
    if constexpr (!ALIGN_EPI) { if (wr == 0) PG8_BAR; }
    PG8_BAR;
    if constexpr (Epi::AFTER_DRAIN) { E.fused(acc, cur, wr, wc, fr, fq, lds, wid, lane); S.done(cur); }
#undef PG8_SA
#undef PG8_SB
#undef PG8_STAGE
#undef PG8_LDA
#undef PG8_LDB
#undef PG8_MMA
#undef PG8_WAIT_V
#undef PG8_WAIT_L
#undef PG8_BAR
#undef PG8_SCHED
}
}

#define GAS __attribute__((address_space(1)))
#define LAS __attribute__((address_space(3)))
typedef unsigned short bf16;
typedef unsigned U4 __attribute__((ext_vector_type(4)));
typedef unsigned U2 __attribute__((ext_vector_type(2)));
typedef float F4 __attribute__((ext_vector_type(4)));
typedef float F2 __attribute__((ext_vector_type(2)));
typedef float F16 __attribute__((ext_vector_type(16)));
typedef short B8 __attribute__((ext_vector_type(8)));
typedef short S4 __attribute__((ext_vector_type(4)));
typedef __bf16 bf16x2_t __attribute__((ext_vector_type(2)));

constexpr int NWAVES = 8, NTHR = 512;
constexpr int DM = 1024, BATCH = 8, SEQ = 8192, NTOK = BATCH * SEQ;
constexpr int DIN = 8200, NPROJ = 8192;
constexpr int CHUNK = 128, NCHUNK = SEQ / CHUNK;
constexpr int NEXP = 32, DEXP = 512;
constexpr int MAXTILES = 544, MAXROWS = MAXTILES * 256;
constexpr float EPS = 1e-6f;
constexpr int LDS_BYTES = 147456;
constexpr int LDS_MISC = 131072;

constexpr size_t MiB = 1u << 20;
constexpr size_t WS_CTL = 0, CTL_ZERO_BYTES = 32768; constexpr int CW_BAR = 1024;
constexpr size_t WS_IF = 1 * MiB;
constexpr size_t WS_THR = 3 * MiB;
constexpr size_t WS_CDEC = 4 * MiB;
constexpr size_t WS_ROUT = 4 * MiB + 65536;
constexpr size_t WS_ROPE = 5 * MiB;
constexpr size_t WS_TOK = 9 * MiB;
constexpr size_t WS_WIN = 12 * MiB;
constexpr size_t WS_WRB = 28 * MiB, WS_WMB = 30 * MiB, WS_WOUT = 32 * MiB;
constexpr size_t WS_H = 34 * MiB;
constexpr size_t WS_MQP = 34 * MiB, WS_MKP = 98 * MiB, WS_MERGED = 34 * MiB;
constexpr size_t WS_RQ = 162 * MiB, WS_RK = 226 * MiB, WS_MQ = 290 * MiB, WS_MK = 354 * MiB;
constexpr size_t WS_WGU = 162 * MiB, WS_WD = 226 * MiB, WS_TMP = 258 * MiB;
constexpr size_t WS_RV = 418 * MiB, WS_RG = 546 * MiB, WS_MV = 674 * MiB, WS_MO = 802 * MiB;
constexpr size_t WS_XS = 418 * MiB, WS_HMID = 690 * MiB, WS_Y = 418 * MiB;
constexpr size_t WS_END = 930 * MiB;
constexpr size_t OUT_GR = 0, OUT_GM = 128 * MiB;
static_assert(WS_XS + (size_t)MAXROWS * 1024 * 2 <= WS_HMID && WS_HMID + (size_t)MAXROWS * 512 * 2 <= WS_END, "ws map");

struct TokInfo { int e0, p0, e1, p1; float w0, w1, rstd, pad; };

__device__ __forceinline__ float bflo(unsigned u) { return __uint_as_float(u << 16); }
__device__ __forceinline__ float bfhi(unsigned u) { return __uint_as_float(u & 0xffff0000u); }
__device__ __forceinline__ float bf2f(short s) { return __uint_as_float(((unsigned)(unsigned short)s) << 16); }
__device__ __forceinline__ unsigned cvtpk(float lo, float hi) { F2 v = {lo, hi}; bf16x2_t b = __builtin_convertvector(v, bf16x2_t); return __builtin_bit_cast(unsigned, b); }
__device__ __forceinline__ float wave_sum(float v) {
#pragma unroll
    for (int o = 1; o < 64; o <<= 1) v += __shfl_xor(v, o);
    return v;
}
__device__ __forceinline__ float sigm(float x) { return 1.f / (1.f + __expf(-x)); }
__device__ __forceinline__ float silu(float x) { return x / (1.f + __expf(-x)); }
__device__ __forceinline__ int crow(int r, int hi) { return (r & 3) + 8 * (r >> 2) + 4 * hi; }
#define MFMA32(a, b, c) __builtin_amdgcn_mfma_f32_32x32x16_bf16((a), (b), (c), 0, 0, 0)
typedef short v4i16_t __attribute__((ext_vector_type(4)));
__device__ __forceinline__ S4 trrd(LAS const unsigned char* p) { return __builtin_bit_cast(S4, __builtin_amdgcn_ds_read_tr16_b64_v4i16((LAS v4i16_t*)p)); }
__device__ __forceinline__ unsigned offb(unsigned row, unsigned ch) { return 256u * row + 16u * (ch ^ (((row & 3) << 2) | ((row >> 2) & 3))); }
__device__ __forceinline__ unsigned offv(unsigned row, unsigned ch) { return 128u * row + 16u * (ch ^ (((row >> 1) & 1) << 2)); }

#define XB_TMO      128
#define XB_XCNT(j)  (256  + 64 * (j))
#define XB_XSUB(j)  (1280 + 64 * (j))
#define XB_XGEN(j)  (2304 + 64 * (j))
#define XB_TOP      3328
#define XB_TOPGEN   3392
#define XCD_BAR_WORDS 3456
#define XB_SPIN_CAP (1u << 18)

__device__ __forceinline__ unsigned xb_ld(unsigned* p)              { return __hip_atomic_load(p, __ATOMIC_RELAXED, __HIP_MEMORY_SCOPE_AGENT); }
__device__ __forceinline__ unsigned xb_add(unsigned* p, unsigned v) { return __hip_atomic_fetch_add(p, v, __ATOMIC_RELAXED, __HIP_MEMORY_SCOPE_AGENT); }
__device__ __forceinline__ unsigned xb_xcc_id() { return (unsigned)__builtin_amdgcn_s_getreg((3 << 11) | 20) & 0xFu; }
#define XB_SPIN(cond, bar) do { unsigned _sp = 0; while (cond) { __builtin_amdgcn_s_sleep(1); \
    if ((++_sp & 255u) == 0u) { if (xb_ld(&(bar)[XB_TMO])) break; if (_sp > XB_SPIN_CAP) { atomicAdd(&(bar)[XB_TMO], 1u); break; } } } } while (0)

struct XcdBarrier {
    unsigned* bar; unsigned x;
    volatile LAS unsigned* st;
};

__device__ __forceinline__ XcdBarrier xcd_barrier_post(unsigned* bar, volatile LAS unsigned* st) {
    XcdBarrier b; b.bar = bar; b.x = xb_xcc_id(); b.st = st;
    if (threadIdx.x == 0) (void)xb_add(&bar[XB_XCNT(b.x)], 1u);
    return b;
}
__device__ __forceinline__ void xcd_barrier_complete(unsigned* bar, unsigned x, unsigned& nloc, unsigned& nx) {
    const unsigned G = gridDim.x * gridDim.y * gridDim.z;
    unsigned sum, cnt, mine, sp = 0u;
    for (;;) {
        sum = 0u; cnt = 0u; mine = 0u;
#pragma unroll
        for (unsigned j = 0; j < 16; ++j) { const unsigned c = xb_ld(&bar[XB_XCNT(j)]); sum += c; cnt += (c > 0u) ? 1u : 0u; mine = (j == x) ? c : mine; }
        if (sum == G) break;
        __builtin_amdgcn_s_sleep(1);
        if ((++sp & 255u) == 0u) { if (xb_ld(&bar[XB_TMO])) break; if (sp > XB_SPIN_CAP) { atomicAdd(&bar[XB_TMO], 1u); break; } }
    }
    nloc = mine > 0u ? mine : 1u; nx = cnt > 0u ? cnt : 1u;
}

__device__ __forceinline__ void xcd_barrier(const XcdBarrier& b) {
    asm volatile("s_waitcnt vmcnt(0)" ::: "memory");
    __syncthreads();
    if (threadIdx.x == 0) {
        unsigned* bar = b.bar;
        __builtin_amdgcn_s_waitcnt(0);
        unsigned nloc = b.st[0], nx = b.st[1];
        if (nloc == 0u) { xcd_barrier_complete(bar, b.x, nloc, nx); b.st[0] = nloc; b.st[1] = nx; }
        const unsigned old = xb_add(&bar[XB_XSUB(b.x)], 1u);
        const unsigned gen = old / nloc;
        if (old + 1u == (gen + 1u) * nloc) {
            __builtin_amdgcn_fence(__ATOMIC_RELEASE, "agent");
            asm volatile("s_waitcnt vmcnt(0)" ::: "memory");
            const unsigned og = xb_add(&bar[XB_TOP], 1u);
            const unsigned tg = og / nx;
            if (og + 1u == (tg + 1u) * nx) xb_add(&bar[XB_TOPGEN], 1u);
            else XB_SPIN(xb_ld(&bar[XB_TOPGEN]) == tg, bar);
            __builtin_amdgcn_fence(__ATOMIC_ACQUIRE, "agent");
            xb_add(&bar[XB_XGEN(b.x)], 1u);
            asm volatile("s_waitcnt vmcnt(0)" ::: "memory");
        } else {
            XB_SPIN(xb_ld(&bar[XB_XGEN(b.x)]) == gen, bar);
            __builtin_amdgcn_fence(__ATOMIC_ACQUIRE, "agent");
            asm volatile("s_waitcnt vmcnt(0)" ::: "memory");
        }
    }
    __syncthreads();
}

namespace pg8 {
struct EpiProj {
    static constexpr bool PERM = true, AFTER_DRAIN = false;
    unsigned char* ws; unsigned char* ob;
    __device__ __forceinline__ void operator()(const f32x4 (&acc)[2][2][4][2], const Unit& u, int wr, int wc, int fr, int fq) const {
        const int pn = u.pn; bf16_t* base; int ld, ct;
        if (pn < 2)       { base = (bf16_t*)(ws + WS_RQ); ld = 512;  ct = pn; }
        else if (pn < 4)  { base = (bf16_t*)(ws + WS_RK); ld = 512;  ct = pn - 2; }
        else if (pn < 8)  { base = (bf16_t*)(ws + WS_RV); ld = 1024; ct = pn - 4; }
        else if (pn < 12) { base = (bf16_t*)(ws + WS_RG); ld = 1024; ct = pn - 8; }
        else if (pn < 14) { base = (bf16_t*)(ws + WS_MQ); ld = 512;  ct = pn - 12; }
        else if (pn < 16) { base = (bf16_t*)(ws + WS_MK); ld = 512;  ct = pn - 14; }
        else if (pn < 20) { base = (bf16_t*)(ws + WS_MV); ld = 1024; ct = pn - 16; }
        else if (pn < 24) { base = (bf16_t*)(ws + WS_MO); ld = 1024; ct = pn - 20; }
        else if (pn < 28) { base = (bf16_t*)(ob + OUT_GR); ld = 1024; ct = pn - 24; }
        else              { base = (bf16_t*)(ob + OUT_GM); ld = 1024; ct = pn - 28; }
        const int row0 = u.pm * BM + wr * 64 + fr, col0 = ct * BM + wc * 32 + 8 * fq;
#pragma unroll
        for (int ai = 0; ai < 2; ++ai)
#pragma unroll
            for (int m = 0; m < 4; ++m) { bf16_t* rowp = base + (size_t)(row0 + ai * HALF + m * 16) * ld + col0;
#pragma unroll
                for (int bj = 0; bj < 2; ++bj) { const f32x4 v0 = acc[ai][bj][m][0], v1 = acc[ai][bj][m][1];
                    u32x4 w; w.x = cvt_pk_bf16(v0[0], v0[1]); w.y = cvt_pk_bf16(v0[2], v0[3]); w.z = cvt_pk_bf16(v1[0], v1[1]); w.w = cvt_pk_bf16(v1[2], v1[3]);
                    *(u32x4*)(rowp + bj * HALF) = w; } }
    }
};
template <int MODE> struct EpiGate {
    static constexpr bool PERM = true, AFTER_DRAIN = false;
    const bf16_t* G; const bf16_t* TI; bf16_t* O;
    __device__ __forceinline__ void operator()(const f32x4 (&acc)[2][2][4][2], const Unit& u, int wr, int wc, int fr, int fq) const {
        const int row0 = u.pm * BM + wr * 64 + fr, col0 = u.pn * BM + wc * 32 + 8 * fq;
#pragma unroll
        for (int ai = 0; ai < 2; ++ai)
#pragma unroll
            for (int m = 0; m < 4; ++m) { const size_t ro = (size_t)(row0 + ai * HALF + m * 16) * 1024 + col0;
#pragma unroll
                for (int bj = 0; bj < 2; ++bj) { const f32x4 v0 = acc[ai][bj][m][0], v1 = acc[ai][bj][m][1];
                    const u32x4 g = *(const u32x4*)(G + ro + bj * HALF);
                    float r[8];
                    r[0] = v0[0] * sigm(bflo(g.x)); r[1] = v0[1] * sigm(bfhi(g.x)); r[2] = v0[2] * sigm(bflo(g.y)); r[3] = v0[3] * sigm(bfhi(g.y));
                    r[4] = v1[0] * sigm(bflo(g.z)); r[5] = v1[1] * sigm(bfhi(g.z)); r[6] = v1[2] * sigm(bflo(g.w)); r[7] = v1[3] * sigm(bfhi(g.w));
                    if (MODE == 1) { const u32x4 t = *(const u32x4*)(TI + ro + bj * HALF);
                        r[0] += bflo(t.x); r[1] += bfhi(t.x); r[2] += bflo(t.y); r[3] += bfhi(t.y); r[4] += bflo(t.z); r[5] += bfhi(t.z); r[6] += bflo(t.w); r[7] += bfhi(t.w); }
                    u32x4 w; w.x = cvt_pk_bf16(r[0], r[1]); w.y = cvt_pk_bf16(r[2], r[3]); w.z = cvt_pk_bf16(r[4], r[5]); w.w = cvt_pk_bf16(r[6], r[7]);
                    *(u32x4*)(O + ro + bj * HALF) = w; } }
    }
};
struct EpiX1 {
    static constexpr bool PERM = true, AFTER_DRAIN = false;
    const float* X; float* O;
    __device__ __forceinline__ void operator()(const f32x4 (&acc)[2][2][4][2], const Unit& u, int wr, int wc, int fr, int fq) const {
        const int row0 = u.pm * BM + wr * 64 + fr, col0 = u.pn * BM + wc * 32 + 8 * fq;
#pragma unroll
        for (int ai = 0; ai < 2; ++ai)
#pragma unroll
            for (int m = 0; m < 4; ++m) { const size_t ro = (size_t)(row0 + ai * HALF + m * 16) * 1024 + col0;
#pragma unroll
                for (int bj = 0; bj < 2; ++bj) {
                    const f32x4 a = *(const f32x4*)(X + ro + bj * HALF), b = *(const f32x4*)(X + ro + bj * HALF + 4);
                    *(f32x4*)(O + ro + bj * HALF) = a + acc[ai][bj][m][0]; *(f32x4*)(O + ro + bj * HALF + 4) = b + acc[ai][bj][m][1]; } }
    }
};
struct EpiSwiglu {
    static constexpr bool PERM = true, AFTER_DRAIN = false;
    bf16_t* O;
    __device__ __forceinline__ void operator()(const f32x4 (&acc)[2][2][4][2], const Unit& u, int wr, int wc, int fr, int fq) const {
        const int row0 = u.pm * BM + wr * 64 + fr, col0 = (u.pn & 3) * HALF + wc * 32 + 8 * fq;
#pragma unroll
        for (int ai = 0; ai < 2; ++ai)
#pragma unroll
            for (int m = 0; m < 4; ++m) { bf16_t* rowp = O + (size_t)(row0 + ai * HALF + m * 16) * 512 + col0;
                const f32x4 g0 = acc[ai][0][m][0], g1 = acc[ai][0][m][1], u0 = acc[ai][1][m][0], u1 = acc[ai][1][m][1];
                u32x4 w; w.x = cvt_pk_bf16(silu(g0[0]) * u0[0], silu(g0[1]) * u0[1]); w.y = cvt_pk_bf16(silu(g0[2]) * u0[2], silu(g0[3]) * u0[3]);
                w.z = cvt_pk_bf16(silu(g1[0]) * u1[0], silu(g1[1]) * u1[1]); w.w = cvt_pk_bf16(silu(g1[2]) * u1[2], silu(g1[3]) * u1[3]);
                *(u32x4*)rowp = w; }
    }
};
struct EpiY {
    static constexpr bool PERM = true, AFTER_DRAIN = false;
    bf16_t* O;
    __device__ __forceinline__ void operator()(const f32x4 (&acc)[2][2][4][2], const Unit& u, int wr, int wc, int fr, int fq) const {
        const int row0 = u.pm * BM + wr * 64 + fr, col0 = (u.pn & 3) * BM + wc * 32 + 8 * fq;
#pragma unroll
        for (int ai = 0; ai < 2; ++ai)
#pragma unroll
            for (int m = 0; m < 4; ++m) { bf16_t* rowp = O + (size_t)(row0 + ai * HALF + m * 16) * 1024 + col0;
#pragma unroll
                for (int bj = 0; bj < 2; ++bj) { const f32x4 v0 = acc[ai][bj][m][0], v1 = acc[ai][bj][m][1];
                    u32x4 w; w.x = cvt_pk_bf16(v0[0], v0[1]); w.y = cvt_pk_bf16(v0[2], v0[3]); w.z = cvt_pk_bf16(v1[0], v1[1]); w.w = cvt_pk_bf16(v1[2], v1[3]);
                    *(u32x4*)(rowp + bj * HALF) = w; } }
    }
};
struct GroupedOrder {
    int ntiles, G, c; const PG8_LAS unsigned char* t2e;
    __device__ __forceinline__ bool next(int i, Unit& u) const {
        const int L = i * G + c; if (L >= ntiles * 4) return false;
        const int rt = L >> 2; u.pm = rt; u.pn = __builtin_amdgcn_readfirstlane((int)t2e[rt]) * 4 + (L & 3); return true;
    }
    __device__ __forceinline__ void a_ready(const Unit&) const {}
    __device__ __forceinline__ void done(const Unit&) const {}
};
}

struct Ctx { LAS unsigned char* lds; int tid, lane, wave, vcu, G; };

__device__ __forceinline__ void transpose_item(const float* W, int ld, int k0, int n0, bf16* WT, int K, int drow0, LAS float* scr, int lane) {
#pragma unroll 8
    for (int i = 0; i < 32; ++i) { const int kk = 2 * i + (lane >> 5); scr[kk * 33 + (lane & 31)] = W[(size_t)(k0 + kk) * ld + n0 + (lane & 31)]; }
    asm volatile("s_waitcnt lgkmcnt(0)" ::: "memory");
    const int c = lane & 7;
#pragma unroll
    for (int j = 0; j < 4; ++j) { const int n = (lane >> 3) + 8 * j; const LAS float* s = scr + (8 * c) * 33 + n;
        U4 o; o.x = cvtpk(s[0 * 33], s[1 * 33]); o.y = cvtpk(s[2 * 33], s[3 * 33]); o.z = cvtpk(s[4 * 33], s[5 * 33]); o.w = cvtpk(s[6 * 33], s[7 * 33]);
        *(U4*)(WT + (size_t)(drow0 + n) * K + k0 + 8 * c) = o; }
    asm volatile("s_waitcnt lgkmcnt(0)" ::: "memory");
}

__device__ __forceinline__ void phase0(const Ctx& C, const float* const* in, unsigned char* ws) {
    const float* x = in[0]; const float* nw = in[1]; const float* w_in = in[2];
    LAS float* scr = (LAS float*)(C.lds + C.wave * 8448);
    LAS float* wif = (LAS float*)(C.lds + 98304);
    LAS double* invf = (LAS double*)(C.lds + 98304 + 32768);
    for (int i = C.tid; i < 8192; i += NTHR) wif[i] = w_in[(size_t)(i >> 3) * DIN + 6144 + (i & 7)];
    if (C.tid < 64) { double r = 1.0; for (int j = 0; j < C.tid; ++j) r *= 0.8659643233600653; invf[C.tid] = r; }
    __syncthreads();
    const int gw = C.vcu * NWAVES + C.wave, NGW = C.G * NWAVES;
    {
        bf16* H = (bf16*)(ws + WS_H); float* IFP = (float*)(ws + WS_IF);
        F4 wv[4];
#pragma unroll
        for (int j = 0; j < 4; ++j) wv[j] = *(const F4*)(nw + 4 * C.lane + 256 * j);
        for (int m = gw; m < NTOK; m += NGW) {
            const F4* xr = (const F4*)(x + (size_t)m * DM) + C.lane;
            F4 v[4]; float s = 0.f;
#pragma unroll
            for (int j = 0; j < 4; ++j) { v[j] = xr[64 * j]; s += (v[j].x * v[j].x + v[j].y * v[j].y) + (v[j].z * v[j].z + v[j].w * v[j].w); }
            const float rstd = rsqrtf(wave_sum(s) * (1.f / DM) + EPS);
            float g[8];
#pragma unroll
            for (int c = 0; c < 8; ++c) g[c] = 0.f;
            unsigned long long* o8 = (unsigned long long*)(H + (size_t)m * DM) + C.lane;
#pragma unroll
            for (int j = 0; j < 4; ++j) { v[j] = v[j] * rstd * wv[j];
                o8[64 * j] = (unsigned long long)cvtpk(v[j].x, v[j].y) | ((unsigned long long)cvtpk(v[j].z, v[j].w) << 32);
#pragma unroll
                for (int i = 0; i < 4; ++i) { const LAS F4* wp = (const LAS F4*)(wif + (4 * C.lane + 256 * j + i) * 8); const F4 wa = wp[0], wb = wp[1]; const float hv = v[j][i];
                    g[0] += hv * wa.x; g[1] += hv * wa.y; g[2] += hv * wa.z; g[3] += hv * wa.w; g[4] += hv * wb.x; g[5] += hv * wb.y; g[6] += hv * wb.z; g[7] += hv * wb.w; } }
#pragma unroll
            for (int c = 0; c < 8; ++c) g[c] = wave_sum(g[c]);
            if (C.lane == 0) { F4* op = (F4*)(IFP + (size_t)m * 8); op[0] = (F4){g[0], g[1], g[2], g[3]}; op[1] = (F4){g[4], g[5], g[6], g[7]}; }
        }
    }
    for (int it = gw; it < 4096 + 3 * 512; it += NGW) {
        if (it < 4096) { const int kb = it >> 8, nb = it & 255; transpose_item(w_in, DIN, kb * 64, nb * 32 + (nb >= 192 ? 8 : 0), (bf16*)(ws + WS_WIN), 1024, nb * 32, scr, C.lane); }
        else { int r = it - 4096; const int mth = r >> 9; r &= 511; const int kb = r >> 5, nb = r & 31;
            const float* W = mth == 0 ? in[4] : (mth == 1 ? in[10] : in[11]); bf16* dst = (bf16*)(ws + (mth == 0 ? WS_WRB : (mth == 1 ? WS_WMB : WS_WOUT)));
            transpose_item(W, 1024, kb * 64, nb * 32, dst, 1024, nb * 32, scr, C.lane); }
    }
    { F2* RT = (F2*)(ws + WS_ROPE);
        for (int idx = C.vcu * NTHR + C.tid; idx < SEQ * 64; idx += C.G * NTHR) { const int pos = idx >> 6, j = idx & 63;
            const double rev = (double)pos * invf[j] * 0.15915494309189535; const float fr = (float)(rev - __builtin_floor(rev));
            RT[idx] = (F2){__builtin_amdgcn_cosf(fr), __builtin_amdgcn_sinf(fr)}; } }
    { F4* WR = (F4*)(ws + WS_ROUT); const float* nfw = in[12]; const float* wg = in[13]; const float* we = in[15];
        for (int idx = C.vcu * NTHR + C.tid; idx < 64 * 3 * 64; idx += C.G * NTHR) { const int l = idx & 63, nt = (idx >> 6) % 3, kb = idx / 192; const int n = 16 * nt + (l & 15);
            F4 o;
#pragma unroll
            for (int j = 0; j < 4; ++j) { const int k = 16 * kb + 4 * (l >> 4) + j; float wv = 0.f; if (n < 4) wv = wg[k * 4 + n]; else if (n < 36) wv = we[k * 32 + (n - 4)]; o[j] = wv * nfw[k]; }
            WR[idx] = o; } }
}

__device__ __forceinline__ float wscan_add(float v, int lane) {
#pragma unroll
    for (int o = 1; o < 64; o <<= 1) { const float t = __shfl_up(v, o); if (lane >= o) v += t; }
    return v;
}
__device__ __forceinline__ float wscan_max(float v, int lane) {
#pragma unroll
    for (int o = 1; o < 64; o <<= 1) { const float t = __shfl_up(v, o); if (lane >= o) v = fmaxf(v, t); }
    return v;
}
__device__ __forceinline__ void phase2(const Ctx& C, const float* const* in, unsigned char* ws) {
    const float* convw = in[5]; const float* convb = in[6]; const float* b_i = in[7]; const float* b_f = in[8];
    LAS float* sQ = (LAS float*)(C.lds);
    LAS float* sK = (LAS float*)(C.lds + 2048);
    const float* IFP = (const float*)(ws + WS_IF); float* THR = (float*)(ws + WS_THR); float* CDEC = (float*)(ws + WS_CDEC);
    const F2* RT = (const F2*)(ws + WS_ROPE);
    for (int it = C.vcu; it < BATCH * NCHUNK; it += C.G) {
        const int b = it >> 6, c = it & 63; const size_t t0 = (size_t)b * SEQ + (size_t)c * CHUNK;
        __syncthreads();
        if (C.wave < 4) { const int hd = C.wave, l = C.lane;
            const float i0 = IFP[(t0 + 2 * l) * 8 + hd] + b_i[hd], i1 = IFP[(t0 + 2 * l + 1) * 8 + hd] + b_i[hd];
            const float f0 = IFP[(t0 + 2 * l) * 8 + 4 + hd] + b_f[hd], f1 = IFP[(t0 + 2 * l + 1) * 8 + 4 + hd] + b_f[hd];
            const float lf0 = fminf(f0, 0.f) - log1pf(__expf(-fabsf(f0))), lf1 = fminf(f1, 0.f) - log1pf(__expf(-fabsf(f1)));
            const float s1 = lf0 + lf1, inc = wscan_add(s1, l), ex = inc - s1;
            const float b0 = ex + lf0, b1 = ex + s1;
            const float u0 = i0 - b0, u1 = i1 - b1, p1 = fmaxf(u0, u1);
            const float pin = wscan_max(p1, l); float pex = __shfl_up(pin, 1); if (l == 0) pex = -INFINITY;
            const float pm0 = fmaxf(pex, u0), pm1 = fmaxf(pex, p1);
            sQ[hd * 128 + 2 * l] = __expf(-pm0); sQ[hd * 128 + 2 * l + 1] = __expf(-pm1);
            sK[hd * 128 + 2 * l] = __expf(u0) * 0.08838834764831845f; sK[hd * 128 + 2 * l + 1] = __expf(u1) * 0.08838834764831845f;
            THR[(t0 + 2 * l) * 4 + hd] = __expf(-b0 - pm0); THR[(t0 + 2 * l + 1) * 4 + hd] = __expf(-b1 - pm1);
            if (l == 63) CDEC[(size_t)it * 4 + hd] = __expf(b1);
        }
        __syncthreads();
        for (int u = C.tid; u < 2 * 4096; u += NTHR) {
            const int arr = u >> 12, g = u & 7, row = (u >> 3) & 127, hd = (u >> 10) & 3;
            bf16* base = (bf16*)(ws + (arr ? WS_RK : WS_RQ)) + (t0 + row) * 512 + hd * 128 + 8 * g;
            const U4 a = *(const U4*)base, bb = *(const U4*)(base + 64);
            const float lg = hd == 0 ? -0.04580368961312479f : (hd == 1 ? -0.02272007650008353f : (hd == 2 ? -0.011315313227834146f : -0.005646563141142063f));
            const float sc = arr ? exp2f(-lg * (float)row) * 0.08838834764831845f : exp2f(lg * (float)row);
            const F2* rt = RT + (size_t)(c * CHUNK + row) * 64 + 8 * g;
            float x1[8], x2[8], y1[8], y2[8];
            x1[0] = bflo(a.x); x1[1] = bfhi(a.x); x1[2] = bflo(a.y); x1[3] = bfhi(a.y); x1[4] = bflo(a.z); x1[5] = bfhi(a.z); x1[6] = bflo(a.w); x1[7] = bfhi(a.w);
            x2[0] = bflo(bb.x); x2[1] = bfhi(bb.x); x2[2] = bflo(bb.y); x2[3] = bfhi(bb.y); x2[4] = bflo(bb.z); x2[5] = bfhi(bb.z); x2[6] = bflo(bb.w); x2[7] = bfhi(bb.w);
#pragma unroll
            for (int i = 0; i < 8; ++i) { const F2 cs = rt[i]; y1[i] = (x1[i] * cs.x - x2[i] * cs.y) * sc; y2[i] = (x2[i] * cs.x + x1[i] * cs.y) * sc; }
            U4 o1, o2; o1.x = cvtpk(y1[0], y1[1]); o1.y = cvtpk(y1[2], y1[3]); o1.z = cvtpk(y1[4], y1[5]); o1.w = cvtpk(y1[6], y1[7]);
            o2.x = cvtpk(y2[0], y2[1]); o2.y = cvtpk(y2[2], y2[3]); o2.z = cvtpk(y2[4], y2[5]); o2.w = cvtpk(y2[6], y2[7]);
            *(U4*)base = o1; *(U4*)(base + 64) = o2;
        }
        for (int u = C.tid; u < 2 * 8192; u += NTHR) {
            const int arr = u >> 13, g = u & 63, row = (u >> 6) & 127, hd = g >> 4;
            const bf16* src = (const bf16*)(ws + (arr ? WS_MK : WS_MQ)) + (t0 + row) * 512 + 8 * g;
            const int chn = arr * 512 + 8 * g;
            float y[8];
            { const F4 b0 = *(const F4*)(convb + chn), b1 = *(const F4*)(convb + chn + 4); y[0] = b0.x; y[1] = b0.y; y[2] = b0.z; y[3] = b0.w; y[4] = b1.x; y[5] = b1.y; y[6] = b1.z; y[7] = b1.w; }
#pragma unroll
            for (int w = 0; w < 4; ++w) { const int back = 3 - w;
                if (c * CHUNK + row - back >= 0) { const U4 a = *(const U4*)(src - (size_t)back * 512);
                    const F4 w0 = *(const F4*)(convw + w * 1024 + chn), w1 = *(const F4*)(convw + w * 1024 + chn + 4);
                    y[0] += bflo(a.x) * w0.x; y[1] += bfhi(a.x) * w0.y; y[2] += bflo(a.y) * w0.z; y[3] += bfhi(a.y) * w0.w;
                    y[4] += bflo(a.z) * w1.x; y[5] += bfhi(a.z) * w1.y; y[6] += bflo(a.w) * w1.z; y[7] += bfhi(a.w) * w1.w; } }
            const float sc = arr ? sK[hd * 128 + row] : sQ[hd * 128 + row];
#pragma unroll
            for (int i = 0; i < 8; ++i) y[i] = silu(y[i]) * sc;
            U4 o; o.x = cvtpk(y[0], y[1]); o.y = cvtpk(y[2], y[3]); o.z = cvtpk(y[4], y[5]); o.w = cvtpk(y[6], y[7]);
            *(U4*)((bf16*)(ws + (arr ? WS_MKP : WS_MQP)) + (t0 + row) * 512 + 8 * g) = o;
        }
    }
}

template <bool ML>
__device__ __forceinline__ void mixer_item(const Ctx& C, const bf16* Qp, const bf16* Kp, bf16* Vp, bf16* Vout, size_t omask, const float* thr, const float* cdec, int b, int hd, int sl) {
    LAS unsigned char* lds = C.lds;
    const int tid = C.tid, lane = C.lane, w = C.wave, l31 = lane & 31, hi = lane >> 5;
    const int lt = (w < 4) ? w : 7 - w, et = w >> 2, dt = w & 3;
    const int q_ = (lane & 15) >> 2, p_ = lane & 3, blk = (lane >> 4) & 1;
    constexpr unsigned KOFF = 0, VOFF = 65536, SOFF = 98304, NOFF = 131072;
    const size_t tok0 = (size_t)b * SEQ;
    const float rdec = hd == 0 ? 0.017183023570817902f : (hd == 1 ? 0.1332151628796484f : (hd == 2 ? 0.3664377159220373f : 0.6059370882290803f));
    __syncthreads();
    for (int i = tid; i < (2 * 16384 + 1024) / 16; i += NTHR) *(LAS U4*)(lds + SOFF + 16 * i) = (U4){0u, 0u, 0u, 0u};
    F16 St;
#pragma unroll
    for (int r = 0; r < 16; ++r) St[r] = 0.f;
    B8 qf[8];
    unsigned ksrc[4], vsrc[2];
#pragma unroll
    for (int i = 0; i < 4; ++i) { const unsigned R = (w * 4 + i) * 4 + (lane >> 4), pc = lane & 15, ch = pc ^ (((R & 3) << 2) | ((R >> 2) & 3)); ksrc[i] = R * 512 + ch * 8; }
#pragma unroll
    for (int i = 0; i < 2; ++i) { const unsigned R = (w * 2 + i) * 8 + (lane >> 3), pc = lane & 7, ch = pc ^ (((R >> 1) & 1) << 2); vsrc[i] = R * 1024 + ch * 8; }
#define MX_DMA(cc, buf) do { \
        const bf16* kp_ = Kp + (tok0 + (size_t)(cc) * CHUNK) * 512 + hd * 128; \
        _Pragma("unroll") for (int i = 0; i < 4; ++i) __builtin_amdgcn_global_load_lds((const unsigned*)(kp_ + ksrc[i]), (LAS unsigned*)(lds + KOFF + (buf) * 32768 + (w * 4 + i) * 1024), 16, 0, 0); \
        const bf16* vp_ = Vp + (tok0 + (size_t)(cc) * CHUNK) * 1024 + hd * 256 + sl * 64; \
        _Pragma("unroll") for (int i = 0; i < 2; ++i) __builtin_amdgcn_global_load_lds((const unsigned*)(vp_ + vsrc[i]), (LAS unsigned*)(lds + VOFF + (buf) * 16384 + (w * 2 + i) * 1024), 16, 0, 0); \
        } while (0)
#define MX_LOADQ(cc) do { \
        const bf16* qp_ = Qp + (tok0 + (size_t)(cc) * CHUNK + 32 * lt + l31) * 512 + hd * 128 + 8 * hi; \
        _Pragma("unroll") for (int s = 0; s < 8; ++s) qf[s] = *(const B8*)(qp_ + 16 * s); } while (0)
    MX_DMA(0, 0);
    MX_LOADQ(0);
    __syncthreads();
    for (int c = 0; c < NCHUNK; ++c) {
        const int cur = c & 1, nxt = cur ^ 1;
        if (c + 1 < NCHUNK) MX_DMA(c + 1, nxt);
        const unsigned KB = KOFF + cur * 32768, VB = VOFF + cur * 16384;
        const float decay = ML ? cdec[((size_t)b * NCHUNK + c) * 4 + hd] : rdec;
        F16 o;
#pragma unroll
        for (int r = 0; r < 16; ++r) o[r] = 0.f;
#pragma unroll
        for (int s = 0; s < 8; ++s) { const B8 a = *(const LAS B8*)(lds + SOFF + cur * 16384 + offb(32 * et + l31, 2 * s + hi)); o = MFMA32(a, qf[s], o); }
        float csum = 0.f;
        for (int jt = 0; jt <= lt; ++jt) {
            F16 st;
#pragma unroll
            for (int r = 0; r < 16; ++r) st[r] = 0.f;
#pragma unroll
            for (int s = 0; s < 8; ++s) { const B8 a = *(const LAS B8*)(lds + KB + offb(32 * jt + l31, 2 * s + hi)); st = MFMA32(a, qf[s], st); }
            if (jt == lt) {
#pragma unroll
                for (int r = 0; r < 16; ++r) if (crow(r, hi) > l31) st[r] = 0.f;
            }
            if (ML) {
#pragma unroll
                for (int r = 0; r < 16; ++r) csum += st[r];
            }
#pragma unroll
            for (int s2 = 0; s2 < 2; ++s2) {
                U4 pk; pk.x = cvtpk(st[8 * s2 + 0], st[8 * s2 + 1]); pk.y = cvtpk(st[8 * s2 + 2], st[8 * s2 + 3]); pk.z = cvtpk(st[8 * s2 + 4], st[8 * s2 + 5]); pk.w = cvtpk(st[8 * s2 + 6], st[8 * s2 + 7]);
                const B8 bfr = __builtin_bit_cast(B8, pk);
                const unsigned R0 = 32 * jt + 16 * s2 + 4 * hi + q_, chv = 4 * et + 2 * blk + (p_ >> 1);
                const S4 lo = trrd(lds + VB + offv(R0, chv) + 8 * (p_ & 1));
                const S4 h4 = trrd(lds + VB + offv(R0 + 8, chv) + 8 * (p_ & 1));
                const B8 afr = __builtin_shufflevector(lo, h4, 0, 1, 2, 3, 4, 5, 6, 7);
                o = MFMA32(afr, bfr, o);
            }
        }
        if (ML) {
            csum += __shfl_xor(csum, 32);
            const LAS float* nv = (const LAS float*)(lds + NOFF + cur * 512);
            float qd = 0.f;
#pragma unroll
            for (int s = 0; s < 8; ++s) { const F4 n0 = *(const LAS F4*)(nv + 16 * s + 8 * hi), n1 = *(const LAS F4*)(nv + 16 * s + 8 * hi + 4);
                qd += bf2f(qf[s][0]) * n0.x + bf2f(qf[s][1]) * n0.y + bf2f(qf[s][2]) * n0.z + bf2f(qf[s][3]) * n0.w
                    + bf2f(qf[s][4]) * n1.x + bf2f(qf[s][5]) * n1.y + bf2f(qf[s][6]) * n1.z + bf2f(qf[s][7]) * n1.w; }
            qd += __shfl_xor(qd, 32);
            const float den = csum + qd, th = thr[(tok0 + (size_t)c * CHUNK + 32 * lt + l31) * 4 + hd];
            const float sc = 1.f / fmaxf(fabsf(den), th);
#pragma unroll
            for (int r = 0; r < 16; ++r) o[r] *= sc;
        }
        { bf16* op = Vout + ((tok0 + (size_t)c * CHUNK + 32 * lt + l31) & omask) * 1024 + hd * 256 + sl * 64 + 32 * et + 4 * hi;
#pragma unroll
            for (int g = 0; g < 4; ++g) { U2 pk; pk.x = cvtpk(o[4 * g], o[4 * g + 1]); pk.y = cvtpk(o[4 * g + 2], o[4 * g + 3]); *(U2*)(op + 8 * g) = pk; } }
        if (c + 1 < NCHUNK) MX_LOADQ(c + 1);
        float ksum = 0.f;
#pragma unroll
        for (int ks = 0; ks < 8; ++ks) {
            const unsigned R0 = 16 * ks + 8 * hi + q_, chk = 4 * dt + 2 * blk + (p_ >> 1), chv = 4 * et + 2 * blk + (p_ >> 1);
            const S4 alo = trrd(lds + KB + offb(R0, chk) + 8 * (p_ & 1)), ahi = trrd(lds + KB + offb(R0 + 4, chk) + 8 * (p_ & 1));
            const S4 blo = trrd(lds + VB + offv(R0, chv) + 8 * (p_ & 1)), bhi = trrd(lds + VB + offv(R0 + 4, chv) + 8 * (p_ & 1));
            const B8 afr = __builtin_shufflevector(alo, ahi, 0, 1, 2, 3, 4, 5, 6, 7), bfr = __builtin_shufflevector(blo, bhi, 0, 1, 2, 3, 4, 5, 6, 7);
            St = MFMA32(afr, bfr, St);
            if (ML) ksum += (bf2f(afr[0]) + bf2f(afr[1])) + (bf2f(afr[2]) + bf2f(afr[3])) + (bf2f(afr[4]) + bf2f(afr[5])) + (bf2f(afr[6]) + bf2f(afr[7]));
        }
#pragma unroll
        for (int r = 0; r < 16; ++r) St[r] *= decay;
#pragma unroll
        for (int g = 0; g < 4; ++g) { U2 pk; pk.x = cvtpk(St[4 * g], St[4 * g + 1]); pk.y = cvtpk(St[4 * g + 2], St[4 * g + 3]);
            *(LAS U2*)(lds + SOFF + nxt * 16384 + offb(32 * et + l31, 4 * dt + g) + 8 * hi) = pk; }
        if (ML) { ksum += __shfl_xor(ksum, 32);
            if (et == 0 && hi == 0) { const LAS float* nv = (const LAS float*)(lds + NOFF + cur * 512); LAS float* nn = (LAS float*)(lds + NOFF + nxt * 512);
                nn[32 * dt + l31] = decay * (nv[32 * dt + l31] + ksum); } }
        __syncthreads();
    }
#undef MX_DMA
#undef MX_LOADQ
}
__device__ __forceinline__ void phase3(const Ctx& C, unsigned char* ws, bool dry) {
    for (int it = C.vcu; it < 256; it += C.G) {
        const int mix = it >> 7, b = (it >> 4) & 7, hd = (it >> 2) & 3, sl = it & 3;
        bf16* vr = (bf16*)(ws + WS_RV); bf16* vm = (bf16*)(ws + WS_MV); bf16* dump = (bf16*)(ws + 930 * MiB);
        if (mix == 0) mixer_item<false>(C, (const bf16*)(ws + WS_RQ), (const bf16*)(ws + WS_RK), vr, dry ? dump : vr, dry ? (size_t)0x7fff : ~(size_t)0, nullptr, nullptr, b, hd, sl);
        else mixer_item<true>(C, (const bf16*)(ws + WS_MQP), (const bf16*)(ws + WS_MKP), vm, dry ? dump : vm, dry ? (size_t)0x7fff : ~(size_t)0, (const float*)(ws + WS_THR), (const float*)(ws + WS_CDEC), b, hd, sl);
    }
}

__device__ __forceinline__ void phase4(const Ctx& C, const float* const* in, unsigned char* ws) {
    const float* rgn = in[3]; const float* mgn = in[9];
    const int gw = C.vcu * NWAVES + C.wave, NGW = C.G * NWAVES;
    const int col = (C.lane >> 4) * 256 + (C.lane & 15) * 16;
    float gr[16], gm[16];
#pragma unroll
    for (int i = 0; i < 4; ++i) { const F4 a = *(const F4*)(rgn + col + 4 * i), bq = *(const F4*)(mgn + col + 4 * i);
        gr[4 * i] = a.x; gr[4 * i + 1] = a.y; gr[4 * i + 2] = a.z; gr[4 * i + 3] = a.w; gm[4 * i] = bq.x; gm[4 * i + 1] = bq.y; gm[4 * i + 2] = bq.z; gm[4 * i + 3] = bq.w; }
    for (int m = gw; m < NTOK; m += NGW) {
#pragma unroll
        for (int mx = 0; mx < 2; ++mx) {
            bf16* op = (bf16*)(ws + (mx ? WS_MV : WS_RV)) + (size_t)m * 1024 + col;
            const bf16* gp = (const bf16*)(ws + (mx ? WS_MO : WS_RG)) + (size_t)m * 1024 + col;
            const U4 o0 = *(const U4*)op, o1 = *(const U4*)(op + 8), g0 = *(const U4*)gp, g1 = *(const U4*)(gp + 8);
            float v[16], g[16];
            v[0] = bflo(o0.x); v[1] = bfhi(o0.x); v[2] = bflo(o0.y); v[3] = bfhi(o0.y); v[4] = bflo(o0.z); v[5] = bfhi(o0.z); v[6] = bflo(o0.w); v[7] = bfhi(o0.w);
            v[8] = bflo(o1.x); v[9] = bfhi(o1.x); v[10] = bflo(o1.y); v[11] = bfhi(o1.y); v[12] = bflo(o1.z); v[13] = bfhi(o1.z); v[14] = bflo(o1.w); v[15] = bfhi(o1.w);
            g[0] = bflo(g0.x); g[1] = bfhi(g0.x); g[2] = bflo(g0.y); g[3] = bfhi(g0.y); g[4] = bflo(g0.z); g[5] = bfhi(g0.z); g[6] = bflo(g0.w); g[7] = bfhi(g0.w);
            g[8] = bflo(g1.x); g[9] = bfhi(g1.x); g[10] = bflo(g1.y); g[11] = bfhi(g1.y); g[12] = bflo(g1.z); g[13] = bfhi(g1.z); g[14] = bflo(g1.w); g[15] = bfhi(g1.w);
            if (mx) {
#pragma unroll
                for (int i = 0; i < 16; ++i) v[i] *= sigm(g[i]);
            }
            float ss = 0.f;
#pragma unroll
            for (int i = 0; i < 16; ++i) ss += v[i] * v[i];
            ss += __shfl_xor(ss, 1); ss += __shfl_xor(ss, 2); ss += __shfl_xor(ss, 4); ss += __shfl_xor(ss, 8);
            const float r = rsqrtf(ss * (1.f / 256.f) + EPS);
            float y[16];
#pragma unroll
            for (int i = 0; i < 16; ++i) y[i] = mx ? v[i] * r * gm[i] : v[i] * r * gr[i] * silu(g[i]);
            U4 w0, w1; w0.x = cvtpk(y[0], y[1]); w0.y = cvtpk(y[2], y[3]); w0.z = cvtpk(y[4], y[5]); w0.w = cvtpk(y[6], y[7]);
            w1.x = cvtpk(y[8], y[9]); w1.y = cvtpk(y[10], y[11]); w1.z = cvtpk(y[12], y[13]); w1.w = cvtpk(y[14], y[15]);
            *(U4*)op = w0; *(U4*)(op + 8) = w1;
        }
    }
    LAS float* scr = (LAS float*)(C.lds + C.wave * 8448);
    const float* wgate = in[17]; const float* wup = in[18]; const float* wdn = in[19];
    for (int it = gw; it < 16384 + 8192; it += NGW) {
        if (it < 16384) { const int e = it >> 9, kb = (it >> 5) & 15, nb = it & 31; const int R0 = nb * 32, tile = R0 >> 8, within = R0 & 255;
            const float* W = (within < 128 ? wgate : wup) + (size_t)e * 1024 * 512;
            transpose_item(W, 512, kb * 64, tile * 128 + (within & 127), (bf16*)(ws + WS_WGU), 1024, e * 1024 + R0, scr, C.lane); }
        else { const int r = it - 16384; const int e = r >> 8, kb = (r >> 5) & 7, nb = r & 31;
            transpose_item(wdn + (size_t)e * 512 * 1024, 1024, kb * 64, nb * 32, (bf16*)(ws + WS_WD), 512, e * 1024 + nb * 32, scr, C.lane); }
    }
}

__device__ __forceinline__ void phase8(const Ctx& C, const float* const* in, const float* x1, unsigned char* ws) {
    const float* bg = in[14]; const float* be = in[16];
    const F4* WR = (const F4*)(ws + WS_ROUT); TokInfo* TI = (TokInfo*)(ws + WS_TOK); unsigned* gcnt = (unsigned*)(ws + WS_CTL);
    LAS float* scr = (LAS float*)(C.lds + C.wave * 4096);
    LAS unsigned* lcnt = (LAS unsigned*)(C.lds + 65536);
    LAS unsigned* lbase = (LAS unsigned*)(C.lds + 65536 + 128);
    const int l = C.lane, l15 = l & 15, kk = l >> 4;
    for (int blkid = C.vcu; blkid < NTOK / 256; blkid += C.G) {
        __syncthreads();
        if (C.tid < 32) lcnt[C.tid] = 0u;
        __syncthreads();
        int e0[2], e1[2]; float w0[2], w1[2], rs[2]; unsigned rk0[2], rk1[2];
#pragma unroll
        for (int tt = 0; tt < 2; ++tt) {
            const int row0 = blkid * 256 + C.wave * 32 + tt * 16;
            F4 acc[3]; for (int n = 0; n < 3; ++n) acc[n] = (F4){0.f, 0.f, 0.f, 0.f};
            float ss = 0.f;
            const float* xr = x1 + (size_t)(row0 + l15) * DM + 4 * kk;
#pragma unroll 4
            for (int kb = 0; kb < 64; ++kb) {
                const F4 a = *(const F4*)(xr + 16 * kb);
                const F4 b0 = WR[(kb * 3 + 0) * 64 + l], b1 = WR[(kb * 3 + 1) * 64 + l], b2 = WR[(kb * 3 + 2) * 64 + l];
                ss += (a.x * a.x + a.y * a.y) + (a.z * a.z + a.w * a.w);
#pragma unroll
                for (int j = 0; j < 4; ++j) {
                    acc[0] = __builtin_amdgcn_mfma_f32_16x16x4f32(a[j], b0[j], acc[0], 0, 0, 0);
                    acc[1] = __builtin_amdgcn_mfma_f32_16x16x4f32(a[j], b1[j], acc[1], 0, 0, 0);
                    acc[2] = __builtin_amdgcn_mfma_f32_16x16x4f32(a[j], b2[j], acc[2], 0, 0, 0); }
            }
            ss += __shfl_xor(ss, 16); ss += __shfl_xor(ss, 32);
            const float rstd = rsqrtf(ss * (1.f / DM) + EPS);
#pragma unroll
            for (int n = 0; n < 3; ++n)
#pragma unroll
                for (int r = 0; r < 4; ++r) scr[(4 * kk + r) * 49 + 16 * n + l15] = acc[n][r];
            if (kk == 0) scr[16 * 49 + l15] = rstd;
            asm volatile("s_waitcnt lgkmcnt(0)" ::: "memory");
            e0[tt] = 0; e1[tt] = 0; w0[tt] = 0.f; w1[tt] = 0.f; rs[tt] = 0.f; rk0[tt] = 0u; rk1[tt] = 0u;
            if (l < 16) {
                const LAS float* lr = scr + l * 49; const float rr = scr[16 * 49 + l];
                float g0 = lr[0] * rr + bg[0], g1 = lr[1] * rr + bg[1], g2 = lr[2] * rr + bg[2], g3 = lr[3] * rr + bg[3];
                int gi = 0; float gmx = g0; if (g1 > gmx) { gmx = g1; gi = 1; } if (g2 > gmx) { gmx = g2; gi = 2; } if (g3 > gmx) { gmx = g3; gi = 3; }
                const float gw = 1.f / (__expf(g0 - gmx) + __expf(g1 - gmx) + __expf(g2 - gmx) + __expf(g3 - gmx));
                float m1 = -INFINITY, m2 = -INFINITY; int i1 = 0, i2 = 0;
#pragma unroll
                for (int i = 0; i < 8; ++i) { const float v = lr[4 + gi * 8 + i] * rr + be[gi * 8 + i];
                    if (v > m1) { m2 = m1; i2 = i1; m1 = v; i1 = i; } else if (v > m2) { m2 = v; i2 = i; } }
                const float ex = __expf(m2 - m1), wa = 1.f / (1.f + ex);
                e0[tt] = gi * 8 + i1; e1[tt] = gi * 8 + i2; w0[tt] = gw * wa; w1[tt] = gw * ex * wa; rs[tt] = rr;
                rk0[tt] = atomicAdd((unsigned*)(lcnt + e0[tt]), 1u); rk1[tt] = atomicAdd((unsigned*)(lcnt + e1[tt]), 1u);
            }
            asm volatile("s_waitcnt lgkmcnt(0)" ::: "memory");
        }
        __syncthreads();
        if (C.tid < 32) lbase[C.tid] = atomicAdd(gcnt + C.tid, lcnt[C.tid]);
        __syncthreads();
#pragma unroll
        for (int tt = 0; tt < 2; ++tt) if (l < 16) {
            TokInfo ti; ti.e0 = e0[tt]; ti.p0 = (int)(lbase[e0[tt]] + rk0[tt]); ti.e1 = e1[tt]; ti.p1 = (int)(lbase[e1[tt]] + rk1[tt]); ti.w0 = w0[tt]; ti.w1 = w1[tt]; ti.rstd = rs[tt]; ti.pad = 0.f;
            TI[blkid * 256 + C.wave * 32 + tt * 16 + l] = ti; }
    }
}

__device__ __forceinline__ int build_rowbase(const Ctx& C, unsigned char* ws) {
    LAS int* rb = (LAS int*)(C.lds + LDS_MISC);
    LAS unsigned char* t2e = (LAS unsigned char*)(C.lds + LDS_MISC + 256);
    const unsigned* gcnt = (const unsigned*)(ws + WS_CTL);
    __syncthreads();
    if (C.tid == 0) { int acc = 0; for (int e = 0; e < NEXP; ++e) { rb[e] = acc; const int n = (int)__hip_atomic_load(gcnt + e, __ATOMIC_RELAXED, __HIP_MEMORY_SCOPE_AGENT); acc += (n + 255) & ~255; } rb[NEXP] = acc; }
    __syncthreads();
    for (int e = C.tid >> 4; e < NEXP; e += NTHR >> 4) for (int t = (rb[e] >> 8) + (C.tid & 15); t < (rb[e + 1] >> 8); t += 16) t2e[t] = (unsigned char)e;
    __syncthreads();
    return rb[NEXP] >> 8;
}

__device__ __forceinline__ void phase9(const Ctx& C, const float* const* in, const float* x1, unsigned char* ws) {
    (void)build_rowbase(C, ws);
    const LAS int* rb = (const LAS int*)(C.lds + LDS_MISC);
    const float* nfw = in[12]; const TokInfo* TI = (const TokInfo*)(ws + WS_TOK); bf16* XS = (bf16*)(ws + WS_XS);
    const int gw = C.vcu * NWAVES + C.wave, NGW = C.G * NWAVES;
    F4 wv[4];
#pragma unroll
    for (int j = 0; j < 4; ++j) wv[j] = *(const F4*)(nfw + 4 * C.lane + 256 * j);
    for (int m = gw; m < NTOK; m += NGW) {
        const TokInfo ti = TI[m];
        const F4* xr = (const F4*)(x1 + (size_t)m * DM) + C.lane;
        unsigned long long* d0 = (unsigned long long*)(XS + (size_t)(rb[ti.e0] + ti.p0) * DM) + C.lane;
        unsigned long long* d1 = (unsigned long long*)(XS + (size_t)(rb[ti.e1] + ti.p1) * DM) + C.lane;
#pragma unroll
        for (int j = 0; j < 4; ++j) { const F4 v = xr[64 * j] * ti.rstd * wv[j];
            const unsigned long long pk = (unsigned long long)cvtpk(v.x, v.y) | ((unsigned long long)cvtpk(v.z, v.w) << 32);
            d0[64 * j] = pk; d1[64 * j] = pk; }
    }
}

__device__ __forceinline__ void phase12(const Ctx& C, const float* const* in, float* xo, unsigned char* ws) {
    (void)build_rowbase(C, ws);
    const LAS int* rb = (const LAS int*)(C.lds + LDS_MISC);
    const float* fw = in[20]; const TokInfo* TI = (const TokInfo*)(ws + WS_TOK); const bf16* Y = (const bf16*)(ws + WS_Y);
    const int gw = C.vcu * NWAVES + C.wave, NGW = C.G * NWAVES;
    F4 wv[4];
#pragma unroll
    for (int j = 0; j < 4; ++j) wv[j] = *(const F4*)(fw + 4 * C.lane + 256 * j);
    for (int m = gw; m < NTOK; m += NGW) {
        const TokInfo ti = TI[m];
        F4* xr = (F4*)(xo + (size_t)m * DM) + C.lane;
        const U2* y0 = (const U2*)(Y + (size_t)(rb[ti.e0] + ti.p0) * DM) + C.lane;
        const U2* y1 = (const U2*)(Y + (size_t)(rb[ti.e1] + ti.p1) * DM) + C.lane;
        F4 v[4]; float s = 0.f;
#pragma unroll
        for (int j = 0; j < 4; ++j) { const U2 a = y0[64 * j], bq = y1[64 * j]; v[j] = xr[64 * j];
            v[j].x += ti.w0 * bflo(a.x) + ti.w1 * bflo(bq.x); v[j].y += ti.w0 * bfhi(a.x) + ti.w1 * bfhi(bq.x);
            v[j].z += ti.w0 * bflo(a.y) + ti.w1 * bflo(bq.y); v[j].w += ti.w0 * bfhi(a.y) + ti.w1 * bfhi(bq.y);
            s += (v[j].x * v[j].x + v[j].y * v[j].y) + (v[j].z * v[j].z + v[j].w * v[j].w); }
        const float rstd = rsqrtf(wave_sum(s) * (1.f / DM) + EPS);
#pragma unroll
        for (int j = 0; j < 4; ++j) xr[64 * j] = v[j] * rstd * wv[j];
    }
}

constexpr int NPHASE = 13;
struct Args { const float* in[21]; float* out; unsigned char* ws; int ph_lo, ph_hi; };
__global__ void __launch_bounds__(NTHR, 2) fwd_kernel(Args args) {
    extern __shared__ __attribute__((aligned(16))) unsigned char lds_raw[];
    cg::grid_group grid = cg::this_grid();
    Ctx C; C.lds = (LAS unsigned char*)lds_raw; C.tid = threadIdx.x; C.lane = C.tid & 63; C.wave = __builtin_amdgcn_readfirstlane(C.tid >> 6);
    C.G = gridDim.x; { const int bx = blockIdx.x; C.vcu = (C.G % 8 == 0) ? (bx % 8) * (C.G / 8) + bx / 8 : bx; }
    unsigned char* ws = args.ws; unsigned char* ob = (unsigned char*)args.out;
    const int lo = args.ph_lo, hi = args.ph_hi;
#ifndef PHMASK
#define PHMASK 0x1fff
#endif
#define IN(k) (((PHMASK >> (k)) & 1) && lo <= (k) && (k) < hi)
    if (C.tid < 2) ((LAS unsigned*)(C.lds + LDS_MISC + 8192))[C.tid] = 0u;
    __syncthreads();
    const XcdBarrier bar = xcd_barrier_post((unsigned*)(ws + WS_CTL) + CW_BAR, (volatile LAS unsigned*)(C.lds + LDS_MISC + 8192));
#define SEAM(k) do { if (IN(k) && IN((k) + 1)) { if ((k) == 0) grid.sync(); else xcd_barrier(bar); } } while (0)
#ifndef DUP_MASK
#define DUP_MASK 0
#endif
#define REP(k) for (int rep_ = 0; rep_ < (((DUP_MASK >> (k)) & 1) ? 2 : 1); ++rep_)
    if (IN(0)) { REP(0) phase0(C, args.in, ws); } SEAM(0);
    if (IN(1)) { pg8::Gemm g{(const pg8::bf16_t*)(ws + WS_H), (const pg8::bf16_t*)(ws + WS_WIN), NTOK, NPROJ, DM}; pg8::StaticOrder S; S.init(NTOK, NPROJ, C.G, (int)blockIdx.x);
        pg8::EpiProj E{ws, ob}; REP(1) pg8::gemm_phase<pg8::EpiProj, pg8::StaticOrder, true, true>(C.lds, g, S, E); } SEAM(1);
    if (IN(2)) { phase2(C, args.in, ws); } SEAM(2);
    if (IN(3)) { if ((DUP_MASK >> 3) & 1) phase3(C, ws, true); phase3(C, ws, false); } SEAM(3);
    if (IN(4)) { phase4(C, args.in, ws); } SEAM(4);
    if (IN(5)) { pg8::Gemm g{(const pg8::bf16_t*)(ws + WS_RV), (const pg8::bf16_t*)(ws + WS_WRB), NTOK, DM, DM}; pg8::StaticOrder S; S.init(NTOK, DM, C.G, (int)blockIdx.x);
        pg8::EpiGate<0> E{(const pg8::bf16_t*)(ob + OUT_GR), nullptr, (pg8::bf16_t*)(ws + WS_TMP)}; REP(5) pg8::gemm_phase<pg8::EpiGate<0>, pg8::StaticOrder, true, true>(C.lds, g, S, E); } SEAM(5);
    if (IN(6)) { pg8::Gemm g{(const pg8::bf16_t*)(ws + WS_MV), (const pg8::bf16_t*)(ws + WS_WMB), NTOK, DM, DM}; pg8::StaticOrder S; S.init(NTOK, DM, C.G, (int)blockIdx.x);
        pg8::EpiGate<1> E{(const pg8::bf16_t*)(ob + OUT_GM), (const pg8::bf16_t*)(ws + WS_TMP), (pg8::bf16_t*)(ws + WS_MERGED)}; REP(6) pg8::gemm_phase<pg8::EpiGate<1>, pg8::StaticOrder, true, true>(C.lds, g, S, E); } SEAM(6);
    if (IN(7)) { pg8::Gemm g{(const pg8::bf16_t*)(ws + WS_MERGED), (const pg8::bf16_t*)(ws + WS_WOUT), NTOK, DM, DM}; pg8::StaticOrder S; S.init(NTOK, DM, C.G, (int)blockIdx.x);
        pg8::EpiX1 E{args.in[0], args.out}; REP(7) pg8::gemm_phase<pg8::EpiX1, pg8::StaticOrder, true, true>(C.lds, g, S, E); } SEAM(7);
    if (IN(8)) { phase8(C, args.in, args.out, ws); } SEAM(8);
    if (IN(9)) { REP(9) phase9(C, args.in, args.out, ws); } SEAM(9);
    if (IN(10)) { const int nt = build_rowbase(C, ws);
        pg8::Gemm g{(const pg8::bf16_t*)(ws + WS_XS), (const pg8::bf16_t*)(ws + WS_WGU), MAXROWS, NEXP * 1024, DM};
        pg8::GroupedOrder S{nt, C.G, C.vcu, (const LAS unsigned char*)(C.lds + LDS_MISC + 256)};
        pg8::EpiSwiglu E{(pg8::bf16_t*)(ws + WS_HMID)}; REP(10) pg8::gemm_phase<pg8::EpiSwiglu, pg8::GroupedOrder, true, true>(C.lds, g, S, E); } SEAM(10);
    if (IN(11)) { const int nt = build_rowbase(C, ws);
        pg8::Gemm g{(const pg8::bf16_t*)(ws + WS_HMID), (const pg8::bf16_t*)(ws + WS_WD), MAXROWS, NEXP * 1024, DEXP};
        pg8::GroupedOrder S{nt, C.G, C.vcu, (const LAS unsigned char*)(C.lds + LDS_MISC + 256)};
        pg8::EpiY E{(pg8::bf16_t*)(ws + WS_Y)}; REP(11) pg8::gemm_phase<pg8::EpiY, pg8::GroupedOrder, true, true>(C.lds, g, S, E); } SEAM(11);
    if (IN(12)) { phase12(C, args.in, args.out, ws); }
#undef IN
#undef SEAM
}

#ifndef MK_SPLIT
#define MK_SPLIT 0
#endif
extern "C" void kernel_launch(void* const* d_in, const int* in_sizes, int n_in, void* d_out, int out_size, void* d_ws, size_t ws_size, hipStream_t stream) {
    static int grid = 0;
    if (grid == 0) {
        if (n_in != 21 || out_size != NTOK * DM || ws_size < WS_END) { fprintf(stderr, "kernel_launch: unexpected shapes (n_in %d out %d ws %zu)\n", n_in, out_size, ws_size); grid = -1; return; }
        int dev = 0, cus = 0, per_cu = 0;
        if (hipGetDevice(&dev) != hipSuccess || hipDeviceGetAttribute(&cus, hipDeviceAttributeMultiprocessorCount, dev) != hipSuccess) { grid = -1; return; }
        if (hipFuncSetAttribute((const void*)fwd_kernel, hipFuncAttributeMaxDynamicSharedMemorySize, LDS_BYTES) != hipSuccess) { fprintf(stderr, "kernel_launch: hipFuncSetAttribute failed\n"); grid = -1; return; }
        if (hipOccupancyMaxActiveBlocksPerMultiprocessor(&per_cu, (const void*)fwd_kernel, NTHR, LDS_BYTES) != hipSuccess || per_cu < 1) { fprintf(stderr, "kernel_launch: occupancy query says %d\n", per_cu); per_cu = 1; }
        (void)hipGetLastError();
        grid = cus;
    }
    if (grid < 0) return;
    (void)hipMemsetAsync((char*)d_ws + WS_CTL, 0, CTL_ZERO_BYTES, stream);
    Args a{};
    for (int i = 0; i < 21; ++i) a.in[i] = (const float*)d_in[i];
    a.out = (float*)d_out; a.ws = (unsigned char*)d_ws;
    void* kargs[] = {&a};
#if MK_SPLIT
    for (int p = 0; p < NPHASE; ++p) { a.ph_lo = p; a.ph_hi = p + 1;
        hipError_t e = hipLaunchCooperativeKernel((const void*)fwd_kernel, dim3(grid), dim3(NTHR), kargs, LDS_BYTES, stream);
        if (e != hipSuccess) { fprintf(stderr, "kernel_launch: launch %d failed: %s\n", p, hipGetErrorString(e)); break; } }
#else
    a.ph_lo = 0; a.ph_hi = NPHASE;
    hipError_t e = hipLaunchCooperativeKernel((const void*)fwd_kernel, dim3(grid), dim3(NTHR), kargs, LDS_BYTES, stream);
    if (e != hipSuccess) fprintf(stderr, "kernel_launch: cooperative launch failed: %s (grid %d)\n", hipGetErrorString(e), grid);
#endif
}
```

```cpp
#include <hip/hip_runtime.h>
#include <hip/hip_cooperative_groups.h>
#include <cstdio>
#include <cstdint>
namespace cg = cooperative_groups;
namespace pg8 {
#define PG8_LAS __attribute__((address_space(3)))
typedef unsigned short bf16_t;
typedef short bf16x8 __attribute__((ext_vector_type(8)));
typedef float f32x4 __attribute__((ext_vector_type(4)));
typedef unsigned u32x4 __attribute__((ext_vector_type(4)));
constexpr int BM = 256, BK = 64, HALF = 128, HTB = HALF * BK * 2  , STAGE_BYTES = 8 * HTB, NXCD = 8, WGM = 8;

__host__ __device__ __forceinline__ int lds_byte(int r, int c) { const int st = (r >> 4) * 2 + (c >> 5), rr = r & 15, cc = c & 31, ob = rr * 64 + cc * 2; return st * 1024 + (ob ^ (((ob >> 9) & 1) << 5)); }
__host__ __device__ __forceinline__ void stage_rc(int b, int& R, int& C) { const int st = b / 1024, sb = b % 1024, swz = sb ^ (((sb >> 9) & 1) << 5); R = (st >> 1) * 16 + swz / 64; C = (st & 1) * 32 + (swz % 64) / 2; }
__host__ __device__ __forceinline__ int perm32(int rho) { const int n = rho >> 4, i = rho & 15; return 8 * (i >> 2) + 4 * n + (i & 3); }

struct Unit { int pm, pn; };
struct Gemm { const bf16_t* A; const bf16_t* Bt; int M, N, K; };

struct StaticOrder {
    int nM, nN, nwg, G, c;
    __host__ __device__ void init(int M, int N, int G_, int c_) { nM = M / BM; nN = N / BM; nwg = nM * nN; G = G_; c = c_; }
    __host__ __device__ bool next(int i, Unit& u) const {
        const long L = (long)i * G + c; if (L >= nwg) return false;
        int wgid = (int)L; { const int q = nwg / NXCD, r = nwg % NXCD, xcd = wgid % NXCD, off = wgid / NXCD; wgid = (xcd < r ? xcd * (q + 1) : r * (q + 1) + (xcd - r) * q) + off; }
        const int nig = WGM * nN, gid = wgid / nig, fm = gid * WGM, gsz = (nM - fm) < WGM ? (nM - fm) : WGM;
        u.pm = fm + ((wgid % nig) % gsz); u.pn = (wgid % nig) / gsz; return true;
    }
    __device__ __forceinline__ void a_ready(const Unit&) const {}
    __device__ __forceinline__ void done(const Unit&) const {}
};

__device__ __forceinline__ unsigned cvt_pk_bf16(float lo, float hi) { unsigned r; asm volatile("v_cvt_pk_bf16_f32 %0, %1, %2" : "=v"(r) : "v"(lo), "v"(hi)); return r; }
typedef float f32x2 __attribute__((ext_vector_type(2)));
__device__ __forceinline__ f32x2 gelu_pk(f32x2 v) {
    const f32x2 av = __builtin_elementwise_abs(v), d = av * 0.2316418882f + 1.0f;
    f32x2 t; t.x = __builtin_amdgcn_rcpf(d.x); t.y = __builtin_amdgcn_rcpf(d.y);
    f32x2 q = t * 0.5307027145f + (-0.7265760135f); q = q * t + 0.7107068705f; q = q * t + (-0.142248368f); q = q * t + 0.127414796f; q = q * t;
    const f32x2 s = (v * v) * (-0.72134752044f);
    f32x2 e; e.x = __builtin_amdgcn_exp2f(s.x); e.y = __builtin_amdgcn_exp2f(s.y);
    const f32x2 m = v * (q * e), r = v - m;
    f32x2 o; o.x = v.x < 0.f ? m.x : r.x; o.y = v.y < 0.f ? m.y : r.y; return o;
}

template <int ACT  > struct EpiBf16 {
    static constexpr bool PERM = true, AFTER_DRAIN = false; static_assert(ACT == 0 || ACT == 1, "EpiBf16: ACT is 0 (none) or 1 (gelu_pk)");
    bf16_t* O; int ldc; const float* bias; int split_cols; size_t split_stride; float scale0;
    __device__ __forceinline__ void operator()(const f32x4 (&acc)[2][2][4][2], const Unit& u, int wr, int wc, int fr, int fq) const {
        const int row0 = u.pm * BM + wr * 64 + fr; int colt = u.pn * BM; bf16_t* base = O;
        float sc = 1.f; if (split_cols) { const int t = colt / split_cols; base += (size_t)t * split_stride; colt -= t * split_cols; if (t == 0) sc = scale0; }
        const int col0 = colt + wc * 32 + 8 * fq, bcol0 = u.pn * BM + wc * 32 + 8 * fq;
        f32x4 bv[2][2];
#pragma unroll
        for (int bj = 0; bj < 2; ++bj)
#pragma unroll
            for (int n = 0; n < 2; ++n) bv[bj][n] = bias ? *(const f32x4*)(bias + bcol0 + bj * HALF + 4 * n) : (f32x4){0.f, 0.f, 0.f, 0.f};
#pragma unroll
        for (int ai = 0; ai < 2; ++ai)
#pragma unroll
            for (int m = 0; m < 4; ++m) { bf16_t* rowp = base + (size_t)(row0 + ai * HALF + m * 16) * ldc + col0;
#pragma unroll
                for (int bj = 0; bj < 2; ++bj) { f32x4 v0 = acc[ai][bj][m][0] + bv[bj][0], v1 = acc[ai][bj][m][1] + bv[bj][1];
                    if (ACT == 1) { f32x2 a = gelu_pk((f32x2){v0[0], v0[1]}), b = gelu_pk((f32x2){v0[2], v0[3]}), c = gelu_pk((f32x2){v1[0], v1[1]}), d = gelu_pk((f32x2){v1[2], v1[3]});
                        v0 = (f32x4){a.x, a.y, b.x, b.y}; v1 = (f32x4){c.x, c.y, d.x, d.y}; }
                    v0 = v0 * sc; v1 = v1 * sc; u32x4 w; w.x = cvt_pk_bf16(v0[0], v0[1]); w.y = cvt_pk_bf16(v0[2], v0[3]); w.z = cvt_pk_bf16(v1[0], v1[1]); w.w = cvt_pk_bf16(v1[2], v1[3]);
                    *(u32x4*)(rowp + bj * HALF) = w; } }
    }
};
template <class Epi, class Sched, bool ALIGN_EPI = false, bool SP2 = false>
__device__ __forceinline__ void gemm_phase(PG8_LAS unsigned char* lds, const Gemm g, const Sched& S, const Epi& E) {
    const int tid = threadIdx.x, wid = __builtin_amdgcn_readfirstlane(tid >> 6), lane = tid & 63, wr = wid >> 2, wc = wid & 3, fr = lane & 15, fq = lane >> 4;
    const int K = g.K, nt = K / BK;
    unsigned voffA[2], voffB[2];
#pragma unroll
    for (int i = 0; i < 2; ++i) { int R, C; stage_rc(tid * 16 + i * 8192, R, C); const int Rb = Epi::PERM ? ((R & ~31) + perm32(R & 31)) : R;
        voffA[i] = (unsigned)(R * K + C) * 2u; voffB[i] = (unsigned)(Rb * K + C) * 2u; }
    const size_t kstep = (size_t)(BK * 2);
    const size_t hstep = (size_t)HALF * K * 2;
    const size_t tstep = 2 * hstep;
    const unsigned ldsw = (unsigned)wid * 1024u;
    const int aoff = lds_byte(wr * 64 + fr, fq * 8), boff = lds_byte(wc * 32 + fr, fq * 8);
#define PG8_SA(b, h) (((b) * 2 + (h)) * HTB)
#define PG8_SB(b, h) ((4 + (b) * 2 + (h)) * HTB)
#define PG8_STAGE(bufoff, gbase, voff) do { _Pragma("unroll") for (int _i = 0; _i < 2; ++_i) \
        __builtin_amdgcn_global_load_lds((const unsigned*)((const char*)(gbase) + (voff)[_i]), (PG8_LAS unsigned*)(lds + (bufoff) + ldsw + _i * 8192), 16, 0, 0); } while (0)
#define PG8_LDA(dst, b, h) do { _Pragma("unroll") for (int m = 0; m < 4; ++m) _Pragma("unroll") for (int k = 0; k < 2; ++k) dst[m][k] = *(const PG8_LAS bf16x8*)(lds + PG8_SA(b, h) + aoff + m * 2048 + k * 1024); } while (0)
#define PG8_LDB(dst, b, h) do { _Pragma("unroll") for (int n = 0; n < 2; ++n) _Pragma("unroll") for (int k = 0; k < 2; ++k) dst[n][k] = *(const PG8_LAS bf16x8*)(lds + PG8_SB(b, h) + boff + n * 2048 + k * 1024); } while (0)
#define PG8_MMA(ai, bj, At, Bt) do { __builtin_amdgcn_s_setprio(1); _Pragma("unroll") for (int m = 0; m < 4; ++m) _Pragma("unroll") for (int n = 0; n < 2; ++n) _Pragma("unroll") for (int k = 0; k < 2; ++k) \
        acc[ai][bj][m][n] = __builtin_amdgcn_mfma_f32_16x16x32_bf16(Bt[n][k], At[m][k], acc[ai][bj][m][n], 0, 0, 0); __builtin_amdgcn_s_setprio(0); } while (0)
#define PG8_WAIT_V(n) asm volatile("s_waitcnt vmcnt(" #n ")" ::: "memory")
#define PG8_WAIT_L(n) asm volatile("s_waitcnt lgkmcnt(" #n ")" ::: "memory")
#define PG8_BAR __builtin_amdgcn_s_barrier()
#define PG8_SCHED __builtin_amdgcn_sched_barrier(0)
    Unit cur, nxt; int ui = 0;
    if (!S.next(0, cur)) return;
    f32x4 acc[2][2][4][2];
#pragma unroll
    for (int a = 0; a < 2; ++a)
#pragma unroll
        for (int b = 0; b < 2; ++b)
#pragma unroll
            for (int m = 0; m < 4; ++m)
#pragma unroll
                for (int n = 0; n < 2; ++n) acc[a][b][m][n] = (f32x4){0.f, 0.f, 0.f, 0.f};
    bf16x8 At[4][2], B0[2][2], B1[2][2];
    const char* cA = (const char*)g.A + (size_t)cur.pm * tstep; const char* cB = (const char*)g.Bt + (size_t)cur.pn * tstep;
    S.a_ready(cur);
    if constexpr (SP2) {
        PG8_STAGE(PG8_SB(0, 0), cB, voffB); PG8_STAGE(PG8_SB(0, 1), cB + hstep, voffB); PG8_STAGE(PG8_SA(0, 0), cA, voffA); PG8_STAGE(PG8_SA(0, 1), cA + hstep, voffA);
        if (wr == 1) PG8_BAR;
        PG8_WAIT_V(2); PG8_BAR;
        PG8_STAGE(PG8_SB(1, 0), cB + kstep, voffB); PG8_STAGE(PG8_SA(1, 0), cA + kstep, voffA); PG8_STAGE(PG8_SB(1, 1), cB + hstep + kstep, voffB);
        PG8_WAIT_V(6); PG8_BAR;
    } else {
        PG8_STAGE(PG8_SB(0, 0), cB, voffB); PG8_STAGE(PG8_SA(0, 0), cA, voffA); PG8_STAGE(PG8_SB(0, 1), cB + hstep, voffB); PG8_STAGE(PG8_SA(0, 1), cA + hstep, voffA);
        if (wr == 1) PG8_BAR;
        PG8_WAIT_V(4); PG8_BAR;
        PG8_STAGE(PG8_SB(1, 0), cB + kstep, voffB); PG8_STAGE(PG8_SA(1, 0), cA + kstep, voffA); PG8_STAGE(PG8_SB(1, 1), cB + hstep + kstep, voffB);
        PG8_WAIT_V(6); PG8_BAR;
    }
    for (;;) {
        const bool has_next = S.next(ui + 1, nxt);
        const char* nA = has_next ? (const char*)g.A + (size_t)nxt.pm * tstep : cA; const char* nB = has_next ? (const char*)g.Bt + (size_t)nxt.pn * tstep : cB;
        for (int t = 0; t < nt; t += 2) {
            const bool last = (t == nt - 2);
            const char* a1 = cA + (size_t)(t + 1) * kstep;
            const char* a2 = last ? nA : cA + (size_t)(t + 2) * kstep; const char* b2 = last ? nB : cB + (size_t)(t + 2) * kstep;
            const char* a3 = a2 + kstep; const char* b3 = b2 + kstep;
            if (last && has_next) S.a_ready(nxt);
            if constexpr (SP2) {
            PG8_LDB(B0, 0, 0); PG8_LDB(B1, 0, 1); PG8_SCHED; PG8_LDA(At, 0, 0); PG8_STAGE(PG8_SA(1, 1), a1 + hstep, voffA);
            PG8_WAIT_V(8); PG8_WAIT_L(0); PG8_BAR; PG8_MMA(0, 0, At, B0); PG8_MMA(0, 1, At, B1); PG8_BAR; PG8_SCHED;
            PG8_LDA(At, 0, 1); PG8_STAGE(PG8_SB(0, 0), b2, voffB); PG8_STAGE(PG8_SB(0, 1), b2 + hstep, voffB); PG8_STAGE(PG8_SA(0, 0), a2, voffA);
            PG8_WAIT_V(8); PG8_WAIT_L(0); PG8_BAR; PG8_MMA(1, 0, At, B0); PG8_MMA(1, 1, At, B1); PG8_BAR; PG8_SCHED;
            PG8_LDB(B0, 1, 0); PG8_LDB(B1, 1, 1); PG8_SCHED; PG8_LDA(At, 1, 0); PG8_STAGE(PG8_SA(0, 1), a2 + hstep, voffA);
            PG8_WAIT_V(8); PG8_WAIT_L(0); PG8_BAR; PG8_MMA(0, 0, At, B0); PG8_MMA(0, 1, At, B1); PG8_BAR; PG8_SCHED;
            PG8_LDA(At, 1, 1); PG8_STAGE(PG8_SB(1, 0), b3, voffB); PG8_STAGE(PG8_SB(1, 1), b3 + hstep, voffB); PG8_STAGE(PG8_SA(1, 0), a3, voffA);
            PG8_WAIT_V(8); PG8_WAIT_L(0); PG8_BAR; PG8_MMA(1, 0, At, B0); PG8_MMA(1, 1, At, B1); PG8_BAR; PG8_SCHED;
            } else {
            PG8_LDB(B0, 0, 0); PG8_SCHED; PG8_LDA(At, 0, 0); PG8_STAGE(PG8_SA(1, 1), a1 + hstep, voffA);
            PG8_WAIT_L(8); PG8_BAR; PG8_WAIT_L(0); PG8_MMA(0, 0, At, B0); PG8_BAR; PG8_SCHED;
            PG8_LDB(B1, 0, 1); PG8_STAGE(PG8_SB(0, 0), b2, voffB);
            PG8_BAR; PG8_WAIT_L(0); PG8_MMA(0, 1, At, B1); PG8_BAR;
            PG8_LDA(At, 0, 1); PG8_STAGE(PG8_SA(0, 0), a2, voffA);
            PG8_BAR; PG8_WAIT_L(0); PG8_MMA(1, 0, At, B0); PG8_BAR; PG8_SCHED;
            PG8_STAGE(PG8_SB(0, 1), b2 + hstep, voffB);
            PG8_WAIT_V(6); PG8_BAR; PG8_MMA(1, 1, At, B1); PG8_BAR;
            PG8_LDB(B0, 1, 0); PG8_SCHED; PG8_LDA(At, 1, 0); PG8_STAGE(PG8_SA(0, 1), a2 + hstep, voffA);
            PG8_WAIT_L(8); PG8_BAR; PG8_WAIT_L(0); PG8_MMA(0, 0, At, B0); PG8_BAR; PG8_SCHED;
            PG8_LDB(B1, 1, 1); PG8_STAGE(PG8_SB(1, 0), b3, voffB);
            PG8_BAR; PG8_WAIT_L(0); PG8_MMA(0, 1, At, B1); PG8_BAR;
            PG8_LDA(At, 1, 1); PG8_STAGE(PG8_SA(1, 0), a3, voffA);
            PG8_BAR; PG8_WAIT_L(0); PG8_MMA(1, 0, At, B0); PG8_BAR; PG8_SCHED;
            PG8_STAGE(PG8_SB(1, 1), b3 + hstep, voffB);
            PG8_WAIT_V(6); PG8_BAR; PG8_MMA(1, 1, At, B1); PG8_BAR;
            }
        }
        if constexpr (ALIGN_EPI) { if (wr == 0) PG8_BAR; }
        if constexpr (!Epi::AFTER_DRAIN) { E(acc, cur, wr, wc, fr, fq); S.done(cur); }
        if (!has_next) break;
#pragma unroll
        for (int a = 0; a < 2; ++a)
#pragma unroll
            for (int b = 0; b < 2; ++b)
#pragma unroll
                for (int m = 0; m < 4; ++m)
#pragma unroll
                    for (int n = 0; n < 2; ++n) acc[a][b][m][n] = (f32x4){0.f, 0.f, 0.f, 0.f};
        cur = nxt; cA = nA; cB = nB; ++ui;
        if constexpr (ALIGN_EPI) { if (wr == 1) PG8_BAR; }
    }
    PG8_WAIT_V(0);
    if constexpr (!ALIGN_EPI) { if (wr == 0) PG8_BAR; }
    PG8_BAR;
    if constexpr (Epi::AFTER_DRAIN) { E.fused(acc, cur, wr, wc, fr, fq, lds, wid, lane); S.done(cur); }
#undef PG8_SA
#undef PG8_SB
#undef PG8_STAGE
#undef PG8_LDA
#undef PG8_LDB
#undef PG8_MMA
#undef PG8_WAIT_V
#undef PG8_WAIT_L
#undef PG8_BAR
#undef PG8_SCHED
}
}

#define GAS __attribute__((address_space(1)))
#define LAS __attribute__((address_space(3)))
typedef unsigned short bf16;
typedef unsigned U4 __attribute__((ext_vector_type(4)));
typedef unsigned U2 __attribute__((ext_vector_type(2)));
typedef float F4 __attribute__((ext_vector_type(4)));
typedef float F2 __attribute__((ext_vector_type(2)));
typedef float F16 __attribute__((ext_vector_type(16)));
typedef short B8 __attribute__((ext_vector_type(8)));
typedef short S4 __attribute__((ext_vector_type(4)));
typedef __bf16 bf16x2_t __attribute__((ext_vector_type(2)));

constexpr int NWAVES = 8, NTHR = 512;
constexpr int DM = 1024, BATCH = 8, SEQ = 8192, NTOK = BATCH * SEQ;
constexpr int DIN = 8200, NPROJ = 8192;
constexpr int CHUNK = 128, NCHUNK = SEQ / CHUNK;
constexpr int NEXP = 32, DEXP = 512;
constexpr int MAXTILES = 544, MAXROWS = MAXTILES * 256;
constexpr float EPS = 1e-6f;
constexpr int LDS_BYTES = 159744;
constexpr int LDS_MISC = 151552;

constexpr size_t MiB = 1u << 20;
constexpr size_t WS_CTL = 0, CTL_ZERO_BYTES = 32768; constexpr int CW_BAR = 1024;
constexpr size_t WS_IF = 1 * MiB;
constexpr size_t WS_THR = 3 * MiB;
constexpr size_t WS_CDEC = 4 * MiB;
constexpr size_t WS_ROUT = 4 * MiB + 65536;
constexpr size_t WS_ROPE = 5 * MiB;
constexpr size_t WS_TOK = 9 * MiB;
constexpr size_t WS_WIN = 12 * MiB;
constexpr size_t WS_WRB = 28 * MiB, WS_WMB = 30 * MiB, WS_WOUT = 32 * MiB;
constexpr size_t WS_H = 34 * MiB;
constexpr size_t WS_MQP = 34 * MiB, WS_MKP = 98 * MiB, WS_MERGED = 34 * MiB;
constexpr size_t WS_RQ = 162 * MiB, WS_RK = 226 * MiB, WS_MQ = 290 * MiB, WS_MK = 354 * MiB;
constexpr size_t WS_WGU = 162 * MiB, WS_WD = 226 * MiB, WS_TMP = 258 * MiB;
constexpr size_t WS_RV = 418 * MiB, WS_RG = 546 * MiB, WS_MV = 674 * MiB, WS_MO = 802 * MiB;
constexpr size_t WS_XS = 418 * MiB, WS_HMID = 690 * MiB, WS_Y = 418 * MiB;
constexpr size_t WS_END = 930 * MiB;
constexpr size_t OUT_GR = 0, OUT_GM = 128 * MiB;
static_assert(WS_XS + (size_t)MAXROWS * 1024 * 2 <= WS_HMID && WS_HMID + (size_t)MAXROWS * 512 * 2 <= WS_END, "ws map");

struct TokInfo { int e0, p0, e1, p1; float w0, w1, rstd, pad; };

__device__ __forceinline__ float bflo(unsigned u) { return __uint_as_float(u << 16); }
__device__ __forceinline__ float bfhi(unsigned u) { return __uint_as_float(u & 0xffff0000u); }
__device__ __forceinline__ float bf2f(short s) { return __uint_as_float(((unsigned)(unsigned short)s) << 16); }
__device__ __forceinline__ unsigned cvtpk(float lo, float hi) { F2 v = {lo, hi}; bf16x2_t b = __builtin_convertvector(v, bf16x2_t); return __builtin_bit_cast(unsigned, b); }
__device__ __forceinline__ float wave_sum(float v) {
#pragma unroll
    for (int o = 1; o < 64; o <<= 1) v += __shfl_xor(v, o);
    return v;
}
__device__ __forceinline__ float sigm(float x) { return 1.f / (1.f + __expf(-x)); }
__device__ __forceinline__ float silu(float x) { return x / (1.f + __expf(-x)); }
__device__ __forceinline__ float dot2bf(unsigned a, unsigned b, float c) { return __builtin_amdgcn_fdot2_f32_bf16(__builtin_bit_cast(bf16x2_t, a), __builtin_bit_cast(bf16x2_t, b), c, false); }
__device__ __forceinline__ int crow(int r, int hi) { return (r & 3) + 8 * (r >> 2) + 4 * hi; }
#define MFMA32(a, b, c) __builtin_amdgcn_mfma_f32_32x32x16_bf16((a), (b), (c), 0, 0, 0)
typedef short v4i16_t __attribute__((ext_vector_type(4)));
__device__ __forceinline__ S4 trrd(LAS const unsigned char* p) { return __builtin_bit_cast(S4, __builtin_amdgcn_ds_read_tr16_b64_v4i16((LAS v4i16_t*)p)); }
__device__ __forceinline__ void glds16(const void* gsrc, unsigned lds_dst) { unsigned keep;
    asm volatile("s_mov_b32 %0, m0\n\ts_mov_b32 m0, %2\n\ts_nop 0\n\tglobal_load_lds_dwordx4 %1, off\n\ts_mov_b32 m0, %0" : "=&s"(keep) : "v"(gsrc), "s"(lds_dst) : "memory"); }
__device__ __forceinline__ unsigned offb(unsigned row, unsigned ch) { return 256u * row + 16u * (ch ^ (((row & 3) << 2) | ((row >> 2) & 3))); }
__device__ __forceinline__ unsigned offv(unsigned row, unsigned ch) { return 128u * row + 16u * (ch ^ (((row >> 1) & 1) << 2)); }

#define XB_TMO      128
#define XB_XCNT(j)  (256  + 64 * (j))
#define XB_XSUB(j)  (1280 + 64 * (j))
#define XB_XGEN(j)  (2304 + 64 * (j))
#define XB_TOP      3328
#define XB_TOPGEN   3392
#define XCD_BAR_WORDS 3456
#define XB_SPIN_CAP (1u << 18)

__device__ __forceinline__ unsigned xb_ld(unsigned* p)              { return __hip_atomic_load(p, __ATOMIC_RELAXED, __HIP_MEMORY_SCOPE_AGENT); }
__device__ __forceinline__ unsigned xb_add(unsigned* p, unsigned v) { return __hip_atomic_fetch_add(p, v, __ATOMIC_RELAXED, __HIP_MEMORY_SCOPE_AGENT); }
__device__ __forceinline__ unsigned xb_xcc_id() { return (unsigned)__builtin_amdgcn_s_getreg((3 << 11) | 20) & 0xFu; }
#define XB_SPIN(cond, bar) do { unsigned _sp = 0; while (cond) { __builtin_amdgcn_s_sleep(1); \
    if ((++_sp & 255u) == 0u) { if (xb_ld(&(bar)[XB_TMO])) break; if (_sp > XB_SPIN_CAP) { atomicAdd(&(bar)[XB_TMO], 1u); break; } } } } while (0)

struct XcdBarrier {
    unsigned* bar; unsigned x;
    volatile LAS unsigned* st;
};

__device__ __forceinline__ XcdBarrier xcd_barrier_post(unsigned* bar, volatile LAS unsigned* st) {
    XcdBarrier b; b.bar = bar; b.x = xb_xcc_id(); b.st = st;
    if (threadIdx.x == 0) (void)xb_add(&bar[XB_XCNT(b.x)], 1u);
    return b;
}
__device__ __forceinline__ void xcd_barrier_complete(unsigned* bar, unsigned x, unsigned& nloc, unsigned& nx) {
    const unsigned G = gridDim.x * gridDim.y * gridDim.z;
    unsigned sum, cnt, mine, sp = 0u;
    for (;;) {
        sum = 0u; cnt = 0u; mine = 0u;
#pragma unroll
        for (unsigned j = 0; j < 16; ++j) { const unsigned c = xb_ld(&bar[XB_XCNT(j)]); sum += c; cnt += (c > 0u) ? 1u : 0u; mine = (j == x) ? c : mine; }
        if (sum == G) break;
        __builtin_amdgcn_s_sleep(1);
        if ((++sp & 255u) == 0u) { if (xb_ld(&bar[XB_TMO])) break; if (sp > XB_SPIN_CAP) { atomicAdd(&bar[XB_TMO], 1u); break; } }
    }
    nloc = mine > 0u ? mine : 1u; nx = cnt > 0u ? cnt : 1u;
}

__device__ __forceinline__ void xcd_barrier(const XcdBarrier& b) {
    asm volatile("s_waitcnt vmcnt(0)" ::: "memory");
    __syncthreads();
    if (threadIdx.x == 0) {
        unsigned* bar = b.bar;
        __builtin_amdgcn_s_waitcnt(0);
        unsigned nloc = b.st[0], nx = b.st[1];
        if (nloc == 0u) { xcd_barrier_complete(bar, b.x, nloc, nx); b.st[0] = nloc; b.st[1] = nx; }
        const unsigned old = xb_add(&bar[XB_XSUB(b.x)], 1u);
        const unsigned gen = old / nloc;
        if (old + 1u == (gen + 1u) * nloc) {
            __builtin_amdgcn_fence(__ATOMIC_RELEASE, "agent");
            asm volatile("s_waitcnt vmcnt(0)" ::: "memory");
            const unsigned og = xb_add(&bar[XB_TOP], 1u);
            const unsigned tg = og / nx;
            if (og + 1u == (tg + 1u) * nx) xb_add(&bar[XB_TOPGEN], 1u);
            else XB_SPIN(xb_ld(&bar[XB_TOPGEN]) == tg, bar);
            __builtin_amdgcn_fence(__ATOMIC_ACQUIRE, "agent");
            xb_add(&bar[XB_XGEN(b.x)], 1u);
            asm volatile("s_waitcnt vmcnt(0)" ::: "memory");
        } else {
            XB_SPIN(xb_ld(&bar[XB_XGEN(b.x)]) == gen, bar);
            __builtin_amdgcn_fence(__ATOMIC_ACQUIRE, "agent");
            asm volatile("s_waitcnt vmcnt(0)" ::: "memory");
        }
    }
    __syncthreads();
}

namespace pg8 {
struct EpiProj {
    static constexpr bool PERM = true, AFTER_DRAIN = false;
    unsigned char* ws; unsigned char* ob;
    __device__ __forceinline__ void operator()(const f32x4 (&acc)[2][2][4][2], const Unit& u, int wr, int wc, int fr, int fq) const {
        const int pn = u.pn; bf16_t* base; int ld, ct;
        if (pn < 2)       { base = (bf16_t*)(ws + WS_RQ); ld = 512;  ct = pn; }
        else if (pn < 4)  { base = (bf16_t*)(ws + WS_RK); ld = 512;  ct = pn - 2; }
        else if (pn < 8)  { base = (bf16_t*)(ws + WS_RV); ld = 1024; ct = pn - 4; }
        else if (pn < 12) { base = (bf16_t*)(ws + WS_RG); ld = 1024; ct = pn - 8; }
        else if (pn < 14) { base = (bf16_t*)(ws + WS_MQ); ld = 512;  ct = pn - 12; }
        else if (pn < 16) { base = (bf16_t*)(ws + WS_MK); ld = 512;  ct = pn - 14; }
        else if (pn < 20) { base = (bf16_t*)(ws + WS_MV); ld = 1024; ct = pn - 16; }
        else if (pn < 24) { base = (bf16_t*)(ws + WS_MO); ld = 1024; ct = pn - 20; }
        else if (pn < 28) { base = (bf16_t*)(ob + OUT_GR); ld = 1024; ct = pn - 24; }
        else              { base = (bf16_t*)(ob + OUT_GM); ld = 1024; ct = pn - 28; }
        const int row0 = u.pm * BM + wr * 64 + fr, col0 = ct * BM + wc * 32 + 8 * fq;
#pragma unroll
        for (int ai = 0; ai < 2; ++ai)
#pragma unroll
            for (int m = 0; m < 4; ++m) { bf16_t* rowp = base + (size_t)(row0 + ai * HALF + m * 16) * ld + col0;
#pragma unroll
                for (int bj = 0; bj < 2; ++bj) { const f32x4 v0 = acc[ai][bj][m][0], v1 = acc[ai][bj][m][1];
                    u32x4 w; w.x = cvt_pk_bf16(v0[0], v0[1]); w.y = cvt_pk_bf16(v0[2], v0[3]); w.z = cvt_pk_bf16(v1[0], v1[1]); w.w = cvt_pk_bf16(v1[2], v1[3]);
                    *(u32x4*)(rowp + bj * HALF) = w; } }
    }
};
template <int MODE> struct EpiGate {
    static constexpr bool PERM = true, AFTER_DRAIN = false;
    const bf16_t* G; const bf16_t* TI; bf16_t* O;
    __device__ __forceinline__ void operator()(const f32x4 (&acc)[2][2][4][2], const Unit& u, int wr, int wc, int fr, int fq) const {
        const int row0 = u.pm * BM + wr * 64 + fr, col0 = u.pn * BM + wc * 32 + 8 * fq;
#pragma unroll
        for (int ai = 0; ai < 2; ++ai)
#pragma unroll
            for (int m = 0; m < 4; ++m) { const size_t ro = (size_t)(row0 + ai * HALF + m * 16) * 1024 + col0;
#pragma unroll
                for (int bj = 0; bj < 2; ++bj) { const f32x4 v0 = acc[ai][bj][m][0], v1 = acc[ai][bj][m][1];
                    const u32x4 g = *(const u32x4*)(G + ro + bj * HALF);
                    float r[8];
                    r[0] = v0[0] * sigm(bflo(g.x)); r[1] = v0[1] * sigm(bfhi(g.x)); r[2] = v0[2] * sigm(bflo(g.y)); r[3] = v0[3] * sigm(bfhi(g.y));
                    r[4] = v1[0] * sigm(bflo(g.z)); r[5] = v1[1] * sigm(bfhi(g.z)); r[6] = v1[2] * sigm(bflo(g.w)); r[7] = v1[3] * sigm(bfhi(g.w));
                    if (MODE == 1) { const u32x4 t = *(const u32x4*)(TI + ro + bj * HALF);
                        r[0] += bflo(t.x); r[1] += bfhi(t.x); r[2] += bflo(t.y); r[3] += bfhi(t.y); r[4] += bflo(t.z); r[5] += bfhi(t.z); r[6] += bflo(t.w); r[7] += bfhi(t.w); }
                    u32x4 w; w.x = cvt_pk_bf16(r[0], r[1]); w.y = cvt_pk_bf16(r[2], r[3]); w.z = cvt_pk_bf16(r[4], r[5]); w.w = cvt_pk_bf16(r[6], r[7]);
                    *(u32x4*)(O + ro + bj * HALF) = w; } }
    }
};
struct EpiX1 {
    static constexpr bool PERM = true, AFTER_DRAIN = false;
    const float* X; float* O;
    __device__ __forceinline__ void operator()(const f32x4 (&acc)[2][2][4][2], const Unit& u, int wr, int wc, int fr, int fq) const {
        const int row0 = u.pm * BM + wr * 64 + fr, col0 = u.pn * BM + wc * 32 + 8 * fq;
#pragma unroll
        for (int ai = 0; ai < 2; ++ai)
#pragma unroll
            for (int m = 0; m < 4; ++m) { const size_t ro = (size_t)(row0 + ai * HALF + m * 16) * 1024 + col0;
#pragma unroll
                for (int bj = 0; bj < 2; ++bj) {
                    const f32x4 a = *(const f32x4*)(X + ro + bj * HALF), b = *(const f32x4*)(X + ro + bj * HALF + 4);
                    *(f32x4*)(O + ro + bj * HALF) = a + acc[ai][bj][m][0]; *(f32x4*)(O + ro + bj * HALF + 4) = b + acc[ai][bj][m][1]; } }
    }
};
struct EpiSwiglu {
    static constexpr bool PERM = true, AFTER_DRAIN = false;
    bf16_t* O;
    __device__ __forceinline__ void operator()(const f32x4 (&acc)[2][2][4][2], const Unit& u, int wr, int wc, int fr, int fq) const {
        const int row0 = u.pm * BM + wr * 64 + fr, col0 = (u.pn & 3) * HALF + wc * 32 + 8 * fq;
#pragma unroll
        for (int ai = 0; ai < 2; ++ai)
#pragma unroll
            for (int m = 0; m < 4; ++m) { bf16_t* rowp = O + (size_t)(row0 + ai * HALF + m * 16) * 512 + col0;
                const f32x4 g0 = acc[ai][0][m][0], g1 = acc[ai][0][m][1], u0 = acc[ai][1][m][0], u1 = acc[ai][1][m][1];
                u32x4 w; w.x = cvt_pk_bf16(silu(g0[0]) * u0[0], silu(g0[1]) * u0[1]); w.y = cvt_pk_bf16(silu(g0[2]) * u0[2], silu(g0[3]) * u0[3]);
                w.z = cvt_pk_bf16(silu(g1[0]) * u1[0], silu(g1[1]) * u1[1]); w.w = cvt_pk_bf16(silu(g1[2]) * u1[2], silu(g1[3]) * u1[3]);
                *(u32x4*)rowp = w; }
    }
};
struct EpiY {
    static constexpr bool PERM = true, AFTER_DRAIN = false;
    bf16_t* O;
    __device__ __forceinline__ void operator()(const f32x4 (&acc)[2][2][4][2], const Unit& u, int wr, int wc, int fr, int fq) const {
        const int row0 = u.pm * BM + wr * 64 + fr, col0 = (u.pn & 3) * BM + wc * 32 + 8 * fq;
#pragma unroll
        for (int ai = 0; ai < 2; ++ai)
#pragma unroll
            for (int m = 0; m < 4; ++m) { bf16_t* rowp = O + (size_t)(row0 + ai * HALF + m * 16) * 1024 + col0;
#pragma unroll
                for (int bj = 0; bj < 2; ++bj) { const f32x4 v0 = acc[ai][bj][m][0], v1 = acc[ai][bj][m][1];
                    u32x4 w; w.x = cvt_pk_bf16(v0[0], v0[1]); w.y = cvt_pk_bf16(v0[2], v0[3]); w.z = cvt_pk_bf16(v1[0], v1[1]); w.w = cvt_pk_bf16(v1[2], v1[3]);
                    *(u32x4*)(rowp + bj * HALF) = w; } }
    }
};
struct GroupedOrder {
    int ntiles, G, c; const PG8_LAS unsigned char* t2e;
    __device__ __forceinline__ bool next(int i, Unit& u) const {
        const int L = i * G + c; if (L >= ntiles * 4) return false;
        const int rt = L >> 2; u.pm = rt; u.pn = __builtin_amdgcn_readfirstlane((int)t2e[rt]) * 4 + (L & 3); return true;
    }
    __device__ __forceinline__ void a_ready(const Unit&) const {}
    __device__ __forceinline__ void done(const Unit&) const {}
};
}

struct Ctx { LAS unsigned char* lds; int tid, lane, wave, vcu, G; };

__device__ __forceinline__ void transpose_item(const float* W, int ld, int k0, int n0, bf16* WT, int K, int drow0, LAS float* scr, int lane) {
#pragma unroll 8
    for (int i = 0; i < 32; ++i) { const int kk = 2 * i + (lane >> 5); scr[kk * 33 + (lane & 31)] = W[(size_t)(k0 + kk) * ld + n0 + (lane & 31)]; }
    asm volatile("s_waitcnt lgkmcnt(0)" ::: "memory");
    const int c = lane & 7;
#pragma unroll
    for (int j = 0; j < 4; ++j) { const int n = (lane >> 3) + 8 * j; const LAS float* s = scr + (8 * c) * 33 + n;
        U4 o; o.x = cvtpk(s[0 * 33], s[1 * 33]); o.y = cvtpk(s[2 * 33], s[3 * 33]); o.z = cvtpk(s[4 * 33], s[5 * 33]); o.w = cvtpk(s[6 * 33], s[7 * 33]);
        *(U4*)(WT + (size_t)(drow0 + n) * K + k0 + 8 * c) = o; }
    asm volatile("s_waitcnt lgkmcnt(0)" ::: "memory");
}

__device__ __forceinline__ void phase0(const Ctx& C, const float* const* in, unsigned char* ws) {
    const float* x = in[0]; const float* nw = in[1]; const float* w_in = in[2];
    LAS float* scr = (LAS float*)(C.lds + C.wave * 8448);
    LAS float* wif = (LAS float*)(C.lds + 98304);
    LAS double* invf = (LAS double*)(C.lds + 98304 + 32768);
    for (int i = C.tid; i < 8192; i += NTHR) wif[i] = w_in[(size_t)(i >> 3) * DIN + 6144 + (i & 7)];
    if (C.tid < 64) { double r = 1.0; for (int j = 0; j < C.tid; ++j) r *= 0.8659643233600653; invf[C.tid] = r; }
    __syncthreads();
    const int gw = C.vcu * NWAVES + C.wave, NGW = C.G * NWAVES;
    {
        bf16* H = (bf16*)(ws + WS_H); float* IFP = (float*)(ws + WS_IF);
        F4 wv[4];
#pragma unroll
        for (int j = 0; j < 4; ++j) wv[j] = *(const F4*)(nw + 4 * C.lane + 256 * j);
        for (int m = gw; m < NTOK; m += NGW) {
            const F4* xr = (const F4*)(x + (size_t)m * DM) + C.lane;
            F4 v[4]; float s = 0.f;
#pragma unroll
            for (int j = 0; j < 4; ++j) { v[j] = xr[64 * j]; s += (v[j].x * v[j].x + v[j].y * v[j].y) + (v[j].z * v[j].z + v[j].w * v[j].w); }
            const float rstd = rsqrtf(wave_sum(s) * (1.f / DM) + EPS);
            float g[8];
#pragma unroll
            for (int c = 0; c < 8; ++c) g[c] = 0.f;
            unsigned long long* o8 = (unsigned long long*)(H + (size_t)m * DM) + C.lane;
#pragma unroll
            for (int j = 0; j < 4; ++j) { v[j] = v[j] * rstd * wv[j];
                o8[64 * j] = (unsigned long long)cvtpk(v[j].x, v[j].y) | ((unsigned long long)cvtpk(v[j].z, v[j].w) << 32);
#pragma unroll
                for (int i = 0; i < 4; ++i) { const LAS F4* wp = (const LAS F4*)(wif + (4 * C.lane + 256 * j + i) * 8); const F4 wa = wp[0], wb = wp[1]; const float hv = v[j][i];
                    g[0] += hv * wa.x; g[1] += hv * wa.y; g[2] += hv * wa.z; g[3] += hv * wa.w; g[4] += hv * wb.x; g[5] += hv * wb.y; g[6] += hv * wb.z; g[7] += hv * wb.w; } }
#pragma unroll
            for (int c = 0; c < 8; ++c) g[c] = wave_sum(g[c]);
            if (C.lane == 0) { F4* op = (F4*)(IFP + (size_t)m * 8); op[0] = (F4){g[0], g[1], g[2], g[3]}; op[1] = (F4){g[4], g[5], g[6], g[7]}; }
        }
    }
    for (int it = gw; it < 4096 + 3 * 512; it += NGW) {
        if (it < 4096) { const int kb = it >> 8, nb = it & 255; transpose_item(w_in, DIN, kb * 64, nb * 32 + (nb >= 192 ? 8 : 0), (bf16*)(ws + WS_WIN), 1024, nb * 32, scr, C.lane); }
        else { int r = it - 4096; const int mth = r >> 9; r &= 511; const int kb = r >> 5, nb = r & 31;
            const float* W = mth == 0 ? in[4] : (mth == 1 ? in[10] : in[11]); bf16* dst = (bf16*)(ws + (mth == 0 ? WS_WRB : (mth == 1 ? WS_WMB : WS_WOUT)));
            transpose_item(W, 1024, kb * 64, nb * 32, dst, 1024, nb * 32, scr, C.lane); }
    }
    { F2* RT = (F2*)(ws + WS_ROPE);
        for (int idx = C.vcu * NTHR + C.tid; idx < SEQ * 64; idx += C.G * NTHR) { const int pos = idx >> 6, j = idx & 63;
            const double rev = (double)pos * invf[j] * 0.15915494309189535; const float fr = (float)(rev - __builtin_floor(rev));
            RT[idx] = (F2){__builtin_amdgcn_cosf(fr), __builtin_amdgcn_sinf(fr)}; } }
    { F4* WR = (F4*)(ws + WS_ROUT); const float* nfw = in[12]; const float* wg = in[13]; const float* we = in[15];
        for (int idx = C.vcu * NTHR + C.tid; idx < 64 * 3 * 64; idx += C.G * NTHR) { const int l = idx & 63, nt = (idx >> 6) % 3, kb = idx / 192; const int n = 16 * nt + (l & 15);
            F4 o;
#pragma unroll
            for (int j = 0; j < 4; ++j) { const int k = 16 * kb + 4 * (l >> 4) + j; float wv = 0.f; if (n < 4) wv = wg[k * 4 + n]; else if (n < 36) wv = we[k * 32 + (n - 4)]; o[j] = wv * nfw[k]; }
            WR[idx] = o; } }
}

__device__ __forceinline__ float wscan_add(float v, int lane) {
#pragma unroll
    for (int o = 1; o < 64; o <<= 1) { const float t = __shfl_up(v, o); if (lane >= o) v += t; }
    return v;
}
__device__ __forceinline__ float wscan_max(float v, int lane) {
#pragma unroll
    for (int o = 1; o < 64; o <<= 1) { const float t = __shfl_up(v, o); if (lane >= o) v = fmaxf(v, t); }
    return v;
}
__device__ __forceinline__ void phase2(const Ctx& C, const float* const* in, unsigned char* ws) {
    const float* convw = in[5]; const float* convb = in[6]; const float* b_i = in[7]; const float* b_f = in[8];
    LAS float* sQ = (LAS float*)(C.lds);
    LAS float* sK = (LAS float*)(C.lds + 2048);
    const float* IFP = (const float*)(ws + WS_IF); float* THR = (float*)(ws + WS_THR); float* CDEC = (float*)(ws + WS_CDEC);
    const F2* RT = (const F2*)(ws + WS_ROPE);
    for (int it = C.vcu; it < BATCH * NCHUNK; it += C.G) {
        const int b = it >> 6, c = it & 63; const size_t t0 = (size_t)b * SEQ + (size_t)c * CHUNK;
        __syncthreads();
        if (C.wave < 4) { const int hd = C.wave, l = C.lane;
            const float i0 = IFP[(t0 + 2 * l) * 8 + hd] + b_i[hd], i1 = IFP[(t0 + 2 * l + 1) * 8 + hd] + b_i[hd];
            const float f0 = IFP[(t0 + 2 * l) * 8 + 4 + hd] + b_f[hd], f1 = IFP[(t0 + 2 * l + 1) * 8 + 4 + hd] + b_f[hd];
            const float lf0 = fminf(f0, 0.f) - log1pf(__expf(-fabsf(f0))), lf1 = fminf(f1, 0.f) - log1pf(__expf(-fabsf(f1)));
            const float s1 = lf0 + lf1, inc = wscan_add(s1, l), ex = inc - s1;
            const float b0 = ex + lf0, b1 = ex + s1;
            const float u0 = i0 - b0, u1 = i1 - b1, p1 = fmaxf(u0, u1);
            const float pin = wscan_max(p1, l); float pex = __shfl_up(pin, 1); if (l == 0) pex = -INFINITY;
            const float pm0 = fmaxf(pex, u0), pm1 = fmaxf(pex, p1);
            sQ[hd * 128 + 2 * l] = __expf(-pm0); sQ[hd * 128 + 2 * l + 1] = __expf(-pm1);
            sK[hd * 128 + 2 * l] = __expf(u0) * 0.08838834764831845f; sK[hd * 128 + 2 * l + 1] = __expf(u1) * 0.08838834764831845f;
            THR[(t0 + 2 * l) * 4 + hd] = __expf(-b0 - pm0); THR[(t0 + 2 * l + 1) * 4 + hd] = __expf(-b1 - pm1);
            if (l == 63) CDEC[(size_t)it * 4 + hd] = __expf(b1);
        }
        __syncthreads();
        for (int u = C.tid; u < 2 * 4096; u += NTHR) {
            const int arr = u >> 12, g = u & 7, row = (u >> 3) & 127, hd = (u >> 10) & 3;
            bf16* base = (bf16*)(ws + (arr ? WS_RK : WS_RQ)) + (t0 + row) * 512 + hd * 128 + 8 * g;
            const U4 a = *(const U4*)base, bb = *(const U4*)(base + 64);
            const float lg = hd == 0 ? -0.04580368961312479f : (hd == 1 ? -0.02272007650008353f : (hd == 2 ? -0.011315313227834146f : -0.005646563141142063f));
            const float sc = arr ? exp2f(-lg * (float)row) * 0.08838834764831845f : exp2f(lg * (float)row);
            const F2* rt = RT + (size_t)(c * CHUNK + row) * 64 + 8 * g;
            float x1[8], x2[8], y1[8], y2[8];
            x1[0] = bflo(a.x); x1[1] = bfhi(a.x); x1[2] = bflo(a.y); x1[3] = bfhi(a.y); x1[4] = bflo(a.z); x1[5] = bfhi(a.z); x1[6] = bflo(a.w); x1[7] = bfhi(a.w);
            x2[0] = bflo(bb.x); x2[1] = bfhi(bb.x); x2[2] = bflo(bb.y); x2[3] = bfhi(bb.y); x2[4] = bflo(bb.z); x2[5] = bfhi(bb.z); x2[6] = bflo(bb.w); x2[7] = bfhi(bb.w);
#pragma unroll
            for (int i = 0; i < 8; ++i) { const F2 cs = rt[i]; y1[i] = (x1[i] * cs.x - x2[i] * cs.y) * sc; y2[i] = (x2[i] * cs.x + x1[i] * cs.y) * sc; }
            U4 o1, o2; o1.x = cvtpk(y1[0], y1[1]); o1.y = cvtpk(y1[2], y1[3]); o1.z = cvtpk(y1[4], y1[5]); o1.w = cvtpk(y1[6], y1[7]);
            o2.x = cvtpk(y2[0], y2[1]); o2.y = cvtpk(y2[2], y2[3]); o2.z = cvtpk(y2[4], y2[5]); o2.w = cvtpk(y2[6], y2[7]);
            *(U4*)base = o1; *(U4*)(base + 64) = o2;
        }
        for (int u = C.tid; u < 2 * 8192; u += NTHR) {
            const int arr = u >> 13, g = u & 63, row = (u >> 6) & 127, hd = g >> 4;
            const bf16* src = (const bf16*)(ws + (arr ? WS_MK : WS_MQ)) + (t0 + row) * 512 + 8 * g;
            const int chn = arr * 512 + 8 * g;
            float y[8];
            { const F4 b0 = *(const F4*)(convb + chn), b1 = *(const F4*)(convb + chn + 4); y[0] = b0.x; y[1] = b0.y; y[2] = b0.z; y[3] = b0.w; y[4] = b1.x; y[5] = b1.y; y[6] = b1.z; y[7] = b1.w; }
#pragma unroll
            for (int w = 0; w < 4; ++w) { const int back = 3 - w;
                if (c * CHUNK + row - back >= 0) { const U4 a = *(const U4*)(src - (size_t)back * 512);
                    const F4 w0 = *(const F4*)(convw + w * 1024 + chn), w1 = *(const F4*)(convw + w * 1024 + chn + 4);
                    y[0] += bflo(a.x) * w0.x; y[1] += bfhi(a.x) * w0.y; y[2] += bflo(a.y) * w0.z; y[3] += bfhi(a.y) * w0.w;
                    y[4] += bflo(a.z) * w1.x; y[5] += bfhi(a.z) * w1.y; y[6] += bflo(a.w) * w1.z; y[7] += bfhi(a.w) * w1.w; } }
            const float sc = arr ? sK[hd * 128 + row] : sQ[hd * 128 + row];
#pragma unroll
            for (int i = 0; i < 8; ++i) y[i] = silu(y[i]) * sc;
            U4 o; o.x = cvtpk(y[0], y[1]); o.y = cvtpk(y[2], y[3]); o.z = cvtpk(y[4], y[5]); o.w = cvtpk(y[6], y[7]);
            *(U4*)((bf16*)(ws + (arr ? WS_MKP : WS_MQP)) + (t0 + row) * 512 + 8 * g) = o;
        }
    }
}

template <bool ML, int ABL = 0>
__device__ __forceinline__ void mixer_item(const Ctx& C, const bf16* Qp, const bf16* Kp, bf16* Vp, bf16* Vout, size_t omask, const float* thr, const float* cdec, int b, int hd, int sl) {
    LAS unsigned char* lds = C.lds;
    const int tid = C.tid, lane = C.lane, w = C.wave, l31 = lane & 31, hi = lane >> 5;
    const int lt = (w < 4) ? w : 7 - w, et = w >> 2, dt = w & 3;
    const int q_ = (lane & 15) >> 2, p_ = lane & 3, blk = (lane >> 4) & 1;
    constexpr unsigned KOFF = 0, VOFF = 65536, QOFF = 98304, SOFF = 131072, NOFF = 147456;
    const size_t tok0 = (size_t)b * SEQ;
    const float rdec = hd == 0 ? 0.017183023570817902f : (hd == 1 ? 0.1332151628796484f : (hd == 2 ? 0.3664377159220373f : 0.6059370882290803f));
    __syncthreads();
    for (int i = tid; i < 16384 / 16; i += NTHR) *(LAS U4*)(lds + SOFF + 16 * i) = (U4){0u, 0u, 0u, 0u};
    if (tid < 384) *(LAS float*)(lds + NOFF + 4 * tid) = 0.f;
    F16 St;
#pragma unroll
    for (int r = 0; r < 16; ++r) St[r] = 0.f;
    B8 qf[8];
    const unsigned lds0 = (unsigned)(uintptr_t)lds;
    unsigned ro[8];
#pragma unroll
    for (int s = 0; s < 8; ++s) ro[s] = offb(l31, 2 * s + hi);
    const unsigned kbase = (16 * w + (lane >> 4)) * 512, kx = (lane & 15) ^ ((lane >> 4) << 2);
    const unsigned vbase = (16 * w + (lane >> 3)) * 1024 + ((lane & 7) ^ (((lane >> 4) & 1) << 2)) * 8;
#define ksrc_(i) (kbase + (i) * 2048 + ((kx ^ (i)) * 8))
#define vsrc_(i) (vbase + (i) * 8192)
#define MX_DMA(cc, buf) do { \
        const bf16* kp_ = Kp + (tok0 + (size_t)(cc) * CHUNK) * 512 + hd * 128; \
        _Pragma("unroll") for (int i = 0; i < 4; ++i) glds16(kp_ + ksrc_(i), (unsigned)__builtin_amdgcn_readfirstlane((int)(lds0 + KOFF + (buf) * 32768 + (w * 4 + i) * 1024))); \
        const bf16* vp_ = Vp + (tok0 + (size_t)(cc) * CHUNK) * 1024 + hd * 256 + sl * 64; \
        _Pragma("unroll") for (int i = 0; i < 2; ++i) glds16(vp_ + vsrc_(i), (unsigned)__builtin_amdgcn_readfirstlane((int)(lds0 + VOFF + (buf) * 16384 + (w * 2 + i) * 1024))); \
        const bf16* qp_ = Qp + (tok0 + (size_t)(cc) * CHUNK) * 512 + hd * 128; \
        _Pragma("unroll") for (int i = 0; i < 4; ++i) glds16(qp_ + ksrc_(i), (unsigned)__builtin_amdgcn_readfirstlane((int)(lds0 + QOFF + (w * 4 + i) * 1024))); \
        } while (0)
    float thn = 1.f, dcn = rdec;
    MX_DMA(0, 0);
    if (ML) { thn = thr[(tok0 + 32 * lt + l31) * 4 + hd]; dcn = cdec[((size_t)b * NCHUNK) * 4 + hd]; }
    asm volatile("s_waitcnt vmcnt(0)" ::: "memory");
    __syncthreads();
    for (int c = 0; c < NCHUNK; ++c) {
        const int cur = c & 1, nxt = cur ^ 1;
        const unsigned KB = KOFF + cur * 32768, VB = VOFF + cur * 16384;
        const float th = thn, decay = dcn;
        B8 af[8];
#pragma unroll
        for (int s = 0; s < 8; ++s) qf[s] = *(const LAS B8*)(lds + (QOFF + 8192 * lt) + ro[s]);
#pragma unroll
        for (int s = 0; s < 8; ++s) af[s] = *(const LAS B8*)(lds + (SOFF + 8192 * et) + ro[s]);
        F16 o;
#pragma unroll
        for (int r = 0; r < 16; ++r) o[r] = 0.f;
#pragma unroll
        for (int s = 0; s < 8; ++s) { o = MFMA32(af[s], qf[s], o); af[s] = *(const LAS B8*)(lds + KB + ro[s]); }
        asm volatile("s_waitcnt lgkmcnt(0)" ::: "memory");
        __syncthreads();
        if (c + 1 < NCHUNK) { if (!(ABL & 4)) MX_DMA(c + 1, nxt);
            if (ML) { thn = thr[(tok0 + (size_t)(c + 1) * CHUNK + 32 * lt + l31) * 4 + hd]; dcn = cdec[((size_t)b * NCHUNK + c + 1) * 4 + hd]; } }
        float csum = 0.f;
        for (int jt = 0; jt <= lt; ++jt) {
            F16 st;
#pragma unroll
            for (int r = 0; r < 16; ++r) st[r] = 0.f;
            S4 vfr[4];
#pragma unroll
            for (int s2 = 0; s2 < 2; ++s2) { const unsigned R0 = 32 * jt + 16 * s2 + 4 * hi + q_, chv = 4 * et + 2 * blk + (p_ >> 1);
                vfr[2 * s2] = trrd(lds + VB + offv(R0, chv) + 8 * (p_ & 1)); vfr[2 * s2 + 1] = trrd(lds + VB + offv(R0 + 8, chv) + 8 * (p_ & 1)); }
#pragma unroll
            for (int s = 0; s < 8; ++s) { st = MFMA32(af[s], qf[s], st); af[s] = *(const LAS B8*)(lds + (KB + 8192 * (jt + 1)) + ro[s]); }
            if (jt == lt) {
#pragma unroll
                for (int r = 0; r < 16; ++r) if (crow(r, hi) > l31) st[r] = 0.f;
            }
            if (ML) {
#pragma unroll
                for (int r = 0; r < 16; ++r) csum += st[r];
            }
#pragma unroll
            for (int s2 = 0; s2 < 2; ++s2) {
                U4 pk; pk.x = cvtpk(st[8 * s2 + 0], st[8 * s2 + 1]); pk.y = cvtpk(st[8 * s2 + 2], st[8 * s2 + 3]); pk.z = cvtpk(st[8 * s2 + 4], st[8 * s2 + 5]); pk.w = cvtpk(st[8 * s2 + 6], st[8 * s2 + 7]);
                const B8 bfr = __builtin_bit_cast(B8, pk);
                const B8 afr = __builtin_shufflevector(vfr[2 * s2], vfr[2 * s2 + 1], 0, 1, 2, 3, 4, 5, 6, 7);
                o = MFMA32(afr, bfr, o);
            }
        }
        if (ML) {
            float qd = 0.f;
#pragma unroll
            for (int s = 0; s < 8; ++s) { const U4 nv = *(const LAS U4*)(lds + NOFF + 1024 + cur * 256 + (16 * s + 8 * hi) * 2); const U4 qv = __builtin_bit_cast(U4, qf[s]);
                qd = dot2bf(qv.x, nv.x, qd); qd = dot2bf(qv.y, nv.y, qd); qd = dot2bf(qv.z, nv.z, qd); qd = dot2bf(qv.w, nv.w, qd); }
            csum += __shfl_xor(csum, 32); qd += __shfl_xor(qd, 32);
            const float den = csum + qd;
            const float sc = 1.f / fmaxf(fabsf(den), th);
#pragma unroll
            for (int r = 0; r < 16; ++r) o[r] *= sc;
        }
        { unsigned pk[8];
#pragma unroll
            for (int g = 0; g < 4; ++g) { pk[2 * g] = cvtpk(o[4 * g], o[4 * g + 1]); pk[2 * g + 1] = cvtpk(o[4 * g + 2], o[4 * g + 3]); }
            U4 s0, s1;
            { auto ra = __builtin_amdgcn_permlane32_swap(pk[0], pk[2], false, false); auto rb = __builtin_amdgcn_permlane32_swap(pk[1], pk[3], false, false);
              s0.x = ra[0]; s0.y = rb[0]; s0.z = ra[1]; s0.w = rb[1]; }
            { auto ra = __builtin_amdgcn_permlane32_swap(pk[4], pk[6], false, false); auto rb = __builtin_amdgcn_permlane32_swap(pk[5], pk[7], false, false);
              s1.x = ra[0]; s1.y = rb[0]; s1.z = ra[1]; s1.w = rb[1]; }
            bf16* op = Vout + ((tok0 + (size_t)c * CHUNK + 32 * lt + l31) & omask) * 1024 + hd * 256 + sl * 64 + 32 * et + 8 * hi;
            if (ABL & 2) { asm volatile("" :: "v"(s0), "v"(s1)); } else { *(U4*)op = s0; *(U4*)(op + 16) = s1; } }
        float ksum = 0.f;
        { const unsigned chk = 4 * dt + 2 * blk + (p_ >> 1), chv = 4 * et + 2 * blk + (p_ >> 1);
          const unsigned ka0 = KB + offb(8 * hi + q_, chk) + 8 * (p_ & 1), ka1 = KB + offb(8 * hi + q_ + 4, chk) + 8 * (p_ & 1);
          const unsigned va0 = VB + offv(8 * hi + q_, chv) + 8 * (p_ & 1), va1 = VB + offv(8 * hi + q_ + 4, chv) + 8 * (p_ & 1);
          S4 ua[2][2], ub[2][2];
          ua[0][0] = trrd(lds + ka0); ua[0][1] = trrd(lds + ka1); ub[0][0] = trrd(lds + va0); ub[0][1] = trrd(lds + va1);
#pragma unroll
          for (int ks = 0; ks < 8; ++ks) { const int cu = ks & 1, nx = cu ^ 1;
            if (ks < 7) { ua[nx][0] = trrd(lds + ka0 + 4096 * (ks + 1)); ua[nx][1] = trrd(lds + ka1 + 4096 * (ks + 1)); ub[nx][0] = trrd(lds + va0 + 2048 * (ks + 1)); ub[nx][1] = trrd(lds + va1 + 2048 * (ks + 1)); }
            const B8 afr = __builtin_shufflevector(ua[cu][0], ua[cu][1], 0, 1, 2, 3, 4, 5, 6, 7), bfr = __builtin_shufflevector(ub[cu][0], ub[cu][1], 0, 1, 2, 3, 4, 5, 6, 7);
            St = MFMA32(afr, bfr, St);
            if (ML) { const U4 av = __builtin_bit_cast(U4, afr); ksum = dot2bf(av.x, 0x3f803f80u, ksum); ksum = dot2bf(av.y, 0x3f803f80u, ksum); ksum = dot2bf(av.z, 0x3f803f80u, ksum); ksum = dot2bf(av.w, 0x3f803f80u, ksum); }
          } }
#pragma unroll
        for (int r = 0; r < 16; ++r) St[r] *= decay;
#pragma unroll
        for (int g = 0; g < 4; ++g) { U2 pk; pk.x = cvtpk(St[4 * g], St[4 * g + 1]); pk.y = cvtpk(St[4 * g + 2], St[4 * g + 3]);
            *(LAS U2*)(lds + SOFF + offb(32 * et + l31, 4 * dt + g) + 8 * hi) = pk; }
        if (ML) { ksum += __shfl_xor(ksum, 32);
            if (et == 0 && hi == 0) { const LAS float* nv = (const LAS float*)(lds + NOFF + cur * 512); LAS float* nn = (LAS float*)(lds + NOFF + nxt * 512);
                const float nval = decay * (nv[32 * dt + l31] + ksum); nn[32 * dt + l31] = nval;
                *(LAS unsigned short*)(lds + NOFF + 1024 + nxt * 256 + (32 * dt + l31) * 2) = (unsigned short)(cvtpk(nval, 0.f) & 0xffffu); } }
        asm volatile("s_waitcnt vmcnt(2)" ::: "memory");
        __syncthreads();
    }
#undef MX_DMA
#undef ksrc_
#undef vsrc_
}
__device__ __forceinline__ void phase3(const Ctx& C, unsigned char* ws, bool dry) {
    for (int it = C.vcu; it < 256; it += C.G) {
        const int mix = it >> 7, b = (it >> 4) & 7, hd = (it >> 2) & 3, sl = it & 3;
        bf16* vr = (bf16*)(ws + WS_RV); bf16* vm = (bf16*)(ws + WS_MV); bf16* dump = (bf16*)(ws + 930 * MiB);
#ifndef DRY_ABL
#define DRY_ABL 0
#endif
        if (dry) {
            if (mix == 0 || (DRY_ABL & 1)) mixer_item<false, DRY_ABL>(C, (const bf16*)(ws + (mix ? WS_MQP : WS_RQ)), (const bf16*)(ws + (mix ? WS_MKP : WS_RK)), mix ? vm : vr, dump, (size_t)0x7fff, nullptr, nullptr, b, hd, sl);
            else mixer_item<true, DRY_ABL>(C, (const bf16*)(ws + WS_MQP), (const bf16*)(ws + WS_MKP), vm, dump, (size_t)0x7fff, (const float*)(ws + WS_THR), (const float*)(ws + WS_CDEC), b, hd, sl);
        } else {
        if (mix == 0) mixer_item<false>(C, (const bf16*)(ws + WS_RQ), (const bf16*)(ws + WS_RK), vr, vr, ~(size_t)0, nullptr, nullptr, b, hd, sl);
        else mixer_item<true>(C, (const bf16*)(ws + WS_MQP), (const bf16*)(ws + WS_MKP), vm, vm, ~(size_t)0, (const float*)(ws + WS_THR), (const float*)(ws + WS_CDEC), b, hd, sl);
        }
    }
}

__device__ __forceinline__ void phase4(const Ctx& C, const float* const* in, unsigned char* ws) {
    const float* rgn = in[3]; const float* mgn = in[9];
    const int gw = C.vcu * NWAVES + C.wave, NGW = C.G * NWAVES;
    const int col = (C.lane >> 4) * 256 + (C.lane & 15) * 16;
    float gr[16], gm[16];
#pragma unroll
    for (int i = 0; i < 4; ++i) { const F4 a = *(const F4*)(rgn + col + 4 * i), bq = *(const F4*)(mgn + col + 4 * i);
        gr[4 * i] = a.x; gr[4 * i + 1] = a.y; gr[4 * i + 2] = a.z; gr[4 * i + 3] = a.w; gm[4 * i] = bq.x; gm[4 * i + 1] = bq.y; gm[4 * i + 2] = bq.z; gm[4 * i + 3] = bq.w; }
    for (int m = gw; m < NTOK; m += NGW) {
#pragma unroll
        for (int mx = 0; mx < 2; ++mx) {
            bf16* op = (bf16*)(ws + (mx ? WS_MV : WS_RV)) + (size_t)m * 1024 + col;
            const bf16* gp = (const bf16*)(ws + (mx ? WS_MO : WS_RG)) + (size_t)m * 1024 + col;
            const U4 o0 = *(const U4*)op, o1 = *(const U4*)(op + 8), g0 = *(const U4*)gp, g1 = *(const U4*)(gp + 8);
            float v[16], g[16];
            v[0] = bflo(o0.x); v[1] = bfhi(o0.x); v[2] = bflo(o0.y); v[3] = bfhi(o0.y); v[4] = bflo(o0.z); v[5] = bfhi(o0.z); v[6] = bflo(o0.w); v[7] = bfhi(o0.w);
            v[8] = bflo(o1.x); v[9] = bfhi(o1.x); v[10] = bflo(o1.y); v[11] = bfhi(o1.y); v[12] = bflo(o1.z); v[13] = bfhi(o1.z); v[14] = bflo(o1.w); v[15] = bfhi(o1.w);
            g[0] = bflo(g0.x); g[1] = bfhi(g0.x); g[2] = bflo(g0.y); g[3] = bfhi(g0.y); g[4] = bflo(g0.z); g[5] = bfhi(g0.z); g[6] = bflo(g0.w); g[7] = bfhi(g0.w);
            g[8] = bflo(g1.x); g[9] = bfhi(g1.x); g[10] = bflo(g1.y); g[11] = bfhi(g1.y); g[12] = bflo(g1.z); g[13] = bfhi(g1.z); g[14] = bflo(g1.w); g[15] = bfhi(g1.w);
            if (mx) {
#pragma unroll
                for (int i = 0; i < 16; ++i) v[i] *= sigm(g[i]);
            }
            float ss = 0.f;
#pragma unroll
            for (int i = 0; i < 16; ++i) ss += v[i] * v[i];
            ss += __shfl_xor(ss, 1); ss += __shfl_xor(ss, 2); ss += __shfl_xor(ss, 4); ss += __shfl_xor(ss, 8);
            const float r = rsqrtf(ss * (1.f / 256.f) + EPS);
            float y[16];
#pragma unroll
            for (int i = 0; i < 16; ++i) y[i] = mx ? v[i] * r * gm[i] : v[i] * r * gr[i] * silu(g[i]);
            U4 w0, w1; w0.x = cvtpk(y[0], y[1]); w0.y = cvtpk(y[2], y[3]); w0.z = cvtpk(y[4], y[5]); w0.w = cvtpk(y[6], y[7]);
            w1.x = cvtpk(y[8], y[9]); w1.y = cvtpk(y[10], y[11]); w1.z = cvtpk(y[12], y[13]); w1.w = cvtpk(y[14], y[15]);
            *(U4*)op = w0; *(U4*)(op + 8) = w1;
        }
    }
    LAS float* scr = (LAS float*)(C.lds + C.wave * 8448);
    const float* wgate = in[17]; const float* wup = in[18]; const float* wdn = in[19];
    for (int it = gw; it < 16384 + 8192; it += NGW) {
        if (it < 16384) { const int e = it >> 9, kb = (it >> 5) & 15, nb = it & 31; const int R0 = nb * 32, tile = R0 >> 8, within = R0 & 255;
            const float* W = (within < 128 ? wgate : wup) + (size_t)e * 1024 * 512;
            transpose_item(W, 512, kb * 64, tile * 128 + (within & 127), (bf16*)(ws + WS_WGU), 1024, e * 1024 + R0, scr, C.lane); }
        else { const int r = it - 16384; const int e = r >> 8, kb = (r >> 5) & 7, nb = r & 31;
            transpose_item(wdn + (size_t)e * 512 * 1024, 1024, kb * 64, nb * 32, (bf16*)(ws + WS_WD), 512, e * 1024 + nb * 32, scr, C.lane); }
    }
}

__device__ __forceinline__ void phase8(const Ctx& C, const float* const* in, const float* x1, unsigned char* ws) {
    const float* bg = in[14]; const float* be = in[16];
    const F4* WR = (const F4*)(ws + WS_ROUT); TokInfo* TI = (TokInfo*)(ws + WS_TOK); unsigned* gcnt = (unsigned*)(ws + WS_CTL);
    LAS float* scr = (LAS float*)(C.lds + C.wave * 4096);
    LAS unsigned* lcnt = (LAS unsigned*)(C.lds + 65536);
    LAS unsigned* lbase = (LAS unsigned*)(C.lds + 65536 + 128);
    const int l = C.lane, l15 = l & 15, kk = l >> 4;
    for (int blkid = C.vcu; blkid < NTOK / 256; blkid += C.G) {
        __syncthreads();
        if (C.tid < 32) lcnt[C.tid] = 0u;
        __syncthreads();
        int e0[2], e1[2]; float w0[2], w1[2], rs[2]; unsigned rk0[2], rk1[2];
#pragma unroll
        for (int tt = 0; tt < 2; ++tt) {
            const int row0 = blkid * 256 + C.wave * 32 + tt * 16;
            F4 acc[3]; for (int n = 0; n < 3; ++n) acc[n] = (F4){0.f, 0.f, 0.f, 0.f};
            float ss = 0.f;
            const float* xr = x1 + (size_t)(row0 + l15) * DM + 4 * kk;
#pragma unroll 4
            for (int kb = 0; kb < 64; ++kb) {
                const F4 a = *(const F4*)(xr + 16 * kb);
                const F4 b0 = WR[(kb * 3 + 0) * 64 + l], b1 = WR[(kb * 3 + 1) * 64 + l], b2 = WR[(kb * 3 + 2) * 64 + l];
                ss += (a.x * a.x + a.y * a.y) + (a.z * a.z + a.w * a.w);
#pragma unroll
                for (int j = 0; j < 4; ++j) {
                    acc[0] = __builtin_amdgcn_mfma_f32_16x16x4f32(a[j], b0[j], acc[0], 0, 0, 0);
                    acc[1] = __builtin_amdgcn_mfma_f32_16x16x4f32(a[j], b1[j], acc[1], 0, 0, 0);
                    acc[2] = __builtin_amdgcn_mfma_f32_16x16x4f32(a[j], b2[j], acc[2], 0, 0, 0); }
            }
            ss += __shfl_xor(ss, 16); ss += __shfl_xor(ss, 32);
            const float rstd = rsqrtf(ss * (1.f / DM) + EPS);
#pragma unroll
            for (int n = 0; n < 3; ++n)
#pragma unroll
                for (int r = 0; r < 4; ++r) scr[(4 * kk + r) * 49 + 16 * n + l15] = acc[n][r];
            if (kk == 0) scr[16 * 49 + l15] = rstd;
            asm volatile("s_waitcnt lgkmcnt(0)" ::: "memory");
            e0[tt] = 0; e1[tt] = 0; w0[tt] = 0.f; w1[tt] = 0.f; rs[tt] = 0.f; rk0[tt] = 0u; rk1[tt] = 0u;
            if (l < 16) {
                const LAS float* lr = scr + l * 49; const float rr = scr[16 * 49 + l];
                float g0 = lr[0] * rr + bg[0], g1 = lr[1] * rr + bg[1], g2 = lr[2] * rr + bg[2], g3 = lr[3] * rr + bg[3];
                int gi = 0; float gmx = g0; if (g1 > gmx) { gmx = g1; gi = 1; } if (g2 > gmx) { gmx = g2; gi = 2; } if (g3 > gmx) { gmx = g3; gi = 3; }
                const float gw = 1.f / (__expf(g0 - gmx) + __expf(g1 - gmx) + __expf(g2 - gmx) + __expf(g3 - gmx));
                float m1 = -INFINITY, m2 = -INFINITY; int i1 = 0, i2 = 0;
#pragma unroll
                for (int i = 0; i < 8; ++i) { const float v = lr[4 + gi * 8 + i] * rr + be[gi * 8 + i];
                    if (v > m1) { m2 = m1; i2 = i1; m1 = v; i1 = i; } else if (v > m2) { m2 = v; i2 = i; } }
                const float ex = __expf(m2 - m1), wa = 1.f / (1.f + ex);
                e0[tt] = gi * 8 + i1; e1[tt] = gi * 8 + i2; w0[tt] = gw * wa; w1[tt] = gw * ex * wa; rs[tt] = rr;
                rk0[tt] = atomicAdd((unsigned*)(lcnt + e0[tt]), 1u); rk1[tt] = atomicAdd((unsigned*)(lcnt + e1[tt]), 1u);
            }
            asm volatile("s_waitcnt lgkmcnt(0)" ::: "memory");
        }
        __syncthreads();
        if (C.tid < 32) lbase[C.tid] = atomicAdd(gcnt + C.tid, lcnt[C.tid]);
        __syncthreads();
#pragma unroll
        for (int tt = 0; tt < 2; ++tt) if (l < 16) {
            TokInfo ti; ti.e0 = e0[tt]; ti.p0 = (int)(lbase[e0[tt]] + rk0[tt]); ti.e1 = e1[tt]; ti.p1 = (int)(lbase[e1[tt]] + rk1[tt]); ti.w0 = w0[tt]; ti.w1 = w1[tt]; ti.rstd = rs[tt]; ti.pad = 0.f;
            TI[blkid * 256 + C.wave * 32 + tt * 16 + l] = ti; }
    }
}

__device__ __forceinline__ int build_rowbase(const Ctx& C, unsigned char* ws) {
    LAS int* rb = (LAS int*)(C.lds + LDS_MISC);
    LAS unsigned char* t2e = (LAS unsigned char*)(C.lds + LDS_MISC + 256);
    const unsigned* gcnt = (const unsigned*)(ws + WS_CTL);
    __syncthreads();
    if (C.tid == 0) { int acc = 0; for (int e = 0; e < NEXP; ++e) { rb[e] = acc; const int n = (int)__hip_atomic_load(gcnt + e, __ATOMIC_RELAXED, __HIP_MEMORY_SCOPE_AGENT); acc += (n + 255) & ~255; } rb[NEXP] = acc; }
    __syncthreads();
    for (int e = C.tid >> 4; e < NEXP; e += NTHR >> 4) for (int t = (rb[e] >> 8) + (C.tid & 15); t < (rb[e + 1] >> 8); t += 16) t2e[t] = (unsigned char)e;
    __syncthreads();
    return rb[NEXP] >> 8;
}

__device__ __forceinline__ void phase9(const Ctx& C, const float* const* in, const float* x1, unsigned char* ws) {
    (void)build_rowbase(C, ws);
    const LAS int* rb = (const LAS int*)(C.lds + LDS_MISC);
    const float* nfw = in[12]; const TokInfo* TI = (const TokInfo*)(ws + WS_TOK); bf16* XS = (bf16*)(ws + WS_XS);
    const int gw = C.vcu * NWAVES + C.wave, NGW = C.G * NWAVES;
    F4 wv[4];
#pragma unroll
    for (int j = 0; j < 4; ++j) wv[j] = *(const F4*)(nfw + 4 * C.lane + 256 * j);
    for (int m = gw; m < NTOK; m += NGW) {
        const TokInfo ti = TI[m];
        const F4* xr = (const F4*)(x1 + (size_t)m * DM) + C.lane;
        unsigned long long* d0 = (unsigned long long*)(XS + (size_t)(rb[ti.e0] + ti.p0) * DM) + C.lane;
        unsigned long long* d1 = (unsigned long long*)(XS + (size_t)(rb[ti.e1] + ti.p1) * DM) + C.lane;
#pragma unroll
        for (int j = 0; j < 4; ++j) { const F4 v = xr[64 * j] * ti.rstd * wv[j];
            const unsigned long long pk = (unsigned long long)cvtpk(v.x, v.y) | ((unsigned long long)cvtpk(v.z, v.w) << 32);
            d0[64 * j] = pk; d1[64 * j] = pk; }
    }
}

__device__ __forceinline__ void phase12(const Ctx& C, const float* const* in, float* xo, unsigned char* ws) {
    (void)build_rowbase(C, ws);
    const LAS int* rb = (const LAS int*)(C.lds + LDS_MISC);
    const float* fw = in[20]; const TokInfo* TI = (const TokInfo*)(ws + WS_TOK); const bf16* Y = (const bf16*)(ws + WS_Y);
    const int gw = C.vcu * NWAVES + C.wave, NGW = C.G * NWAVES;
    F4 wv[4];
#pragma unroll
    for (int j = 0; j < 4; ++j) wv[j] = *(const F4*)(fw + 4 * C.lane + 256 * j);
    for (int m = gw; m < NTOK; m += NGW) {
        const TokInfo ti = TI[m];
        F4* xr = (F4*)(xo + (size_t)m * DM) + C.lane;
        const U2* y0 = (const U2*)(Y + (size_t)(rb[ti.e0] + ti.p0) * DM) + C.lane;
        const U2* y1 = (const U2*)(Y + (size_t)(rb[ti.e1] + ti.p1) * DM) + C.lane;
        F4 v[4]; float s = 0.f;
#pragma unroll
        for (int j = 0; j < 4; ++j) { const U2 a = y0[64 * j], bq = y1[64 * j]; v[j] = xr[64 * j];
            v[j].x += ti.w0 * bflo(a.x) + ti.w1 * bflo(bq.x); v[j].y += ti.w0 * bfhi(a.x) + ti.w1 * bfhi(bq.x);
            v[j].z += ti.w0 * bflo(a.y) + ti.w1 * bflo(bq.y); v[j].w += ti.w0 * bfhi(a.y) + ti.w1 * bfhi(bq.y);
            s += (v[j].x * v[j].x + v[j].y * v[j].y) + (v[j].z * v[j].z + v[j].w * v[j].w); }
        const float rstd = rsqrtf(wave_sum(s) * (1.f / DM) + EPS);
#pragma unroll
        for (int j = 0; j < 4; ++j) xr[64 * j] = v[j] * rstd * wv[j];
    }
}

constexpr int NPHASE = 13;
struct Args { const float* in[21]; float* out; unsigned char* ws; int ph_lo, ph_hi; };
__global__ void __launch_bounds__(NTHR, 2) fwd_kernel(Args args) {
    extern __shared__ __attribute__((aligned(16))) unsigned char lds_raw[];
    cg::grid_group grid = cg::this_grid();
    Ctx C; C.lds = (LAS unsigned char*)lds_raw; C.tid = threadIdx.x; C.lane = C.tid & 63; C.wave = __builtin_amdgcn_readfirstlane(C.tid >> 6);
    C.G = gridDim.x; { const int bx = blockIdx.x; C.vcu = (C.G % 8 == 0) ? (bx % 8) * (C.G / 8) + bx / 8 : bx; }
    unsigned char* ws = args.ws; unsigned char* ob = (unsigned char*)args.out;
    const int lo = args.ph_lo, hi = args.ph_hi;
#ifndef PHMASK
#define PHMASK 0x1fff
#endif
#define IN(k) (((PHMASK >> (k)) & 1) && lo <= (k) && (k) < hi)
    if (C.tid < 2) ((LAS unsigned*)(C.lds + LDS_MISC + 4096))[C.tid] = 0u;
    __syncthreads();
    const XcdBarrier bar = xcd_barrier_post((unsigned*)(ws + WS_CTL) + CW_BAR, (volatile LAS unsigned*)(C.lds + LDS_MISC + 4096));
#define SEAM(k) do { if (IN(k) && IN((k) + 1)) { if ((k) == 0) grid.sync(); else xcd_barrier(bar); } } while (0)
#ifndef DUP_MASK
#define DUP_MASK 0
#endif
#define REP(k) for (int rep_ = 0; rep_ < (((DUP_MASK >> (k)) & 1) ? 2 : 1); ++rep_)
    if (IN(0)) { REP(0) phase0(C, args.in, ws); } SEAM(0);
    if (IN(1)) { pg8::Gemm g{(const pg8::bf16_t*)(ws + WS_H), (const pg8::bf16_t*)(ws + WS_WIN), NTOK, NPROJ, DM}; pg8::StaticOrder S; S.init(NTOK, NPROJ, C.G, (int)blockIdx.x);
        pg8::EpiProj E{ws, ob}; REP(1) pg8::gemm_phase<pg8::EpiProj, pg8::StaticOrder, true, true>(C.lds, g, S, E); } SEAM(1);
    if (IN(2)) { phase2(C, args.in, ws); } SEAM(2);
    if (IN(3)) { if ((DUP_MASK >> 3) & 1) phase3(C, ws, true); phase3(C, ws, false); } SEAM(3);
    if (IN(4)) { phase4(C, args.in, ws); } SEAM(4);
    if (IN(5)) { pg8::Gemm g{(const pg8::bf16_t*)(ws + WS_RV), (const pg8::bf16_t*)(ws + WS_WRB), NTOK, DM, DM}; pg8::StaticOrder S; S.init(NTOK, DM, C.G, (int)blockIdx.x);
        pg8::EpiGate<0> E{(const pg8::bf16_t*)(ob + OUT_GR), nullptr, (pg8::bf16_t*)(ws + WS_TMP)}; REP(5) pg8::gemm_phase<pg8::EpiGate<0>, pg8::StaticOrder, true, true>(C.lds, g, S, E); } SEAM(5);
    if (IN(6)) { pg8::Gemm g{(const pg8::bf16_t*)(ws + WS_MV), (const pg8::bf16_t*)(ws + WS_WMB), NTOK, DM, DM}; pg8::StaticOrder S; S.init(NTOK, DM, C.G, (int)blockIdx.x);
        pg8::EpiGate<1> E{(const pg8::bf16_t*)(ob + OUT_GM), (const pg8::bf16_t*)(ws + WS_TMP), (pg8::bf16_t*)(ws + WS_MERGED)}; REP(6) pg8::gemm_phase<pg8::EpiGate<1>, pg8::StaticOrder, true, true>(C.lds, g, S, E); } SEAM(6);
    if (IN(7)) { pg8::Gemm g{(const pg8::bf16_t*)(ws + WS_MERGED), (const pg8::bf16_t*)(ws + WS_WOUT), NTOK, DM, DM}; pg8::StaticOrder S; S.init(NTOK, DM, C.G, (int)blockIdx.x);
        pg8::EpiX1 E{args.in[0], args.out}; REP(7) pg8::gemm_phase<pg8::EpiX1, pg8::StaticOrder, true, true>(C.lds, g, S, E); } SEAM(7);
    if (IN(8)) { phase8(C, args.in, args.out, ws); } SEAM(8);
    if (IN(9)) { REP(9) phase9(C, args.in, args.out, ws); } SEAM(9);
    if (IN(10)) { const int nt = build_rowbase(C, ws);
        pg8::Gemm g{(const pg8::bf16_t*)(ws + WS_XS), (const pg8::bf16_t*)(ws + WS_WGU), MAXROWS, NEXP * 1024, DM};
        pg8::GroupedOrder S{nt, C.G, C.vcu, (const LAS unsigned char*)(C.lds + LDS_MISC + 256)};
        pg8::EpiSwiglu E{(pg8::bf16_t*)(ws + WS_HMID)}; REP(10) pg8::gemm_phase<pg8::EpiSwiglu, pg8::GroupedOrder, true, true>(C.lds, g, S, E); } SEAM(10);
    if (IN(11)) { const int nt = build_rowbase(C, ws);
        pg8::Gemm g{(const pg8::bf16_t*)(ws + WS_HMID), (const pg8::bf16_t*)(ws + WS_WD), MAXROWS, NEXP * 1024, DEXP};
        pg8::GroupedOrder S{nt, C.G, C.vcu, (const LAS unsigned char*)(C.lds + LDS_MISC + 256)};
        pg8::EpiY E{(pg8::bf16_t*)(ws + WS_Y)}; REP(11) pg8::gemm_phase<pg8::EpiY, pg8::GroupedOrder, true, true>(C.lds, g, S, E); } SEAM(11);
    if (IN(12)) { phase12(C, args.in, args.out, ws); }
#undef IN
#undef SEAM
}

#ifndef MK_SPLIT
#define MK_SPLIT 0
#endif
extern "C" void kernel_launch(void* const* d_in, const int* in_sizes, int n_in, void* d_out, int out_size, void* d_ws, size_t ws_size, hipStream_t stream) {
    static int grid = 0;
    if (grid == 0) {
        if (n_in != 21 || out_size != NTOK * DM || ws_size < WS_END) { fprintf(stderr, "kernel_launch: unexpected shapes (n_in %d out %d ws %zu)\n", n_in, out_size, ws_size); grid = -1; return; }
        int dev = 0, cus = 0, per_cu = 0;
        if (hipGetDevice(&dev) != hipSuccess || hipDeviceGetAttribute(&cus, hipDeviceAttributeMultiprocessorCount, dev) != hipSuccess) { grid = -1; return; }
        if (hipFuncSetAttribute((const void*)fwd_kernel, hipFuncAttributeMaxDynamicSharedMemorySize, LDS_BYTES) != hipSuccess) { fprintf(stderr, "kernel_launch: hipFuncSetAttribute failed\n"); grid = -1; return; }
        if (hipOccupancyMaxActiveBlocksPerMultiprocessor(&per_cu, (const void*)fwd_kernel, NTHR, LDS_BYTES) != hipSuccess || per_cu < 1) { fprintf(stderr, "kernel_launch: occupancy query says %d\n", per_cu); per_cu = 1; }
        (void)hipGetLastError();
        grid = cus;
    }
    if (grid < 0) return;
    (void)hipMemsetAsync((char*)d_ws + WS_CTL, 0, CTL_ZERO_BYTES, stream);
    Args a{};
    for (int i = 0; i < 21; ++i) a.in[i] = (const float*)d_in[i];
    a.out = (float*)d_out; a.ws = (unsigned char*)d_ws;
    void* kargs[] = {&a};
#if MK_SPLIT
    for (int p = 0; p < NPHASE; ++p) { a.ph_lo = p; a.ph_hi = p + 1;
        hipError_t e = hipLaunchCooperativeKernel((const void*)fwd_kernel, dim3(grid), dim3(NTHR), kargs, LDS_BYTES, stream);
        if (e != hipSuccess) { fprintf(stderr, "kernel_launch: launch %d failed: %s\n", p, hipGetErrorString(e)); break; } }
#else
    a.ph_lo = 0; a.ph_hi = NPHASE;
    hipError_t e = hipLaunchCooperativeKernel((const void*)fwd_kernel, dim3(grid), dim3(NTHR), kargs, LDS_BYTES, stream);
    if (e != hipSuccess) fprintf(stderr, "kernel_launch: cooperative launch failed: %s (grid %d)\n", hipGetErrorString(e), grid);
#endif
}
```

```cpp
#include <hip/hip_runtime.h>
#include <hip/hip_cooperative_groups.h>
#include <cstdio>
#include <cstdint>
namespace cg = cooperative_groups;
namespace pg8 {
#define PG8_LAS __attribute__((address_space(3)))
typedef unsigned short bf16_t;
typedef short bf16x8 __attribute__((ext_vector_type(8)));
typedef float f32x4 __attribute__((ext_vector_type(4)));
typedef unsigned u32x4 __attribute__((ext_vector_type(4)));
constexpr int BM = 256, BK = 64, HALF = 128, HTB = HALF * BK * 2  , STAGE_BYTES = 8 * HTB, NXCD = 8, WGM = 8;

__host__ __device__ __forceinline__ int lds_byte(int r, int c) { const int st = (r >> 4) * 2 + (c >> 5), rr = r & 15, cc = c & 31, ob = rr * 64 + cc * 2; return st * 1024 + (ob ^ (((ob >> 9) & 1) << 5)); }
__host__ __device__ __forceinline__ void stage_rc(int b, int& R, int& C) { const int st = b / 1024, sb = b % 1024, swz = sb ^ (((sb >> 9) & 1) << 5); R = (st >> 1) * 16 + swz / 64; C = (st & 1) * 32 + (swz % 64) / 2; }
__host__ __device__ __forceinline__ int perm32(int rho) { const int n = rho >> 4, i = rho & 15; return 8 * (i >> 2) + 4 * n + (i & 3); }

struct Unit { int pm, pn; };
struct Gemm { const bf16_t* A; const bf16_t* Bt; int M, N, K; };

struct StaticOrder {
    int nM, nN, nwg, G, c;
    __host__ __device__ void init(int M, int N, int G_, int c_) { nM = M / BM; nN = N / BM; nwg = nM * nN; G = G_; c = c_; }
    __host__ __device__ bool next(int i, Unit& u) const {
        const long L = (long)i * G + c; if (L >= nwg) return false;
        int wgid = (int)L; { const int q = nwg / NXCD, r = nwg % NXCD, xcd = wgid % NXCD, off = wgid / NXCD; wgid = (xcd < r ? xcd * (q + 1) : r * (q + 1) + (xcd - r) * q) + off; }
        const int nig = WGM * nN, gid = wgid / nig, fm = gid * WGM, gsz = (nM - fm) < WGM ? (nM - fm) : WGM;
        u.pm = fm + ((wgid % nig) % gsz); u.pn = (wgid % nig) / gsz; return true;
    }
    __device__ __forceinline__ void a_ready(const Unit&) const {}
    __device__ __forceinline__ void done(const Unit&) const {}
};

__device__ __forceinline__ unsigned cvt_pk_bf16(float lo, float hi) { unsigned r; asm volatile("v_cvt_pk_bf16_f32 %0, %1, %2" : "=v"(r) : "v"(lo), "v"(hi)); return r; }
typedef float f32x2 __attribute__((ext_vector_type(2)));
__device__ __forceinline__ f32x2 gelu_pk(f32x2 v) {
    const f32x2 av = __builtin_elementwise_abs(v), d = av * 0.2316418882f + 1.0f;
    f32x2 t; t.x = __builtin_amdgcn_rcpf(d.x); t.y = __builtin_amdgcn_rcpf(d.y);
    f32x2 q = t * 0.5307027145f + (-0.7265760135f); q = q * t + 0.7107068705f; q = q * t + (-0.142248368f); q = q * t + 0.127414796f; q = q * t;
    const f32x2 s = (v * v) * (-0.72134752044f);
    f32x2 e; e.x = __builtin_amdgcn_exp2f(s.x); e.y = __builtin_amdgcn_exp2f(s.y);
    const f32x2 m = v * (q * e), r = v - m;
    f32x2 o; o.x = v.x < 0.f ? m.x : r.x; o.y = v.y < 0.f ? m.y : r.y; return o;
}

template <int ACT  > struct EpiBf16 {
    static constexpr bool PERM = true, AFTER_DRAIN = false, MIDK = false; static_assert(ACT == 0 || ACT == 1, "EpiBf16: ACT is 0 (none) or 1 (gelu_pk)");
    bf16_t* O; int ldc; const float* bias; int split_cols; size_t split_stride; float scale0;
    __device__ __forceinline__ void operator()(const f32x4 (&acc)[2][2][4][2], const Unit& u, int wr, int wc, int fr, int fq) const {
        const int row0 = u.pm * BM + wr * 64 + fr; int colt = u.pn * BM; bf16_t* base = O;
        float sc = 1.f; if (split_cols) { const int t = colt / split_cols; base += (size_t)t * split_stride; colt -= t * split_cols; if (t == 0) sc = scale0; }
        const int col0 = colt + wc * 32 + 8 * fq, bcol0 = u.pn * BM + wc * 32 + 8 * fq;
        f32x4 bv[2][2];
#pragma unroll
        for (int bj = 0; bj < 2; ++bj)
#pragma unroll
            for (int n = 0; n < 2; ++n) bv[bj][n] = bias ? *(const f32x4*)(bias + bcol0 + bj * HALF + 4 * n) : (f32x4){0.f, 0.f, 0.f, 0.f};
#pragma unroll
        for (int ai = 0; ai < 2; ++ai)
#pragma unroll
            for (int m = 0; m < 4; ++m) { bf16_t* rowp = base + (size_t)(row0 + ai * HALF + m * 16) * ldc + col0;
#pragma unroll
                for (int bj = 0; bj < 2; ++bj) { f32x4 v0 = acc[ai][bj][m][0] + bv[bj][0], v1 = acc[ai][bj][m][1] + bv[bj][1];
                    if (ACT == 1) { f32x2 a = gelu_pk((f32x2){v0[0], v0[1]}), b = gelu_pk((f32x2){v0[2], v0[3]}), c = gelu_pk((f32x2){v1[0], v1[1]}), d = gelu_pk((f32x2){v1[2], v1[3]});
                        v0 = (f32x4){a.x, a.y, b.x, b.y}; v1 = (f32x4){c.x, c.y, d.x, d.y}; }
                    v0 = v0 * sc; v1 = v1 * sc; u32x4 w; w.x = cvt_pk_bf16(v0[0], v0[1]); w.y = cvt_pk_bf16(v0[2], v0[3]); w.z = cvt_pk_bf16(v1[0], v1[1]); w.w = cvt_pk_bf16(v1[2], v1[3]);
                    *(u32x4*)(rowp + bj * HALF) = w; } }
    }
};
template <class Epi, class Sched, bool ALIGN_EPI = false, bool SP2 = false>
__device__ __forceinline__ void gemm_phase(PG8_LAS unsigned char* lds, const Gemm g, const Sched& S, const Epi& E) {
    const int tid = threadIdx.x, wid = __builtin_amdgcn_readfirstlane(tid >> 6), lane = tid & 63, wr = wid >> 2, wc = wid & 3, fr = lane & 15, fq = lane >> 4;
    const int K = g.K, nt = K / BK;
    unsigned voffA[2], voffB[2];
#pragma unroll
    for (int i = 0; i < 2; ++i) { int R, C; stage_rc(tid * 16 + i * 8192, R, C); const int Rb = Epi::PERM ? ((R & ~31) + perm32(R & 31)) : R;
        voffA[i] = (unsigned)(R * K + C) * 2u; voffB[i] = (unsigned)(Rb * K + C) * 2u; }
    const size_t kstep = (size_t)(BK * 2);
    const size_t hstep = (size_t)HALF * K * 2;
    const size_t tstep = 2 * hstep;
    const unsigned ldsw = (unsigned)wid * 1024u;
    const int aoff = lds_byte(wr * 64 + fr, fq * 8), boff = lds_byte(wc * 32 + fr, fq * 8);
#define PG8_SA(b, h) (((b) * 2 + (h)) * HTB)
#define PG8_SB(b, h) ((4 + (b) * 2 + (h)) * HTB)
#define PG8_STAGE(bufoff, gbase, voff) do { _Pragma("unroll") for (int _i = 0; _i < 2; ++_i) \
        __builtin_amdgcn_global_load_lds((const unsigned*)((const char*)(gbase) + (voff)[_i]), (PG8_LAS unsigned*)(lds + (bufoff) + ldsw + _i * 8192), 16, 0, 0); } while (0)
#define PG8_LDA(dst, b, h) do { _Pragma("unroll") for (int m = 0; m < 4; ++m) _Pragma("unroll") for (int k = 0; k < 2; ++k) dst[m][k] = *(const PG8_LAS bf16x8*)(lds + PG8_SA(b, h) + aoff + m * 2048 + k * 1024); } while (0)
#define PG8_LDB(dst, b, h) do { _Pragma("unroll") for (int n = 0; n < 2; ++n) _Pragma("unroll") for (int k = 0; k < 2; ++k) dst[n][k] = *(const PG8_LAS bf16x8*)(lds + PG8_SB(b, h) + boff + n * 2048 + k * 1024); } while (0)
#define PG8_MMA(ai, bj, At, Bt) do { __builtin_amdgcn_s_setprio(1); _Pragma("unroll") for (int m = 0; m < 4; ++m) _Pragma("unroll") for (int n = 0; n < 2; ++n) _Pragma("unroll") for (int k = 0; k < 2; ++k) \
        acc[ai][bj][m][n] = __builtin_amdgcn_mfma_f32_16x16x32_bf16(Bt[n][k], At[m][k], acc[ai][bj][m][n], 0, 0, 0); __builtin_amdgcn_s_setprio(0); } while (0)
#define PG8_WAIT_V(n) asm volatile("s_waitcnt vmcnt(" #n ")" ::: "memory")
#define PG8_WAIT_L(n) asm volatile("s_waitcnt lgkmcnt(" #n ")" ::: "memory")
#define PG8_BAR __builtin_amdgcn_s_barrier()
#define PG8_SCHED __builtin_amdgcn_sched_barrier(0)
    Unit cur, nxt; int ui = 0;
    if (!S.next(0, cur)) return;
    f32x4 acc[2][2][4][2];
#pragma unroll
    for (int a = 0; a < 2; ++a)
#pragma unroll
        for (int b = 0; b < 2; ++b)
#pragma unroll
            for (int m = 0; m < 4; ++m)
#pragma unroll
                for (int n = 0; n < 2; ++n) acc[a][b][m][n] = (f32x4){0.f, 0.f, 0.f, 0.f};
    bf16x8 At[4][2], B0[2][2], B1[2][2];
    const char* cA = (const char*)g.A + (size_t)cur.pm * tstep; const char* cB = (const char*)g.Bt + (size_t)cur.pn * tstep;
    S.a_ready(cur);
    if constexpr (SP2) {
        PG8_STAGE(PG8_SB(0, 0), cB, voffB); PG8_STAGE(PG8_SB(0, 1), cB + hstep, voffB); PG8_STAGE(PG8_SA(0, 0), cA, voffA); PG8_STAGE(PG8_SA(0, 1), cA + hstep, voffA);
        if (wr == 1) PG8_BAR;
        PG8_WAIT_V(2); PG8_BAR;
        PG8_STAGE(PG8_SB(1, 0), cB + kstep, voffB); PG8_STAGE(PG8_SA(1, 0), cA + kstep, voffA); PG8_STAGE(PG8_SB(1, 1), cB + hstep + kstep, voffB);
        PG8_WAIT_V(6); PG8_BAR;
    } else {
        PG8_STAGE(PG8_SB(0, 0), cB, voffB); PG8_STAGE(PG8_SA(0, 0), cA, voffA); PG8_STAGE(PG8_SB(0, 1), cB + hstep, voffB); PG8_STAGE(PG8_SA(0, 1), cA + hstep, voffA);
        if (wr == 1) PG8_BAR;
        PG8_WAIT_V(4); PG8_BAR;
        PG8_STAGE(PG8_SB(1, 0), cB + kstep, voffB); PG8_STAGE(PG8_SA(1, 0), cA + kstep, voffA); PG8_STAGE(PG8_SB(1, 1), cB + hstep + kstep, voffB);
        PG8_WAIT_V(6); PG8_BAR;
    }
    for (;;) {
        const bool has_next = S.next(ui + 1, nxt);
        const char* nA = has_next ? (const char*)g.A + (size_t)nxt.pm * tstep : cA; const char* nB = has_next ? (const char*)g.Bt + (size_t)nxt.pn * tstep : cB;
        for (int t = 0; t < nt; t += 2) {
            if constexpr (Epi::MIDK) { if (t == nt / 2) E.midk(acc, cur, wr, wc, fr, fq); }
            const bool last = (t == nt - 2);
            const char* a1 = cA + (size_t)(t + 1) * kstep;
            const char* a2 = last ? nA : cA + (size_t)(t + 2) * kstep; const char* b2 = last ? nB : cB + (size_t)(t + 2) * kstep;
            const char* a3 = a2 + kstep; const char* b3 = b2 + kstep;
            if (last && has_next) S.a_ready(nxt);
            if constexpr (SP2) {
            PG8_LDB(B0, 0, 0); PG8_LDB(B1, 0, 1); PG8_SCHED; PG8_LDA(At, 0, 0); PG8_STAGE(PG8_SA(1, 1), a1 + hstep, voffA);
            PG8_WAIT_V(8); PG8_WAIT_L(0); PG8_BAR; PG8_MMA(0, 0, At, B0); PG8_MMA(0, 1, At, B1); PG8_BAR; PG8_SCHED;
            PG8_LDA(At, 0, 1); PG8_STAGE(PG8_SB(0, 0), b2, voffB); PG8_STAGE(PG8_SB(0, 1), b2 + hstep, voffB); PG8_STAGE(PG8_SA(0, 0), a2, voffA);
            PG8_WAIT_V(8); PG8_WAIT_L(0); PG8_BAR; PG8_MMA(1, 0, At, B0); PG8_MMA(1, 1, At, B1); PG8_BAR; PG8_SCHED;
            PG8_LDB(B0, 1, 0); PG8_LDB(B1, 1, 1); PG8_SCHED; PG8_LDA(At, 1, 0); PG8_STAGE(PG8_SA(0, 1), a2 + hstep, voffA);
            PG8_WAIT_V(8); PG8_WAIT_L(0); PG8_BAR; PG8_MMA(0, 0, At, B0); PG8_MMA(0, 1, At, B1); PG8_BAR; PG8_SCHED;
            PG8_LDA(At, 1, 1); PG8_STAGE(PG8_SB(1, 0), b3, voffB); PG8_STAGE(PG8_SB(1, 1), b3 + hstep, voffB); PG8_STAGE(PG8_SA(1, 0), a3, voffA);
            PG8_WAIT_V(8); PG8_WAIT_L(0); PG8_BAR; PG8_MMA(1, 0, At, B0); PG8_MMA(1, 1, At, B1); PG8_BAR; PG8_SCHED;
            } else {
            PG8_LDB(B0, 0, 0); PG8_SCHED; PG8_LDA(At, 0, 0); PG8_STAGE(PG8_SA(1, 1), a1 + hstep, voffA);
            PG8_WAIT_L(8); PG8_BAR; PG8_WAIT_L(0); PG8_MMA(0, 0, At, B0); PG8_BAR; PG8_SCHED;
            PG8_LDB(B1, 0, 1); PG8_STAGE(PG8_SB(0, 0), b2, voffB);
            PG8_BAR; PG8_WAIT_L(0); PG8_MMA(0, 1, At, B1); PG8_BAR;
            PG8_LDA(At, 0, 1); PG8_STAGE(PG8_SA(0, 0), a2, voffA);
            PG8_BAR; PG8_WAIT_L(0); PG8_MMA(1, 0, At, B0); PG8_BAR; PG8_SCHED;
            PG8_STAGE(PG8_SB(0, 1), b2 + hstep, voffB);
            PG8_WAIT_V(6); PG8_BAR; PG8_MMA(1, 1, At, B1); PG8_BAR;
            PG8_LDB(B0, 1, 0); PG8_SCHED; PG8_LDA(At, 1, 0); PG8_STAGE(PG8_SA(0, 1), a2 + hstep, voffA);
            PG8_WAIT_L(8); PG8_BAR; PG8_WAIT_L(0); PG8_MMA(0, 0, At, B0); PG8_BAR; PG8_SCHED;
            PG8_LDB(B1, 1, 1); PG8_STAGE(PG8_SB(1, 0), b3, voffB);
            PG8_BAR; PG8_WAIT_L(0); PG8_MMA(0, 1, At, B1); PG8_BAR;
            PG8_LDA(At, 1, 1); PG8_STAGE(PG8_SA(1, 0), a3, voffA);
            PG8_BAR; PG8_WAIT_L(0); PG8_MMA(1, 0, At, B0); PG8_BAR; PG8_SCHED;
            PG8_STAGE(PG8_SB(1, 1), b3 + hstep, voffB);
            PG8_WAIT_V(6); PG8_BAR; PG8_MMA(1, 1, At, B1); PG8_BAR;
            }
        }
        if constexpr (ALIGN_EPI) { if (wr == 0) PG8_BAR; }
        if constexpr (!Epi::AFTER_DRAIN) { E(acc, cur, wr, wc, fr, fq); S.done(cur); }
        if (!has_next) break;
#pragma unroll
        for (int a = 0; a < 2; ++a)
#pragma unroll
            for (int b = 0; b < 2; ++b)
#pragma unroll
                for (int m = 0; m < 4; ++m)
#pragma unroll
                    for (int n = 0; n < 2; ++n) acc[a][b][m][n] = (f32x4){0.f, 0.f, 0.f, 0.f};
        cur = nxt; cA = nA; cB = nB; ++ui;
        if constexpr (ALIGN_EPI) { if (wr == 1) PG8_BAR; }
    }
    PG8_WAIT_V(0);
    if constexpr (!ALIGN_EPI) { if (wr == 0) PG8_BAR; }
    PG8_BAR;
    if constexpr (Epi::AFTER_DRAIN) { E.fused(acc, cur, wr, wc, fr, fq, lds, wid, lane); S.done(cur); }
#undef PG8_SA
#undef PG8_SB
#undef PG8_STAGE
#undef PG8_LDA
#undef PG8_LDB
#undef PG8_MMA
#undef PG8_WAIT_V
#undef PG8_WAIT_L
#undef PG8_BAR
#undef PG8_SCHED
}
}

#define GAS __attribute__((address_space(1)))
#define LAS __attribute__((address_space(3)))
typedef unsigned short bf16;
typedef unsigned U4 __attribute__((ext_vector_type(4)));
typedef unsigned U2 __attribute__((ext_vector_type(2)));
typedef float F4 __attribute__((ext_vector_type(4)));
typedef float F2 __attribute__((ext_vector_type(2)));
typedef float F16 __attribute__((ext_vector_type(16)));
typedef short B8 __attribute__((ext_vector_type(8)));
typedef short S4 __attribute__((ext_vector_type(4)));
typedef __bf16 bf16x2_t __attribute__((ext_vector_type(2)));

constexpr int NWAVES = 8, NTHR = 512;
constexpr int DM = 1024, BATCH = 8, SEQ = 8192, NTOK = BATCH * SEQ;
constexpr int DIN = 8200, NPROJ = 8192;
constexpr int CHUNK = 128, NCHUNK = SEQ / CHUNK;
constexpr int NEXP = 32, DEXP = 512;
constexpr int MAXTILES = 544, MAXROWS = MAXTILES * 256;
constexpr float EPS = 1e-6f;
constexpr int LDS_BYTES = 159744;
constexpr int LDS_MISC = 151552;

constexpr size_t MiB = 1u << 20;
constexpr size_t WS_CTL = 0, CTL_ZERO_BYTES = 32768; constexpr int CW_BAR = 1024;
constexpr size_t WS_IF = 1 * MiB;
constexpr size_t WS_THR = 3 * MiB;
constexpr size_t WS_CDEC = 4 * MiB;
constexpr size_t WS_ROUT = 4 * MiB + 65536;
constexpr size_t WS_ROPE = 5 * MiB;
constexpr size_t WS_TOK = 9 * MiB;
constexpr size_t WS_WIN = 12 * MiB;
constexpr size_t WS_WCAT = 28 * MiB, WS_WOUT = 32 * MiB;
constexpr size_t WS_H = 34 * MiB;
constexpr size_t WS_MQP = 34 * MiB, WS_MKP = 98 * MiB, WS_WGU = 34 * MiB, WS_WD = 98 * MiB;
constexpr size_t WS_RQ = 162 * MiB, WS_RK = 226 * MiB, WS_MQ = 290 * MiB, WS_MK = 354 * MiB;
constexpr size_t WS_XCAT = 162 * MiB;
constexpr size_t WS_RV = 418 * MiB, WS_RG = 546 * MiB, WS_MV = 674 * MiB, WS_MO = 802 * MiB;
constexpr size_t WS_MERGED = 802 * MiB;
constexpr size_t WS_XS = 418 * MiB, WS_HMID = 690 * MiB, WS_Y = 418 * MiB;
constexpr size_t WS_END = 930 * MiB;
constexpr size_t OUT_GR = 0, OUT_GM = 128 * MiB;
static_assert(WS_XS + (size_t)MAXROWS * 1024 * 2 <= WS_HMID && WS_HMID + (size_t)MAXROWS * 512 * 2 <= WS_END, "ws map");

struct TokInfo { int e0, p0, e1, p1; float w0, w1, rstd, pad; };

__device__ __forceinline__ float bflo(unsigned u) { return __uint_as_float(u << 16); }
__device__ __forceinline__ float bfhi(unsigned u) { return __uint_as_float(u & 0xffff0000u); }
__device__ __forceinline__ float bf2f(short s) { return __uint_as_float(((unsigned)(unsigned short)s) << 16); }
__device__ __forceinline__ unsigned cvtpk(float lo, float hi) { F2 v = {lo, hi}; bf16x2_t b = __builtin_convertvector(v, bf16x2_t); return __builtin_bit_cast(unsigned, b); }
__device__ __forceinline__ float wave_sum(float v) {
#pragma unroll
    for (int o = 1; o < 64; o <<= 1) v += __shfl_xor(v, o);
    return v;
}
__device__ __forceinline__ float sigm(float x) { return __builtin_amdgcn_rcpf(1.f + __expf(-x)); }
__device__ __forceinline__ float silu(float x) { return x * __builtin_amdgcn_rcpf(1.f + __expf(-x)); }
__device__ __forceinline__ float dot2bf(unsigned a, unsigned b, float c) { return __builtin_amdgcn_fdot2_f32_bf16(__builtin_bit_cast(bf16x2_t, a), __builtin_bit_cast(bf16x2_t, b), c, false); }
__device__ __forceinline__ int crow(int r, int hi) { return (r & 3) + 8 * (r >> 2) + 4 * hi; }
#define MFMA32(a, b, c) __builtin_amdgcn_mfma_f32_32x32x16_bf16((a), (b), (c), 0, 0, 0)
typedef short v4i16_t __attribute__((ext_vector_type(4)));
__device__ __forceinline__ S4 trrd(LAS const unsigned char* p) { return __builtin_bit_cast(S4, __builtin_amdgcn_ds_read_tr16_b64_v4i16((LAS v4i16_t*)p)); }
__device__ __forceinline__ void glds16(const void* gsrc, unsigned lds_dst) { unsigned keep;
    asm volatile("s_mov_b32 %0, m0\n\ts_mov_b32 m0, %2\n\ts_nop 0\n\tglobal_load_lds_dwordx4 %1, off\n\ts_mov_b32 m0, %0" : "=&s"(keep) : "v"(gsrc), "s"(lds_dst) : "memory"); }
__device__ __forceinline__ unsigned offb(unsigned row, unsigned ch) { return 256u * row + 16u * (ch ^ (((row & 3) << 2) | ((row >> 2) & 3))); }
__device__ __forceinline__ unsigned offv(unsigned row, unsigned ch) { return 128u * row + 16u * (ch ^ (((row >> 1) & 1) << 2)); }

#define XB_TMO      128
#define XB_XCNT(j)  (256  + 64 * (j))
#define XB_XSUB(j)  (1280 + 64 * (j))
#define XB_XGEN(j)  (2304 + 64 * (j))
#define XB_TOP      3328
#define XB_TOPGEN   3392
#define XCD_BAR_WORDS 3456
#define XB_SPIN_CAP (1u << 18)

__device__ __forceinline__ unsigned xb_ld(unsigned* p)              { return __hip_atomic_load(p, __ATOMIC_RELAXED, __HIP_MEMORY_SCOPE_AGENT); }
__device__ __forceinline__ unsigned xb_add(unsigned* p, unsigned v) { return __hip_atomic_fetch_add(p, v, __ATOMIC_RELAXED, __HIP_MEMORY_SCOPE_AGENT); }
__device__ __forceinline__ unsigned xb_xcc_id() { return (unsigned)__builtin_amdgcn_s_getreg((3 << 11) | 20) & 0xFu; }
#define XB_SPIN(cond, bar) do { unsigned _sp = 0; while (cond) { __builtin_amdgcn_s_sleep(1); \
    if ((++_sp & 255u) == 0u) { if (xb_ld(&(bar)[XB_TMO])) break; if (_sp > XB_SPIN_CAP) { atomicAdd(&(bar)[XB_TMO], 1u); break; } } } } while (0)

struct XcdBarrier {
    unsigned* bar; unsigned x;
    volatile LAS unsigned* st;
};

__device__ __forceinline__ XcdBarrier xcd_barrier_post(unsigned* bar, volatile LAS unsigned* st) {
    XcdBarrier b; b.bar = bar; b.x = xb_xcc_id(); b.st = st;
    if (threadIdx.x == 0) (void)xb_add(&bar[XB_XCNT(b.x)], 1u);
    return b;
}
__device__ __forceinline__ void xcd_barrier_complete(unsigned* bar, unsigned x, unsigned& nloc, unsigned& nx) {
    const unsigned G = gridDim.x * gridDim.y * gridDim.z;
    unsigned sum, cnt, mine, sp = 0u;
    for (;;) {
        sum = 0u; cnt = 0u; mine = 0u;
#pragma unroll
        for (unsigned j = 0; j < 16; ++j) { const unsigned c = xb_ld(&bar[XB_XCNT(j)]); sum += c; cnt += (c > 0u) ? 1u : 0u; mine = (j == x) ? c : mine; }
        if (sum == G) break;
        __builtin_amdgcn_s_sleep(1);
        if ((++sp & 255u) == 0u) { if (xb_ld(&bar[XB_TMO])) break; if (sp > XB_SPIN_CAP) { atomicAdd(&bar[XB_TMO], 1u); break; } }
    }
    nloc = mine > 0u ? mine : 1u; nx = cnt > 0u ? cnt : 1u;
}

__device__ __forceinline__ void xcd_barrier(const XcdBarrier& b) {
    asm volatile("s_waitcnt vmcnt(0)" ::: "memory");
    __syncthreads();
    if (threadIdx.x == 0) {
        unsigned* bar = b.bar;
        __builtin_amdgcn_s_waitcnt(0);
        unsigned nloc = b.st[0], nx = b.st[1];
        if (nloc == 0u) { xcd_barrier_complete(bar, b.x, nloc, nx); b.st[0] = nloc; b.st[1] = nx; }
        const unsigned old = xb_add(&bar[XB_XSUB(b.x)], 1u);
        const unsigned gen = old / nloc;
        if (old + 1u == (gen + 1u) * nloc) {
            __builtin_amdgcn_fence(__ATOMIC_RELEASE, "agent");
            asm volatile("s_waitcnt vmcnt(0)" ::: "memory");
            const unsigned og = xb_add(&bar[XB_TOP], 1u);
            const unsigned tg = og / nx;
            if (og + 1u == (tg + 1u) * nx) xb_add(&bar[XB_TOPGEN], 1u);
            else XB_SPIN(xb_ld(&bar[XB_TOPGEN]) == tg, bar);
            __builtin_amdgcn_fence(__ATOMIC_ACQUIRE, "agent");
            xb_add(&bar[XB_XGEN(b.x)], 1u);
            asm volatile("s_waitcnt vmcnt(0)" ::: "memory");
        } else {
            XB_SPIN(xb_ld(&bar[XB_XGEN(b.x)]) == gen, bar);
            __builtin_amdgcn_fence(__ATOMIC_ACQUIRE, "agent");
            asm volatile("s_waitcnt vmcnt(0)" ::: "memory");
        }
    }
    __syncthreads();
}

namespace pg8 {
struct EpiProj {
    static constexpr bool PERM = true, AFTER_DRAIN = false, MIDK = false;
    unsigned char* ws; unsigned char* ob;
    __device__ __forceinline__ void operator()(const f32x4 (&acc)[2][2][4][2], const Unit& u, int wr, int wc, int fr, int fq) const {
        const int pn = u.pn; bf16_t* base; int ld, ct;
        if (pn < 2)       { base = (bf16_t*)(ws + WS_RQ); ld = 512;  ct = pn; }
        else if (pn < 4)  { base = (bf16_t*)(ws + WS_RK); ld = 512;  ct = pn - 2; }
        else if (pn < 8)  { base = (bf16_t*)(ws + WS_RV); ld = 1024; ct = pn - 4; }
        else if (pn < 12) { base = (bf16_t*)(ws + WS_RG); ld = 1024; ct = pn - 8; }
        else if (pn < 14) { base = (bf16_t*)(ws + WS_MQ); ld = 512;  ct = pn - 12; }
        else if (pn < 16) { base = (bf16_t*)(ws + WS_MK); ld = 512;  ct = pn - 14; }
        else if (pn < 20) { base = (bf16_t*)(ws + WS_MV); ld = 1024; ct = pn - 16; }
        else if (pn < 24) { base = (bf16_t*)(ws + WS_MO); ld = 1024; ct = pn - 20; }
        else if (pn < 28) { base = (bf16_t*)(ob + OUT_GR); ld = 1024; ct = pn - 24; }
        else              { base = (bf16_t*)(ob + OUT_GM); ld = 1024; ct = pn - 28; }
        const int row0 = u.pm * BM + wr * 64 + fr, col0 = ct * BM + wc * 32 + 8 * fq;
#pragma unroll
        for (int ai = 0; ai < 2; ++ai)
#pragma unroll
            for (int m = 0; m < 4; ++m) { bf16_t* rowp = base + (size_t)(row0 + ai * HALF + m * 16) * ld + col0;
#pragma unroll
                for (int bj = 0; bj < 2; ++bj) { f32x4 v0 = acc[ai][bj][m][0], v1 = acc[ai][bj][m][1];
                    if (pn >= 24) { v0[0] = sigm(v0[0]); v0[1] = sigm(v0[1]); v0[2] = sigm(v0[2]); v0[3] = sigm(v0[3]); v1[0] = sigm(v1[0]); v1[1] = sigm(v1[1]); v1[2] = sigm(v1[2]); v1[3] = sigm(v1[3]); }
                    u32x4 w; w.x = cvt_pk_bf16(v0[0], v0[1]); w.y = cvt_pk_bf16(v0[2], v0[3]); w.z = cvt_pk_bf16(v1[0], v1[1]); w.w = cvt_pk_bf16(v1[2], v1[3]);
                    *(u32x4*)(rowp + bj * HALF) = w; } }
    }
};
struct EpiGateFused {
    static constexpr bool PERM = true, AFTER_DRAIN = false, MIDK = true;
    const bf16_t* GR; const bf16_t* GM; bf16_t* O;
    __device__ __forceinline__ void midk(f32x4 (&acc)[2][2][4][2], const Unit& u, int wr, int wc, int fr, int fq) const {
        int row0 = u.pm * BM + wr * 64 + fr, col0 = u.pn * BM + wc * 32 + 8 * fq;
        asm volatile("" : "+v"(row0), "+v"(col0));
#pragma unroll
        for (int ai = 0; ai < 2; ++ai) {
#pragma unroll
            for (int m = 0; m < 4; ++m) { const size_t ro = (size_t)(row0 + ai * HALF + m * 16) * 1024 + col0;
#pragma unroll
                for (int bj = 0; bj < 2; ++bj) {
                    const u32x4 a = *(const u32x4*)(GR + ro + bj * HALF), b = *(const u32x4*)(GM + ro + bj * HALF);
                    f32x4 r0, r1;
                    r0[0] = bflo(a.x) * __builtin_amdgcn_rcpf(bflo(b.x)); r0[1] = bfhi(a.x) * __builtin_amdgcn_rcpf(bfhi(b.x)); r0[2] = bflo(a.y) * __builtin_amdgcn_rcpf(bflo(b.y)); r0[3] = bfhi(a.y) * __builtin_amdgcn_rcpf(bfhi(b.y));
                    r1[0] = bflo(a.z) * __builtin_amdgcn_rcpf(bflo(b.z)); r1[1] = bfhi(a.z) * __builtin_amdgcn_rcpf(bfhi(b.z)); r1[2] = bflo(a.w) * __builtin_amdgcn_rcpf(bflo(b.w)); r1[3] = bfhi(a.w) * __builtin_amdgcn_rcpf(bfhi(b.w));
                    acc[ai][bj][m][0] *= r0; acc[ai][bj][m][1] *= r1; } }
            asm volatile("" ::: "memory"); }
    }
    __device__ __forceinline__ void operator()(const f32x4 (&acc)[2][2][4][2], const Unit& u, int wr, int wc, int fr, int fq) const {
        int row0 = u.pm * BM + wr * 64 + fr, col0 = u.pn * BM + wc * 32 + 8 * fq;
        asm volatile("" : "+v"(row0), "+v"(col0));
#pragma unroll
        for (int ai = 0; ai < 2; ++ai)
#pragma unroll
            for (int m = 0; m < 4; ++m) { const size_t ro = (size_t)(row0 + ai * HALF + m * 16) * 1024 + col0;
#pragma unroll
                for (int bj = 0; bj < 2; ++bj) { const f32x4 v0 = acc[ai][bj][m][0], v1 = acc[ai][bj][m][1];
                    const u32x4 g = *(const u32x4*)(GM + ro + bj * HALF);
                    u32x4 w; w.x = cvt_pk_bf16(v0[0] * bflo(g.x), v0[1] * bfhi(g.x)); w.y = cvt_pk_bf16(v0[2] * bflo(g.y), v0[3] * bfhi(g.y));
                    w.z = cvt_pk_bf16(v1[0] * bflo(g.z), v1[1] * bfhi(g.z)); w.w = cvt_pk_bf16(v1[2] * bflo(g.w), v1[3] * bfhi(g.w));
                    *(u32x4*)(O + ro + bj * HALF) = w; } }
    }
};
struct EpiX1 {
    static constexpr bool PERM = true, AFTER_DRAIN = false, MIDK = false;
    const float* X; float* O;
    __device__ __forceinline__ void operator()(const f32x4 (&acc)[2][2][4][2], const Unit& u, int wr, int wc, int fr, int fq) const {
        const int row0 = u.pm * BM + wr * 64 + fr, col0 = u.pn * BM + wc * 32 + 8 * fq;
#pragma unroll
        for (int ai = 0; ai < 2; ++ai)
#pragma unroll
            for (int m = 0; m < 4; ++m) { const size_t ro = (size_t)(row0 + ai * HALF + m * 16) * 1024 + col0;
#pragma unroll
                for (int bj = 0; bj < 2; ++bj) {
                    const f32x4 a = *(const f32x4*)(X + ro + bj * HALF), b = *(const f32x4*)(X + ro + bj * HALF + 4);
                    *(f32x4*)(O + ro + bj * HALF) = a + acc[ai][bj][m][0]; *(f32x4*)(O + ro + bj * HALF + 4) = b + acc[ai][bj][m][1]; } }
    }
};
struct EpiSwiglu {
    static constexpr bool PERM = true, AFTER_DRAIN = false, MIDK = false;
    bf16_t* O;
    __device__ __forceinline__ void operator()(const f32x4 (&acc)[2][2][4][2], const Unit& u, int wr, int wc, int fr, int fq) const {
        const int row0 = u.pm * BM + wr * 64 + fr, col0 = (u.pn & 3) * HALF + wc * 32 + 8 * fq;
#pragma unroll
        for (int ai = 0; ai < 2; ++ai)
#pragma unroll
            for (int m = 0; m < 4; ++m) { bf16_t* rowp = O + (size_t)(row0 + ai * HALF + m * 16) * 512 + col0;
                const f32x4 g0 = acc[ai][0][m][0], g1 = acc[ai][0][m][1], u0 = acc[ai][1][m][0], u1 = acc[ai][1][m][1];
                u32x4 w; w.x = cvt_pk_bf16(silu(g0[0]) * u0[0], silu(g0[1]) * u0[1]); w.y = cvt_pk_bf16(silu(g0[2]) * u0[2], silu(g0[3]) * u0[3]);
                w.z = cvt_pk_bf16(silu(g1[0]) * u1[0], silu(g1[1]) * u1[1]); w.w = cvt_pk_bf16(silu(g1[2]) * u1[2], silu(g1[3]) * u1[3]);
                *(u32x4*)rowp = w; }
    }
};
struct EpiY {
    static constexpr bool PERM = true, AFTER_DRAIN = false, MIDK = false;
    bf16_t* O;
    __device__ __forceinline__ void operator()(const f32x4 (&acc)[2][2][4][2], const Unit& u, int wr, int wc, int fr, int fq) const {
        const int row0 = u.pm * BM + wr * 64 + fr, col0 = (u.pn & 3) * BM + wc * 32 + 8 * fq;
#pragma unroll
        for (int ai = 0; ai < 2; ++ai)
#pragma unroll
            for (int m = 0; m < 4; ++m) { bf16_t* rowp = O + (size_t)(row0 + ai * HALF + m * 16) * 1024 + col0;
#pragma unroll
                for (int bj = 0; bj < 2; ++bj) { const f32x4 v0 = acc[ai][bj][m][0], v1 = acc[ai][bj][m][1];
                    u32x4 w; w.x = cvt_pk_bf16(v0[0], v0[1]); w.y = cvt_pk_bf16(v0[2], v0[3]); w.z = cvt_pk_bf16(v1[0], v1[1]); w.w = cvt_pk_bf16(v1[2], v1[3]);
                    *(u32x4*)(rowp + bj * HALF) = w; } }
    }
};
struct GroupedOrder {
    int ntiles, G, c; const PG8_LAS unsigned char* t2e;
    __device__ __forceinline__ bool next(int i, Unit& u) const {
        const int L = i * G + c; if (L >= ntiles * 4) return false;
        const int rt = L >> 2; u.pm = rt; u.pn = __builtin_amdgcn_readfirstlane((int)t2e[rt]) * 4 + (L & 3); return true;
    }
    __device__ __forceinline__ void a_ready(const Unit&) const {}
    __device__ __forceinline__ void done(const Unit&) const {}
};
}

struct Ctx { LAS unsigned char* lds; int tid, lane, wave, vcu, G; };

__device__ __forceinline__ void transpose_item(const float* W, int ld, int k0, int n0, bf16* WT, int K, int drow0, LAS float* scr, int lane, int kdst = 0) {
#pragma unroll 8
    for (int i = 0; i < 32; ++i) { const int kk = 2 * i + (lane >> 5); scr[kk * 33 + (lane & 31)] = W[(size_t)(k0 + kk) * ld + n0 + (lane & 31)]; }
    asm volatile("s_waitcnt lgkmcnt(0)" ::: "memory");
    const int c = lane & 7;
#pragma unroll
    for (int j = 0; j < 4; ++j) { const int n = (lane >> 3) + 8 * j; const LAS float* s = scr + (8 * c) * 33 + n;
        U4 o; o.x = cvtpk(s[0 * 33], s[1 * 33]); o.y = cvtpk(s[2 * 33], s[3 * 33]); o.z = cvtpk(s[4 * 33], s[5 * 33]); o.w = cvtpk(s[6 * 33], s[7 * 33]);
        *(U4*)(WT + (size_t)(drow0 + n) * K + kdst + k0 + 8 * c) = o; }
    asm volatile("s_waitcnt lgkmcnt(0)" ::: "memory");
}

__device__ __forceinline__ void phase0(const Ctx& C, const float* const* in, unsigned char* ws) {
    const float* x = in[0]; const float* nw = in[1]; const float* w_in = in[2];
    LAS float* scr = (LAS float*)(C.lds + C.wave * 8448);
    LAS float* wif = (LAS float*)(C.lds + 98304);
    LAS double* invf = (LAS double*)(C.lds + 98304 + 32768);
    for (int i = C.tid; i < 8192; i += NTHR) wif[i] = w_in[(size_t)(i >> 3) * DIN + 6144 + (i & 7)];
    if (C.tid < 64) { double r = 1.0; for (int j = 0; j < C.tid; ++j) r *= 0.8659643233600653; invf[C.tid] = r; }
    __syncthreads();
    const int gw = C.vcu * NWAVES + C.wave, NGW = C.G * NWAVES;
    {
        bf16* H = (bf16*)(ws + WS_H); float* IFP = (float*)(ws + WS_IF);
        F4 wv[4];
#pragma unroll
        for (int j = 0; j < 4; ++j) wv[j] = *(const F4*)(nw + 4 * C.lane + 256 * j);
        for (int m = gw; m < NTOK; m += NGW) {
            const F4* xr = (const F4*)(x + (size_t)m * DM) + C.lane;
            F4 v[4]; float s = 0.f;
#pragma unroll
            for (int j = 0; j < 4; ++j) { v[j] = xr[64 * j]; s += (v[j].x * v[j].x + v[j].y * v[j].y) + (v[j].z * v[j].z + v[j].w * v[j].w); }
            const float rstd = rsqrtf(wave_sum(s) * (1.f / DM) + EPS);
            float g[8];
#pragma unroll
            for (int c = 0; c < 8; ++c) g[c] = 0.f;
            unsigned long long* o8 = (unsigned long long*)(H + (size_t)m * DM) + C.lane;
#pragma unroll
            for (int j = 0; j < 4; ++j) { v[j] = v[j] * rstd * wv[j];
                o8[64 * j] = (unsigned long long)cvtpk(v[j].x, v[j].y) | ((unsigned long long)cvtpk(v[j].z, v[j].w) << 32);
#pragma unroll
                for (int i = 0; i < 4; ++i) { const LAS F4* wp = (const LAS F4*)(wif + (4 * C.lane + 256 * j + i) * 8); const F4 wa = wp[0], wb = wp[1]; const float hv = v[j][i];
                    g[0] += hv * wa.x; g[1] += hv * wa.y; g[2] += hv * wa.z; g[3] += hv * wa.w; g[4] += hv * wb.x; g[5] += hv * wb.y; g[6] += hv * wb.z; g[7] += hv * wb.w; } }
#pragma unroll
            for (int c = 0; c < 8; ++c) g[c] = wave_sum(g[c]);
            if (C.lane == 0) { F4* op = (F4*)(IFP + (size_t)m * 8); op[0] = (F4){g[0], g[1], g[2], g[3]}; op[1] = (F4){g[4], g[5], g[6], g[7]}; }
        }
    }
    for (int it = gw; it < 4096 + 3 * 512; it += NGW) {
        if (it < 4096) { const int kb = it >> 8, nb = it & 255; transpose_item(w_in, DIN, kb * 64, nb * 32 + (nb >= 192 ? 8 : 0), (bf16*)(ws + WS_WIN), 1024, nb * 32, scr, C.lane); }
        else { int r = it - 4096; const int mth = r >> 9; r &= 511; const int kb = r >> 5, nb = r & 31;
            const float* W = mth == 0 ? in[4] : (mth == 1 ? in[10] : in[11]);
            if (mth < 2) transpose_item(W, 1024, kb * 64, nb * 32, (bf16*)(ws + WS_WCAT), 2048, nb * 32, scr, C.lane, mth * 1024);
            else transpose_item(W, 1024, kb * 64, nb * 32, (bf16*)(ws + WS_WOUT), 1024, nb * 32, scr, C.lane); }
    }
    { F2* RT = (F2*)(ws + WS_ROPE);
        for (int idx = C.vcu * NTHR + C.tid; idx < SEQ * 64; idx += C.G * NTHR) { const int pos = idx >> 6, j = idx & 63;
            const double rev = (double)pos * invf[j] * 0.15915494309189535; const float fr = (float)(rev - __builtin_floor(rev));
            RT[idx] = (F2){__builtin_amdgcn_cosf(fr), __builtin_amdgcn_sinf(fr)}; } }
    { F4* WR = (F4*)(ws + WS_ROUT); const float* nfw = in[12]; const float* wg = in[13]; const float* we = in[15];
        for (int idx = C.vcu * NTHR + C.tid; idx < 64 * 3 * 64; idx += C.G * NTHR) { const int l = idx & 63, nt = (idx >> 6) % 3, kb = idx / 192; const int n = 16 * nt + (l & 15);
            F4 o;
#pragma unroll
            for (int j = 0; j < 4; ++j) { const int k = 16 * kb + 4 * (l >> 4) + j; float wv = 0.f; if (n < 4) wv = wg[k * 4 + n]; else if (n < 36) wv = we[k * 32 + (n - 4)]; o[j] = wv * nfw[k]; }
            WR[idx] = o; } }
}

__device__ __forceinline__ float wscan_add(float v, int lane) {
#pragma unroll
    for (int o = 1; o < 64; o <<= 1) { const float t = __shfl_up(v, o); if (lane >= o) v += t; }
    return v;
}
__device__ __forceinline__ float wscan_max(float v, int lane) {
#pragma unroll
    for (int o = 1; o < 64; o <<= 1) { const float t = __shfl_up(v, o); if (lane >= o) v = fmaxf(v, t); }
    return v;
}
__device__ __forceinline__ void phase2(const Ctx& C, const float* const* in, unsigned char* ws) {
    const float* convw = in[5]; const float* convb = in[6]; const float* b_i = in[7]; const float* b_f = in[8];
    LAS float* sQ = (LAS float*)(C.lds);
    LAS float* sK = (LAS float*)(C.lds + 2048);
    const float* IFP = (const float*)(ws + WS_IF); float* THR = (float*)(ws + WS_THR); float* CDEC = (float*)(ws + WS_CDEC);
    const F2* RT = (const F2*)(ws + WS_ROPE);
    for (int it = C.vcu; it < BATCH * NCHUNK; it += C.G) {
        const int b = it >> 6, c = it & 63; const size_t t0 = (size_t)b * SEQ + (size_t)c * CHUNK;
        __syncthreads();
        if (C.wave < 4) { const int hd = C.wave, l = C.lane;
            const float i0 = IFP[(t0 + 2 * l) * 8 + hd] + b_i[hd], i1 = IFP[(t0 + 2 * l + 1) * 8 + hd] + b_i[hd];
            const float f0 = IFP[(t0 + 2 * l) * 8 + 4 + hd] + b_f[hd], f1 = IFP[(t0 + 2 * l + 1) * 8 + 4 + hd] + b_f[hd];
            const float lf0 = fminf(f0, 0.f) - log1pf(__expf(-fabsf(f0))), lf1 = fminf(f1, 0.f) - log1pf(__expf(-fabsf(f1)));
            const float s1 = lf0 + lf1, inc = wscan_add(s1, l), ex = inc - s1;
            const float b0 = ex + lf0, b1 = ex + s1;
            const float u0 = i0 - b0, u1 = i1 - b1, p1 = fmaxf(u0, u1);
            const float pin = wscan_max(p1, l); float pex = __shfl_up(pin, 1); if (l == 0) pex = -INFINITY;
            const float pm0 = fmaxf(pex, u0), pm1 = fmaxf(pex, p1);
            sQ[hd * 128 + 2 * l] = __expf(-pm0); sQ[hd * 128 + 2 * l + 1] = __expf(-pm1);
            sK[hd * 128 + 2 * l] = __expf(u0) * 0.08838834764831845f; sK[hd * 128 + 2 * l + 1] = __expf(u1) * 0.08838834764831845f;
            THR[(t0 + 2 * l) * 4 + hd] = __expf(-b0 - pm0); THR[(t0 + 2 * l + 1) * 4 + hd] = __expf(-b1 - pm1);
            if (l == 63) CDEC[(size_t)it * 4 + hd] = __expf(b1);
        }
        __syncthreads();
        for (int u = C.tid; u < 2 * 4096; u += NTHR) {
            const int arr = u >> 12, g = u & 7, row = (u >> 3) & 127, hd = (u >> 10) & 3;
            bf16* base = (bf16*)(ws + (arr ? WS_RK : WS_RQ)) + (t0 + row) * 512 + hd * 128 + 8 * g;
            const U4 a = *(const U4*)base, bb = *(const U4*)(base + 64);
            const float lg = hd == 0 ? -0.04580368961312479f : (hd == 1 ? -0.02272007650008353f : (hd == 2 ? -0.011315313227834146f : -0.005646563141142063f));
            const float sc = arr ? exp2f(-lg * (float)row) * 0.08838834764831845f : exp2f(lg * (float)row);
            const F2* rt = RT + (size_t)(c * CHUNK + row) * 64 + 8 * g;
            float x1[8], x2[8], y1[8], y2[8];
            x1[0] = bflo(a.x); x1[1] = bfhi(a.x); x1[2] = bflo(a.y); x1[3] = bfhi(a.y); x1[4] = bflo(a.z); x1[5] = bfhi(a.z); x1[6] = bflo(a.w); x1[7] = bfhi(a.w);
            x2[0] = bflo(bb.x); x2[1] = bfhi(bb.x); x2[2] = bflo(bb.y); x2[3] = bfhi(bb.y); x2[4] = bflo(bb.z); x2[5] = bfhi(bb.z); x2[6] = bflo(bb.w); x2[7] = bfhi(bb.w);
#pragma unroll
            for (int i = 0; i < 8; ++i) { const F2 cs = rt[i]; y1[i] = (x1[i] * cs.x - x2[i] * cs.y) * sc; y2[i] = (x2[i] * cs.x + x1[i] * cs.y) * sc; }
            U4 o1, o2; o1.x = cvtpk(y1[0], y1[1]); o1.y = cvtpk(y1[2], y1[3]); o1.z = cvtpk(y1[4], y1[5]); o1.w = cvtpk(y1[6], y1[7]);
            o2.x = cvtpk(y2[0], y2[1]); o2.y = cvtpk(y2[2], y2[3]); o2.z = cvtpk(y2[4], y2[5]); o2.w = cvtpk(y2[6], y2[7]);
            *(U4*)base = o1; *(U4*)(base + 64) = o2;
        }
        for (int u = C.tid; u < 2 * 8192; u += NTHR) {
            const int arr = u >> 13, g = u & 63, row = (u >> 6) & 127, hd = g >> 4;
            const bf16* src = (const bf16*)(ws + (arr ? WS_MK : WS_MQ)) + (t0 + row) * 512 + 8 * g;
            const int chn = arr * 512 + 8 * g;
            float y[8];
            { const F4 b0 = *(const F4*)(convb + chn), b1 = *(const F4*)(convb + chn + 4); y[0] = b0.x; y[1] = b0.y; y[2] = b0.z; y[3] = b0.w; y[4] = b1.x; y[5] = b1.y; y[6] = b1.z; y[7] = b1.w; }
#pragma unroll
            for (int w = 0; w < 4; ++w) { const int back = 3 - w;
                if (c * CHUNK + row - back >= 0) { const U4 a = *(const U4*)(src - (size_t)back * 512);
                    const F4 w0 = *(const F4*)(convw + w * 1024 + chn), w1 = *(const F4*)(convw + w * 1024 + chn + 4);
                    y[0] += bflo(a.x) * w0.x; y[1] += bfhi(a.x) * w0.y; y[2] += bflo(a.y) * w0.z; y[3] += bfhi(a.y) * w0.w;
                    y[4] += bflo(a.z) * w1.x; y[5] += bfhi(a.z) * w1.y; y[6] += bflo(a.w) * w1.z; y[7] += bfhi(a.w) * w1.w; } }
            const float sc = arr ? sK[hd * 128 + row] : sQ[hd * 128 + row];
#pragma unroll
            for (int i = 0; i < 8; ++i) y[i] = silu(y[i]) * sc;
            U4 o; o.x = cvtpk(y[0], y[1]); o.y = cvtpk(y[2], y[3]); o.z = cvtpk(y[4], y[5]); o.w = cvtpk(y[6], y[7]);
            *(U4*)((bf16*)(ws + (arr ? WS_MKP : WS_MQP)) + (t0 + row) * 512 + 8 * g) = o;
        }
    }
}

template <bool ML, int ABL = 0>
__device__ __forceinline__ void mixer_item(const Ctx& C, const bf16* Qp, const bf16* Kp, bf16* Vp, bf16* Vout, size_t omask, const float* thr, const float* cdec, int b, int hd, int sl) {
    LAS unsigned char* lds = C.lds;
    const int tid = C.tid, lane = C.lane, w = C.wave, l31 = lane & 31, hi = lane >> 5;
    const int lt = (w < 4) ? w : 7 - w, et = w >> 2, dt = w & 3;
    const int q_ = (lane & 15) >> 2, p_ = lane & 3, blk = (lane >> 4) & 1;
    constexpr unsigned KOFF = 0, VOFF = 65536, QOFF = 98304, SOFF = 131072, NOFF = 147456;
    const size_t tok0 = (size_t)b * SEQ;
    const float rdec = hd == 0 ? 0.017183023570817902f : (hd == 1 ? 0.1332151628796484f : (hd == 2 ? 0.3664377159220373f : 0.6059370882290803f));
    __syncthreads();
    for (int i = tid; i < 16384 / 16; i += NTHR) *(LAS U4*)(lds + SOFF + 16 * i) = (U4){0u, 0u, 0u, 0u};
    if (tid < 384) *(LAS float*)(lds + NOFF + 4 * tid) = 0.f;
    F16 St;
#pragma unroll
    for (int r = 0; r < 16; ++r) St[r] = 0.f;
    B8 qf[8];
    const unsigned lds0 = (unsigned)(uintptr_t)lds;
    unsigned ro[8];
#pragma unroll
    for (int s = 0; s < 8; ++s) ro[s] = offb(l31, 2 * s + hi);
    const unsigned kbase = (16 * w + (lane >> 4)) * 512, kx = (lane & 15) ^ ((lane >> 4) << 2);
    const unsigned vbase = (16 * w + (lane >> 3)) * 1024 + ((lane & 7) ^ (((lane >> 4) & 1) << 2)) * 8;
#define ksrc_(i) (kbase + (i) * 2048 + ((kx ^ (i)) * 8))
#define vsrc_(i) (vbase + (i) * 8192)
#define MX_DMA(cc, buf) do { \
        const bf16* kp_ = Kp + (tok0 + (size_t)(cc) * CHUNK) * 512 + hd * 128; \
        _Pragma("unroll") for (int i = 0; i < 4; ++i) glds16(kp_ + ksrc_(i), (unsigned)__builtin_amdgcn_readfirstlane((int)(lds0 + KOFF + (buf) * 32768 + (w * 4 + i) * 1024))); \
        const bf16* vp_ = Vp + (tok0 + (size_t)(cc) * CHUNK) * 1024 + hd * 256 + sl * 64; \
        _Pragma("unroll") for (int i = 0; i < 2; ++i) glds16(vp_ + vsrc_(i), (unsigned)__builtin_amdgcn_readfirstlane((int)(lds0 + VOFF + (buf) * 16384 + (w * 2 + i) * 1024))); \
        const bf16* qp_ = Qp + (tok0 + (size_t)(cc) * CHUNK) * 512 + hd * 128; \
        _Pragma("unroll") for (int i = 0; i < 4; ++i) glds16(qp_ + ksrc_(i), (unsigned)__builtin_amdgcn_readfirstlane((int)(lds0 + QOFF + (w * 4 + i) * 1024))); \
        } while (0)
    float thn = 1.f, dcn = rdec;
    MX_DMA(0, 0);
    if (ML) { thn = thr[(tok0 + 32 * lt + l31) * 4 + hd]; dcn = cdec[((size_t)b * NCHUNK) * 4 + hd]; }
    asm volatile("s_waitcnt vmcnt(0)" ::: "memory");
    __syncthreads();
    for (int c = 0; c < NCHUNK; ++c) {
        const int cur = c & 1, nxt = cur ^ 1;
        const unsigned KB = KOFF + cur * 32768, VB = VOFF + cur * 16384;
        const float th = thn, decay = dcn;
        B8 af[8];
#pragma unroll
        for (int s = 0; s < 8; ++s) qf[s] = *(const LAS B8*)(lds + (QOFF + 8192 * lt) + ro[s]);
#pragma unroll
        for (int s = 0; s < 8; ++s) af[s] = *(const LAS B8*)(lds + (SOFF + 8192 * et) + ro[s]);
        F16 o;
#pragma unroll
        for (int r = 0; r < 16; ++r) o[r] = 0.f;
#pragma unroll
        for (int s = 0; s < 8; ++s) { o = MFMA32(af[s], qf[s], o); af[s] = *(const LAS B8*)(lds + KB + ro[s]); }
        asm volatile("s_waitcnt lgkmcnt(0)" ::: "memory");
        __syncthreads();
        if (c + 1 < NCHUNK) { if (!(ABL & 4)) MX_DMA(c + 1, nxt);
            if (ML) { thn = thr[(tok0 + (size_t)(c + 1) * CHUNK + 32 * lt + l31) * 4 + hd]; dcn = cdec[((size_t)b * NCHUNK + c + 1) * 4 + hd]; } }
        float csum = 0.f;
        for (int jt = 0; jt <= lt; ++jt) {
            F16 st;
#pragma unroll
            for (int r = 0; r < 16; ++r) st[r] = 0.f;
            S4 vfr[4];
#pragma unroll
            for (int s2 = 0; s2 < 2; ++s2) { const unsigned R0 = 32 * jt + 16 * s2 + 4 * hi + q_, chv = 4 * et + 2 * blk + (p_ >> 1);
                vfr[2 * s2] = trrd(lds + VB + offv(R0, chv) + 8 * (p_ & 1)); vfr[2 * s2 + 1] = trrd(lds + VB + offv(R0 + 8, chv) + 8 * (p_ & 1)); }
#pragma unroll
            for (int s = 0; s < 8; ++s) { st = MFMA32(af[s], qf[s], st); af[s] = *(const LAS B8*)(lds + (KB + 8192 * (jt + 1)) + ro[s]); }
            if (jt == lt) {
#pragma unroll
                for (int r = 0; r < 16; ++r) if (crow(r, hi) > l31) st[r] = 0.f;
            }
            if (ML) {
#pragma unroll
                for (int r = 0; r < 16; ++r) csum += st[r];
            }
#pragma unroll
            for (int s2 = 0; s2 < 2; ++s2) {
                U4 pk; pk.x = cvtpk(st[8 * s2 + 0], st[8 * s2 + 1]); pk.y = cvtpk(st[8 * s2 + 2], st[8 * s2 + 3]); pk.z = cvtpk(st[8 * s2 + 4], st[8 * s2 + 5]); pk.w = cvtpk(st[8 * s2 + 6], st[8 * s2 + 7]);
                const B8 bfr = __builtin_bit_cast(B8, pk);
                const B8 afr = __builtin_shufflevector(vfr[2 * s2], vfr[2 * s2 + 1], 0, 1, 2, 3, 4, 5, 6, 7);
                o = MFMA32(afr, bfr, o);
            }
        }
        if (ML) {
            float qd = 0.f;
#pragma unroll
            for (int s = 0; s < 8; ++s) { const U4 nv = *(const LAS U4*)(lds + NOFF + 1024 + cur * 256 + (16 * s + 8 * hi) * 2); const U4 qv = __builtin_bit_cast(U4, qf[s]);
                qd = dot2bf(qv.x, nv.x, qd); qd = dot2bf(qv.y, nv.y, qd); qd = dot2bf(qv.z, nv.z, qd); qd = dot2bf(qv.w, nv.w, qd); }
            csum += __shfl_xor(csum, 32); qd += __shfl_xor(qd, 32);
            const float den = csum + qd;
            const float sc = 1.f / fmaxf(fabsf(den), th);
#pragma unroll
            for (int r = 0; r < 16; ++r) o[r] *= sc;
        }
        { unsigned pk[8];
#pragma unroll
            for (int g = 0; g < 4; ++g) { pk[2 * g] = cvtpk(o[4 * g], o[4 * g + 1]); pk[2 * g + 1] = cvtpk(o[4 * g + 2], o[4 * g + 3]); }
            U4 s0, s1;
            { auto ra = __builtin_amdgcn_permlane32_swap(pk[0], pk[2], false, false); auto rb = __builtin_amdgcn_permlane32_swap(pk[1], pk[3], false, false);
              s0.x = ra[0]; s0.y = rb[0]; s0.z = ra[1]; s0.w = rb[1]; }
            { auto ra = __builtin_amdgcn_permlane32_swap(pk[4], pk[6], false, false); auto rb = __builtin_amdgcn_permlane32_swap(pk[5], pk[7], false, false);
              s1.x = ra[0]; s1.y = rb[0]; s1.z = ra[1]; s1.w = rb[1]; }
            bf16* op = Vout + ((tok0 + (size_t)c * CHUNK + 32 * lt + l31) & omask) * 1024 + hd * 256 + sl * 64 + 32 * et + 8 * hi;
            if (ABL & 2) { asm volatile("" :: "v"(s0), "v"(s1)); } else { *(U4*)op = s0; *(U4*)(op + 16) = s1; } }
        float ksum = 0.f;
        { const unsigned chk = 4 * dt + 2 * blk + (p_ >> 1), chv = 4 * et + 2 * blk + (p_ >> 1);
          const unsigned ka0 = KB + offb(8 * hi + q_, chk) + 8 * (p_ & 1), ka1 = KB + offb(8 * hi + q_ + 4, chk) + 8 * (p_ & 1);
          const unsigned va0 = VB + offv(8 * hi + q_, chv) + 8 * (p_ & 1), va1 = VB + offv(8 * hi + q_ + 4, chv) + 8 * (p_ & 1);
          S4 ua[2][2], ub[2][2];
          ua[0][0] = trrd(lds + ka0); ua[0][1] = trrd(lds + ka1); ub[0][0] = trrd(lds + va0); ub[0][1] = trrd(lds + va1);
#pragma unroll
          for (int ks = 0; ks < 8; ++ks) { const int cu = ks & 1, nx = cu ^ 1;
            if (ks < 7) { ua[nx][0] = trrd(lds + ka0 + 4096 * (ks + 1)); ua[nx][1] = trrd(lds + ka1 + 4096 * (ks + 1)); ub[nx][0] = trrd(lds + va0 + 2048 * (ks + 1)); ub[nx][1] = trrd(lds + va1 + 2048 * (ks + 1)); }
            const B8 afr = __builtin_shufflevector(ua[cu][0], ua[cu][1], 0, 1, 2, 3, 4, 5, 6, 7), bfr = __builtin_shufflevector(ub[cu][0], ub[cu][1], 0, 1, 2, 3, 4, 5, 6, 7);
            St = MFMA32(afr, bfr, St);
            if (ML) { const U4 av = __builtin_bit_cast(U4, afr); ksum = dot2bf(av.x, 0x3f803f80u, ksum); ksum = dot2bf(av.y, 0x3f803f80u, ksum); ksum = dot2bf(av.z, 0x3f803f80u, ksum); ksum = dot2bf(av.w, 0x3f803f80u, ksum); }
          } }
#pragma unroll
        for (int r = 0; r < 16; ++r) St[r] *= decay;
#pragma unroll
        for (int g = 0; g < 4; ++g) { U2 pk; pk.x = cvtpk(St[4 * g], St[4 * g + 1]); pk.y = cvtpk(St[4 * g + 2], St[4 * g + 3]);
            *(LAS U2*)(lds + SOFF + offb(32 * et + l31, 4 * dt + g) + 8 * hi) = pk; }
        if (ML) { ksum += __shfl_xor(ksum, 32);
            if (et == 0 && hi == 0) { const LAS float* nv = (const LAS float*)(lds + NOFF + cur * 512); LAS float* nn = (LAS float*)(lds + NOFF + nxt * 512);
                const float nval = decay * (nv[32 * dt + l31] + ksum); nn[32 * dt + l31] = nval;
                *(LAS unsigned short*)(lds + NOFF + 1024 + nxt * 256 + (32 * dt + l31) * 2) = (unsigned short)(cvtpk(nval, 0.f) & 0xffffu); } }
        asm volatile("s_waitcnt vmcnt(2)" ::: "memory");
        __syncthreads();
    }
#undef MX_DMA
#undef ksrc_
#undef vsrc_
}
__device__ __forceinline__ void phase3(const Ctx& C, unsigned char* ws, bool dry) {
    for (int it = C.vcu; it < 256; it += C.G) {
        const int mix = it >> 7, b = (it >> 4) & 7, hd = (it >> 2) & 3, sl = it & 3;
        bf16* vr = (bf16*)(ws + WS_RV); bf16* vm = (bf16*)(ws + WS_MV); bf16* dump = (bf16*)(ws + 930 * MiB);
#ifndef DRY_ABL
#define DRY_ABL 0
#endif
        if (dry) {
            if (mix == 0 || (DRY_ABL & 1)) mixer_item<false, DRY_ABL>(C, (const bf16*)(ws + (mix ? WS_MQP : WS_RQ)), (const bf16*)(ws + (mix ? WS_MKP : WS_RK)), mix ? vm : vr, dump, (size_t)0x7fff, nullptr, nullptr, b, hd, sl);
            else mixer_item<true, DRY_ABL>(C, (const bf16*)(ws + WS_MQP), (const bf16*)(ws + WS_MKP), vm, dump, (size_t)0x7fff, (const float*)(ws + WS_THR), (const float*)(ws + WS_CDEC), b, hd, sl);
        } else {
        if (mix == 0) mixer_item<false>(C, (const bf16*)(ws + WS_RQ), (const bf16*)(ws + WS_RK), vr, vr, ~(size_t)0, nullptr, nullptr, b, hd, sl);
        else mixer_item<true>(C, (const bf16*)(ws + WS_MQP), (const bf16*)(ws + WS_MKP), vm, vm, ~(size_t)0, (const float*)(ws + WS_THR), (const float*)(ws + WS_CDEC), b, hd, sl);
        }
    }
}

__device__ __forceinline__ void phase4(const Ctx& C, const float* const* in, unsigned char* ws) {
    const float* rgn = in[3]; const float* mgn = in[9];
    const int gw = C.vcu * NWAVES + C.wave, NGW = C.G * NWAVES;
    const int col = (C.lane >> 4) * 256 + (C.lane & 15) * 16;
    float gr[16], gm[16];
#pragma unroll
    for (int i = 0; i < 4; ++i) { const F4 a = *(const F4*)(rgn + col + 4 * i), bq = *(const F4*)(mgn + col + 4 * i);
        gr[4 * i] = a.x; gr[4 * i + 1] = a.y; gr[4 * i + 2] = a.z; gr[4 * i + 3] = a.w; gm[4 * i] = bq.x; gm[4 * i + 1] = bq.y; gm[4 * i + 2] = bq.z; gm[4 * i + 3] = bq.w; }
    for (int m = gw; m < NTOK; m += NGW) {
#pragma unroll
        for (int mx = 0; mx < 2; ++mx) {
            const bf16* ip = (const bf16*)(ws + (mx ? WS_MV : WS_RV)) + (size_t)m * 1024 + col;
            bf16* op = (bf16*)(ws + WS_XCAT) + (size_t)m * 2048 + mx * 1024 + col;
            const bf16* gp = (const bf16*)(ws + (mx ? WS_MO : WS_RG)) + (size_t)m * 1024 + col;
            const U4 o0 = *(const U4*)ip, o1 = *(const U4*)(ip + 8), g0 = *(const U4*)gp, g1 = *(const U4*)(gp + 8);
            float v[16], g[16];
            v[0] = bflo(o0.x); v[1] = bfhi(o0.x); v[2] = bflo(o0.y); v[3] = bfhi(o0.y); v[4] = bflo(o0.z); v[5] = bfhi(o0.z); v[6] = bflo(o0.w); v[7] = bfhi(o0.w);
            v[8] = bflo(o1.x); v[9] = bfhi(o1.x); v[10] = bflo(o1.y); v[11] = bfhi(o1.y); v[12] = bflo(o1.z); v[13] = bfhi(o1.z); v[14] = bflo(o1.w); v[15] = bfhi(o1.w);
            g[0] = bflo(g0.x); g[1] = bfhi(g0.x); g[2] = bflo(g0.y); g[3] = bfhi(g0.y); g[4] = bflo(g0.z); g[5] = bfhi(g0.z); g[6] = bflo(g0.w); g[7] = bfhi(g0.w);
            g[8] = bflo(g1.x); g[9] = bfhi(g1.x); g[10] = bflo(g1.y); g[11] = bfhi(g1.y); g[12] = bflo(g1.z); g[13] = bfhi(g1.z); g[14] = bflo(g1.w); g[15] = bfhi(g1.w);
            if (mx) {
#pragma unroll
                for (int i = 0; i < 16; ++i) v[i] *= sigm(g[i]);
            }
            float ss = 0.f;
#pragma unroll
            for (int i = 0; i < 16; ++i) ss += v[i] * v[i];
            ss += __shfl_xor(ss, 1); ss += __shfl_xor(ss, 2); ss += __shfl_xor(ss, 4); ss += __shfl_xor(ss, 8);
            const float r = rsqrtf(ss * (1.f / 256.f) + EPS);
            float y[16];
#pragma unroll
            for (int i = 0; i < 16; ++i) y[i] = mx ? v[i] * r * gm[i] : v[i] * r * gr[i] * silu(g[i]);
            U4 w0, w1; w0.x = cvtpk(y[0], y[1]); w0.y = cvtpk(y[2], y[3]); w0.z = cvtpk(y[4], y[5]); w0.w = cvtpk(y[6], y[7]);
            w1.x = cvtpk(y[8], y[9]); w1.y = cvtpk(y[10], y[11]); w1.z = cvtpk(y[12], y[13]); w1.w = cvtpk(y[14], y[15]);
            *(U4*)op = w0; *(U4*)(op + 8) = w1;
        }
    }
    LAS float* scr = (LAS float*)(C.lds + C.wave * 8448);
    const float* wgate = in[17]; const float* wup = in[18]; const float* wdn = in[19];
    for (int it = gw; it < 16384 + 8192; it += NGW) {
        if (it < 16384) { const int e = it >> 9, kb = (it >> 5) & 15, nb = it & 31; const int R0 = nb * 32, tile = R0 >> 8, within = R0 & 255;
            const float* W = (within < 128 ? wgate : wup) + (size_t)e * 1024 * 512;
            transpose_item(W, 512, kb * 64, tile * 128 + (within & 127), (bf16*)(ws + WS_WGU), 1024, e * 1024 + R0, scr, C.lane); }
        else { const int r = it - 16384; const int e = r >> 8, kb = (r >> 5) & 7, nb = r & 31;
            transpose_item(wdn + (size_t)e * 512 * 1024, 1024, kb * 64, nb * 32, (bf16*)(ws + WS_WD), 512, e * 1024 + nb * 32, scr, C.lane); }
    }
}

__device__ __forceinline__ void phase8(const Ctx& C, const float* const* in, const float* x1, unsigned char* ws) {
    const float* bg = in[14]; const float* be = in[16];
    const F4* WR = (const F4*)(ws + WS_ROUT); TokInfo* TI = (TokInfo*)(ws + WS_TOK); unsigned* gcnt = (unsigned*)(ws + WS_CTL);
    LAS float* scr = (LAS float*)(C.lds + C.wave * 4096);
    LAS unsigned* lcnt = (LAS unsigned*)(C.lds + 65536);
    LAS unsigned* lbase = (LAS unsigned*)(C.lds + 65536 + 128);
    const int l = C.lane, l15 = l & 15, kk = l >> 4;
    for (int blkid = C.vcu; blkid < NTOK / 256; blkid += C.G) {
        __syncthreads();
        if (C.tid < 32) lcnt[C.tid] = 0u;
        __syncthreads();
        int e0[2], e1[2]; float w0[2], w1[2], rs[2]; unsigned rk0[2], rk1[2];
#pragma unroll
        for (int tt = 0; tt < 2; ++tt) {
            const int row0 = blkid * 256 + C.wave * 32 + tt * 16;
            F4 acc[3]; for (int n = 0; n < 3; ++n) acc[n] = (F4){0.f, 0.f, 0.f, 0.f};
            float ss = 0.f;
            const float* xr = x1 + (size_t)(row0 + l15) * DM + 4 * kk;
#pragma unroll 4
            for (int kb = 0; kb < 64; ++kb) {
                const F4 a = *(const F4*)(xr + 16 * kb);
                const F4 b0 = WR[(kb * 3 + 0) * 64 + l], b1 = WR[(kb * 3 + 1) * 64 + l], b2 = WR[(kb * 3 + 2) * 64 + l];
                ss += (a.x * a.x + a.y * a.y) + (a.z * a.z + a.w * a.w);
#pragma unroll
                for (int j = 0; j < 4; ++j) {
                    acc[0] = __builtin_amdgcn_mfma_f32_16x16x4f32(a[j], b0[j], acc[0], 0, 0, 0);
                    acc[1] = __builtin_amdgcn_mfma_f32_16x16x4f32(a[j], b1[j], acc[1], 0, 0, 0);
                    acc[2] = __builtin_amdgcn_mfma_f32_16x16x4f32(a[j], b2[j], acc[2], 0, 0, 0); }
            }
            ss += __shfl_xor(ss, 16); ss += __shfl_xor(ss, 32);
            const float rstd = rsqrtf(ss * (1.f / DM) + EPS);
#pragma unroll
            for (int n = 0; n < 3; ++n)
#pragma unroll
                for (int r = 0; r < 4; ++r) scr[(4 * kk + r) * 49 + 16 * n + l15] = acc[n][r];
            if (kk == 0) scr[16 * 49 + l15] = rstd;
            asm volatile("s_waitcnt lgkmcnt(0)" ::: "memory");
            e0[tt] = 0; e1[tt] = 0; w0[tt] = 0.f; w1[tt] = 0.f; rs[tt] = 0.f; rk0[tt] = 0u; rk1[tt] = 0u;
            if (l < 16) {
                const LAS float* lr = scr + l * 49; const float rr = scr[16 * 49 + l];
                float g0 = lr[0] * rr + bg[0], g1 = lr[1] * rr + bg[1], g2 = lr[2] * rr + bg[2], g3 = lr[3] * rr + bg[3];
                int gi = 0; float gmx = g0; if (g1 > gmx) { gmx = g1; gi = 1; } if (g2 > gmx) { gmx = g2; gi = 2; } if (g3 > gmx) { gmx = g3; gi = 3; }
                const float gw = 1.f / (__expf(g0 - gmx) + __expf(g1 - gmx) + __expf(g2 - gmx) + __expf(g3 - gmx));
                float m1 = -INFINITY, m2 = -INFINITY; int i1 = 0, i2 = 0;
#pragma unroll
                for (int i = 0; i < 8; ++i) { const float v = lr[4 + gi * 8 + i] * rr + be[gi * 8 + i];
                    if (v > m1) { m2 = m1; i2 = i1; m1 = v; i1 = i; } else if (v > m2) { m2 = v; i2 = i; } }
                const float ex = __expf(m2 - m1), wa = 1.f / (1.f + ex);
                e0[tt] = gi * 8 + i1; e1[tt] = gi * 8 + i2; w0[tt] = gw * wa; w1[tt] = gw * ex * wa; rs[tt] = rr;
                rk0[tt] = atomicAdd((unsigned*)(lcnt + e0[tt]), 1u); rk1[tt] = atomicAdd((unsigned*)(lcnt + e1[tt]), 1u);
            }
            asm volatile("s_waitcnt lgkmcnt(0)" ::: "memory");
        }
        __syncthreads();
        if (C.tid < 32) lbase[C.tid] = atomicAdd(gcnt + C.tid, lcnt[C.tid]);
        __syncthreads();
#pragma unroll
        for (int tt = 0; tt < 2; ++tt) if (l < 16) {
            TokInfo ti; ti.e0 = e0[tt]; ti.p0 = (int)(lbase[e0[tt]] + rk0[tt]); ti.e1 = e1[tt]; ti.p1 = (int)(lbase[e1[tt]] + rk1[tt]); ti.w0 = w0[tt]; ti.w1 = w1[tt]; ti.rstd = rs[tt]; ti.pad = 0.f;
            TI[blkid * 256 + C.wave * 32 + tt * 16 + l] = ti; }
    }
}

__device__ __forceinline__ int build_rowbase(const Ctx& C, unsigned char* ws) {
    LAS int* rb = (LAS int*)(C.lds + LDS_MISC);
    LAS unsigned char* t2e = (LAS unsigned char*)(C.lds + LDS_MISC + 256);
    const unsigned* gcnt = (const unsigned*)(ws + WS_CTL);
    __syncthreads();
    if (C.tid == 0) { int acc = 0; for (int e = 0; e < NEXP; ++e) { rb[e] = acc; const int n = (int)__hip_atomic_load(gcnt + e, __ATOMIC_RELAXED, __HIP_MEMORY_SCOPE_AGENT); acc += (n + 255) & ~255; } rb[NEXP] = acc; }
    __syncthreads();
    for (int e = C.tid >> 4; e < NEXP; e += NTHR >> 4) for (int t = (rb[e] >> 8) + (C.tid & 15); t < (rb[e + 1] >> 8); t += 16) t2e[t] = (unsigned char)e;
    __syncthreads();
    return rb[NEXP] >> 8;
}

__device__ __forceinline__ void phase9(const Ctx& C, const float* const* in, const float* x1, unsigned char* ws) {
    (void)build_rowbase(C, ws);
    const LAS int* rb = (const LAS int*)(C.lds + LDS_MISC);
    const float* nfw = in[12]; const TokInfo* TI = (const TokInfo*)(ws + WS_TOK); bf16* XS = (bf16*)(ws + WS_XS);
    const int gw = C.vcu * NWAVES + C.wave, NGW = C.G * NWAVES;
    F4 wv[4];
#pragma unroll
    for (int j = 0; j < 4; ++j) wv[j] = *(const F4*)(nfw + 4 * C.lane + 256 * j);
    for (int m = gw; m < NTOK; m += NGW) {
        const TokInfo ti = TI[m];
        const F4* xr = (const F4*)(x1 + (size_t)m * DM) + C.lane;
        unsigned long long* d0 = (unsigned long long*)(XS + (size_t)(rb[ti.e0] + ti.p0) * DM) + C.lane;
        unsigned long long* d1 = (unsigned long long*)(XS + (size_t)(rb[ti.e1] + ti.p1) * DM) + C.lane;
#pragma unroll
        for (int j = 0; j < 4; ++j) { const F4 v = xr[64 * j] * ti.rstd * wv[j];
            const unsigned long long pk = (unsigned long long)cvtpk(v.x, v.y) | ((unsigned long long)cvtpk(v.z, v.w) << 32);
            d0[64 * j] = pk; d1[64 * j] = pk; }
    }
}

__device__ __forceinline__ void phase12(const Ctx& C, const float* const* in, float* xo, unsigned char* ws) {
    (void)build_rowbase(C, ws);
    const LAS int* rb = (const LAS int*)(C.lds + LDS_MISC);
    const float* fw = in[20]; const TokInfo* TI = (const TokInfo*)(ws + WS_TOK); const bf16* Y = (const bf16*)(ws + WS_Y);
    const int gw = C.vcu * NWAVES + C.wave, NGW = C.G * NWAVES;
    F4 wv[4];
#pragma unroll
    for (int j = 0; j < 4; ++j) wv[j] = *(const F4*)(fw + 4 * C.lane + 256 * j);
    for (int m = gw; m < NTOK; m += NGW) {
        const TokInfo ti = TI[m];
        F4* xr = (F4*)(xo + (size_t)m * DM) + C.lane;
        const U2* y0 = (const U2*)(Y + (size_t)(rb[ti.e0] + ti.p0) * DM) + C.lane;
        const U2* y1 = (const U2*)(Y + (size_t)(rb[ti.e1] + ti.p1) * DM) + C.lane;
        F4 v[4]; float s = 0.f;
#pragma unroll
        for (int j = 0; j < 4; ++j) { const U2 a = y0[64 * j], bq = y1[64 * j]; v[j] = xr[64 * j];
            v[j].x += ti.w0 * bflo(a.x) + ti.w1 * bflo(bq.x); v[j].y += ti.w0 * bfhi(a.x) + ti.w1 * bfhi(bq.x);
            v[j].z += ti.w0 * bflo(a.y) + ti.w1 * bflo(bq.y); v[j].w += ti.w0 * bfhi(a.y) + ti.w1 * bfhi(bq.y);
            s += (v[j].x * v[j].x + v[j].y * v[j].y) + (v[j].z * v[j].z + v[j].w * v[j].w); }
        const float rstd = rsqrtf(wave_sum(s) * (1.f / DM) + EPS);
#pragma unroll
        for (int j = 0; j < 4; ++j) xr[64 * j] = v[j] * rstd * wv[j];
    }
}

constexpr int NPHASE = 13;
struct Args { const float* in[21]; float* out; unsigned char* ws; int ph_lo, ph_hi; };
__global__ void __launch_bounds__(NTHR, 2) fwd_kernel(Args args) {
    extern __shared__ __attribute__((aligned(16))) unsigned char lds_raw[];
    cg::grid_group grid = cg::this_grid();
    Ctx C; C.lds = (LAS unsigned char*)lds_raw; C.tid = threadIdx.x; C.lane = C.tid & 63; C.wave = __builtin_amdgcn_readfirstlane(C.tid >> 6);
    C.G = gridDim.x; { const int bx = blockIdx.x; C.vcu = (C.G % 8 == 0) ? (bx % 8) * (C.G / 8) + bx / 8 : bx; }
    unsigned char* ws = args.ws; unsigned char* ob = (unsigned char*)args.out;
    const int lo = args.ph_lo, hi = args.ph_hi;
#ifndef PHMASK
#define PHMASK 0x1fff
#endif
#define IN(k) (((PHMASK >> (k)) & 1) && lo <= (k) && (k) < hi)
    if (C.tid < 2) ((LAS unsigned*)(C.lds + LDS_MISC + 4096))[C.tid] = 0u;
    __syncthreads();
    const XcdBarrier bar = xcd_barrier_post((unsigned*)(ws + WS_CTL) + CW_BAR, (volatile LAS unsigned*)(C.lds + LDS_MISC + 4096));
#define SEAM(k) do { if (IN(k) && IN((k) + 1)) { if ((k) == 0) grid.sync(); else xcd_barrier(bar); } } while (0)
#ifndef DUP_MASK
#define DUP_MASK 0
#endif
#define REP(k) for (int rep_ = 0; rep_ < (((DUP_MASK >> (k)) & 1) ? 2 : 1); ++rep_)
    if (IN(0)) { REP(0) phase0(C, args.in, ws); } SEAM(0);
    if (IN(1)) { pg8::Gemm g{(const pg8::bf16_t*)(ws + WS_H), (const pg8::bf16_t*)(ws + WS_WIN), NTOK, NPROJ, DM}; pg8::StaticOrder S; S.init(NTOK, NPROJ, C.G, (int)blockIdx.x);
        pg8::EpiProj E{ws, ob}; REP(1) pg8::gemm_phase<pg8::EpiProj, pg8::StaticOrder, true, true>(C.lds, g, S, E); } SEAM(1);
    if (IN(2)) { phase2(C, args.in, ws); } SEAM(2);
    if (IN(3)) { if ((DUP_MASK >> 3) & 1) phase3(C, ws, true); phase3(C, ws, false); } SEAM(3);
    if (IN(4)) { phase4(C, args.in, ws); } SEAM(4);
    if (IN(5)) { pg8::Gemm g{(const pg8::bf16_t*)(ws + WS_XCAT), (const pg8::bf16_t*)(ws + WS_WCAT), NTOK, DM, 2 * DM}; pg8::StaticOrder S; S.init(NTOK, DM, C.G, (int)blockIdx.x);
        pg8::EpiGateFused E{(const pg8::bf16_t*)(ob + OUT_GR), (const pg8::bf16_t*)(ob + OUT_GM), (pg8::bf16_t*)(ws + WS_MERGED)}; REP(5) pg8::gemm_phase<pg8::EpiGateFused, pg8::StaticOrder, true, true>(C.lds, g, S, E); }
    if (IN(5) && IN(7)) xcd_barrier(bar);
    if (IN(7)) { pg8::Gemm g{(const pg8::bf16_t*)(ws + WS_MERGED), (const pg8::bf16_t*)(ws + WS_WOUT), NTOK, DM, DM}; pg8::StaticOrder S; S.init(NTOK, DM, C.G, (int)blockIdx.x);
        pg8::EpiX1 E{args.in[0], args.out}; REP(7) pg8::gemm_phase<pg8::EpiX1, pg8::StaticOrder, true, true>(C.lds, g, S, E); } SEAM(7);
    if (IN(8)) { phase8(C, args.in, args.out, ws); } SEAM(8);
    if (IN(9)) { REP(9) phase9(C, args.in, args.out, ws); } SEAM(9);
    if (IN(10)) { const int nt = build_rowbase(C, ws);
        pg8::Gemm g{(const pg8::bf16_t*)(ws + WS_XS), (const pg8::bf16_t*)(ws + WS_WGU), MAXROWS, NEXP * 1024, DM};
        pg8::GroupedOrder S{nt, C.G, C.vcu, (const LAS unsigned char*)(C.lds + LDS_MISC + 256)};
        pg8::EpiSwiglu E{(pg8::bf16_t*)(ws + WS_HMID)}; REP(10) pg8::gemm_phase<pg8::EpiSwiglu, pg8::GroupedOrder, true, true>(C.lds, g, S, E); } SEAM(10);
    if (IN(11)) { const int nt = build_rowbase(C, ws);
        pg8::Gemm g{(const pg8::bf16_t*)(ws + WS_HMID), (const pg8::bf16_t*)(ws + WS_WD), MAXROWS, NEXP * 1024, DEXP};
        pg8::GroupedOrder S{nt, C.G, C.vcu, (const LAS unsigned char*)(C.lds + LDS_MISC + 256)};
        pg8::EpiY E{(pg8::bf16_t*)(ws + WS_Y)}; REP(11) pg8::gemm_phase<pg8::EpiY, pg8::GroupedOrder, true, true>(C.lds, g, S, E); } SEAM(11);
    if (IN(12)) { phase12(C, args.in, args.out, ws); }
#undef IN
#undef SEAM
}

#ifndef MK_SPLIT
#define MK_SPLIT 0
#endif
extern "C" void kernel_launch(void* const* d_in, const int* in_sizes, int n_in, void* d_out, int out_size, void* d_ws, size_t ws_size, hipStream_t stream) {
    static int grid = 0;
    if (grid == 0) {
        if (n_in != 21 || out_size != NTOK * DM || ws_size < WS_END) { fprintf(stderr, "kernel_launch: unexpected shapes (n_in %d out %d ws %zu)\n", n_in, out_size, ws_size); grid = -1; return; }
        int dev = 0, cus = 0, per_cu = 0;
        if (hipGetDevice(&dev) != hipSuccess || hipDeviceGetAttribute(&cus, hipDeviceAttributeMultiprocessorCount, dev) != hipSuccess) { grid = -1; return; }
        if (hipFuncSetAttribute((const void*)fwd_kernel, hipFuncAttributeMaxDynamicSharedMemorySize, LDS_BYTES) != hipSuccess) { fprintf(stderr, "kernel_launch: hipFuncSetAttribute failed\n"); grid = -1; return; }
        if (hipOccupancyMaxActiveBlocksPerMultiprocessor(&per_cu, (const void*)fwd_kernel, NTHR, LDS_BYTES) != hipSuccess || per_cu < 1) { fprintf(stderr, "kernel_launch: occupancy query says %d\n", per_cu); per_cu = 1; }
        (void)hipGetLastError();
        grid = cus;
    }
    if (grid < 0) return;
    (void)hipMemsetAsync((char*)d_ws + WS_CTL, 0, CTL_ZERO_BYTES, stream);
    Args a{};
    for (int i = 0; i < 21; ++i) a.in[i] = (const float*)d_in[i];
    a.out = (float*)d_out; a.ws = (unsigned char*)d_ws;
    void* kargs[] = {&a};
#if MK_SPLIT
    for (int p = 0; p < NPHASE; ++p) { a.ph_lo = p; a.ph_hi = p + 1;
        hipError_t e = hipLaunchCooperativeKernel((const void*)fwd_kernel, dim3(grid), dim3(NTHR), kargs, LDS_BYTES, stream);
        if (e != hipSuccess) { fprintf(stderr, "kernel_launch: launch %d failed: %s\n", p, hipGetErrorString(e)); break; } }
#else
    a.ph_lo = 0; a.ph_hi = NPHASE;
    hipError_t e = hipLaunchCooperativeKernel((const void*)fwd_kernel, dim3(grid), dim3(NTHR), kargs, LDS_BYTES, stream);
    if (e != hipSuccess) fprintf(stderr, "kernel_launch: cooperative launch failed: %s (grid %d)\n", hipGetErrorString(e), grid);
#endif
}
```

```cpp
#include <hip/hip_runtime.h>
#include <hip/hip_cooperative_groups.h>
#include <cstdio>
#include <cstdint>
namespace cg = cooperative_groups;
namespace pg8 {
#define PG8_LAS __attribute__((address_space(3)))
typedef unsigned short bf16_t;
typedef short bf16x8 __attribute__((ext_vector_type(8)));
typedef float f32x4 __attribute__((ext_vector_type(4)));
typedef unsigned u32x4 __attribute__((ext_vector_type(4)));
constexpr int BM = 256, BK = 64, HALF = 128, HTB = HALF * BK * 2  , STAGE_BYTES = 8 * HTB, NXCD = 8, WGM = 8;

__host__ __device__ __forceinline__ int lds_byte(int r, int c) { const int st = (r >> 4) * 2 + (c >> 5), rr = r & 15, cc = c & 31, ob = rr * 64 + cc * 2; return st * 1024 + (ob ^ (((ob >> 9) & 1) << 5)); }
__host__ __device__ __forceinline__ void stage_rc(int b, int& R, int& C) { const int st = b / 1024, sb = b % 1024, swz = sb ^ (((sb >> 9) & 1) << 5); R = (st >> 1) * 16 + swz / 64; C = (st & 1) * 32 + (swz % 64) / 2; }
__host__ __device__ __forceinline__ int perm32(int rho) { const int n = rho >> 4, i = rho & 15; return 8 * (i >> 2) + 4 * n + (i & 3); }

struct Unit { int pm, pn, pa; };
struct Gemm { const bf16_t* A; const bf16_t* Bt; int M, N, K; };

struct StaticOrder {
    static constexpr bool GATHER = false;
    int nM, nN, nwg, G, c;
    __host__ __device__ void init(int M, int N, int G_, int c_) { nM = M / BM; nN = N / BM; nwg = nM * nN; G = G_; c = c_; }
    __host__ __device__ bool next(int i, Unit& u) const {
        const long L = (long)i * G + c; if (L >= nwg) return false;
        int wgid = (int)L; { const int q = nwg / NXCD, r = nwg % NXCD, xcd = wgid % NXCD, off = wgid / NXCD; wgid = (xcd < r ? xcd * (q + 1) : r * (q + 1) + (xcd - r) * q) + off; }
        const int nig = WGM * nN, gid = wgid / nig, fm = gid * WGM, gsz = (nM - fm) < WGM ? (nM - fm) : WGM;
        u.pm = fm + ((wgid % nig) % gsz); u.pn = (wgid % nig) / gsz; u.pa = 0; return true;
    }
    __device__ __forceinline__ void a_ready(const Unit&) const {}
    __device__ __forceinline__ void done(const Unit&) const {}
};

__device__ __forceinline__ unsigned cvt_pk_bf16(float lo, float hi) { unsigned r; asm volatile("v_cvt_pk_bf16_f32 %0, %1, %2" : "=v"(r) : "v"(lo), "v"(hi)); return r; }
typedef float f32x2 __attribute__((ext_vector_type(2)));
__device__ __forceinline__ f32x2 gelu_pk(f32x2 v) {
    const f32x2 av = __builtin_elementwise_abs(v), d = av * 0.2316418882f + 1.0f;
    f32x2 t; t.x = __builtin_amdgcn_rcpf(d.x); t.y = __builtin_amdgcn_rcpf(d.y);
    f32x2 q = t * 0.5307027145f + (-0.7265760135f); q = q * t + 0.7107068705f; q = q * t + (-0.142248368f); q = q * t + 0.127414796f; q = q * t;
    const f32x2 s = (v * v) * (-0.72134752044f);
    f32x2 e; e.x = __builtin_amdgcn_exp2f(s.x); e.y = __builtin_amdgcn_exp2f(s.y);
    const f32x2 m = v * (q * e), r = v - m;
    f32x2 o; o.x = v.x < 0.f ? m.x : r.x; o.y = v.y < 0.f ? m.y : r.y; return o;
}

template <int ACT  > struct EpiBf16 {
    static constexpr bool PERM = true, AFTER_DRAIN = false, MIDK = false; static_assert(ACT == 0 || ACT == 1, "EpiBf16: ACT is 0 (none) or 1 (gelu_pk)");
    bf16_t* O; int ldc; const float* bias; int split_cols; size_t split_stride; float scale0;
    __device__ __forceinline__ void operator()(const f32x4 (&acc)[2][2][4][2], const Unit& u, int wr, int wc, int fr, int fq) const {
        const int row0 = u.pm * BM + wr * 64 + fr; int colt = u.pn * BM; bf16_t* base = O;
        float sc = 1.f; if (split_cols) { const int t = colt / split_cols; base += (size_t)t * split_stride; colt -= t * split_cols; if (t == 0) sc = scale0; }
        const int col0 = colt + wc * 32 + 8 * fq, bcol0 = u.pn * BM + wc * 32 + 8 * fq;
        f32x4 bv[2][2];
#pragma unroll
        for (int bj = 0; bj < 2; ++bj)
#pragma unroll
            for (int n = 0; n < 2; ++n) bv[bj][n] = bias ? *(const f32x4*)(bias + bcol0 + bj * HALF + 4 * n) : (f32x4){0.f, 0.f, 0.f, 0.f};
#pragma unroll
        for (int ai = 0; ai < 2; ++ai)
#pragma unroll
            for (int m = 0; m < 4; ++m) { bf16_t* rowp = base + (size_t)(row0 + ai * HALF + m * 16) * ldc + col0;
#pragma unroll
                for (int bj = 0; bj < 2; ++bj) { f32x4 v0 = acc[ai][bj][m][0] + bv[bj][0], v1 = acc[ai][bj][m][1] + bv[bj][1];
                    if (ACT == 1) { f32x2 a = gelu_pk((f32x2){v0[0], v0[1]}), b = gelu_pk((f32x2){v0[2], v0[3]}), c = gelu_pk((f32x2){v1[0], v1[1]}), d = gelu_pk((f32x2){v1[2], v1[3]});
                        v0 = (f32x4){a.x, a.y, b.x, b.y}; v1 = (f32x4){c.x, c.y, d.x, d.y}; }
                    v0 = v0 * sc; v1 = v1 * sc; u32x4 w; w.x = cvt_pk_bf16(v0[0], v0[1]); w.y = cvt_pk_bf16(v0[2], v0[3]); w.z = cvt_pk_bf16(v1[0], v1[1]); w.w = cvt_pk_bf16(v1[2], v1[3]);
                    *(u32x4*)(rowp + bj * HALF) = w; } }
    }
};
template <class Epi, class Sched, bool ALIGN_EPI = false, bool SP2 = false>
__device__ __forceinline__ void gemm_phase(PG8_LAS unsigned char* lds, const Gemm g, const Sched& S, const Epi& E) {
    const int tid = threadIdx.x, wid = __builtin_amdgcn_readfirstlane(tid >> 6), lane = tid & 63, wr = wid >> 2, wc = wid & 3, fr = lane & 15, fq = lane >> 4;
    const int K = g.K, nt = K / BK;
    unsigned voffA[2], voffB[2]; int Rr[2], Cc[2];
#pragma unroll
    for (int i = 0; i < 2; ++i) { int R, C; stage_rc(tid * 16 + i * 8192, R, C); const int Rb = Epi::PERM ? ((R & ~31) + perm32(R & 31)) : R; Rr[i] = R; Cc[i] = C;
        voffA[i] = (unsigned)(R * K + C) * 2u; voffB[i] = (unsigned)(Rb * K + C) * 2u; }
    const size_t kstep = (size_t)(BK * 2);
    const size_t hstep = (size_t)HALF * K * 2;
    const size_t tstep = 2 * hstep;
    unsigned vAc[2][2], vAn[2][2];
#define PG8_AOFF(dst, un) do { _Pragma("unroll") for (int h_ = 0; h_ < 2; ++h_) _Pragma("unroll") for (int i_ = 0; i_ < 2; ++i_) { \
        if constexpr (Sched::GATHER) (dst)[h_][i_] = (unsigned)S.arow((un), h_ * HALF + Rr[i_]) * (unsigned)(K * 2) + (unsigned)(Cc[i_] * 2); \
        else (dst)[h_][i_] = voffA[i_] + (unsigned)(h_ * (int)hstep); } } while (0)
    const unsigned ldsw = (unsigned)wid * 1024u;
    const int aoff = lds_byte(wr * 64 + fr, fq * 8), boff = lds_byte(wc * 32 + fr, fq * 8);
#define PG8_SA(b, h) (((b) * 2 + (h)) * HTB)
#define PG8_SB(b, h) ((4 + (b) * 2 + (h)) * HTB)
#define PG8_STAGE(bufoff, gbase, voff) do { _Pragma("unroll") for (int _i = 0; _i < 2; ++_i) \
        __builtin_amdgcn_global_load_lds((const unsigned*)((const char*)(gbase) + (voff)[_i]), (PG8_LAS unsigned*)(lds + (bufoff) + ldsw + _i * 8192), 16, 0, 0); } while (0)
#define PG8_LDA(dst, b, h) do { _Pragma("unroll") for (int m = 0; m < 4; ++m) _Pragma("unroll") for (int k = 0; k < 2; ++k) dst[m][k] = *(const PG8_LAS bf16x8*)(lds + PG8_SA(b, h) + aoff + m * 2048 + k * 1024); } while (0)
#define PG8_LDB(dst, b, h) do { _Pragma("unroll") for (int n = 0; n < 2; ++n) _Pragma("unroll") for (int k = 0; k < 2; ++k) dst[n][k] = *(const PG8_LAS bf16x8*)(lds + PG8_SB(b, h) + boff + n * 2048 + k * 1024); } while (0)
#define PG8_MMA(ai, bj, At, Bt) do { __builtin_amdgcn_s_setprio(1); _Pragma("unroll") for (int m = 0; m < 4; ++m) _Pragma("unroll") for (int n = 0; n < 2; ++n) _Pragma("unroll") for (int k = 0; k < 2; ++k) \
        acc[ai][bj][m][n] = __builtin_amdgcn_mfma_f32_16x16x32_bf16(Bt[n][k], At[m][k], acc[ai][bj][m][n], 0, 0, 0); __builtin_amdgcn_s_setprio(0); } while (0)
#define PG8_WAIT_V(n) asm volatile("s_waitcnt vmcnt(" #n ")" ::: "memory")
#define PG8_WAIT_L(n) asm volatile("s_waitcnt lgkmcnt(" #n ")" ::: "memory")
#define PG8_BAR __builtin_amdgcn_s_barrier()
#define PG8_SCHED __builtin_amdgcn_sched_barrier(0)
    Unit cur, nxt; int ui = 0;
    if (!S.next(0, cur)) return;
    f32x4 acc[2][2][4][2];
#pragma unroll
    for (int a = 0; a < 2; ++a)
#pragma unroll
        for (int b = 0; b < 2; ++b)
#pragma unroll
            for (int m = 0; m < 4; ++m)
#pragma unroll
                for (int n = 0; n < 2; ++n) acc[a][b][m][n] = (f32x4){0.f, 0.f, 0.f, 0.f};
    bf16x8 At[4][2], B0[2][2], B1[2][2];
    const char* cA = (const char*)g.A + (Sched::GATHER ? (size_t)0 : (size_t)cur.pm * tstep); const char* cB = (const char*)g.Bt + (size_t)cur.pn * tstep;
    PG8_AOFF(vAc, cur);
    S.a_ready(cur);
    if constexpr (SP2) {
        PG8_STAGE(PG8_SB(0, 0), cB, voffB); PG8_STAGE(PG8_SB(0, 1), cB + hstep, voffB); PG8_STAGE(PG8_SA(0, 0), cA, vAc[0]); PG8_STAGE(PG8_SA(0, 1), cA, vAc[1]);
        if (wr == 1) PG8_BAR;
        PG8_WAIT_V(2); PG8_BAR;
        PG8_STAGE(PG8_SB(1, 0), cB + kstep, voffB); PG8_STAGE(PG8_SA(1, 0), cA + kstep, vAc[0]); PG8_STAGE(PG8_SB(1, 1), cB + hstep + kstep, voffB);
        PG8_WAIT_V(6); PG8_BAR;
    } else {
        PG8_STAGE(PG8_SB(0, 0), cB, voffB); PG8_STAGE(PG8_SA(0, 0), cA, vAc[0]); PG8_STAGE(PG8_SB(0, 1), cB + hstep, voffB); PG8_STAGE(PG8_SA(0, 1), cA, vAc[1]);
        if (wr == 1) PG8_BAR;
        PG8_WAIT_V(4); PG8_BAR;
        PG8_STAGE(PG8_SB(1, 0), cB + kstep, voffB); PG8_STAGE(PG8_SA(1, 0), cA + kstep, vAc[0]); PG8_STAGE(PG8_SB(1, 1), cB + hstep + kstep, voffB);
        PG8_WAIT_V(6); PG8_BAR;
    }
    for (;;) {
        const bool has_next = S.next(ui + 1, nxt);
        const char* nA = has_next ? (const char*)g.A + (Sched::GATHER ? (size_t)0 : (size_t)nxt.pm * tstep) : cA; const char* nB = has_next ? (const char*)g.Bt + (size_t)nxt.pn * tstep : cB;
        if (has_next) { PG8_AOFF(vAn, nxt); } else {
#pragma unroll
            for (int h_ = 0; h_ < 2; ++h_)
#pragma unroll
                for (int i_ = 0; i_ < 2; ++i_) vAn[h_][i_] = vAc[h_][i_]; }
        for (int t = 0; t < nt; t += 2) {
            if constexpr (Epi::MIDK) { if (t == nt / 2) E.midk(acc, cur, wr, wc, fr, fq); }
            const bool last = (t == nt - 2);
            const char* a1 = cA + (size_t)(t + 1) * kstep;
            const char* a2 = last ? nA : cA + (size_t)(t + 2) * kstep; const char* b2 = last ? nB : cB + (size_t)(t + 2) * kstep;
            const char* a3 = a2 + kstep; const char* b3 = b2 + kstep;
            unsigned vA2[2][2];
#pragma unroll
            for (int h_ = 0; h_ < 2; ++h_)
#pragma unroll
                for (int i_ = 0; i_ < 2; ++i_) vA2[h_][i_] = vAc[h_][i_];
            if (last) { asm volatile("" ::: "memory");
#pragma unroll
                for (int h_ = 0; h_ < 2; ++h_)
#pragma unroll
                    for (int i_ = 0; i_ < 2; ++i_) vA2[h_][i_] = vAn[h_][i_]; }
            if (last && has_next) S.a_ready(nxt);
            if constexpr (SP2) {
            PG8_LDB(B0, 0, 0); PG8_LDB(B1, 0, 1); PG8_SCHED; PG8_LDA(At, 0, 0); PG8_STAGE(PG8_SA(1, 1), a1, vAc[1]);
            PG8_WAIT_V(8); PG8_WAIT_L(0); PG8_BAR; PG8_MMA(0, 0, At, B0); PG8_MMA(0, 1, At, B1); PG8_BAR; PG8_SCHED;
            PG8_LDA(At, 0, 1); PG8_STAGE(PG8_SB(0, 0), b2, voffB); PG8_STAGE(PG8_SB(0, 1), b2 + hstep, voffB); PG8_STAGE(PG8_SA(0, 0), a2, vA2[0]);
            PG8_WAIT_V(8); PG8_WAIT_L(0); PG8_BAR; PG8_MMA(1, 0, At, B0); PG8_MMA(1, 1, At, B1); PG8_BAR; PG8_SCHED;
            PG8_LDB(B0, 1, 0); PG8_LDB(B1, 1, 1); PG8_SCHED; PG8_LDA(At, 1, 0); PG8_STAGE(PG8_SA(0, 1), a2, vA2[1]);
            PG8_WAIT_V(8); PG8_WAIT_L(0); PG8_BAR; PG8_MMA(0, 0, At, B0); PG8_MMA(0, 1, At, B1); PG8_BAR; PG8_SCHED;
            PG8_LDA(At, 1, 1); PG8_STAGE(PG8_SB(1, 0), b3, voffB); PG8_STAGE(PG8_SB(1, 1), b3 + hstep, voffB); PG8_STAGE(PG8_SA(1, 0), a3, vA2[0]);
            PG8_WAIT_V(8); PG8_WAIT_L(0); PG8_BAR; PG8_MMA(1, 0, At, B0); PG8_MMA(1, 1, At, B1); PG8_BAR; PG8_SCHED;
            } else {
            PG8_LDB(B0, 0, 0); PG8_SCHED; PG8_LDA(At, 0, 0); PG8_STAGE(PG8_SA(1, 1), a1, vAc[1]);
            PG8_WAIT_L(8); PG8_BAR; PG8_WAIT_L(0); PG8_MMA(0, 0, At, B0); PG8_BAR; PG8_SCHED;
            PG8_LDB(B1, 0, 1); PG8_STAGE(PG8_SB(0, 0), b2, voffB);
            PG8_BAR; PG8_WAIT_L(0); PG8_MMA(0, 1, At, B1); PG8_BAR;
            PG8_LDA(At, 0, 1); PG8_STAGE(PG8_SA(0, 0), a2, vA2[0]);
            PG8_BAR; PG8_WAIT_L(0); PG8_MMA(1, 0, At, B0); PG8_BAR; PG8_SCHED;
            PG8_STAGE(PG8_SB(0, 1), b2 + hstep, voffB);
            PG8_WAIT_V(6); PG8_BAR; PG8_MMA(1, 1, At, B1); PG8_BAR;
            PG8_LDB(B0, 1, 0); PG8_SCHED; PG8_LDA(At, 1, 0); PG8_STAGE(PG8_SA(0, 1), a2, vA2[1]);
            PG8_WAIT_L(8); PG8_BAR; PG8_WAIT_L(0); PG8_MMA(0, 0, At, B0); PG8_BAR; PG8_SCHED;
            PG8_LDB(B1, 1, 1); PG8_STAGE(PG8_SB(1, 0), b3, voffB);
            PG8_BAR; PG8_WAIT_L(0); PG8_MMA(0, 1, At, B1); PG8_BAR;
            PG8_LDA(At, 1, 1); PG8_STAGE(PG8_SA(1, 0), a3, vA2[0]);
            PG8_BAR; PG8_WAIT_L(0); PG8_MMA(1, 0, At, B0); PG8_BAR; PG8_SCHED;
            PG8_STAGE(PG8_SB(1, 1), b3 + hstep, voffB);
            PG8_WAIT_V(6); PG8_BAR; PG8_MMA(1, 1, At, B1); PG8_BAR;
            }
        }
        if constexpr (ALIGN_EPI) { if (wr == 0) PG8_BAR; }
        if constexpr (!Epi::AFTER_DRAIN) { E(acc, cur, wr, wc, fr, fq); S.done(cur); }
        if (!has_next) break;
#pragma unroll
        for (int a = 0; a < 2; ++a)
#pragma unroll
            for (int b = 0; b < 2; ++b)
#pragma unroll
                for (int m = 0; m < 4; ++m)
#pragma unroll
                    for (int n = 0; n < 2; ++n) acc[a][b][m][n] = (f32x4){0.f, 0.f, 0.f, 0.f};
        cur = nxt; cA = nA; cB = nB; ++ui;
#pragma unroll
        for (int h_ = 0; h_ < 2; ++h_)
#pragma unroll
            for (int i_ = 0; i_ < 2; ++i_) vAc[h_][i_] = vAn[h_][i_];
        if constexpr (ALIGN_EPI) { if (wr == 1) PG8_BAR; }
    }
    PG8_WAIT_V(0);
    if constexpr (!ALIGN_EPI) { if (wr == 0) PG8_BAR; }
    PG8_BAR;
    if constexpr (Epi::AFTER_DRAIN) { E.fused(acc, cur, wr, wc, fr, fq, lds, wid, lane); S.done(cur); }
#undef PG8_AOFF
#undef PG8_SA
#undef PG8_SB
#undef PG8_STAGE
#undef PG8_LDA
#undef PG8_LDB
#undef PG8_MMA
#undef PG8_WAIT_V
#undef PG8_WAIT_L
#undef PG8_BAR
#undef PG8_SCHED
}
}

#define GAS __attribute__((address_space(1)))
#define LAS __attribute__((address_space(3)))
typedef unsigned short bf16;
typedef unsigned U4 __attribute__((ext_vector_type(4)));
typedef unsigned U2 __attribute__((ext_vector_type(2)));
typedef float F4 __attribute__((ext_vector_type(4)));
typedef float F2 __attribute__((ext_vector_type(2)));
typedef float F16 __attribute__((ext_vector_type(16)));
typedef short B8 __attribute__((ext_vector_type(8)));
typedef short S4 __attribute__((ext_vector_type(4)));
typedef __bf16 bf16x2_t __attribute__((ext_vector_type(2)));

constexpr int NWAVES = 8, NTHR = 512;
constexpr int DM = 1024, BATCH = 8, SEQ = 8192, NTOK = BATCH * SEQ;
constexpr int DIN = 8200, NPROJ = 8192;
constexpr int CHUNK = 128, NCHUNK = SEQ / CHUNK;
constexpr int NEXP = 32, DEXP = 512;
constexpr int MAXTILES = 544, MAXROWS = MAXTILES * 256;
constexpr float EPS = 1e-6f;
constexpr int LDS_BYTES = 159744;
constexpr int LDS_MISC = 151552;

constexpr size_t MiB = 1u << 20;
constexpr size_t WS_CTL = 0, CTL_ZERO_BYTES = 32768; constexpr int CW_BAR = 1024;
constexpr size_t WS_IF = 1 * MiB;
constexpr size_t WS_THR = 3 * MiB;
constexpr size_t WS_CDEC = 4 * MiB;
constexpr size_t WS_ROUT = 4 * MiB + 65536;
constexpr size_t WS_ROPE = 5 * MiB;
constexpr size_t WS_TOK = 9 * MiB;
constexpr size_t WS_WIN = 12 * MiB;
constexpr size_t WS_WCAT = 28 * MiB, WS_WOUT = 32 * MiB;
constexpr size_t WS_H = 34 * MiB;
constexpr size_t WS_MQP = 34 * MiB, WS_MKP = 98 * MiB, WS_WGU = 34 * MiB, WS_WD = 98 * MiB;
constexpr size_t WS_RQ = 162 * MiB, WS_RK = 226 * MiB, WS_MQ = 290 * MiB, WS_MK = 354 * MiB;
constexpr size_t WS_XCAT = 162 * MiB;
constexpr size_t WS_RV = 418 * MiB, WS_RG = 546 * MiB, WS_MV = 674 * MiB, WS_MO = 802 * MiB;
constexpr size_t WS_MERGED = 802 * MiB;
constexpr size_t WS_YO = 162 * MiB, WS_H2U = 290 * MiB;
constexpr size_t WS_XS = 418 * MiB, WS_HMID = 690 * MiB, WS_Y = 418 * MiB;
constexpr size_t WS_TOKMAP = 930 * MiB, WS_SRSTD = 938 * MiB;
constexpr size_t WS_END = 946 * MiB;
constexpr size_t OUT_GR = 0, OUT_GM = 128 * MiB;
static_assert(WS_XS + (size_t)MAXROWS * 1024 * 2 <= WS_HMID && WS_HMID + (size_t)MAXROWS * 512 * 2 <= WS_END, "ws map");

struct TokInfo { int e0, p0, e1, p1; float w0, w1, rstd, pad; };

__device__ __forceinline__ float bflo(unsigned u) { return __uint_as_float(u << 16); }
__device__ __forceinline__ float bfhi(unsigned u) { return __uint_as_float(u & 0xffff0000u); }
__device__ __forceinline__ float bf2f(short s) { return __uint_as_float(((unsigned)(unsigned short)s) << 16); }
__device__ __forceinline__ unsigned cvtpk(float lo, float hi) { F2 v = {lo, hi}; bf16x2_t b = __builtin_convertvector(v, bf16x2_t); return __builtin_bit_cast(unsigned, b); }
__device__ __forceinline__ float wave_sum(float v) {
#pragma unroll
    for (int o = 1; o < 64; o <<= 1) v += __shfl_xor(v, o);
    return v;
}
__device__ __forceinline__ float sigm(float x) { return __builtin_amdgcn_rcpf(1.f + __expf(-x)); }
__device__ __forceinline__ float silu(float x) { return x * __builtin_amdgcn_rcpf(1.f + __expf(-x)); }
__device__ __forceinline__ float dot2bf(unsigned a, unsigned b, float c) { return __builtin_amdgcn_fdot2_f32_bf16(__builtin_bit_cast(bf16x2_t, a), __builtin_bit_cast(bf16x2_t, b), c, false); }
__device__ __forceinline__ int crow(int r, int hi) { return (r & 3) + 8 * (r >> 2) + 4 * hi; }
#define MFMA32(a, b, c) __builtin_amdgcn_mfma_f32_32x32x16_bf16((a), (b), (c), 0, 0, 0)
typedef short v4i16_t __attribute__((ext_vector_type(4)));
__device__ __forceinline__ S4 trrd(LAS const unsigned char* p) { return __builtin_bit_cast(S4, __builtin_amdgcn_ds_read_tr16_b64_v4i16((LAS v4i16_t*)p)); }
__device__ __forceinline__ void glds16(const void* gsrc, unsigned lds_dst) { unsigned keep;
    asm volatile("s_mov_b32 %0, m0\n\ts_mov_b32 m0, %2\n\ts_nop 0\n\tglobal_load_lds_dwordx4 %1, off\n\ts_mov_b32 m0, %0" : "=&s"(keep) : "v"(gsrc), "s"(lds_dst) : "memory"); }
__device__ __forceinline__ unsigned offb(unsigned row, unsigned ch) { return 256u * row + 16u * (ch ^ (((row & 3) << 2) | ((row >> 2) & 3))); }
__device__ __forceinline__ unsigned offv(unsigned row, unsigned ch) { return 128u * row + 16u * (ch ^ (((row >> 1) & 1) << 2)); }

#define XB_TMO      128
#define XB_XCNT(j)  (256  + 64 * (j))
#define XB_XSUB(j)  (1280 + 64 * (j))
#define XB_XGEN(j)  (2304 + 64 * (j))
#define XB_TOP      3328
#define XB_TOPGEN   3392
#define XCD_BAR_WORDS 3456
#define XB_SPIN_CAP (1u << 18)

__device__ __forceinline__ unsigned xb_ld(unsigned* p)              { return __hip_atomic_load(p, __ATOMIC_RELAXED, __HIP_MEMORY_SCOPE_AGENT); }
__device__ __forceinline__ unsigned xb_add(unsigned* p, unsigned v) { return __hip_atomic_fetch_add(p, v, __ATOMIC_RELAXED, __HIP_MEMORY_SCOPE_AGENT); }
__device__ __forceinline__ unsigned xb_xcc_id() { return (unsigned)__builtin_amdgcn_s_getreg((3 << 11) | 20) & 0xFu; }
#define XB_SPIN(cond, bar) do { unsigned _sp = 0; while (cond) { __builtin_amdgcn_s_sleep(1); \
    if ((++_sp & 255u) == 0u) { if (xb_ld(&(bar)[XB_TMO])) break; if (_sp > XB_SPIN_CAP) { atomicAdd(&(bar)[XB_TMO], 1u); break; } } } } while (0)

struct XcdBarrier {
    unsigned* bar; unsigned x;
    volatile LAS unsigned* st;
};

__device__ __forceinline__ XcdBarrier xcd_barrier_post(unsigned* bar, volatile LAS unsigned* st) {
    XcdBarrier b; b.bar = bar; b.x = xb_xcc_id(); b.st = st;
    if (threadIdx.x == 0) (void)xb_add(&bar[XB_XCNT(b.x)], 1u);
    return b;
}
__device__ __forceinline__ void xcd_barrier_complete(unsigned* bar, unsigned x, unsigned& nloc, unsigned& nx) {
    const unsigned G = gridDim.x * gridDim.y * gridDim.z;
    unsigned sum, cnt, mine, sp = 0u;
    for (;;) {
        sum = 0u; cnt = 0u; mine = 0u;
#pragma unroll
        for (unsigned j = 0; j < 16; ++j) { const unsigned c = xb_ld(&bar[XB_XCNT(j)]); sum += c; cnt += (c > 0u) ? 1u : 0u; mine = (j == x) ? c : mine; }
        if (sum == G) break;
        __builtin_amdgcn_s_sleep(1);
        if ((++sp & 255u) == 0u) { if (xb_ld(&bar[XB_TMO])) break; if (sp > XB_SPIN_CAP) { atomicAdd(&bar[XB_TMO], 1u); break; } }
    }
    nloc = mine > 0u ? mine : 1u; nx = cnt > 0u ? cnt : 1u;
}

__device__ __forceinline__ void xcd_barrier(const XcdBarrier& b) {
    asm volatile("s_waitcnt vmcnt(0)" ::: "memory");
    __syncthreads();
    if (threadIdx.x == 0) {
        unsigned* bar = b.bar;
        __builtin_amdgcn_s_waitcnt(0);
        unsigned nloc = b.st[0], nx = b.st[1];
        if (nloc == 0u) { xcd_barrier_complete(bar, b.x, nloc, nx); b.st[0] = nloc; b.st[1] = nx; }
        const unsigned old = xb_add(&bar[XB_XSUB(b.x)], 1u);
        const unsigned gen = old / nloc;
        if (old + 1u == (gen + 1u) * nloc) {
            __builtin_amdgcn_fence(__ATOMIC_RELEASE, "agent");
            asm volatile("s_waitcnt vmcnt(0)" ::: "memory");
            const unsigned og = xb_add(&bar[XB_TOP], 1u);
            const unsigned tg = og / nx;
            if (og + 1u == (tg + 1u) * nx) xb_add(&bar[XB_TOPGEN], 1u);
            else XB_SPIN(xb_ld(&bar[XB_TOPGEN]) == tg, bar);
            __builtin_amdgcn_fence(__ATOMIC_ACQUIRE, "agent");
            xb_add(&bar[XB_XGEN(b.x)], 1u);
            asm volatile("s_waitcnt vmcnt(0)" ::: "memory");
        } else {
            XB_SPIN(xb_ld(&bar[XB_XGEN(b.x)]) == gen, bar);
            __builtin_amdgcn_fence(__ATOMIC_ACQUIRE, "agent");
            asm volatile("s_waitcnt vmcnt(0)" ::: "memory");
        }
    }
    __syncthreads();
}

namespace pg8 {
struct EpiProj {
    static constexpr bool PERM = true, AFTER_DRAIN = false, MIDK = false;
    unsigned char* ws; unsigned char* ob;
    __device__ __forceinline__ void operator()(const f32x4 (&acc)[2][2][4][2], const Unit& u, int wr, int wc, int fr, int fq) const {
        const int pn = u.pn; bf16_t* base; int ld, ct;
        if (pn < 2)       { base = (bf16_t*)(ws + WS_RQ); ld = 512;  ct = pn; }
        else if (pn < 4)  { base = (bf16_t*)(ws + WS_RK); ld = 512;  ct = pn - 2; }
        else if (pn < 8)  { base = (bf16_t*)(ws + WS_RV); ld = 1024; ct = pn - 4; }
        else if (pn < 12) { base = (bf16_t*)(ws + WS_RG); ld = 1024; ct = pn - 8; }
        else if (pn < 14) { base = (bf16_t*)(ws + WS_MQ); ld = 512;  ct = pn - 12; }
        else if (pn < 16) { base = (bf16_t*)(ws + WS_MK); ld = 512;  ct = pn - 14; }
        else if (pn < 20) { base = (bf16_t*)(ws + WS_MV); ld = 1024; ct = pn - 16; }
        else if (pn < 24) { base = (bf16_t*)(ws + WS_MO); ld = 1024; ct = pn - 20; }
        else if (pn < 28) { base = (bf16_t*)(ob + OUT_GR); ld = 1024; ct = pn - 24; }
        else              { base = (bf16_t*)(ob + OUT_GM); ld = 1024; ct = pn - 28; }
        const int row0 = u.pm * BM + wr * 64 + fr, col0 = ct * BM + wc * 32 + 8 * fq;
#pragma unroll
        for (int ai = 0; ai < 2; ++ai)
#pragma unroll
            for (int m = 0; m < 4; ++m) { bf16_t* rowp = base + (size_t)(row0 + ai * HALF + m * 16) * ld + col0;
#pragma unroll
                for (int bj = 0; bj < 2; ++bj) { f32x4 v0 = acc[ai][bj][m][0], v1 = acc[ai][bj][m][1];
                    if (pn >= 24) { v0[0] = sigm(v0[0]); v0[1] = sigm(v0[1]); v0[2] = sigm(v0[2]); v0[3] = sigm(v0[3]); v1[0] = sigm(v1[0]); v1[1] = sigm(v1[1]); v1[2] = sigm(v1[2]); v1[3] = sigm(v1[3]); }
                    u32x4 w; w.x = cvt_pk_bf16(v0[0], v0[1]); w.y = cvt_pk_bf16(v0[2], v0[3]); w.z = cvt_pk_bf16(v1[0], v1[1]); w.w = cvt_pk_bf16(v1[2], v1[3]);
                    *(u32x4*)(rowp + bj * HALF) = w; } }
    }
};
struct EpiGateFused {
    static constexpr bool PERM = true, AFTER_DRAIN = false, MIDK = true;
    const bf16_t* GR; const bf16_t* GM; bf16_t* O;
    __device__ __forceinline__ void midk(f32x4 (&acc)[2][2][4][2], const Unit& u, int wr, int wc, int fr, int fq) const {
        int row0 = u.pm * BM + wr * 64 + fr, col0 = u.pn * BM + wc * 32 + 8 * fq;
        asm volatile("" : "+v"(row0), "+v"(col0));
#pragma unroll
        for (int ai = 0; ai < 2; ++ai) {
#pragma unroll
            for (int m = 0; m < 4; ++m) { const size_t ro = (size_t)(row0 + ai * HALF + m * 16) * 1024 + col0;
#pragma unroll
                for (int bj = 0; bj < 2; ++bj) {
                    const u32x4 a = *(const u32x4*)(GR + ro + bj * HALF), b = *(const u32x4*)(GM + ro + bj * HALF);
                    f32x4 r0, r1;
                    r0[0] = bflo(a.x) * __builtin_amdgcn_rcpf(bflo(b.x)); r0[1] = bfhi(a.x) * __builtin_amdgcn_rcpf(bfhi(b.x)); r0[2] = bflo(a.y) * __builtin_amdgcn_rcpf(bflo(b.y)); r0[3] = bfhi(a.y) * __builtin_amdgcn_rcpf(bfhi(b.y));
                    r1[0] = bflo(a.z) * __builtin_amdgcn_rcpf(bflo(b.z)); r1[1] = bfhi(a.z) * __builtin_amdgcn_rcpf(bfhi(b.z)); r1[2] = bflo(a.w) * __builtin_amdgcn_rcpf(bflo(b.w)); r1[3] = bfhi(a.w) * __builtin_amdgcn_rcpf(bfhi(b.w));
                    acc[ai][bj][m][0] *= r0; acc[ai][bj][m][1] *= r1; } }
            asm volatile("" ::: "memory"); }
    }
    __device__ __forceinline__ void operator()(const f32x4 (&acc)[2][2][4][2], const Unit& u, int wr, int wc, int fr, int fq) const {
        int row0 = u.pm * BM + wr * 64 + fr, col0 = u.pn * BM + wc * 32 + 8 * fq;
        asm volatile("" : "+v"(row0), "+v"(col0));
#pragma unroll
        for (int ai = 0; ai < 2; ++ai)
#pragma unroll
            for (int m = 0; m < 4; ++m) { const size_t ro = (size_t)(row0 + ai * HALF + m * 16) * 1024 + col0;
#pragma unroll
                for (int bj = 0; bj < 2; ++bj) { const f32x4 v0 = acc[ai][bj][m][0], v1 = acc[ai][bj][m][1];
                    const u32x4 g = *(const u32x4*)(GM + ro + bj * HALF);
                    u32x4 w; w.x = cvt_pk_bf16(v0[0] * bflo(g.x), v0[1] * bfhi(g.x)); w.y = cvt_pk_bf16(v0[2] * bflo(g.y), v0[3] * bfhi(g.y));
                    w.z = cvt_pk_bf16(v1[0] * bflo(g.z), v1[1] * bfhi(g.z)); w.w = cvt_pk_bf16(v1[2] * bflo(g.w), v1[3] * bfhi(g.w));
                    *(u32x4*)(O + ro + bj * HALF) = w; } }
    }
};
struct EpiX1 {
    static constexpr bool PERM = true, AFTER_DRAIN = false, MIDK = false;
    const float* X; float* O;
    __device__ __forceinline__ void operator()(const f32x4 (&acc)[2][2][4][2], const Unit& u, int wr, int wc, int fr, int fq) const {
        const int row0 = u.pm * BM + wr * 64 + fr, col0 = u.pn * BM + wc * 32 + 8 * fq;
#pragma unroll
        for (int ai = 0; ai < 2; ++ai)
#pragma unroll
            for (int m = 0; m < 4; ++m) { const size_t ro = (size_t)(row0 + ai * HALF + m * 16) * 1024 + col0;
#pragma unroll
                for (int bj = 0; bj < 2; ++bj) {
                    const f32x4 a = *(const f32x4*)(X + ro + bj * HALF), b = *(const f32x4*)(X + ro + bj * HALF + 4);
                    *(f32x4*)(O + ro + bj * HALF) = a + acc[ai][bj][m][0]; *(f32x4*)(O + ro + bj * HALF + 4) = b + acc[ai][bj][m][1]; } }
    }
};
struct EpiSwiglu {
    static constexpr bool PERM = true, AFTER_DRAIN = false, MIDK = false;
    bf16_t* O; const float* srstd;
    __device__ __forceinline__ void operator()(const f32x4 (&acc)[2][2][4][2], const Unit& u, int wr, int wc, int fr, int fq) const {
        const int row0 = u.pm * BM + wr * 64 + fr, col0 = (u.pn & 3) * HALF + wc * 32 + 8 * fq;
        float rs[2][4];
#pragma unroll
        for (int ai = 0; ai < 2; ++ai)
#pragma unroll
            for (int m = 0; m < 4; ++m) rs[ai][m] = srstd[u.pa + wr * 64 + fr + ai * HALF + m * 16];
#pragma unroll
        for (int ai = 0; ai < 2; ++ai)
#pragma unroll
            for (int m = 0; m < 4; ++m) { bf16_t* rowp = O + (size_t)(row0 + ai * HALF + m * 16) * 512 + col0; const float r = rs[ai][m];
                const f32x4 g0 = acc[ai][0][m][0] * r, g1 = acc[ai][0][m][1] * r, u0 = acc[ai][1][m][0] * r, u1 = acc[ai][1][m][1] * r;
                u32x4 w; w.x = cvt_pk_bf16(silu(g0[0]) * u0[0], silu(g0[1]) * u0[1]); w.y = cvt_pk_bf16(silu(g0[2]) * u0[2], silu(g0[3]) * u0[3]);
                w.z = cvt_pk_bf16(silu(g1[0]) * u1[0], silu(g1[1]) * u1[1]); w.w = cvt_pk_bf16(silu(g1[2]) * u1[2], silu(g1[3]) * u1[3]);
                *(u32x4*)rowp = w; }
    }
};
struct EpiY {
    static constexpr bool PERM = true, AFTER_DRAIN = false, MIDK = false;
    bf16_t* O;
    __device__ __forceinline__ void operator()(const f32x4 (&acc)[2][2][4][2], const Unit& u, int wr, int wc, int fr, int fq) const {
        const int row0 = u.pm * BM + wr * 64 + fr, col0 = (u.pn & 3) * BM + wc * 32 + 8 * fq;
#pragma unroll
        for (int ai = 0; ai < 2; ++ai)
#pragma unroll
            for (int m = 0; m < 4; ++m) { bf16_t* rowp = O + (size_t)(row0 + ai * HALF + m * 16) * 1024 + col0;
#pragma unroll
                for (int bj = 0; bj < 2; ++bj) { const f32x4 v0 = acc[ai][bj][m][0], v1 = acc[ai][bj][m][1];
                    u32x4 w; w.x = cvt_pk_bf16(v0[0], v0[1]); w.y = cvt_pk_bf16(v0[2], v0[3]); w.z = cvt_pk_bf16(v1[0], v1[1]); w.w = cvt_pk_bf16(v1[2], v1[3]);
                    *(u32x4*)(rowp + bj * HALF) = w; } }
    }
};
template <bool GATHER_> struct GroupedOrder {
    static constexpr bool GATHER = GATHER_;
    int ntiles, G, c; const PG8_LAS unsigned char* t2e; const PG8_LAS int* rb; const int* tokmap;
    __device__ __forceinline__ bool next(int i, Unit& u) const {
        const int L = i * G + c; if (L >= ntiles * 4) return false;
        const int rt = L >> 2; const int e = __builtin_amdgcn_readfirstlane((int)t2e[rt]);
        u.pm = rt; u.pn = e * 4 + (L & 3); u.pa = e * 65536 + ((rt - (__builtin_amdgcn_readfirstlane(rb[e]) >> 8)) << 8); return true;
    }
    __device__ __forceinline__ unsigned arow(const Unit& u, int r) const { const unsigned t = (unsigned)tokmap[u.pa + r]; return t < (unsigned)NTOK ? t : (unsigned)(NTOK - 1); }
    __device__ __forceinline__ void a_ready(const Unit&) const {}
    __device__ __forceinline__ void done(const Unit&) const {}
};
}

struct Ctx { LAS unsigned char* lds; int tid, lane, wave, vcu, G; };

__device__ __forceinline__ void transpose_item(const float* W, int ld, int k0, int n0, bf16* WT, int K, int drow0, LAS float* scr, int lane, int kdst = 0) {
#pragma unroll 8
    for (int i = 0; i < 32; ++i) { const int kk = 2 * i + (lane >> 5); scr[kk * 33 + (lane & 31)] = W[(size_t)(k0 + kk) * ld + n0 + (lane & 31)]; }
    asm volatile("s_waitcnt lgkmcnt(0)" ::: "memory");
    const int c = lane & 7;
#pragma unroll
    for (int j = 0; j < 4; ++j) { const int n = (lane >> 3) + 8 * j; const LAS float* s = scr + (8 * c) * 33 + n;
        U4 o; o.x = cvtpk(s[0 * 33], s[1 * 33]); o.y = cvtpk(s[2 * 33], s[3 * 33]); o.z = cvtpk(s[4 * 33], s[5 * 33]); o.w = cvtpk(s[6 * 33], s[7 * 33]);
        *(U4*)(WT + (size_t)(drow0 + n) * K + kdst + k0 + 8 * c) = o; }
    asm volatile("s_waitcnt lgkmcnt(0)" ::: "memory");
}

__device__ __forceinline__ void phase0(const Ctx& C, const float* const* in, unsigned char* ws) {
    const float* x = in[0]; const float* nw = in[1]; const float* w_in = in[2];
    LAS float* scr = (LAS float*)(C.lds + C.wave * 8448);
    LAS float* wif = (LAS float*)(C.lds + 98304);
    LAS double* invf = (LAS double*)(C.lds + 98304 + 32768);
    for (int i = C.tid; i < 8192; i += NTHR) wif[i] = w_in[(size_t)(i >> 3) * DIN + 6144 + (i & 7)];
    if (C.tid < 64) { double r = 1.0; for (int j = 0; j < C.tid; ++j) r *= 0.8659643233600653; invf[C.tid] = r; }
    __syncthreads();
    const int gw = C.vcu * NWAVES + C.wave, NGW = C.G * NWAVES;
    {
        bf16* H = (bf16*)(ws + WS_H); float* IFP = (float*)(ws + WS_IF);
        F4 wv[4];
#pragma unroll
        for (int j = 0; j < 4; ++j) wv[j] = *(const F4*)(nw + 4 * C.lane + 256 * j);
        for (int m = gw; m < NTOK; m += NGW) {
            const F4* xr = (const F4*)(x + (size_t)m * DM) + C.lane;
            F4 v[4]; float s = 0.f;
#pragma unroll
            for (int j = 0; j < 4; ++j) { v[j] = xr[64 * j]; s += (v[j].x * v[j].x + v[j].y * v[j].y) + (v[j].z * v[j].z + v[j].w * v[j].w); }
            const float rstd = rsqrtf(wave_sum(s) * (1.f / DM) + EPS);
            float g[8];
#pragma unroll
            for (int c = 0; c < 8; ++c) g[c] = 0.f;
            unsigned long long* o8 = (unsigned long long*)(H + (size_t)m * DM) + C.lane;
#pragma unroll
            for (int j = 0; j < 4; ++j) { v[j] = v[j] * rstd * wv[j];
                o8[64 * j] = (unsigned long long)cvtpk(v[j].x, v[j].y) | ((unsigned long long)cvtpk(v[j].z, v[j].w) << 32);
#pragma unroll
                for (int i = 0; i < 4; ++i) { const LAS F4* wp = (const LAS F4*)(wif + (4 * C.lane + 256 * j + i) * 8); const F4 wa = wp[0], wb = wp[1]; const float hv = v[j][i];
                    g[0] += hv * wa.x; g[1] += hv * wa.y; g[2] += hv * wa.z; g[3] += hv * wa.w; g[4] += hv * wb.x; g[5] += hv * wb.y; g[6] += hv * wb.z; g[7] += hv * wb.w; } }
#pragma unroll
            for (int c = 0; c < 8; ++c) g[c] = wave_sum(g[c]);
            if (C.lane == 0) { F4* op = (F4*)(IFP + (size_t)m * 8); op[0] = (F4){g[0], g[1], g[2], g[3]}; op[1] = (F4){g[4], g[5], g[6], g[7]}; }
        }
    }
    for (int it = gw; it < 4096 + 3 * 512; it += NGW) {
        if (it < 4096) { const int kb = it >> 8, nb = it & 255; transpose_item(w_in, DIN, kb * 64, nb * 32 + (nb >= 192 ? 8 : 0), (bf16*)(ws + WS_WIN), 1024, nb * 32, scr, C.lane); }
        else { int r = it - 4096; const int mth = r >> 9; r &= 511; const int kb = r >> 5, nb = r & 31;
            const float* W = mth == 0 ? in[4] : (mth == 1 ? in[10] : in[11]);
            if (mth < 2) transpose_item(W, 1024, kb * 64, nb * 32, (bf16*)(ws + WS_WCAT), 2048, nb * 32, scr, C.lane, mth * 1024);
            else transpose_item(W, 1024, kb * 64, nb * 32, (bf16*)(ws + WS_WOUT), 1024, nb * 32, scr, C.lane); }
    }
    { F2* RT = (F2*)(ws + WS_ROPE);
        for (int idx = C.vcu * NTHR + C.tid; idx < SEQ * 64; idx += C.G * NTHR) { const int pos = idx >> 6, j = idx & 63;
            const double rev = (double)pos * invf[j] * 0.15915494309189535; const float fr = (float)(rev - __builtin_floor(rev));
            RT[idx] = (F2){__builtin_amdgcn_cosf(fr), __builtin_amdgcn_sinf(fr)}; } }
    { F4* WR = (F4*)(ws + WS_ROUT); const float* nfw = in[12]; const float* wg = in[13]; const float* we = in[15];
        for (int idx = C.vcu * NTHR + C.tid; idx < 32 * 3 * 2 * 64; idx += C.G * NTHR) { const int l = idx & 63, half = (idx >> 6) & 1, nt = (idx >> 7) % 3, kb2 = idx / 384; const int n = 16 * nt + (l & 15);
            F4 o;
#pragma unroll
            for (int j = 0; j < 4; ++j) { const int k = 32 * kb2 + 8 * (l >> 4) + 4 * half + j; float wv = 0.f; if (n < 4) wv = wg[k * 4 + n]; else if (n < 36) wv = we[k * 32 + (n - 4)]; o[j] = wv * nfw[k]; }
            WR[idx] = o; } }
}

__device__ __forceinline__ float wscan_add(float v, int lane) {
#pragma unroll
    for (int o = 1; o < 64; o <<= 1) { const float t = __shfl_up(v, o); if (lane >= o) v += t; }
    return v;
}
__device__ __forceinline__ float wscan_max(float v, int lane) {
#pragma unroll
    for (int o = 1; o < 64; o <<= 1) { const float t = __shfl_up(v, o); if (lane >= o) v = fmaxf(v, t); }
    return v;
}
__device__ __forceinline__ void phase2(const Ctx& C, const float* const* in, unsigned char* ws) {
    const float* convw = in[5]; const float* convb = in[6]; const float* b_i = in[7]; const float* b_f = in[8];
    LAS float* sQ = (LAS float*)(C.lds);
    LAS float* sK = (LAS float*)(C.lds + 2048);
    const float* IFP = (const float*)(ws + WS_IF); float* THR = (float*)(ws + WS_THR); float* CDEC = (float*)(ws + WS_CDEC);
    const F2* RT = (const F2*)(ws + WS_ROPE);
    for (int it = C.vcu; it < BATCH * NCHUNK; it += C.G) {
        const int b = it >> 6, c = it & 63; const size_t t0 = (size_t)b * SEQ + (size_t)c * CHUNK;
        __syncthreads();
        if (C.wave < 4) { const int hd = C.wave, l = C.lane;
            const float i0 = IFP[(t0 + 2 * l) * 8 + hd] + b_i[hd], i1 = IFP[(t0 + 2 * l + 1) * 8 + hd] + b_i[hd];
            const float f0 = IFP[(t0 + 2 * l) * 8 + 4 + hd] + b_f[hd], f1 = IFP[(t0 + 2 * l + 1) * 8 + 4 + hd] + b_f[hd];
            const float lf0 = fminf(f0, 0.f) - log1pf(__expf(-fabsf(f0))), lf1 = fminf(f1, 0.f) - log1pf(__expf(-fabsf(f1)));
            const float s1 = lf0 + lf1, inc = wscan_add(s1, l), ex = inc - s1;
            const float b0 = ex + lf0, b1 = ex + s1;
            const float u0 = i0 - b0, u1 = i1 - b1, p1 = fmaxf(u0, u1);
            const float pin = wscan_max(p1, l); float pex = __shfl_up(pin, 1); if (l == 0) pex = -INFINITY;
            const float pm0 = fmaxf(pex, u0), pm1 = fmaxf(pex, p1);
            sQ[hd * 128 + 2 * l] = __expf(-pm0); sQ[hd * 128 + 2 * l + 1] = __expf(-pm1);
            sK[hd * 128 + 2 * l] = __expf(u0) * 0.08838834764831845f; sK[hd * 128 + 2 * l + 1] = __expf(u1) * 0.08838834764831845f;
            THR[(t0 + 2 * l) * 4 + hd] = __expf(-b0 - pm0); THR[(t0 + 2 * l + 1) * 4 + hd] = __expf(-b1 - pm1);
            if (l == 63) CDEC[(size_t)it * 4 + hd] = __expf(b1);
        }
        __syncthreads();
        for (int u = C.tid; u < 2 * 4096; u += NTHR) {
            const int arr = u >> 12, g = u & 7, row = (u >> 3) & 127, hd = (u >> 10) & 3;
            bf16* base = (bf16*)(ws + (arr ? WS_RK : WS_RQ)) + (t0 + row) * 512 + hd * 128 + 8 * g;
            const U4 a = *(const U4*)base, bb = *(const U4*)(base + 64);
            const float lg = hd == 0 ? -0.04580368961312479f : (hd == 1 ? -0.02272007650008353f : (hd == 2 ? -0.011315313227834146f : -0.005646563141142063f));
            const float sc = arr ? exp2f(-lg * (float)row) * 0.08838834764831845f : exp2f(lg * (float)row);
            const F2* rt = RT + (size_t)(c * CHUNK + row) * 64 + 8 * g;
            float x1[8], x2[8], y1[8], y2[8];
            x1[0] = bflo(a.x); x1[1] = bfhi(a.x); x1[2] = bflo(a.y); x1[3] = bfhi(a.y); x1[4] = bflo(a.z); x1[5] = bfhi(a.z); x1[6] = bflo(a.w); x1[7] = bfhi(a.w);
            x2[0] = bflo(bb.x); x2[1] = bfhi(bb.x); x2[2] = bflo(bb.y); x2[3] = bfhi(bb.y); x2[4] = bflo(bb.z); x2[5] = bfhi(bb.z); x2[6] = bflo(bb.w); x2[7] = bfhi(bb.w);
#pragma unroll
            for (int i = 0; i < 8; ++i) { const F2 cs = rt[i]; y1[i] = (x1[i] * cs.x - x2[i] * cs.y) * sc; y2[i] = (x2[i] * cs.x + x1[i] * cs.y) * sc; }
            U4 o1, o2; o1.x = cvtpk(y1[0], y1[1]); o1.y = cvtpk(y1[2], y1[3]); o1.z = cvtpk(y1[4], y1[5]); o1.w = cvtpk(y1[6], y1[7]);
            o2.x = cvtpk(y2[0], y2[1]); o2.y = cvtpk(y2[2], y2[3]); o2.z = cvtpk(y2[4], y2[5]); o2.w = cvtpk(y2[6], y2[7]);
            *(U4*)base = o1; *(U4*)(base + 64) = o2;
        }
        for (int u = C.tid; u < 2 * 8192; u += NTHR) {
            const int arr = u >> 13, g = u & 63, row = (u >> 6) & 127, hd = g >> 4;
            const bf16* src = (const bf16*)(ws + (arr ? WS_MK : WS_MQ)) + (t0 + row) * 512 + 8 * g;
            const int chn = arr * 512 + 8 * g;
            float y[8];
            { const F4 b0 = *(const F4*)(convb + chn), b1 = *(const F4*)(convb + chn + 4); y[0] = b0.x; y[1] = b0.y; y[2] = b0.z; y[3] = b0.w; y[4] = b1.x; y[5] = b1.y; y[6] = b1.z; y[7] = b1.w; }
#pragma unroll
            for (int w = 0; w < 4; ++w) { const int back = 3 - w;
                if (c * CHUNK + row - back >= 0) { const U4 a = *(const U4*)(src - (size_t)back * 512);
                    const F4 w0 = *(const F4*)(convw + w * 1024 + chn), w1 = *(const F4*)(convw + w * 1024 + chn + 4);
                    y[0] += bflo(a.x) * w0.x; y[1] += bfhi(a.x) * w0.y; y[2] += bflo(a.y) * w0.z; y[3] += bfhi(a.y) * w0.w;
                    y[4] += bflo(a.z) * w1.x; y[5] += bfhi(a.z) * w1.y; y[6] += bflo(a.w) * w1.z; y[7] += bfhi(a.w) * w1.w; } }
            const float sc = arr ? sK[hd * 128 + row] : sQ[hd * 128 + row];
#pragma unroll
            for (int i = 0; i < 8; ++i) y[i] = silu(y[i]) * sc;
            U4 o; o.x = cvtpk(y[0], y[1]); o.y = cvtpk(y[2], y[3]); o.z = cvtpk(y[4], y[5]); o.w = cvtpk(y[6], y[7]);
            *(U4*)((bf16*)(ws + (arr ? WS_MKP : WS_MQP)) + (t0 + row) * 512 + 8 * g) = o;
        }
    }
}

template <bool ML, int ABL = 0>
__device__ __forceinline__ void mixer_item(const Ctx& C, const bf16* Qp, const bf16* Kp, bf16* Vp, bf16* Vout, size_t omask, const float* thr, const float* cdec, int b, int hd, int sl) {
    LAS unsigned char* lds = C.lds;
    const int tid = C.tid, lane = C.lane, w = C.wave, l31 = lane & 31, hi = lane >> 5;
    const int lt = (w < 4) ? w : 7 - w, et = w >> 2, dt = w & 3;
    const int q_ = (lane & 15) >> 2, p_ = lane & 3, blk = (lane >> 4) & 1;
    constexpr unsigned KOFF = 0, VOFF = 65536, QOFF = 98304, SOFF = 131072, NOFF = 147456;
    const size_t tok0 = (size_t)b * SEQ;
    const float rdec = hd == 0 ? 0.017183023570817902f : (hd == 1 ? 0.1332151628796484f : (hd == 2 ? 0.3664377159220373f : 0.6059370882290803f));
    __syncthreads();
    for (int i = tid; i < 16384 / 16; i += NTHR) *(LAS U4*)(lds + SOFF + 16 * i) = (U4){0u, 0u, 0u, 0u};
    if (tid < 384) *(LAS float*)(lds + NOFF + 4 * tid) = 0.f;
    F16 St;
#pragma unroll
    for (int r = 0; r < 16; ++r) St[r] = 0.f;
    B8 qf[8];
    const unsigned lds0 = (unsigned)(uintptr_t)lds;
    unsigned ro[8];
#pragma unroll
    for (int s = 0; s < 8; ++s) ro[s] = offb(l31, 2 * s + hi);
    const unsigned kbase = (16 * w + (lane >> 4)) * 512, kx = (lane & 15) ^ ((lane >> 4) << 2);
    const unsigned vbase = (16 * w + (lane >> 3)) * 1024 + ((lane & 7) ^ (((lane >> 4) & 1) << 2)) * 8;
#define ksrc_(i) (kbase + (i) * 2048 + ((kx ^ (i)) * 8))
#define vsrc_(i) (vbase + (i) * 8192)
#define MX_DMA(cc, buf) do { \
        const bf16* kp_ = Kp + (tok0 + (size_t)(cc) * CHUNK) * 512 + hd * 128; \
        _Pragma("unroll") for (int i = 0; i < 4; ++i) glds16(kp_ + ksrc_(i), (unsigned)__builtin_amdgcn_readfirstlane((int)(lds0 + KOFF + (buf) * 32768 + (w * 4 + i) * 1024))); \
        const bf16* vp_ = Vp + (tok0 + (size_t)(cc) * CHUNK) * 1024 + hd * 256 + sl * 64; \
        _Pragma("unroll") for (int i = 0; i < 2; ++i) glds16(vp_ + vsrc_(i), (unsigned)__builtin_amdgcn_readfirstlane((int)(lds0 + VOFF + (buf) * 16384 + (w * 2 + i) * 1024))); \
        const bf16* qp_ = Qp + (tok0 + (size_t)(cc) * CHUNK) * 512 + hd * 128; \
        _Pragma("unroll") for (int i = 0; i < 4; ++i) glds16(qp_ + ksrc_(i), (unsigned)__builtin_amdgcn_readfirstlane((int)(lds0 + QOFF + (w * 4 + i) * 1024))); \
        } while (0)
    float thn = 1.f, dcn = rdec;
    MX_DMA(0, 0);
    if (ML) { thn = thr[(tok0 + 32 * lt + l31) * 4 + hd]; dcn = cdec[((size_t)b * NCHUNK) * 4 + hd]; }
    asm volatile("s_waitcnt vmcnt(0)" ::: "memory");
    __syncthreads();
    for (int c = 0; c < NCHUNK; ++c) {
        const int cur = c & 1, nxt = cur ^ 1;
        const unsigned KB = KOFF + cur * 32768, VB = VOFF + cur * 16384;
        const float th = thn, decay = dcn;
        B8 af[8];
#pragma unroll
        for (int s = 0; s < 8; ++s) qf[s] = *(const LAS B8*)(lds + (QOFF + 8192 * lt) + ro[s]);
#pragma unroll
        for (int s = 0; s < 8; ++s) af[s] = *(const LAS B8*)(lds + (SOFF + 8192 * et) + ro[s]);
        F16 o;
#pragma unroll
        for (int r = 0; r < 16; ++r) o[r] = 0.f;
#pragma unroll
        for (int s = 0; s < 8; ++s) { o = MFMA32(af[s], qf[s], o); af[s] = *(const LAS B8*)(lds + KB + ro[s]); }
        asm volatile("s_waitcnt lgkmcnt(0)" ::: "memory");
        __syncthreads();
        if (c + 1 < NCHUNK) { if (!(ABL & 4)) MX_DMA(c + 1, nxt);
            if (ML) { thn = thr[(tok0 + (size_t)(c + 1) * CHUNK + 32 * lt + l31) * 4 + hd]; dcn = cdec[((size_t)b * NCHUNK + c + 1) * 4 + hd]; } }
        float csum = 0.f;
        for (int jt = 0; jt <= lt; ++jt) {
            F16 st;
#pragma unroll
            for (int r = 0; r < 16; ++r) st[r] = 0.f;
            S4 vfr[4];
#pragma unroll
            for (int s2 = 0; s2 < 2; ++s2) { const unsigned R0 = 32 * jt + 16 * s2 + 4 * hi + q_, chv = 4 * et + 2 * blk + (p_ >> 1);
                vfr[2 * s2] = trrd(lds + VB + offv(R0, chv) + 8 * (p_ & 1)); vfr[2 * s2 + 1] = trrd(lds + VB + offv(R0 + 8, chv) + 8 * (p_ & 1)); }
#pragma unroll
            for (int s = 0; s < 8; ++s) { st = MFMA32(af[s], qf[s], st); af[s] = *(const LAS B8*)(lds + (KB + 8192 * (jt + 1)) + ro[s]); }
            if (jt == lt) {
#pragma unroll
                for (int r = 0; r < 16; ++r) if (crow(r, hi) > l31) st[r] = 0.f;
            }
            if (ML) {
#pragma unroll
                for (int r = 0; r < 16; ++r) csum += st[r];
            }
#pragma unroll
            for (int s2 = 0; s2 < 2; ++s2) {
                U4 pk; pk.x = cvtpk(st[8 * s2 + 0], st[8 * s2 + 1]); pk.y = cvtpk(st[8 * s2 + 2], st[8 * s2 + 3]); pk.z = cvtpk(st[8 * s2 + 4], st[8 * s2 + 5]); pk.w = cvtpk(st[8 * s2 + 6], st[8 * s2 + 7]);
                const B8 bfr = __builtin_bit_cast(B8, pk);
                const B8 afr = __builtin_shufflevector(vfr[2 * s2], vfr[2 * s2 + 1], 0, 1, 2, 3, 4, 5, 6, 7);
                o = MFMA32(afr, bfr, o);
            }
        }
        if (ML) {
            float qd = 0.f;
#pragma unroll
            for (int s = 0; s < 8; ++s) { const U4 nv = *(const LAS U4*)(lds + NOFF + 1024 + cur * 256 + (16 * s + 8 * hi) * 2); const U4 qv = __builtin_bit_cast(U4, qf[s]);
                qd = dot2bf(qv.x, nv.x, qd); qd = dot2bf(qv.y, nv.y, qd); qd = dot2bf(qv.z, nv.z, qd); qd = dot2bf(qv.w, nv.w, qd); }
            csum += __shfl_xor(csum, 32); qd += __shfl_xor(qd, 32);
            const float den = csum + qd;
            const float sc = 1.f / fmaxf(fabsf(den), th);
#pragma unroll
            for (int r = 0; r < 16; ++r) o[r] *= sc;
        }
        { unsigned pk[8];
#pragma unroll
            for (int g = 0; g < 4; ++g) { pk[2 * g] = cvtpk(o[4 * g], o[4 * g + 1]); pk[2 * g + 1] = cvtpk(o[4 * g + 2], o[4 * g + 3]); }
            U4 s0, s1;
            { auto ra = __builtin_amdgcn_permlane32_swap(pk[0], pk[2], false, false); auto rb = __builtin_amdgcn_permlane32_swap(pk[1], pk[3], false, false);
              s0.x = ra[0]; s0.y = rb[0]; s0.z = ra[1]; s0.w = rb[1]; }
            { auto ra = __builtin_amdgcn_permlane32_swap(pk[4], pk[6], false, false); auto rb = __builtin_amdgcn_permlane32_swap(pk[5], pk[7], false, false);
              s1.x = ra[0]; s1.y = rb[0]; s1.z = ra[1]; s1.w = rb[1]; }
            bf16* op = Vout + ((tok0 + (size_t)c * CHUNK + 32 * lt + l31) & omask) * 1024 + hd * 256 + sl * 64 + 32 * et + 8 * hi;
            if (ABL & 2) { asm volatile("" :: "v"(s0), "v"(s1)); } else { *(U4*)op = s0; *(U4*)(op + 16) = s1; } }
        float ksum = 0.f;
        { const unsigned chk = 4 * dt + 2 * blk + (p_ >> 1), chv = 4 * et + 2 * blk + (p_ >> 1);
          const unsigned ka0 = KB + offb(8 * hi + q_, chk) + 8 * (p_ & 1), ka1 = KB + offb(8 * hi + q_ + 4, chk) + 8 * (p_ & 1);
          const unsigned va0 = VB + offv(8 * hi + q_, chv) + 8 * (p_ & 1), va1 = VB + offv(8 * hi + q_ + 4, chv) + 8 * (p_ & 1);
          S4 ua[2][2], ub[2][2];
          ua[0][0] = trrd(lds + ka0); ua[0][1] = trrd(lds + ka1); ub[0][0] = trrd(lds + va0); ub[0][1] = trrd(lds + va1);
#pragma unroll
          for (int ks = 0; ks < 8; ++ks) { const int cu = ks & 1, nx = cu ^ 1;
            if (ks < 7) { ua[nx][0] = trrd(lds + ka0 + 4096 * (ks + 1)); ua[nx][1] = trrd(lds + ka1 + 4096 * (ks + 1)); ub[nx][0] = trrd(lds + va0 + 2048 * (ks + 1)); ub[nx][1] = trrd(lds + va1 + 2048 * (ks + 1)); }
            const B8 afr = __builtin_shufflevector(ua[cu][0], ua[cu][1], 0, 1, 2, 3, 4, 5, 6, 7), bfr = __builtin_shufflevector(ub[cu][0], ub[cu][1], 0, 1, 2, 3, 4, 5, 6, 7);
            St = MFMA32(afr, bfr, St);
            if (ML) { const U4 av = __builtin_bit_cast(U4, afr); ksum = dot2bf(av.x, 0x3f803f80u, ksum); ksum = dot2bf(av.y, 0x3f803f80u, ksum); ksum = dot2bf(av.z, 0x3f803f80u, ksum); ksum = dot2bf(av.w, 0x3f803f80u, ksum); }
          } }
#pragma unroll
        for (int r = 0; r < 16; ++r) St[r] *= decay;
#pragma unroll
        for (int g = 0; g < 4; ++g) { U2 pk; pk.x = cvtpk(St[4 * g], St[4 * g + 1]); pk.y = cvtpk(St[4 * g + 2], St[4 * g + 3]);
            *(LAS U2*)(lds + SOFF + offb(32 * et + l31, 4 * dt + g) + 8 * hi) = pk; }
        if (ML) { ksum += __shfl_xor(ksum, 32);
            if (et == 0 && hi == 0) { const LAS float* nv = (const LAS float*)(lds + NOFF + cur * 512); LAS float* nn = (LAS float*)(lds + NOFF + nxt * 512);
                const float nval = decay * (nv[32 * dt + l31] + ksum); nn[32 * dt + l31] = nval;
                *(LAS unsigned short*)(lds + NOFF + 1024 + nxt * 256 + (32 * dt + l31) * 2) = (unsigned short)(cvtpk(nval, 0.f) & 0xffffu); } }
        asm volatile("s_waitcnt vmcnt(2)" ::: "memory");
        __syncthreads();
    }
#undef MX_DMA
#undef ksrc_
#undef vsrc_
}
__device__ __forceinline__ void phase3(const Ctx& C, unsigned char* ws, bool dry) {
    for (int it = C.vcu; it < 256; it += C.G) {
        const int mix = it >> 7, b = (it >> 4) & 7, hd = (it >> 2) & 3, sl = it & 3;
        bf16* vr = (bf16*)(ws + WS_RV); bf16* vm = (bf16*)(ws + WS_MV); bf16* dump = (bf16*)(ws + 930 * MiB);
#ifndef DRY_ABL
#define DRY_ABL 0
#endif
        if (dry) {
            if (mix == 0 || (DRY_ABL & 1)) mixer_item<false, DRY_ABL>(C, (const bf16*)(ws + (mix ? WS_MQP : WS_RQ)), (const bf16*)(ws + (mix ? WS_MKP : WS_RK)), mix ? vm : vr, dump, (size_t)0x7fff, nullptr, nullptr, b, hd, sl);
            else mixer_item<true, DRY_ABL>(C, (const bf16*)(ws + WS_MQP), (const bf16*)(ws + WS_MKP), vm, dump, (size_t)0x7fff, (const float*)(ws + WS_THR), (const float*)(ws + WS_CDEC), b, hd, sl);
        } else {
        if (mix == 0) mixer_item<false>(C, (const bf16*)(ws + WS_RQ), (const bf16*)(ws + WS_RK), vr, vr, ~(size_t)0, nullptr, nullptr, b, hd, sl);
        else mixer_item<true>(C, (const bf16*)(ws + WS_MQP), (const bf16*)(ws + WS_MKP), vm, vm, ~(size_t)0, (const float*)(ws + WS_THR), (const float*)(ws + WS_CDEC), b, hd, sl);
        }
    }
}

__device__ __forceinline__ void phase4(const Ctx& C, const float* const* in, unsigned char* ws) {
    const float* rgn = in[3]; const float* mgn = in[9];
    const int gw = C.vcu * NWAVES + C.wave, NGW = C.G * NWAVES;
    const int col = (C.lane >> 4) * 256 + (C.lane & 15) * 16;
    float gr[16], gm[16];
#pragma unroll
    for (int i = 0; i < 4; ++i) { const F4 a = *(const F4*)(rgn + col + 4 * i), bq = *(const F4*)(mgn + col + 4 * i);
        gr[4 * i] = a.x; gr[4 * i + 1] = a.y; gr[4 * i + 2] = a.z; gr[4 * i + 3] = a.w; gm[4 * i] = bq.x; gm[4 * i + 1] = bq.y; gm[4 * i + 2] = bq.z; gm[4 * i + 3] = bq.w; }
    for (int m = gw; m < NTOK; m += NGW) {
#pragma unroll
        for (int mx = 0; mx < 2; ++mx) {
            const bf16* ip = (const bf16*)(ws + (mx ? WS_MV : WS_RV)) + (size_t)m * 1024 + col;
            bf16* op = (bf16*)(ws + WS_XCAT) + (size_t)m * 2048 + mx * 1024 + col;
            const bf16* gp = (const bf16*)(ws + (mx ? WS_MO : WS_RG)) + (size_t)m * 1024 + col;
            const U4 o0 = *(const U4*)ip, o1 = *(const U4*)(ip + 8), g0 = *(const U4*)gp, g1 = *(const U4*)(gp + 8);
            float v[16], g[16];
            v[0] = bflo(o0.x); v[1] = bfhi(o0.x); v[2] = bflo(o0.y); v[3] = bfhi(o0.y); v[4] = bflo(o0.z); v[5] = bfhi(o0.z); v[6] = bflo(o0.w); v[7] = bfhi(o0.w);
            v[8] = bflo(o1.x); v[9] = bfhi(o1.x); v[10] = bflo(o1.y); v[11] = bfhi(o1.y); v[12] = bflo(o1.z); v[13] = bfhi(o1.z); v[14] = bflo(o1.w); v[15] = bfhi(o1.w);
            g[0] = bflo(g0.x); g[1] = bfhi(g0.x); g[2] = bflo(g0.y); g[3] = bfhi(g0.y); g[4] = bflo(g0.z); g[5] = bfhi(g0.z); g[6] = bflo(g0.w); g[7] = bfhi(g0.w);
            g[8] = bflo(g1.x); g[9] = bfhi(g1.x); g[10] = bflo(g1.y); g[11] = bfhi(g1.y); g[12] = bflo(g1.z); g[13] = bfhi(g1.z); g[14] = bflo(g1.w); g[15] = bfhi(g1.w);
            if (mx) {
#pragma unroll
                for (int i = 0; i < 16; ++i) v[i] *= sigm(g[i]);
            }
            float ss = 0.f;
#pragma unroll
            for (int i = 0; i < 16; ++i) ss += v[i] * v[i];
            ss += __shfl_xor(ss, 1); ss += __shfl_xor(ss, 2); ss += __shfl_xor(ss, 4); ss += __shfl_xor(ss, 8);
            const float r = rsqrtf(ss * (1.f / 256.f) + EPS);
            float y[16];
#pragma unroll
            for (int i = 0; i < 16; ++i) y[i] = mx ? v[i] * r * gm[i] : v[i] * r * gr[i] * silu(g[i]);
            U4 w0, w1; w0.x = cvtpk(y[0], y[1]); w0.y = cvtpk(y[2], y[3]); w0.z = cvtpk(y[4], y[5]); w0.w = cvtpk(y[6], y[7]);
            w1.x = cvtpk(y[8], y[9]); w1.y = cvtpk(y[10], y[11]); w1.z = cvtpk(y[12], y[13]); w1.w = cvtpk(y[14], y[15]);
            *(U4*)op = w0; *(U4*)(op + 8) = w1;
        }
    }
    LAS float* scr = (LAS float*)(C.lds + C.wave * 8448);
    const float* wgate = in[17]; const float* wup = in[18]; const float* wdn = in[19];
    for (int it = gw; it < 16384 + 8192; it += NGW) {
        if (it < 16384) { const int e = it >> 9, kb = (it >> 5) & 15, nb = it & 31; const int R0 = nb * 32, tile = R0 >> 8, within = R0 & 255;
            const float* W = (within < 128 ? wgate : wup) + (size_t)e * 1024 * 512;
            transpose_item(W, 512, kb * 64, tile * 128 + (within & 127), (bf16*)(ws + WS_WGU), 1024, e * 1024 + R0, scr, C.lane); }
        else { const int r = it - 16384; const int e = r >> 8, kb = (r >> 5) & 7, nb = r & 31;
            transpose_item(wdn + (size_t)e * 512 * 1024, 1024, kb * 64, nb * 32, (bf16*)(ws + WS_WD), 512, e * 1024 + nb * 32, scr, C.lane); }
    }
}

__device__ __forceinline__ void phase8(const Ctx& C, const float* const* in, unsigned char* ws) {
    const float* x = in[0]; const float* nfw = in[12]; const float* bg = in[14]; const float* be = in[16];
    const bf16* YO = (const bf16*)(ws + WS_YO); bf16* H2U = (bf16*)(ws + WS_H2U);
    const F4* WR = (const F4*)(ws + WS_ROUT); TokInfo* TI = (TokInfo*)(ws + WS_TOK); unsigned* gcnt = (unsigned*)(ws + WS_CTL);
    int* TM = (int*)(ws + WS_TOKMAP); float* SR = (float*)(ws + WS_SRSTD);
    LAS float* scr = (LAS float*)(C.lds + C.wave * 4096);
    LAS unsigned* lcnt = (LAS unsigned*)(C.lds + 65536);
    LAS unsigned* lbase = (LAS unsigned*)(C.lds + 65536 + 128);
    LAS float* nwl = (LAS float*)(C.lds + 69632);
    for (int i = C.tid; i < DM; i += NTHR) nwl[i] = nfw[i];
    const int l = C.lane, l15 = l & 15, kk = l >> 4;
    for (int blkid = C.vcu; blkid < NTOK / 256; blkid += C.G) {
        __syncthreads();
        if (C.tid < 32) lcnt[C.tid] = 0u;
        __syncthreads();
        int e0[2], e1[2]; float w0[2], w1[2], rs[2]; unsigned rk0[2], rk1[2];
#pragma unroll
        for (int tt = 0; tt < 2; ++tt) {
            const int row0 = blkid * 256 + C.wave * 32 + tt * 16;
            F4 acc[3];
#pragma unroll
            for (int n = 0; n < 3; ++n) acc[n] = (F4){0.f, 0.f, 0.f, 0.f};
            float ss = 0.f;
            const size_t ro = (size_t)(row0 + l15) * DM + 8 * kk;
#pragma unroll 2
            for (int kb2 = 0; kb2 < 32; ++kb2) {
                const F4 xa = *(const F4*)(x + ro + 32 * kb2), xb = *(const F4*)(x + ro + 32 * kb2 + 4);
                const U4 yv = *(const U4*)(YO + ro + 32 * kb2);
                const F4 na = *(const LAS F4*)(nwl + 32 * kb2 + 8 * kk), nb = *(const LAS F4*)(nwl + 32 * kb2 + 8 * kk + 4);
                F4 a0, a1;
                a0.x = xa.x + bflo(yv.x); a0.y = xa.y + bfhi(yv.x); a0.z = xa.z + bflo(yv.y); a0.w = xa.w + bfhi(yv.y);
                a1.x = xb.x + bflo(yv.z); a1.y = xb.y + bfhi(yv.z); a1.z = xb.z + bflo(yv.w); a1.w = xb.w + bfhi(yv.w);
                ss += ((a0.x * a0.x + a0.y * a0.y) + (a0.z * a0.z + a0.w * a0.w)) + ((a1.x * a1.x + a1.y * a1.y) + (a1.z * a1.z + a1.w * a1.w));
                U4 hv; hv.x = cvtpk(a0.x * na.x, a0.y * na.y); hv.y = cvtpk(a0.z * na.z, a0.w * na.w); hv.z = cvtpk(a1.x * nb.x, a1.y * nb.y); hv.w = cvtpk(a1.z * nb.z, a1.w * nb.w);
                *(U4*)(H2U + ro + 32 * kb2) = hv;
#pragma unroll
                for (int n = 0; n < 3; ++n) { const F4 b0 = WR[((kb2 * 3 + n) * 2 + 0) * 64 + l], b1 = WR[((kb2 * 3 + n) * 2 + 1) * 64 + l];
#pragma unroll
                    for (int j = 0; j < 4; ++j) acc[n] = __builtin_amdgcn_mfma_f32_16x16x4f32(a0[j], b0[j], acc[n], 0, 0, 0);
#pragma unroll
                    for (int j = 0; j < 4; ++j) acc[n] = __builtin_amdgcn_mfma_f32_16x16x4f32(a1[j], b1[j], acc[n], 0, 0, 0); }
            }
            ss += __shfl_xor(ss, 16); ss += __shfl_xor(ss, 32);
            const float rstd = rsqrtf(ss * (1.f / DM) + EPS);
#pragma unroll
            for (int n = 0; n < 3; ++n)
#pragma unroll
                for (int r = 0; r < 4; ++r) scr[(4 * kk + r) * 49 + 16 * n + l15] = acc[n][r];
            if (kk == 0) scr[16 * 49 + l15] = rstd;
            asm volatile("s_waitcnt lgkmcnt(0)" ::: "memory");
            e0[tt] = 0; e1[tt] = 0; w0[tt] = 0.f; w1[tt] = 0.f; rs[tt] = 0.f; rk0[tt] = 0u; rk1[tt] = 0u;
            if (l < 16) {
                const LAS float* lr = scr + l * 49; const float rr = scr[16 * 49 + l];
                float g0 = lr[0] * rr + bg[0], g1 = lr[1] * rr + bg[1], g2 = lr[2] * rr + bg[2], g3 = lr[3] * rr + bg[3];
                int gi = 0; float gmx = g0; if (g1 > gmx) { gmx = g1; gi = 1; } if (g2 > gmx) { gmx = g2; gi = 2; } if (g3 > gmx) { gmx = g3; gi = 3; }
                const float gw = __builtin_amdgcn_rcpf(__expf(g0 - gmx) + __expf(g1 - gmx) + __expf(g2 - gmx) + __expf(g3 - gmx));
                float m1 = -INFINITY, m2 = -INFINITY; int i1 = 0, i2 = 0;
#pragma unroll
                for (int i = 0; i < 8; ++i) { const float v = lr[4 + gi * 8 + i] * rr + be[gi * 8 + i];
                    if (v > m1) { m2 = m1; i2 = i1; m1 = v; i1 = i; } else if (v > m2) { m2 = v; i2 = i; } }
                const float ex = __expf(m2 - m1), wa = __builtin_amdgcn_rcpf(1.f + ex);
                e0[tt] = gi * 8 + i1; e1[tt] = gi * 8 + i2; w0[tt] = gw * wa; w1[tt] = gw * ex * wa; rs[tt] = rr;
                rk0[tt] = atomicAdd((unsigned*)(lcnt + e0[tt]), 1u); rk1[tt] = atomicAdd((unsigned*)(lcnt + e1[tt]), 1u);
            }
            asm volatile("s_waitcnt lgkmcnt(0)" ::: "memory");
        }
        __syncthreads();
        if (C.tid < 32) lbase[C.tid] = atomicAdd(gcnt + C.tid, lcnt[C.tid]);
        __syncthreads();
#pragma unroll
        for (int tt = 0; tt < 2; ++tt) if (l < 16) {
            const int t = blkid * 256 + C.wave * 32 + tt * 16 + l;
            TokInfo ti; ti.e0 = e0[tt]; ti.p0 = (int)(lbase[e0[tt]] + rk0[tt]); ti.e1 = e1[tt]; ti.p1 = (int)(lbase[e1[tt]] + rk1[tt]); ti.w0 = w0[tt]; ti.w1 = w1[tt]; ti.rstd = rs[tt]; ti.pad = 0.f;
            TI[t] = ti;
            TM[ti.e0 * 65536 + ti.p0] = t; SR[ti.e0 * 65536 + ti.p0] = rs[tt];
            TM[ti.e1 * 65536 + ti.p1] = t; SR[ti.e1 * 65536 + ti.p1] = rs[tt]; }
    }
}

__device__ __forceinline__ int build_rowbase(const Ctx& C, unsigned char* ws) {
    LAS int* rb = (LAS int*)(C.lds + LDS_MISC);
    LAS unsigned char* t2e = (LAS unsigned char*)(C.lds + LDS_MISC + 256);
    const unsigned* gcnt = (const unsigned*)(ws + WS_CTL);
    __syncthreads();
    if (C.tid == 0) { int acc = 0; for (int e = 0; e < NEXP; ++e) { rb[e] = acc; const int n = (int)__hip_atomic_load(gcnt + e, __ATOMIC_RELAXED, __HIP_MEMORY_SCOPE_AGENT); acc += (n + 255) & ~255; } rb[NEXP] = acc; }
    __syncthreads();
    for (int e = C.tid >> 4; e < NEXP; e += NTHR >> 4) for (int t = (rb[e] >> 8) + (C.tid & 15); t < (rb[e + 1] >> 8); t += 16) t2e[t] = (unsigned char)e;
    __syncthreads();
    return rb[NEXP] >> 8;
}

__device__ __forceinline__ void phase12(const Ctx& C, const float* const* in, float* out, unsigned char* ws) {
    (void)build_rowbase(C, ws);
    const LAS int* rb = (const LAS int*)(C.lds + LDS_MISC);
    const float* x = in[0]; const float* fw = in[20]; const TokInfo* TI = (const TokInfo*)(ws + WS_TOK); const bf16* Y = (const bf16*)(ws + WS_Y); const bf16* YO = (const bf16*)(ws + WS_YO);
    const int gw = C.vcu * NWAVES + C.wave, NGW = C.G * NWAVES;
    F4 wv[4];
#pragma unroll
    for (int j = 0; j < 4; ++j) wv[j] = *(const F4*)(fw + 4 * C.lane + 256 * j);
    for (int m = gw; m < NTOK; m += NGW) {
        const TokInfo ti = TI[m];
        const F4* xr = (const F4*)(x + (size_t)m * DM) + C.lane;
        const U2* yo = (const U2*)(YO + (size_t)m * DM) + C.lane;
        const U2* y0 = (const U2*)(Y + (size_t)(rb[ti.e0] + ti.p0) * DM) + C.lane;
        const U2* y1 = (const U2*)(Y + (size_t)(rb[ti.e1] + ti.p1) * DM) + C.lane;
        F4 v[4]; float s = 0.f;
#pragma unroll
        for (int j = 0; j < 4; ++j) { const U2 a = y0[64 * j], bq = y1[64 * j], c = yo[64 * j]; v[j] = xr[64 * j];
            v[j].x += bflo(c.x) + ti.w0 * bflo(a.x) + ti.w1 * bflo(bq.x); v[j].y += bfhi(c.x) + ti.w0 * bfhi(a.x) + ti.w1 * bfhi(bq.x);
            v[j].z += bflo(c.y) + ti.w0 * bflo(a.y) + ti.w1 * bflo(bq.y); v[j].w += bfhi(c.y) + ti.w0 * bfhi(a.y) + ti.w1 * bfhi(bq.y);
            s += (v[j].x * v[j].x + v[j].y * v[j].y) + (v[j].z * v[j].z + v[j].w * v[j].w); }
        const float rstd = rsqrtf(wave_sum(s) * (1.f / DM) + EPS);
        F4* xw = (F4*)(out + (size_t)m * DM) + C.lane;
#pragma unroll
        for (int j = 0; j < 4; ++j) xw[64 * j] = v[j] * rstd * wv[j];
    }
}

constexpr int NPHASE = 13;
struct Args { const float* in[21]; float* out; unsigned char* ws; int ph_lo, ph_hi; };
__global__ void __launch_bounds__(NTHR, 2) fwd_kernel(Args args) {
    extern __shared__ __attribute__((aligned(16))) unsigned char lds_raw[];
    cg::grid_group grid = cg::this_grid();
    Ctx C; C.lds = (LAS unsigned char*)lds_raw; C.tid = threadIdx.x; C.lane = C.tid & 63; C.wave = __builtin_amdgcn_readfirstlane(C.tid >> 6);
    C.G = gridDim.x; { const int bx = blockIdx.x; C.vcu = (C.G % 8 == 0) ? (bx % 8) * (C.G / 8) + bx / 8 : bx; }
    unsigned char* ws = args.ws; unsigned char* ob = (unsigned char*)args.out;
    const int lo = args.ph_lo, hi = args.ph_hi;
#ifndef PHMASK
#define PHMASK 0x1fff
#endif
#define IN(k) (((PHMASK >> (k)) & 1) && lo <= (k) && (k) < hi)
    if (C.tid < 2) ((LAS unsigned*)(C.lds + LDS_MISC + 4096))[C.tid] = 0u;
    __syncthreads();
    const XcdBarrier bar = xcd_barrier_post((unsigned*)(ws + WS_CTL) + CW_BAR, (volatile LAS unsigned*)(C.lds + LDS_MISC + 4096));
#define SEAM(k) do { if (IN(k) && IN((k) + 1)) { if ((k) == 0) grid.sync(); else xcd_barrier(bar); } } while (0)
#ifndef DUP_MASK
#define DUP_MASK 0
#endif
#define REP(k) for (int rep_ = 0; rep_ < (((DUP_MASK >> (k)) & 1) ? 2 : 1); ++rep_)
    if (IN(0)) { REP(0) phase0(C, args.in, ws); } SEAM(0);
    if (IN(1)) { pg8::Gemm g{(const pg8::bf16_t*)(ws + WS_H), (const pg8::bf16_t*)(ws + WS_WIN), NTOK, NPROJ, DM}; pg8::StaticOrder S; S.init(NTOK, NPROJ, C.G, (int)blockIdx.x);
        pg8::EpiProj E{ws, ob}; REP(1) pg8::gemm_phase<pg8::EpiProj, pg8::StaticOrder, true, true>(C.lds, g, S, E); } SEAM(1);
    if (IN(2)) { phase2(C, args.in, ws); } SEAM(2);
    if (IN(3)) { if ((DUP_MASK >> 3) & 1) phase3(C, ws, true); phase3(C, ws, false); } SEAM(3);
    if (IN(4)) { phase4(C, args.in, ws); } SEAM(4);
    if (IN(5)) { pg8::Gemm g{(const pg8::bf16_t*)(ws + WS_XCAT), (const pg8::bf16_t*)(ws + WS_WCAT), NTOK, DM, 2 * DM}; pg8::StaticOrder S; S.init(NTOK, DM, C.G, (int)blockIdx.x);
        pg8::EpiGateFused E{(const pg8::bf16_t*)(ob + OUT_GR), (const pg8::bf16_t*)(ob + OUT_GM), (pg8::bf16_t*)(ws + WS_MERGED)}; REP(5) pg8::gemm_phase<pg8::EpiGateFused, pg8::StaticOrder, true, true>(C.lds, g, S, E); }
    if (IN(5) && IN(7)) xcd_barrier(bar);
    if (IN(7)) { pg8::Gemm g{(const pg8::bf16_t*)(ws + WS_MERGED), (const pg8::bf16_t*)(ws + WS_WOUT), NTOK, DM, DM}; pg8::StaticOrder S; S.init(NTOK, DM, C.G, (int)blockIdx.x);
        pg8::EpiBf16<0> E{(pg8::bf16_t*)(ws + WS_YO), DM, nullptr, 0, 0, 1.f}; REP(7) pg8::gemm_phase<pg8::EpiBf16<0>, pg8::StaticOrder, true, true>(C.lds, g, S, E); } SEAM(7);
    if (IN(8)) { phase8(C, args.in, ws); }
    if (IN(8) && IN(10)) xcd_barrier(bar);
    if (IN(10)) { const int nt = build_rowbase(C, ws);
        pg8::Gemm g{(const pg8::bf16_t*)(ws + WS_H2U), (const pg8::bf16_t*)(ws + WS_WGU), MAXROWS, NEXP * 1024, DM};
        pg8::GroupedOrder<true> S{nt, C.G, C.vcu, (const LAS unsigned char*)(C.lds + LDS_MISC + 256), (const LAS int*)(C.lds + LDS_MISC), (const int*)(ws + WS_TOKMAP)};
        pg8::EpiSwiglu E{(pg8::bf16_t*)(ws + WS_HMID), (const float*)(ws + WS_SRSTD)}; REP(10) pg8::gemm_phase<pg8::EpiSwiglu, pg8::GroupedOrder<true>, true, true>(C.lds, g, S, E); } SEAM(10);
    if (IN(11)) { const int nt = build_rowbase(C, ws);
        pg8::Gemm g{(const pg8::bf16_t*)(ws + WS_HMID), (const pg8::bf16_t*)(ws + WS_WD), MAXROWS, NEXP * 1024, DEXP};
        pg8::GroupedOrder<false> S{nt, C.G, C.vcu, (const LAS unsigned char*)(C.lds + LDS_MISC + 256), (const LAS int*)(C.lds + LDS_MISC), nullptr};
        pg8::EpiY E{(pg8::bf16_t*)(ws + WS_Y)}; REP(11) pg8::gemm_phase<pg8::EpiY, pg8::GroupedOrder<false>, true, true>(C.lds, g, S, E); } SEAM(11);
    if (IN(12)) { phase12(C, args.in, args.out, ws); }
#undef IN
#undef SEAM
}

#ifndef MK_SPLIT
#define MK_SPLIT 0
#endif
extern "C" void kernel_launch(void* const* d_in, const int* in_sizes, int n_in, void* d_out, int out_size, void* d_ws, size_t ws_size, hipStream_t stream) {
    static int grid = 0;
    if (grid == 0) {
        if (n_in != 21 || out_size != NTOK * DM || ws_size < WS_END) { fprintf(stderr, "kernel_launch: unexpected shapes (n_in %d out %d ws %zu)\n", n_in, out_size, ws_size); grid = -1; return; }
        int dev = 0, cus = 0, per_cu = 0;
        if (hipGetDevice(&dev) != hipSuccess || hipDeviceGetAttribute(&cus, hipDeviceAttributeMultiprocessorCount, dev) != hipSuccess) { grid = -1; return; }
        if (hipFuncSetAttribute((const void*)fwd_kernel, hipFuncAttributeMaxDynamicSharedMemorySize, LDS_BYTES) != hipSuccess) { fprintf(stderr, "kernel_launch: hipFuncSetAttribute failed\n"); grid = -1; return; }
        if (hipOccupancyMaxActiveBlocksPerMultiprocessor(&per_cu, (const void*)fwd_kernel, NTHR, LDS_BYTES) != hipSuccess || per_cu < 1) { fprintf(stderr, "kernel_launch: occupancy query says %d\n", per_cu); per_cu = 1; }
        (void)hipGetLastError();
        grid = cus;
    }
    if (grid < 0) return;
    (void)hipMemsetAsync((char*)d_ws + WS_CTL, 0, CTL_ZERO_BYTES, stream);
    Args a{};
    for (int i = 0; i < 21; ++i) a.in[i] = (const float*)d_in[i];
    a.out = (float*)d_out; a.ws = (unsigned char*)d_ws;
    void* kargs[] = {&a};
#if MK_SPLIT
    for (int p = 0; p < NPHASE; ++p) { a.ph_lo = p; a.ph_hi = p + 1;
        hipError_t e = hipLaunchCooperativeKernel((const void*)fwd_kernel, dim3(grid), dim3(NTHR), kargs, LDS_BYTES, stream);
        if (e != hipSuccess) { fprintf(stderr, "kernel_launch: launch %d failed: %s\n", p, hipGetErrorString(e)); break; } }
#else
    a.ph_lo = 0; a.ph_hi = NPHASE;
    hipError_t e = hipLaunchCooperativeKernel((const void*)fwd_kernel, dim3(grid), dim3(NTHR), kargs, LDS_BYTES, stream);
    if (e != hipSuccess) fprintf(stderr, "kernel_launch: cooperative launch failed: %s (grid %d)\n", hipGetErrorString(e), grid);
#endif
}
```

```cpp
#include <hip/hip_runtime.h>
#include <hip/hip_cooperative_groups.h>
#include <cstdio>
#include <cstdint>
namespace cg = cooperative_groups;
namespace pg8 {
#define PG8_LAS __attribute__((address_space(3)))
typedef unsigned short bf16_t;
typedef short bf16x8 __attribute__((ext_vector_type(8)));
typedef float f32x4 __attribute__((ext_vector_type(4)));
typedef unsigned u32x4 __attribute__((ext_vector_type(4)));
constexpr int BM = 256, BK = 64, HALF = 128, HTB = HALF * BK * 2  , STAGE_BYTES = 8 * HTB, NXCD = 8, WGM = 8;

__host__ __device__ __forceinline__ int lds_byte(int r, int c) { const int st = (r >> 4) * 2 + (c >> 5), rr = r & 15, cc = c & 31, ob = rr * 64 + cc * 2; return st * 1024 + (ob ^ (((ob >> 9) & 1) << 5)); }
__host__ __device__ __forceinline__ void stage_rc(int b, int& R, int& C) { const int st = b / 1024, sb = b % 1024, swz = sb ^ (((sb >> 9) & 1) << 5); R = (st >> 1) * 16 + swz / 64; C = (st & 1) * 32 + (swz % 64) / 2; }
__host__ __device__ __forceinline__ int perm32(int rho) { const int n = rho >> 4, i = rho & 15; return 8 * (i >> 2) + 4 * n + (i & 3); }

struct Unit { int pm, pn, pa; };
struct Gemm { const bf16_t* A; const bf16_t* Bt; int M, N, K; };

struct StaticOrder {
    static constexpr bool GATHER = false;
    int nM, nN, nwg, G, c;
    __host__ __device__ void init(int M, int N, int G_, int c_) { nM = M / BM; nN = N / BM; nwg = nM * nN; G = G_; c = c_; }
    __host__ __device__ bool next(int i, Unit& u) const {
        const long L = (long)i * G + c; if (L >= nwg) return false;
        int wgid = (int)L; { const int q = nwg / NXCD, r = nwg % NXCD, xcd = wgid % NXCD, off = wgid / NXCD; wgid = (xcd < r ? xcd * (q + 1) : r * (q + 1) + (xcd - r) * q) + off; }
        const int nig = WGM * nN, gid = wgid / nig, fm = gid * WGM, gsz = (nM - fm) < WGM ? (nM - fm) : WGM;
        u.pm = fm + ((wgid % nig) % gsz); u.pn = (wgid % nig) / gsz; u.pa = 0; return true;
    }
    __device__ __forceinline__ void a_ready(const Unit&) const {}
    __device__ __forceinline__ void done(const Unit&) const {}
};

__device__ __forceinline__ unsigned cvt_pk_bf16(float lo, float hi) { unsigned r; asm volatile("v_cvt_pk_bf16_f32 %0, %1, %2" : "=v"(r) : "v"(lo), "v"(hi)); return r; }
typedef float f32x2 __attribute__((ext_vector_type(2)));
__device__ __forceinline__ f32x2 gelu_pk(f32x2 v) {
    const f32x2 av = __builtin_elementwise_abs(v), d = av * 0.2316418882f + 1.0f;
    f32x2 t; t.x = __builtin_amdgcn_rcpf(d.x); t.y = __builtin_amdgcn_rcpf(d.y);
    f32x2 q = t * 0.5307027145f + (-0.7265760135f); q = q * t + 0.7107068705f; q = q * t + (-0.142248368f); q = q * t + 0.127414796f; q = q * t;
    const f32x2 s = (v * v) * (-0.72134752044f);
    f32x2 e; e.x = __builtin_amdgcn_exp2f(s.x); e.y = __builtin_amdgcn_exp2f(s.y);
    const f32x2 m = v * (q * e), r = v - m;
    f32x2 o; o.x = v.x < 0.f ? m.x : r.x; o.y = v.y < 0.f ? m.y : r.y; return o;
}

template <int ACT  > struct EpiBf16 {
    static constexpr bool PERM = true, AFTER_DRAIN = false, MIDK = false; static_assert(ACT == 0 || ACT == 1, "EpiBf16: ACT is 0 (none) or 1 (gelu_pk)");
    bf16_t* O; int ldc; const float* bias; int split_cols; size_t split_stride; float scale0;
    __device__ __forceinline__ void operator()(const f32x4 (&acc)[2][2][4][2], const Unit& u, int wr, int wc, int fr, int fq) const {
        const int row0 = u.pm * BM + wr * 64 + fr; int colt = u.pn * BM; bf16_t* base = O;
        float sc = 1.f; if (split_cols) { const int t = colt / split_cols; base += (size_t)t * split_stride; colt -= t * split_cols; if (t == 0) sc = scale0; }
        const int col0 = colt + wc * 32 + 8 * fq, bcol0 = u.pn * BM + wc * 32 + 8 * fq;
        f32x4 bv[2][2];
#pragma unroll
        for (int bj = 0; bj < 2; ++bj)
#pragma unroll
            for (int n = 0; n < 2; ++n) bv[bj][n] = bias ? *(const f32x4*)(bias + bcol0 + bj * HALF + 4 * n) : (f32x4){0.f, 0.f, 0.f, 0.f};
#pragma unroll
        for (int ai = 0; ai < 2; ++ai)
#pragma unroll
            for (int m = 0; m < 4; ++m) { bf16_t* rowp = base + (size_t)(row0 + ai * HALF + m * 16) * ldc + col0;
#pragma unroll
                for (int bj = 0; bj < 2; ++bj) { f32x4 v0 = acc[ai][bj][m][0] + bv[bj][0], v1 = acc[ai][bj][m][1] + bv[bj][1];
                    if (ACT == 1) { f32x2 a = gelu_pk((f32x2){v0[0], v0[1]}), b = gelu_pk((f32x2){v0[2], v0[3]}), c = gelu_pk((f32x2){v1[0], v1[1]}), d = gelu_pk((f32x2){v1[2], v1[3]});
                        v0 = (f32x4){a.x, a.y, b.x, b.y}; v1 = (f32x4){c.x, c.y, d.x, d.y}; }
                    v0 = v0 * sc; v1 = v1 * sc; u32x4 w; w.x = cvt_pk_bf16(v0[0], v0[1]); w.y = cvt_pk_bf16(v0[2], v0[3]); w.z = cvt_pk_bf16(v1[0], v1[1]); w.w = cvt_pk_bf16(v1[2], v1[3]);
                    *(u32x4*)(rowp + bj * HALF) = w; } }
    }
};
template <class Epi, class Sched, bool ALIGN_EPI = false, bool SP2 = false>
__device__ __forceinline__ void gemm_phase(PG8_LAS unsigned char* lds, const Gemm g, const Sched& S, const Epi& E) {
    const int tid = threadIdx.x, wid = __builtin_amdgcn_readfirstlane(tid >> 6), lane = tid & 63, wr = wid >> 2, wc = wid & 3, fr = lane & 15, fq = lane >> 4;
    const int K = g.K, nt = K / BK;
    unsigned voffA[2], voffB[2]; int Rr[2], Cc[2];
#pragma unroll
    for (int i = 0; i < 2; ++i) { int R, C; stage_rc(tid * 16 + i * 8192, R, C); const int Rb = Epi::PERM ? ((R & ~31) + perm32(R & 31)) : R; Rr[i] = R; Cc[i] = C;
        voffA[i] = (unsigned)(R * K + C) * 2u; voffB[i] = (unsigned)(Rb * K + C) * 2u; }
    const size_t kstep = (size_t)(BK * 2);
    const size_t hstep = (size_t)HALF * K * 2;
    const size_t tstep = 2 * hstep;
    unsigned vAc[2][2], vAn[2][2];
#define PG8_AOFF(dst, un) do { _Pragma("unroll") for (int h_ = 0; h_ < 2; ++h_) _Pragma("unroll") for (int i_ = 0; i_ < 2; ++i_) { \
        if constexpr (Sched::GATHER) (dst)[h_][i_] = (unsigned)S.arow((un), h_ * HALF + Rr[i_]) * (unsigned)(K * 2) + (unsigned)(Cc[i_] * 2); \
        else (dst)[h_][i_] = voffA[i_] + (unsigned)(h_ * (int)hstep); } } while (0)
    const unsigned ldsw = (unsigned)wid * 1024u;
    const int aoff = lds_byte(wr * 64 + fr, fq * 8), boff = lds_byte(wc * 32 + fr, fq * 8);
#define PG8_SA(b, h) (((b) * 2 + (h)) * HTB)
#define PG8_SB(b, h) ((4 + (b) * 2 + (h)) * HTB)
#define PG8_STAGE(bufoff, gbase, voff) do { _Pragma("unroll") for (int _i = 0; _i < 2; ++_i) \
        __builtin_amdgcn_global_load_lds((const unsigned*)((const char*)(gbase) + (voff)[_i]), (PG8_LAS unsigned*)(lds + (bufoff) + ldsw + _i * 8192), 16, 0, 0); } while (0)
#define PG8_LDA(dst, b, h) do { _Pragma("unroll") for (int m = 0; m < 4; ++m) _Pragma("unroll") for (int k = 0; k < 2; ++k) dst[m][k] = *(const PG8_LAS bf16x8*)(lds + PG8_SA(b, h) + aoff + m * 2048 + k * 1024); } while (0)
#define PG8_LDB(dst, b, h) do { _Pragma("unroll") for (int n = 0; n < 2; ++n) _Pragma("unroll") for (int k = 0; k < 2; ++k) dst[n][k] = *(const PG8_LAS bf16x8*)(lds + PG8_SB(b, h) + boff + n * 2048 + k * 1024); } while (0)
#define PG8_MMA(ai, bj, At, Bt) do { __builtin_amdgcn_s_setprio(1); _Pragma("unroll") for (int m = 0; m < 4; ++m) _Pragma("unroll") for (int n = 0; n < 2; ++n) _Pragma("unroll") for (int k = 0; k < 2; ++k) \
        acc[ai][bj][m][n] = __builtin_amdgcn_mfma_f32_16x16x32_bf16(Bt[n][k], At[m][k], acc[ai][bj][m][n], 0, 0, 0); __builtin_amdgcn_s_setprio(0); } while (0)
#define PG8_WAIT_V(n) asm volatile("s_waitcnt vmcnt(" #n ")" ::: "memory")
#define PG8_WAIT_L(n) asm volatile("s_waitcnt lgkmcnt(" #n ")" ::: "memory")
#define PG8_BAR __builtin_amdgcn_s_barrier()
#define PG8_SCHED __builtin_amdgcn_sched_barrier(0)
    Unit cur, nxt; int ui = 0;
    if (!S.next(0, cur)) return;
    f32x4 acc[2][2][4][2];
#pragma unroll
    for (int a = 0; a < 2; ++a)
#pragma unroll
        for (int b = 0; b < 2; ++b)
#pragma unroll
            for (int m = 0; m < 4; ++m)
#pragma unroll
                for (int n = 0; n < 2; ++n) acc[a][b][m][n] = (f32x4){0.f, 0.f, 0.f, 0.f};
    bf16x8 At[4][2], B0[2][2], B1[2][2];
    const char* cA = (const char*)g.A + (Sched::GATHER ? (size_t)0 : (size_t)cur.pm * tstep); const char* cB = (const char*)g.Bt + (size_t)cur.pn * tstep;
    PG8_AOFF(vAc, cur);
    S.a_ready(cur);
    if constexpr (SP2) {
        PG8_STAGE(PG8_SB(0, 0), cB, voffB); PG8_STAGE(PG8_SB(0, 1), cB + hstep, voffB); PG8_STAGE(PG8_SA(0, 0), cA, vAc[0]); PG8_STAGE(PG8_SA(0, 1), cA, vAc[1]);
        if (wr == 1) PG8_BAR;
        PG8_WAIT_V(2); PG8_BAR;
        PG8_STAGE(PG8_SB(1, 0), cB + kstep, voffB); PG8_STAGE(PG8_SA(1, 0), cA + kstep, vAc[0]); PG8_STAGE(PG8_SB(1, 1), cB + hstep + kstep, voffB);
        PG8_WAIT_V(6); PG8_BAR;
    } else {
        PG8_STAGE(PG8_SB(0, 0), cB, voffB); PG8_STAGE(PG8_SA(0, 0), cA, vAc[0]); PG8_STAGE(PG8_SB(0, 1), cB + hstep, voffB); PG8_STAGE(PG8_SA(0, 1), cA, vAc[1]);
        if (wr == 1) PG8_BAR;
        PG8_WAIT_V(4); PG8_BAR;
        PG8_STAGE(PG8_SB(1, 0), cB + kstep, voffB); PG8_STAGE(PG8_SA(1, 0), cA + kstep, vAc[0]); PG8_STAGE(PG8_SB(1, 1), cB + hstep + kstep, voffB);
        PG8_WAIT_V(6); PG8_BAR;
    }
    for (;;) {
        const bool has_next = S.next(ui + 1, nxt);
        const char* nA = has_next ? (const char*)g.A + (Sched::GATHER ? (size_t)0 : (size_t)nxt.pm * tstep) : cA; const char* nB = has_next ? (const char*)g.Bt + (size_t)nxt.pn * tstep : cB;
        if (has_next) { PG8_AOFF(vAn, nxt); } else {
#pragma unroll
            for (int h_ = 0; h_ < 2; ++h_)
#pragma unroll
                for (int i_ = 0; i_ < 2; ++i_) vAn[h_][i_] = vAc[h_][i_]; }
        for (int t = 0; t < nt; t += 2) {
            if constexpr (Epi::MIDK) { if (t == nt / 2) E.midk(acc, cur, wr, wc, fr, fq); }
            const bool last = (t == nt - 2);
            const char* a1 = cA + (size_t)(t + 1) * kstep;
            const char* a2 = last ? nA : cA + (size_t)(t + 2) * kstep; const char* b2 = last ? nB : cB + (size_t)(t + 2) * kstep;
            const char* a3 = a2 + kstep; const char* b3 = b2 + kstep;
            unsigned vA2[2][2];
#pragma unroll
            for (int h_ = 0; h_ < 2; ++h_)
#pragma unroll
                for (int i_ = 0; i_ < 2; ++i_) vA2[h_][i_] = vAc[h_][i_];
            if (last) { asm volatile("" ::: "memory");
#pragma unroll
                for (int h_ = 0; h_ < 2; ++h_)
#pragma unroll
                    for (int i_ = 0; i_ < 2; ++i_) vA2[h_][i_] = vAn[h_][i_]; }
            if (last && has_next) S.a_ready(nxt);
            if constexpr (SP2) {
            PG8_LDB(B0, 0, 0); PG8_LDB(B1, 0, 1); PG8_SCHED; PG8_LDA(At, 0, 0); PG8_STAGE(PG8_SA(1, 1), a1, vAc[1]);
            PG8_WAIT_V(8); PG8_WAIT_L(0); PG8_BAR; PG8_MMA(0, 0, At, B0); PG8_MMA(0, 1, At, B1); PG8_BAR; PG8_SCHED;
            PG8_LDA(At, 0, 1); PG8_STAGE(PG8_SB(0, 0), b2, voffB); PG8_STAGE(PG8_SB(0, 1), b2 + hstep, voffB); PG8_STAGE(PG8_SA(0, 0), a2, vA2[0]);
            PG8_WAIT_V(8); PG8_WAIT_L(0); PG8_BAR; PG8_MMA(1, 0, At, B0); PG8_MMA(1, 1, At, B1); PG8_BAR; PG8_SCHED;
            PG8_LDB(B0, 1, 0); PG8_LDB(B1, 1, 1); PG8_SCHED; PG8_LDA(At, 1, 0); PG8_STAGE(PG8_SA(0, 1), a2, vA2[1]);
            PG8_WAIT_V(8); PG8_WAIT_L(0); PG8_BAR; PG8_MMA(0, 0, At, B0); PG8_MMA(0, 1, At, B1); PG8_BAR; PG8_SCHED;
            PG8_LDA(At, 1, 1); PG8_STAGE(PG8_SB(1, 0), b3, voffB); PG8_STAGE(PG8_SB(1, 1), b3 + hstep, voffB); PG8_STAGE(PG8_SA(1, 0), a3, vA2[0]);
            PG8_WAIT_V(8); PG8_WAIT_L(0); PG8_BAR; PG8_MMA(1, 0, At, B0); PG8_MMA(1, 1, At, B1); PG8_BAR; PG8_SCHED;
            } else {
            PG8_LDB(B0, 0, 0); PG8_SCHED; PG8_LDA(At, 0, 0); PG8_STAGE(PG8_SA(1, 1), a1, vAc[1]);
            PG8_WAIT_L(8); PG8_BAR; PG8_WAIT_L(0); PG8_MMA(0, 0, At, B0); PG8_BAR; PG8_SCHED;
            PG8_LDB(B1, 0, 1); PG8_STAGE(PG8_SB(0, 0), b2, voffB);
            PG8_BAR; PG8_WAIT_L(0); PG8_MMA(0, 1, At, B1); PG8_BAR;
            PG8_LDA(At, 0, 1); PG8_STAGE(PG8_SA(0, 0), a2, vA2[0]);
            PG8_BAR; PG8_WAIT_L(0); PG8_MMA(1, 0, At, B0); PG8_BAR; PG8_SCHED;
            PG8_STAGE(PG8_SB(0, 1), b2 + hstep, voffB);
            PG8_WAIT_V(6); PG8_BAR; PG8_MMA(1, 1, At, B1); PG8_BAR;
            PG8_LDB(B0, 1, 0); PG8_SCHED; PG8_LDA(At, 1, 0); PG8_STAGE(PG8_SA(0, 1), a2, vA2[1]);
            PG8_WAIT_L(8); PG8_BAR; PG8_WAIT_L(0); PG8_MMA(0, 0, At, B0); PG8_BAR; PG8_SCHED;
            PG8_LDB(B1, 1, 1); PG8_STAGE(PG8_SB(1, 0), b3, voffB);
            PG8_BAR; PG8_WAIT_L(0); PG8_MMA(0, 1, At, B1); PG8_BAR;
            PG8_LDA(At, 1, 1); PG8_STAGE(PG8_SA(1, 0), a3, vA2[0]);
            PG8_BAR; PG8_WAIT_L(0); PG8_MMA(1, 0, At, B0); PG8_BAR; PG8_SCHED;
            PG8_STAGE(PG8_SB(1, 1), b3 + hstep, voffB);
            PG8_WAIT_V(6); PG8_BAR; PG8_MMA(1, 1, At, B1); PG8_BAR;
            }
        }
        if constexpr (ALIGN_EPI) { if (wr == 0) PG8_BAR; }
        if constexpr (!Epi::AFTER_DRAIN) { E(acc, cur, wr, wc, fr, fq); S.done(cur); }
        if (!has_next) break;
#pragma unroll
        for (int a = 0; a < 2; ++a)
#pragma unroll
            for (int b = 0; b < 2; ++b)
#pragma unroll
                for (int m = 0; m < 4; ++m)
#pragma unroll
                    for (int n = 0; n < 2; ++n) acc[a][b][m][n] = (f32x4){0.f, 0.f, 0.f, 0.f};
        cur = nxt; cA = nA; cB = nB; ++ui;
#pragma unroll
        for (int h_ = 0; h_ < 2; ++h_)
#pragma unroll
            for (int i_ = 0; i_ < 2; ++i_) vAc[h_][i_] = vAn[h_][i_];
        if constexpr (ALIGN_EPI) { if (wr == 1) PG8_BAR; }
    }
    PG8_WAIT_V(0);
    if constexpr (!ALIGN_EPI) { if (wr == 0) PG8_BAR; }
    PG8_BAR;
    if constexpr (Epi::AFTER_DRAIN) { E.fused(acc, cur, wr, wc, fr, fq, lds, wid, lane); S.done(cur); }
#undef PG8_AOFF
#undef PG8_SA
#undef PG8_SB
#undef PG8_STAGE
#undef PG8_LDA
#undef PG8_LDB
#undef PG8_MMA
#undef PG8_WAIT_V
#undef PG8_WAIT_L
#undef PG8_BAR
#undef PG8_SCHED
}
}

#define GAS __attribute__((address_space(1)))
#define LAS __attribute__((address_space(3)))
typedef unsigned short bf16;
typedef unsigned U4 __attribute__((ext_vector_type(4)));
typedef unsigned U2 __attribute__((ext_vector_type(2)));
typedef float F4 __attribute__((ext_vector_type(4)));
typedef float F2 __attribute__((ext_vector_type(2)));
typedef float F16 __attribute__((ext_vector_type(16)));
typedef short B8 __attribute__((ext_vector_type(8)));
typedef short S4 __attribute__((ext_vector_type(4)));
typedef __bf16 bf16x2_t __attribute__((ext_vector_type(2)));

constexpr int NWAVES = 8, NTHR = 512;
constexpr int DM = 1024, BATCH = 8, SEQ = 8192, NTOK = BATCH * SEQ;
constexpr int DIN = 8200, NPROJ = 8192;
constexpr int CHUNK = 128, NCHUNK = SEQ / CHUNK;
constexpr int NEXP = 32, DEXP = 512;
constexpr int MAXTILES = 544, MAXROWS = MAXTILES * 256;
constexpr float EPS = 1e-6f;
constexpr int LDS_BYTES = 159744;
constexpr int LDS_MISC = 151552;

constexpr size_t MiB = 1u << 20;
constexpr size_t WS_CTL = 0, CTL_ZERO_BYTES = 32768; constexpr int CW_BAR = 1024;
constexpr size_t WS_IF = 1 * MiB;
constexpr size_t WS_THR = 3 * MiB;
constexpr size_t WS_CDEC = 4 * MiB;
constexpr size_t WS_ROUT = 4 * MiB + 65536;
constexpr size_t WS_ROPE = 5 * MiB;
constexpr size_t WS_TOK = 9 * MiB;
constexpr size_t WS_WIN = 12 * MiB;
constexpr size_t WS_WCAT = 28 * MiB, WS_WOUT = 32 * MiB;
constexpr size_t WS_H = 34 * MiB;
constexpr size_t WS_MQP = 34 * MiB, WS_MKP = 98 * MiB, WS_WGU = 34 * MiB, WS_WD = 98 * MiB;
constexpr size_t WS_RQ = 162 * MiB, WS_RK = 226 * MiB, WS_MQ = 290 * MiB, WS_MK = 354 * MiB;
constexpr size_t WS_XCAT = 162 * MiB;
constexpr size_t WS_RV = 418 * MiB, WS_RG = 546 * MiB, WS_MV = 674 * MiB, WS_MO = 802 * MiB;
constexpr size_t WS_MERGED = 802 * MiB;
constexpr size_t WS_YO = 162 * MiB, WS_H2U = 290 * MiB;
constexpr size_t WS_XS = 418 * MiB, WS_HMID = 690 * MiB, WS_Y = 418 * MiB;
constexpr size_t WS_TOKMAP = 930 * MiB, WS_SRSTD = 938 * MiB;
constexpr size_t WS_END = 946 * MiB;
constexpr size_t OUT_GR = 0, OUT_GM = 128 * MiB;
static_assert(WS_XS + (size_t)MAXROWS * 1024 * 2 <= WS_HMID && WS_HMID + (size_t)MAXROWS * 512 * 2 <= WS_END, "ws map");

struct TokInfo { int e0, p0, e1, p1; float w0, w1, rstd, pad; };

__device__ __forceinline__ float bflo(unsigned u) { return __uint_as_float(u << 16); }
__device__ __forceinline__ float bfhi(unsigned u) { return __uint_as_float(u & 0xffff0000u); }
__device__ __forceinline__ float bf2f(short s) { return __uint_as_float(((unsigned)(unsigned short)s) << 16); }
__device__ __forceinline__ unsigned cvtpk(float lo, float hi) { F2 v = {lo, hi}; bf16x2_t b = __builtin_convertvector(v, bf16x2_t); return __builtin_bit_cast(unsigned, b); }
__device__ __forceinline__ float wave_sum(float v) {
#pragma unroll
    for (int o = 1; o < 64; o <<= 1) v += __shfl_xor(v, o);
    return v;
}
__device__ __forceinline__ float sigm(float x) { return __builtin_amdgcn_rcpf(1.f + __expf(-x)); }
__device__ __forceinline__ float silu(float x) { return x * __builtin_amdgcn_rcpf(1.f + __expf(-x)); }
__device__ __forceinline__ float dot2bf(unsigned a, unsigned b, float c) { return __builtin_amdgcn_fdot2_f32_bf16(__builtin_bit_cast(bf16x2_t, a), __builtin_bit_cast(bf16x2_t, b), c, false); }
__device__ __forceinline__ int crow(int r, int hi) { return (r & 3) + 8 * (r >> 2) + 4 * hi; }
#define MFMA32(a, b, c) __builtin_amdgcn_mfma_f32_32x32x16_bf16((a), (b), (c), 0, 0, 0)
typedef short v4i16_t __attribute__((ext_vector_type(4)));
__device__ __forceinline__ S4 trrd(LAS const unsigned char* p) { return __builtin_bit_cast(S4, __builtin_amdgcn_ds_read_tr16_b64_v4i16((LAS v4i16_t*)p)); }
__device__ __forceinline__ void glds16(const void* gsrc, unsigned lds_dst) { unsigned keep;
    asm volatile("s_mov_b32 %0, m0\n\ts_mov_b32 m0, %2\n\ts_nop 0\n\tglobal_load_lds_dwordx4 %1, off\n\ts_mov_b32 m0, %0" : "=&s"(keep) : "v"(gsrc), "s"(lds_dst) : "memory"); }
__device__ __forceinline__ unsigned offb(unsigned row, unsigned ch) { return 256u * row + 16u * (ch ^ (((row & 3) << 2) | ((row >> 2) & 3))); }
__device__ __forceinline__ unsigned offv(unsigned row, unsigned ch) { return 128u * row + 16u * (ch ^ (((row >> 1) & 1) << 2)); }

#define XB_TMO      128
#define XB_XCNT(j)  (256  + 64 * (j))
#define XB_XSUB(j)  (1280 + 64 * (j))
#define XB_XGEN(j)  (2304 + 64 * (j))
#define XB_TOP      3328
#define XB_TOPGEN   3392
#define XCD_BAR_WORDS 3456
#define XB_SPIN_CAP (1u << 18)

__device__ __forceinline__ unsigned xb_ld(unsigned* p)              { return __hip_atomic_load(p, __ATOMIC_RELAXED, __HIP_MEMORY_SCOPE_AGENT); }
__device__ __forceinline__ unsigned xb_add(unsigned* p, unsigned v) { return __hip_atomic_fetch_add(p, v, __ATOMIC_RELAXED, __HIP_MEMORY_SCOPE_AGENT); }
__device__ __forceinline__ unsigned xb_xcc_id() { return (unsigned)__builtin_amdgcn_s_getreg((3 << 11) | 20) & 0xFu; }
#define XB_SPIN(cond, bar) do { unsigned _sp = 0; while (cond) { __builtin_amdgcn_s_sleep(1); \
    if ((++_sp & 255u) == 0u) { if (xb_ld(&(bar)[XB_TMO])) break; if (_sp > XB_SPIN_CAP) { atomicAdd(&(bar)[XB_TMO], 1u); break; } } } } while (0)

struct XcdBarrier {
    unsigned* bar; unsigned x;
    volatile LAS unsigned* st;
};

__device__ __forceinline__ XcdBarrier xcd_barrier_post(unsigned* bar, volatile LAS unsigned* st) {
    XcdBarrier b; b.bar = bar; b.x = xb_xcc_id(); b.st = st;
    if (threadIdx.x == 0) (void)xb_add(&bar[XB_XCNT(b.x)], 1u);
    return b;
}
__device__ __forceinline__ void xcd_barrier_complete(unsigned* bar, unsigned x, unsigned& nloc, unsigned& nx) {
    const unsigned G = gridDim.x * gridDim.y * gridDim.z;
    unsigned sum, cnt, mine, sp = 0u;
    for (;;) {
        sum = 0u; cnt = 0u; mine = 0u;
#pragma unroll
        for (unsigned j = 0; j < 16; ++j) { const unsigned c = xb_ld(&bar[XB_XCNT(j)]); sum += c; cnt += (c > 0u) ? 1u : 0u; mine = (j == x) ? c : mine; }
        if (sum == G) break;
        __builtin_amdgcn_s_sleep(1);
        if ((++sp & 255u) == 0u) { if (xb_ld(&bar[XB_TMO])) break; if (sp > XB_SPIN_CAP) { atomicAdd(&bar[XB_TMO], 1u); break; } }
    }
    nloc = mine > 0u ? mine : 1u; nx = cnt > 0u ? cnt : 1u;
}

__device__ __forceinline__ void xcd_barrier(const XcdBarrier& b) {
    asm volatile("s_waitcnt vmcnt(0)" ::: "memory");
    __syncthreads();
    if (threadIdx.x == 0) {
        unsigned* bar = b.bar;
        __builtin_amdgcn_s_waitcnt(0);
        unsigned nloc = b.st[0], nx = b.st[1];
        if (nloc == 0u) { xcd_barrier_complete(bar, b.x, nloc, nx); b.st[0] = nloc; b.st[1] = nx; }
        const unsigned old = xb_add(&bar[XB_XSUB(b.x)], 1u);
        const unsigned gen = old / nloc;
        if (old + 1u == (gen + 1u) * nloc) {
            __builtin_amdgcn_fence(__ATOMIC_RELEASE, "agent");
            asm volatile("s_waitcnt vmcnt(0)" ::: "memory");
            const unsigned og = xb_add(&bar[XB_TOP], 1u);
            const unsigned tg = og / nx;
            if (og + 1u == (tg + 1u) * nx) xb_add(&bar[XB_TOPGEN], 1u);
            else XB_SPIN(xb_ld(&bar[XB_TOPGEN]) == tg, bar);
            __builtin_amdgcn_fence(__ATOMIC_ACQUIRE, "agent");
            xb_add(&bar[XB_XGEN(b.x)], 1u);
            asm volatile("s_waitcnt vmcnt(0)" ::: "memory");
        } else {
            XB_SPIN(xb_ld(&bar[XB_XGEN(b.x)]) == gen, bar);
            __builtin_amdgcn_fence(__ATOMIC_ACQUIRE, "agent");
            asm volatile("s_waitcnt vmcnt(0)" ::: "memory");
        }
    }
    __syncthreads();
}

namespace pg8 {
struct EpiProj {
    static constexpr bool PERM = true, AFTER_DRAIN = false, MIDK = false;
    unsigned char* ws; unsigned char* ob;
    __device__ __forceinline__ void operator()(const f32x4 (&acc)[2][2][4][2], const Unit& u, int wr, int wc, int fr, int fq) const {
        const int pn = u.pn; bf16_t* base; int ld, ct;
        if (pn < 2)       { base = (bf16_t*)(ws + WS_RQ); ld = 512;  ct = pn; }
        else if (pn < 4)  { base = (bf16_t*)(ws + WS_RK); ld = 512;  ct = pn - 2; }
        else if (pn < 8)  { base = (bf16_t*)(ws + WS_RV); ld = 1024; ct = pn - 4; }
        else if (pn < 12) { base = (bf16_t*)(ws + WS_RG); ld = 1024; ct = pn - 8; }
        else if (pn < 14) { base = (bf16_t*)(ws + WS_MQ); ld = 512;  ct = pn - 12; }
        else if (pn < 16) { base = (bf16_t*)(ws + WS_MK); ld = 512;  ct = pn - 14; }
        else if (pn < 20) { base = (bf16_t*)(ws + WS_MV); ld = 1024; ct = pn - 16; }
        else if (pn < 24) { base = (bf16_t*)(ws + WS_MO); ld = 1024; ct = pn - 20; }
        else if (pn < 28) { base = (bf16_t*)(ob + OUT_GR); ld = 1024; ct = pn - 24; }
        else              { base = (bf16_t*)(ob + OUT_GM); ld = 1024; ct = pn - 28; }
        int row0 = u.pm * BM + wr * 64 + fr, col0 = ct * BM + wc * 32 + 8 * fq;
        asm volatile("" : "+v"(row0), "+v"(col0));
        if (pn < 4) {
            const int hd = (pn & 1) * 2 + (wc >> 1), d1 = 32 * (wc & 1) + 8 * fq;
            const float lg = hd == 0 ? -0.04580368961312479f : (hd == 1 ? -0.02272007650008353f : (hd == 2 ? -0.011315313227834146f : -0.005646563141142063f));
            const float2* RT = (const float2*)(ws + WS_ROPE);
#pragma unroll
            for (int ai = 0; ai < 2; ++ai)
#pragma unroll
                for (int m = 0; m < 4; ++m) { const int r = row0 + ai * HALF + m * 16, pos = r & (SEQ - 1), l = r & (CHUNK - 1);
                    const float sc = pn < 2 ? exp2f(lg * (float)l) : exp2f(-lg * (float)l) * 0.08838834764831845f;
                    const f32x4* rt = (const f32x4*)(RT + (size_t)pos * 64 + d1);
                    const f32x4 c0 = rt[0], c1 = rt[1], c2 = rt[2], c3 = rt[3];
                    const f32x4 a0 = acc[ai][0][m][0], a1 = acc[ai][0][m][1], b0 = acc[ai][1][m][0], b1 = acc[ai][1][m][1];
                    u32x4 w1, w2;
                    w1.x = cvt_pk_bf16((a0[0] * c0[0] - b0[0] * c0[1]) * sc, (a0[1] * c0[2] - b0[1] * c0[3]) * sc); w1.y = cvt_pk_bf16((a0[2] * c1[0] - b0[2] * c1[1]) * sc, (a0[3] * c1[2] - b0[3] * c1[3]) * sc);
                    w1.z = cvt_pk_bf16((a1[0] * c2[0] - b1[0] * c2[1]) * sc, (a1[1] * c2[2] - b1[1] * c2[3]) * sc); w1.w = cvt_pk_bf16((a1[2] * c3[0] - b1[2] * c3[1]) * sc, (a1[3] * c3[2] - b1[3] * c3[3]) * sc);
                    w2.x = cvt_pk_bf16((b0[0] * c0[0] + a0[0] * c0[1]) * sc, (b0[1] * c0[2] + a0[1] * c0[3]) * sc); w2.y = cvt_pk_bf16((b0[2] * c1[0] + a0[2] * c1[1]) * sc, (b0[3] * c1[2] + a0[3] * c1[3]) * sc);
                    w2.z = cvt_pk_bf16((b1[0] * c2[0] + a1[0] * c2[1]) * sc, (b1[1] * c2[2] + a1[1] * c2[3]) * sc); w2.w = cvt_pk_bf16((b1[2] * c3[0] + a1[2] * c3[1]) * sc, (b1[3] * c3[2] + a1[3] * c3[3]) * sc);
                    bf16_t* rowp = base + (size_t)r * 512 + hd * 128 + d1;
                    *(u32x4*)rowp = w1; *(u32x4*)(rowp + 64) = w2; }
            return;
        }
#pragma unroll
        for (int ai = 0; ai < 2; ++ai)
#pragma unroll
            for (int m = 0; m < 4; ++m) { bf16_t* rowp = base + (size_t)(row0 + ai * HALF + m * 16) * ld + col0;
#pragma unroll
                for (int bj = 0; bj < 2; ++bj) { f32x4 v0 = acc[ai][bj][m][0], v1 = acc[ai][bj][m][1];
                    if (pn >= 24) { v0[0] = sigm(v0[0]); v0[1] = sigm(v0[1]); v0[2] = sigm(v0[2]); v0[3] = sigm(v0[3]); v1[0] = sigm(v1[0]); v1[1] = sigm(v1[1]); v1[2] = sigm(v1[2]); v1[3] = sigm(v1[3]); }
                    u32x4 w; w.x = cvt_pk_bf16(v0[0], v0[1]); w.y = cvt_pk_bf16(v0[2], v0[3]); w.z = cvt_pk_bf16(v1[0], v1[1]); w.w = cvt_pk_bf16(v1[2], v1[3]);
                    *(u32x4*)(rowp + bj * HALF) = w; } }
    }
};
struct EpiGateFused {
    static constexpr bool PERM = true, AFTER_DRAIN = false, MIDK = true;
    const bf16_t* GR; const bf16_t* GM; bf16_t* O;
    __device__ __forceinline__ void midk(f32x4 (&acc)[2][2][4][2], const Unit& u, int wr, int wc, int fr, int fq) const {
        int row0 = u.pm * BM + wr * 64 + fr, col0 = u.pn * BM + wc * 32 + 8 * fq;
        asm volatile("" : "+v"(row0), "+v"(col0));
#pragma unroll
        for (int ai = 0; ai < 2; ++ai) {
#pragma unroll
            for (int m = 0; m < 4; ++m) { const size_t ro = (size_t)(row0 + ai * HALF + m * 16) * 1024 + col0;
#pragma unroll
                for (int bj = 0; bj < 2; ++bj) {
                    const u32x4 a = *(const u32x4*)(GR + ro + bj * HALF), b = *(const u32x4*)(GM + ro + bj * HALF);
                    f32x4 r0, r1;
                    r0[0] = bflo(a.x) * __builtin_amdgcn_rcpf(bflo(b.x)); r0[1] = bfhi(a.x) * __builtin_amdgcn_rcpf(bfhi(b.x)); r0[2] = bflo(a.y) * __builtin_amdgcn_rcpf(bflo(b.y)); r0[3] = bfhi(a.y) * __builtin_amdgcn_rcpf(bfhi(b.y));
                    r1[0] = bflo(a.z) * __builtin_amdgcn_rcpf(bflo(b.z)); r1[1] = bfhi(a.z) * __builtin_amdgcn_rcpf(bfhi(b.z)); r1[2] = bflo(a.w) * __builtin_amdgcn_rcpf(bflo(b.w)); r1[3] = bfhi(a.w) * __builtin_amdgcn_rcpf(bfhi(b.w));
                    acc[ai][bj][m][0] *= r0; acc[ai][bj][m][1] *= r1; } }
            asm volatile("" ::: "memory"); }
    }
    __device__ __forceinline__ void operator()(const f32x4 (&acc)[2][2][4][2], const Unit& u, int wr, int wc, int fr, int fq) const {
        int row0 = u.pm * BM + wr * 64 + fr, col0 = u.pn * BM + wc * 32 + 8 * fq;
        asm volatile("" : "+v"(row0), "+v"(col0));
#pragma unroll
        for (int ai = 0; ai < 2; ++ai)
#pragma unroll
            for (int m = 0; m < 4; ++m) { const size_t ro = (size_t)(row0 + ai * HALF + m * 16) * 1024 + col0;
#pragma unroll
                for (int bj = 0; bj < 2; ++bj) { const f32x4 v0 = acc[ai][bj][m][0], v1 = acc[ai][bj][m][1];
                    const u32x4 g = *(const u32x4*)(GM + ro + bj * HALF);
                    u32x4 w; w.x = cvt_pk_bf16(v0[0] * bflo(g.x), v0[1] * bfhi(g.x)); w.y = cvt_pk_bf16(v0[2] * bflo(g.y), v0[3] * bfhi(g.y));
                    w.z = cvt_pk_bf16(v1[0] * bflo(g.z), v1[1] * bfhi(g.z)); w.w = cvt_pk_bf16(v1[2] * bflo(g.w), v1[3] * bfhi(g.w));
                    *(u32x4*)(O + ro + bj * HALF) = w; } }
    }
};
struct EpiX1 {
    static constexpr bool PERM = true, AFTER_DRAIN = false, MIDK = false;
    const float* X; float* O;
    __device__ __forceinline__ void operator()(const f32x4 (&acc)[2][2][4][2], const Unit& u, int wr, int wc, int fr, int fq) const {
        const int row0 = u.pm * BM + wr * 64 + fr, col0 = u.pn * BM + wc * 32 + 8 * fq;
#pragma unroll
        for (int ai = 0; ai < 2; ++ai)
#pragma unroll
            for (int m = 0; m < 4; ++m) { const size_t ro = (size_t)(row0 + ai * HALF + m * 16) * 1024 + col0;
#pragma unroll
                for (int bj = 0; bj < 2; ++bj) {
                    const f32x4 a = *(const f32x4*)(X + ro + bj * HALF), b = *(const f32x4*)(X + ro + bj * HALF + 4);
                    *(f32x4*)(O + ro + bj * HALF) = a + acc[ai][bj][m][0]; *(f32x4*)(O + ro + bj * HALF + 4) = b + acc[ai][bj][m][1]; } }
    }
};
struct EpiSwiglu {
    static constexpr bool PERM = true, AFTER_DRAIN = false, MIDK = false;
    bf16_t* O; const float* srstd;
    __device__ __forceinline__ void operator()(const f32x4 (&acc)[2][2][4][2], const Unit& u, int wr, int wc, int fr, int fq) const {
        const int row0 = u.pm * BM + wr * 64 + fr, col0 = (u.pn & 3) * HALF + wc * 32 + 8 * fq;
        float rs[2][4];
#pragma unroll
        for (int ai = 0; ai < 2; ++ai)
#pragma unroll
            for (int m = 0; m < 4; ++m) rs[ai][m] = srstd[u.pa + wr * 64 + fr + ai * HALF + m * 16];
#pragma unroll
        for (int ai = 0; ai < 2; ++ai)
#pragma unroll
            for (int m = 0; m < 4; ++m) { bf16_t* rowp = O + (size_t)(row0 + ai * HALF + m * 16) * 512 + col0; const float r = rs[ai][m];
                const f32x4 g0 = acc[ai][0][m][0] * r, g1 = acc[ai][0][m][1] * r, u0 = acc[ai][1][m][0] * r, u1 = acc[ai][1][m][1] * r;
                u32x4 w; w.x = cvt_pk_bf16(silu(g0[0]) * u0[0], silu(g0[1]) * u0[1]); w.y = cvt_pk_bf16(silu(g0[2]) * u0[2], silu(g0[3]) * u0[3]);
                w.z = cvt_pk_bf16(silu(g1[0]) * u1[0], silu(g1[1]) * u1[1]); w.w = cvt_pk_bf16(silu(g1[2]) * u1[2], silu(g1[3]) * u1[3]);
                *(u32x4*)rowp = w; }
    }
};
struct EpiY {
    static constexpr bool PERM = true, AFTER_DRAIN = false, MIDK = false;
    bf16_t* O;
    __device__ __forceinline__ void operator()(const f32x4 (&acc)[2][2][4][2], const Unit& u, int wr, int wc, int fr, int fq) const {
        const int row0 = u.pm * BM + wr * 64 + fr, col0 = (u.pn & 3) * BM + wc * 32 + 8 * fq;
#pragma unroll
        for (int ai = 0; ai < 2; ++ai)
#pragma unroll
            for (int m = 0; m < 4; ++m) { bf16_t* rowp = O + (size_t)(row0 + ai * HALF + m * 16) * 1024 + col0;
#pragma unroll
                for (int bj = 0; bj < 2; ++bj) { const f32x4 v0 = acc[ai][bj][m][0], v1 = acc[ai][bj][m][1];
                    u32x4 w; w.x = cvt_pk_bf16(v0[0], v0[1]); w.y = cvt_pk_bf16(v0[2], v0[3]); w.z = cvt_pk_bf16(v1[0], v1[1]); w.w = cvt_pk_bf16(v1[2], v1[3]);
                    *(u32x4*)(rowp + bj * HALF) = w; } }
    }
};
template <bool GATHER_> struct GroupedOrder {
    static constexpr bool GATHER = GATHER_;
    int ntiles, G, c; const PG8_LAS unsigned char* t2e; const PG8_LAS int* rb; const int* tokmap;
    __device__ __forceinline__ bool next(int i, Unit& u) const {
        const int L = i * G + c; if (L >= ntiles * 4) return false;
        const int rt = L >> 2; const int e = __builtin_amdgcn_readfirstlane((int)t2e[rt]);
        u.pm = rt; u.pn = e * 4 + (L & 3); u.pa = e * 65536 + ((rt - (__builtin_amdgcn_readfirstlane(rb[e]) >> 8)) << 8); return true;
    }
    __device__ __forceinline__ unsigned arow(const Unit& u, int r) const { const unsigned t = (unsigned)tokmap[u.pa + r]; return t < (unsigned)NTOK ? t : (unsigned)(NTOK - 1); }
    __device__ __forceinline__ void a_ready(const Unit&) const {}
    __device__ __forceinline__ void done(const Unit&) const {}
};
}

struct Ctx { LAS unsigned char* lds; int tid, lane, wave, vcu, G; };

__device__ __forceinline__ void transpose_item(const float* W, int ld, int k0, int n0, bf16* WT, int K, int drow0, LAS float* scr, int lane, int kdst = 0) {
#pragma unroll 8
    for (int i = 0; i < 32; ++i) { const int kk = 2 * i + (lane >> 5); scr[kk * 33 + (lane & 31)] = W[(size_t)(k0 + kk) * ld + n0 + (lane & 31)]; }
    asm volatile("s_waitcnt lgkmcnt(0)" ::: "memory");
    const int c = lane & 7;
#pragma unroll
    for (int j = 0; j < 4; ++j) { const int n = (lane >> 3) + 8 * j; const LAS float* s = scr + (8 * c) * 33 + n;
        U4 o; o.x = cvtpk(s[0 * 33], s[1 * 33]); o.y = cvtpk(s[2 * 33], s[3 * 33]); o.z = cvtpk(s[4 * 33], s[5 * 33]); o.w = cvtpk(s[6 * 33], s[7 * 33]);
        *(U4*)(WT + (size_t)(drow0 + n) * K + kdst + k0 + 8 * c) = o; }
    asm volatile("s_waitcnt lgkmcnt(0)" ::: "memory");
}

__device__ __forceinline__ void phase0(const Ctx& C, const float* const* in, unsigned char* ws) {
    const float* x = in[0]; const float* nw = in[1]; const float* w_in = in[2];
    LAS float* scr = (LAS float*)(C.lds + C.wave * 8448);
    LAS float* wif = (LAS float*)(C.lds + 98304);
    LAS double* invf = (LAS double*)(C.lds + 98304 + 32768);
    for (int i = C.tid; i < 8192; i += NTHR) { const int c = i & 3, e = i >> 2, l = e & 63, jj = (e >> 6) & 15, p = e >> 10; const int k = 4 * l + 256 * (jj >> 2) + (jj & 3);
        wif[i] = w_in[(size_t)k * DIN + 6144 + 4 * p + c]; }
    if (C.tid < 64) { double r = 1.0; for (int j = 0; j < C.tid; ++j) r *= 0.8659643233600653; invf[C.tid] = r; }
    __syncthreads();
    const int gw = C.vcu * NWAVES + C.wave, NGW = C.G * NWAVES;
    {
        bf16* H = (bf16*)(ws + WS_H); float* IFP = (float*)(ws + WS_IF);
        F4 wv[4];
#pragma unroll
        for (int j = 0; j < 4; ++j) wv[j] = *(const F4*)(nw + 4 * C.lane + 256 * j);
        for (int m = gw; m < NTOK; m += NGW) {
            const F4* xr = (const F4*)(x + (size_t)m * DM) + C.lane;
            F4 v[4]; float s = 0.f;
#pragma unroll
            for (int j = 0; j < 4; ++j) { v[j] = xr[64 * j]; s += (v[j].x * v[j].x + v[j].y * v[j].y) + (v[j].z * v[j].z + v[j].w * v[j].w); }
            const float rstd = rsqrtf(wave_sum(s) * (1.f / DM) + EPS);
            float g[8];
#pragma unroll
            for (int c = 0; c < 8; ++c) g[c] = 0.f;
            unsigned long long* o8 = (unsigned long long*)(H + (size_t)m * DM) + C.lane;
#pragma unroll
            for (int j = 0; j < 4; ++j) { v[j] = v[j] * rstd * wv[j];
                o8[64 * j] = (unsigned long long)cvtpk(v[j].x, v[j].y) | ((unsigned long long)cvtpk(v[j].z, v[j].w) << 32);
#pragma unroll
                for (int i = 0; i < 4; ++i) { const LAS F4* wp = (const LAS F4*)wif + (j * 4 + i) * 64 + C.lane; const F4 wa = wp[0], wb = wp[1024]; const float hv = v[j][i];
                    g[0] += hv * wa.x; g[1] += hv * wa.y; g[2] += hv * wa.z; g[3] += hv * wa.w; g[4] += hv * wb.x; g[5] += hv * wb.y; g[6] += hv * wb.z; g[7] += hv * wb.w; } }
#pragma unroll
            for (int c = 0; c < 8; ++c) g[c] = wave_sum(g[c]);
            if (C.lane == 0) { F4* op = (F4*)(IFP + (size_t)m * 8); op[0] = (F4){g[0], g[1], g[2], g[3]}; op[1] = (F4){g[4], g[5], g[6], g[7]}; }
        }
    }
    for (int it = gw; it < 4096 + 3 * 512; it += NGW) {
        if (it < 4096) { const int kb = it >> 8, nb = it & 255; int src = nb * 32 + (nb >= 192 ? 8 : 0);
            if (nb < 32) { const int p0 = (nb * 32) & 255, q0 = p0 & 127; src = (nb >> 3) * 256 + (q0 >> 6) * 128 + (q0 & 63) + 64 * (p0 >> 7); }
            transpose_item(w_in, DIN, kb * 64, src, (bf16*)(ws + WS_WIN), 1024, nb * 32, scr, C.lane); }
        else { int r = it - 4096; const int mth = r >> 9; r &= 511; const int kb = r >> 5, nb = r & 31;
            const float* W = mth == 0 ? in[4] : (mth == 1 ? in[10] : in[11]);
            if (mth < 2) transpose_item(W, 1024, kb * 64, nb * 32, (bf16*)(ws + WS_WCAT), 2048, nb * 32, scr, C.lane, mth * 1024);
            else transpose_item(W, 1024, kb * 64, nb * 32, (bf16*)(ws + WS_WOUT), 1024, nb * 32, scr, C.lane); }
    }
    { F2* RT = (F2*)(ws + WS_ROPE);
        for (int idx = C.vcu * NTHR + C.tid; idx < SEQ * 64; idx += C.G * NTHR) { const int pos = idx >> 6, j = idx & 63;
            const double rev = (double)pos * invf[j] * 0.15915494309189535; const float fr = (float)(rev - __builtin_floor(rev));
            RT[idx] = (F2){__builtin_amdgcn_cosf(fr), __builtin_amdgcn_sinf(fr)}; } }
    { F4* WR = (F4*)(ws + WS_ROUT); const float* nfw = in[12]; const float* wg = in[13]; const float* we = in[15];
        for (int idx = C.vcu * NTHR + C.tid; idx < 32 * 3 * 2 * 64; idx += C.G * NTHR) { const int l = idx & 63, half = (idx >> 6) & 1, nt = (idx >> 7) % 3, kb2 = idx / 384; const int n = 16 * nt + (l & 15);
            F4 o;
#pragma unroll
            for (int j = 0; j < 4; ++j) { const int k = 32 * kb2 + 8 * (l >> 4) + 4 * half + j; float wv = 0.f; if (n < 4) wv = wg[k * 4 + n]; else if (n < 36) wv = we[k * 32 + (n - 4)]; o[j] = wv * nfw[k]; }
            WR[idx] = o; } }
}

__device__ __forceinline__ float wscan_add(float v, int lane) {
#pragma unroll
    for (int o = 1; o < 64; o <<= 1) { const float t = __shfl_up(v, o); if (lane >= o) v += t; }
    return v;
}
__device__ __forceinline__ float wscan_max(float v, int lane) {
#pragma unroll
    for (int o = 1; o < 64; o <<= 1) { const float t = __shfl_up(v, o); if (lane >= o) v = fmaxf(v, t); }
    return v;
}
__device__ __forceinline__ void phase2(const Ctx& C, const float* const* in, unsigned char* ws) {
    const float* convw = in[5]; const float* convb = in[6]; const float* b_i = in[7]; const float* b_f = in[8];
    LAS float* sQ = (LAS float*)(C.lds);
    LAS float* sK = (LAS float*)(C.lds + 2048);
    const float* IFP = (const float*)(ws + WS_IF); float* THR = (float*)(ws + WS_THR); float* CDEC = (float*)(ws + WS_CDEC);
    const F2* RT = (const F2*)(ws + WS_ROPE);
    for (int it = C.vcu; it < BATCH * NCHUNK; it += C.G) {
        const int b = it >> 6, c = it & 63; const size_t t0 = (size_t)b * SEQ + (size_t)c * CHUNK;
        __syncthreads();
        if (C.wave < 4) { const int hd = C.wave, l = C.lane;
            const float i0 = IFP[(t0 + 2 * l) * 8 + hd] + b_i[hd], i1 = IFP[(t0 + 2 * l + 1) * 8 + hd] + b_i[hd];
            const float f0 = IFP[(t0 + 2 * l) * 8 + 4 + hd] + b_f[hd], f1 = IFP[(t0 + 2 * l + 1) * 8 + 4 + hd] + b_f[hd];
            const float lf0 = fminf(f0, 0.f) - log1pf(__expf(-fabsf(f0))), lf1 = fminf(f1, 0.f) - log1pf(__expf(-fabsf(f1)));
            const float s1 = lf0 + lf1, inc = wscan_add(s1, l), ex = inc - s1;
            const float b0 = ex + lf0, b1 = ex + s1;
            const float u0 = i0 - b0, u1 = i1 - b1, p1 = fmaxf(u0, u1);
            const float pin = wscan_max(p1, l); float pex = __shfl_up(pin, 1); if (l == 0) pex = -INFINITY;
            const float pm0 = fmaxf(pex, u0), pm1 = fmaxf(pex, p1);
            sQ[hd * 128 + 2 * l] = __expf(-pm0); sQ[hd * 128 + 2 * l + 1] = __expf(-pm1);
            sK[hd * 128 + 2 * l] = __expf(u0) * 0.08838834764831845f; sK[hd * 128 + 2 * l + 1] = __expf(u1) * 0.08838834764831845f;
            THR[(t0 + 2 * l) * 4 + hd] = __expf(-b0 - pm0); THR[(t0 + 2 * l + 1) * 4 + hd] = __expf(-b1 - pm1);
            if (l == 63) CDEC[(size_t)it * 4 + hd] = __expf(b1);
        }
        __syncthreads();
        for (int u = C.tid; u < 2 * 8192; u += NTHR) {
            const int arr = u >> 13, g = u & 63, row = (u >> 6) & 127, hd = g >> 4;
            const bf16* src = (const bf16*)(ws + (arr ? WS_MK : WS_MQ)) + (t0 + row) * 512 + 8 * g;
            const int chn = arr * 512 + 8 * g;
            float y[8];
            { const F4 b0 = *(const F4*)(convb + chn), b1 = *(const F4*)(convb + chn + 4); y[0] = b0.x; y[1] = b0.y; y[2] = b0.z; y[3] = b0.w; y[4] = b1.x; y[5] = b1.y; y[6] = b1.z; y[7] = b1.w; }
#pragma unroll
            for (int w = 0; w < 4; ++w) { const int back = 3 - w;
                if (c * CHUNK + row - back >= 0) { const U4 a = *(const U4*)(src - (size_t)back * 512);
                    const F4 w0 = *(const F4*)(convw + w * 1024 + chn), w1 = *(const F4*)(convw + w * 1024 + chn + 4);
                    y[0] += bflo(a.x) * w0.x; y[1] += bfhi(a.x) * w0.y; y[2] += bflo(a.y) * w0.z; y[3] += bfhi(a.y) * w0.w;
                    y[4] += bflo(a.z) * w1.x; y[5] += bfhi(a.z) * w1.y; y[6] += bflo(a.w) * w1.z; y[7] += bfhi(a.w) * w1.w; } }
            const float sc = arr ? sK[hd * 128 + row] : sQ[hd * 128 + row];
#pragma unroll
            for (int i = 0; i < 8; ++i) y[i] = silu(y[i]) * sc;
            U4 o; o.x = cvtpk(y[0], y[1]); o.y = cvtpk(y[2], y[3]); o.z = cvtpk(y[4], y[5]); o.w = cvtpk(y[6], y[7]);
            *(U4*)((bf16*)(ws + (arr ? WS_MKP : WS_MQP)) + (t0 + row) * 512 + 8 * g) = o;
        }
    }
}

template <bool ML, int ABL = 0>
__device__ __forceinline__ void mixer_item(const Ctx& C, const bf16* Qp, const bf16* Kp, bf16* Vp, bf16* Vout, size_t omask, const float* thr, const float* cdec, int b, int hd, int sl) {
    LAS unsigned char* lds = C.lds;
    const int tid = C.tid, lane = C.lane, w = C.wave, l31 = lane & 31, hi = lane >> 5;
    const int lt = (w < 4) ? w : 7 - w, et = w >> 2, dt = w & 3;
    const int q_ = (lane & 15) >> 2, p_ = lane & 3, blk = (lane >> 4) & 1;
    constexpr unsigned KOFF = 0, VOFF = 65536, QOFF = 98304, SOFF = 131072, NOFF = 147456;
    const size_t tok0 = (size_t)b * SEQ;
    const float rdec = hd == 0 ? 0.017183023570817902f : (hd == 1 ? 0.1332151628796484f : (hd == 2 ? 0.3664377159220373f : 0.6059370882290803f));
    __syncthreads();
    for (int i = tid; i < 16384 / 16; i += NTHR) *(LAS U4*)(lds + SOFF + 16 * i) = (U4){0u, 0u, 0u, 0u};
    if (tid < 384) *(LAS float*)(lds + NOFF + 4 * tid) = 0.f;
    F16 St;
#pragma unroll
    for (int r = 0; r < 16; ++r) St[r] = 0.f;
    B8 qf[8];
    const unsigned lds0 = (unsigned)(uintptr_t)lds;
    unsigned ro[8];
#pragma unroll
    for (int s = 0; s < 8; ++s) ro[s] = offb(l31, 2 * s + hi);
    const unsigned kbase = (16 * w + (lane >> 4)) * 512, kx = (lane & 15) ^ ((lane >> 4) << 2);
    const unsigned vbase = (16 * w + (lane >> 3)) * 1024 + ((lane & 7) ^ (((lane >> 4) & 1) << 2)) * 8;
#define ksrc_(i) (kbase + (i) * 2048 + ((kx ^ (i)) * 8))
#define vsrc_(i) (vbase + (i) * 8192)
#define MX_DMA(cc, buf) do { \
        const bf16* kp_ = Kp + (tok0 + (size_t)(cc) * CHUNK) * 512 + hd * 128; \
        _Pragma("unroll") for (int i = 0; i < 4; ++i) glds16(kp_ + ksrc_(i), (unsigned)__builtin_amdgcn_readfirstlane((int)(lds0 + KOFF + (buf) * 32768 + (w * 4 + i) * 1024))); \
        const bf16* vp_ = Vp + (tok0 + (size_t)(cc) * CHUNK) * 1024 + hd * 256 + sl * 64; \
        _Pragma("unroll") for (int i = 0; i < 2; ++i) glds16(vp_ + vsrc_(i), (unsigned)__builtin_amdgcn_readfirstlane((int)(lds0 + VOFF + (buf) * 16384 + (w * 2 + i) * 1024))); \
        const bf16* qp_ = Qp + (tok0 + (size_t)(cc) * CHUNK) * 512 + hd * 128; \
        _Pragma("unroll") for (int i = 0; i < 4; ++i) glds16(qp_ + ksrc_(i), (unsigned)__builtin_amdgcn_readfirstlane((int)(lds0 + QOFF + (w * 4 + i) * 1024))); \
        } while (0)
    float thn = 1.f, dcn = rdec;
    MX_DMA(0, 0);
    if (ML) { thn = thr[(tok0 + 32 * lt + l31) * 4 + hd]; dcn = cdec[((size_t)b * NCHUNK) * 4 + hd]; }
    asm volatile("s_waitcnt vmcnt(0)" ::: "memory");
    __syncthreads();
    for (int c = 0; c < NCHUNK; ++c) {
        const int cur = c & 1, nxt = cur ^ 1;
        const unsigned KB = KOFF + cur * 32768, VB = VOFF + cur * 16384;
        const float th = thn, decay = dcn;
        B8 af[8];
#pragma unroll
        for (int s = 0; s < 8; ++s) qf[s] = *(const LAS B8*)(lds + (QOFF + 8192 * lt) + ro[s]);
#pragma unroll
        for (int s = 0; s < 8; ++s) af[s] = *(const LAS B8*)(lds + (SOFF + 8192 * et) + ro[s]);
        F16 o;
#pragma unroll
        for (int r = 0; r < 16; ++r) o[r] = 0.f;
#pragma unroll
        for (int s = 0; s < 8; ++s) { o = MFMA32(af[s], qf[s], o); af[s] = *(const LAS B8*)(lds + KB + ro[s]); }
        asm volatile("s_waitcnt lgkmcnt(0)" ::: "memory");
        __syncthreads();
        if (c + 1 < NCHUNK) { if (!(ABL & 4)) MX_DMA(c + 1, nxt);
            if (ML) { thn = thr[(tok0 + (size_t)(c + 1) * CHUNK + 32 * lt + l31) * 4 + hd]; dcn = cdec[((size_t)b * NCHUNK + c + 1) * 4 + hd]; } }
        float csum = 0.f;
        for (int jt = 0; jt <= lt; ++jt) {
            F16 st;
#pragma unroll
            for (int r = 0; r < 16; ++r) st[r] = 0.f;
            S4 vfr[4];
#pragma unroll
            for (int s2 = 0; s2 < 2; ++s2) { const unsigned R0 = 32 * jt + 16 * s2 + 4 * hi + q_, chv = 4 * et + 2 * blk + (p_ >> 1);
                vfr[2 * s2] = trrd(lds + VB + offv(R0, chv) + 8 * (p_ & 1)); vfr[2 * s2 + 1] = trrd(lds + VB + offv(R0 + 8, chv) + 8 * (p_ & 1)); }
#pragma unroll
            for (int s = 0; s < 8; ++s) { st = MFMA32(af[s], qf[s], st); af[s] = *(const LAS B8*)(lds + (KB + 8192 * (jt + 1)) + ro[s]); }
            if (jt == lt) {
#pragma unroll
                for (int r = 0; r < 16; ++r) if (crow(r, hi) > l31) st[r] = 0.f;
            }
            if (ML) {
#pragma unroll
                for (int r = 0; r < 16; ++r) csum += st[r];
            }
#pragma unroll
            for (int s2 = 0; s2 < 2; ++s2) {
                U4 pk; pk.x = cvtpk(st[8 * s2 + 0], st[8 * s2 + 1]); pk.y = cvtpk(st[8 * s2 + 2], st[8 * s2 + 3]); pk.z = cvtpk(st[8 * s2 + 4], st[8 * s2 + 5]); pk.w = cvtpk(st[8 * s2 + 6], st[8 * s2 + 7]);
                const B8 bfr = __builtin_bit_cast(B8, pk);
                const B8 afr = __builtin_shufflevector(vfr[2 * s2], vfr[2 * s2 + 1], 0, 1, 2, 3, 4, 5, 6, 7);
                o = MFMA32(afr, bfr, o);
            }
        }
        if (ML) {
            float qd = 0.f;
#pragma unroll
            for (int s = 0; s < 8; ++s) { const U4 nv = *(const LAS U4*)(lds + NOFF + 1024 + cur * 256 + (16 * s + 8 * hi) * 2); const U4 qv = __builtin_bit_cast(U4, qf[s]);
                qd = dot2bf(qv.x, nv.x, qd); qd = dot2bf(qv.y, nv.y, qd); qd = dot2bf(qv.z, nv.z, qd); qd = dot2bf(qv.w, nv.w, qd); }
            csum += __shfl_xor(csum, 32); qd += __shfl_xor(qd, 32);
            const float den = csum + qd;
            const float sc = 1.f / fmaxf(fabsf(den), th);
#pragma unroll
            for (int r = 0; r < 16; ++r) o[r] *= sc;
        }
        { unsigned pk[8];
#pragma unroll
            for (int g = 0; g < 4; ++g) { pk[2 * g] = cvtpk(o[4 * g], o[4 * g + 1]); pk[2 * g + 1] = cvtpk(o[4 * g + 2], o[4 * g + 3]); }
            U4 s0, s1;
            { auto ra = __builtin_amdgcn_permlane32_swap(pk[0], pk[2], false, false); auto rb = __builtin_amdgcn_permlane32_swap(pk[1], pk[3], false, false);
              s0.x = ra[0]; s0.y = rb[0]; s0.z = ra[1]; s0.w = rb[1]; }
            { auto ra = __builtin_amdgcn_permlane32_swap(pk[4], pk[6], false, false); auto rb = __builtin_amdgcn_permlane32_swap(pk[5], pk[7], false, false);
              s1.x = ra[0]; s1.y = rb[0]; s1.z = ra[1]; s1.w = rb[1]; }
            bf16* op = Vout + ((tok0 + (size_t)c * CHUNK + 32 * lt + l31) & omask) * 1024 + hd * 256 + sl * 64 + 32 * et + 8 * hi;
            if (ABL & 2) { asm volatile("" :: "v"(s0), "v"(s1)); } else { *(U4*)op = s0; *(U4*)(op + 16) = s1; } }
        float ksum = 0.f;
        { const unsigned chk = 4 * dt + 2 * blk + (p_ >> 1), chv = 4 * et + 2 * blk + (p_ >> 1);
          const unsigned ka0 = KB + offb(8 * hi + q_, chk) + 8 * (p_ & 1), ka1 = KB + offb(8 * hi + q_ + 4, chk) + 8 * (p_ & 1);
          const unsigned va0 = VB + offv(8 * hi + q_, chv) + 8 * (p_ & 1), va1 = VB + offv(8 * hi + q_ + 4, chv) + 8 * (p_ & 1);
          S4 ua[2][2], ub[2][2];
          ua[0][0] = trrd(lds + ka0); ua[0][1] = trrd(lds + ka1); ub[0][0] = trrd(lds + va0); ub[0][1] = trrd(lds + va1);
#pragma unroll
          for (int ks = 0; ks < 8; ++ks) { const int cu = ks & 1, nx = cu ^ 1;
            if (ks < 7) { ua[nx][0] = trrd(lds + ka0 + 4096 * (ks + 1)); ua[nx][1] = trrd(lds + ka1 + 4096 * (ks + 1)); ub[nx][0] = trrd(lds + va0 + 2048 * (ks + 1)); ub[nx][1] = trrd(lds + va1 + 2048 * (ks + 1)); }
            const B8 afr = __builtin_shufflevector(ua[cu][0], ua[cu][1], 0, 1, 2, 3, 4, 5, 6, 7), bfr = __builtin_shufflevector(ub[cu][0], ub[cu][1], 0, 1, 2, 3, 4, 5, 6, 7);
            St = MFMA32(afr, bfr, St);
            if (ML) { const U4 av = __builtin_bit_cast(U4, afr); ksum = dot2bf(av.x, 0x3f803f80u, ksum); ksum = dot2bf(av.y, 0x3f803f80u, ksum); ksum = dot2bf(av.z, 0x3f803f80u, ksum); ksum = dot2bf(av.w, 0x3f803f80u, ksum); }
          } }
#pragma unroll
        for (int r = 0; r < 16; ++r) St[r] *= decay;
#pragma unroll
        for (int g = 0; g < 4; ++g) { U2 pk; pk.x = cvtpk(St[4 * g], St[4 * g + 1]); pk.y = cvtpk(St[4 * g + 2], St[4 * g + 3]);
            *(LAS U2*)(lds + SOFF + offb(32 * et + l31, 4 * dt + g) + 8 * hi) = pk; }
        if (ML) { ksum += __shfl_xor(ksum, 32);
            if (et == 0 && hi == 0) { const LAS float* nv = (const LAS float*)(lds + NOFF + cur * 512); LAS float* nn = (LAS float*)(lds + NOFF + nxt * 512);
                const float nval = decay * (nv[32 * dt + l31] + ksum); nn[32 * dt + l31] = nval;
                *(LAS unsigned short*)(lds + NOFF + 1024 + nxt * 256 + (32 * dt + l31) * 2) = (unsigned short)(cvtpk(nval, 0.f) & 0xffffu); } }
        asm volatile("s_waitcnt vmcnt(2)" ::: "memory");
        __syncthreads();
    }
#undef MX_DMA
#undef ksrc_
#undef vsrc_
}
__device__ __forceinline__ void phase3(const Ctx& C, unsigned char* ws, bool dry) {
    for (int it = C.vcu; it < 256; it += C.G) {
        const int mix = it >> 7, b = (it >> 4) & 7, hd = (it >> 2) & 3, sl = it & 3;
        bf16* vr = (bf16*)(ws + WS_RV); bf16* vm = (bf16*)(ws + WS_MV); bf16* dump = (bf16*)(ws + 930 * MiB);
#ifndef DRY_ABL
#define DRY_ABL 0
#endif
        if (dry) {
            if (mix == 0 || (DRY_ABL & 1)) mixer_item<false, DRY_ABL>(C, (const bf16*)(ws + (mix ? WS_MQP : WS_RQ)), (const bf16*)(ws + (mix ? WS_MKP : WS_RK)), mix ? vm : vr, dump, (size_t)0x7fff, nullptr, nullptr, b, hd, sl);
            else mixer_item<true, DRY_ABL>(C, (const bf16*)(ws + WS_MQP), (const bf16*)(ws + WS_MKP), vm, dump, (size_t)0x7fff, (const float*)(ws + WS_THR), (const float*)(ws + WS_CDEC), b, hd, sl);
        } else {
        if (mix == 0) mixer_item<false>(C, (const bf16*)(ws + WS_RQ), (const bf16*)(ws + WS_RK), vr, vr, ~(size_t)0, nullptr, nullptr, b, hd, sl);
        else mixer_item<true>(C, (const bf16*)(ws + WS_MQP), (const bf16*)(ws + WS_MKP), vm, vm, ~(size_t)0, (const float*)(ws + WS_THR), (const float*)(ws + WS_CDEC), b, hd, sl);
        }
    }
}

__device__ __forceinline__ void phase4(const Ctx& C, const float* const* in, unsigned char* ws) {
    const float* rgn = in[3]; const float* mgn = in[9];
    const int gw = C.vcu * NWAVES + C.wave, NGW = C.G * NWAVES;
    const int col = (C.lane >> 4) * 256 + (C.lane & 15) * 16;
    float gr[16], gm[16];
#pragma unroll
    for (int i = 0; i < 4; ++i) { const F4 a = *(const F4*)(rgn + col + 4 * i), bq = *(const F4*)(mgn + col + 4 * i);
        gr[4 * i] = a.x; gr[4 * i + 1] = a.y; gr[4 * i + 2] = a.z; gr[4 * i + 3] = a.w; gm[4 * i] = bq.x; gm[4 * i + 1] = bq.y; gm[4 * i + 2] = bq.z; gm[4 * i + 3] = bq.w; }
    for (int m = gw; m < NTOK; m += NGW) {
#pragma unroll
        for (int mx = 0; mx < 2; ++mx) {
            const bf16* ip = (const bf16*)(ws + (mx ? WS_MV : WS_RV)) + (size_t)m * 1024 + col;
            bf16* op = (bf16*)(ws + WS_XCAT) + (size_t)m * 2048 + mx * 1024 + col;
            const bf16* gp = (const bf16*)(ws + (mx ? WS_MO : WS_RG)) + (size_t)m * 1024 + col;
            const U4 o0 = *(const U4*)ip, o1 = *(const U4*)(ip + 8), g0 = *(const U4*)gp, g1 = *(const U4*)(gp + 8);
            float v[16], g[16];
            v[0] = bflo(o0.x); v[1] = bfhi(o0.x); v[2] = bflo(o0.y); v[3] = bfhi(o0.y); v[4] = bflo(o0.z); v[5] = bfhi(o0.z); v[6] = bflo(o0.w); v[7] = bfhi(o0.w);
            v[8] = bflo(o1.x); v[9] = bfhi(o1.x); v[10] = bflo(o1.y); v[11] = bfhi(o1.y); v[12] = bflo(o1.z); v[13] = bfhi(o1.z); v[14] = bflo(o1.w); v[15] = bfhi(o1.w);
            g[0] = bflo(g0.x); g[1] = bfhi(g0.x); g[2] = bflo(g0.y); g[3] = bfhi(g0.y); g[4] = bflo(g0.z); g[5] = bfhi(g0.z); g[6] = bflo(g0.w); g[7] = bfhi(g0.w);
            g[8] = bflo(g1.x); g[9] = bfhi(g1.x); g[10] = bflo(g1.y); g[11] = bfhi(g1.y); g[12] = bflo(g1.z); g[13] = bfhi(g1.z); g[14] = bflo(g1.w); g[15] = bfhi(g1.w);
            if (mx) {
#pragma unroll
                for (int i = 0; i < 16; ++i) v[i] *= sigm(g[i]);
            }
            float ss = 0.f;
#pragma unroll
            for (int i = 0; i < 16; ++i) ss += v[i] * v[i];
            ss += __shfl_xor(ss, 1); ss += __shfl_xor(ss, 2); ss += __shfl_xor(ss, 4); ss += __shfl_xor(ss, 8);
            const float r = rsqrtf(ss * (1.f / 256.f) + EPS);
            float y[16];
#pragma unroll
            for (int i = 0; i < 16; ++i) y[i] = mx ? v[i] * r * gm[i] : v[i] * r * gr[i] * silu(g[i]);
            U4 w0, w1; w0.x = cvtpk(y[0], y[1]); w0.y = cvtpk(y[2], y[3]); w0.z = cvtpk(y[4], y[5]); w0.w = cvtpk(y[6], y[7]);
            w1.x = cvtpk(y[8], y[9]); w1.y = cvtpk(y[10], y[11]); w1.z = cvtpk(y[12], y[13]); w1.w = cvtpk(y[14], y[15]);
            *(U4*)op = w0; *(U4*)(op + 8) = w1;
        }
    }
    LAS float* scr = (LAS float*)(C.lds + C.wave * 8448);
    const float* wgate = in[17]; const float* wup = in[18]; const float* wdn = in[19];
    for (int it = gw; it < 16384 + 8192; it += NGW) {
        if (it < 16384) { const int e = it >> 9, kb = (it >> 5) & 15, nb = it & 31; const int R0 = nb * 32, tile = R0 >> 8, within = R0 & 255;
            const float* W = (within < 128 ? wgate : wup) + (size_t)e * 1024 * 512;
            transpose_item(W, 512, kb * 64, tile * 128 + (within & 127), (bf16*)(ws + WS_WGU), 1024, e * 1024 + R0, scr, C.lane); }
        else { const int r = it - 16384; const int e = r >> 8, kb = (r >> 5) & 7, nb = r & 31;
            transpose_item(wdn + (size_t)e * 512 * 1024, 1024, kb * 64, nb * 32, (bf16*)(ws + WS_WD), 512, e * 1024 + nb * 32, scr, C.lane); }
    }
}

__device__ __forceinline__ void phase8(const Ctx& C, const float* const* in, unsigned char* ws) {
    const float* x = in[0]; const float* nfw = in[12]; const float* bg = in[14]; const float* be = in[16];
    const bf16* YO = (const bf16*)(ws + WS_YO); bf16* H2U = (bf16*)(ws + WS_H2U);
    const F4* WR = (const F4*)(ws + WS_ROUT); TokInfo* TI = (TokInfo*)(ws + WS_TOK); unsigned* gcnt = (unsigned*)(ws + WS_CTL);
    int* TM = (int*)(ws + WS_TOKMAP); float* SR = (float*)(ws + WS_SRSTD);
    LAS float* scr = (LAS float*)(C.lds + C.wave * 4096);
    LAS unsigned* lcnt = (LAS unsigned*)(C.lds + 65536);
    LAS unsigned* lbase = (LAS unsigned*)(C.lds + 65536 + 128);
    LAS float* nwl = (LAS float*)(C.lds + 69632);
    for (int i = C.tid; i < DM; i += NTHR) nwl[i] = nfw[i];
    const int l = C.lane, l15 = l & 15, kk = l >> 4;
    for (int blkid = C.vcu; blkid < NTOK / 256; blkid += C.G) {
        __syncthreads();
        if (C.tid < 32) lcnt[C.tid] = 0u;
        __syncthreads();
        int e0[2], e1[2]; float w0[2], w1[2], rs[2]; unsigned rk0[2], rk1[2];
#pragma unroll
        for (int tt = 0; tt < 2; ++tt) {
            const int row0 = blkid * 256 + C.wave * 32 + tt * 16;
            F4 acc[3];
#pragma unroll
            for (int n = 0; n < 3; ++n) acc[n] = (F4){0.f, 0.f, 0.f, 0.f};
            float ss = 0.f;
            const size_t ro = (size_t)(row0 + l15) * DM + 8 * kk;
#pragma unroll 2
            for (int kb2 = 0; kb2 < 32; ++kb2) {
                const F4 xa = *(const F4*)(x + ro + 32 * kb2), xb = *(const F4*)(x + ro + 32 * kb2 + 4);
                const U4 yv = *(const U4*)(YO + ro + 32 * kb2);
                const F4 na = *(const LAS F4*)(nwl + 32 * kb2 + 8 * kk), nb = *(const LAS F4*)(nwl + 32 * kb2 + 8 * kk + 4);
                F4 a0, a1;
                a0.x = xa.x + bflo(yv.x); a0.y = xa.y + bfhi(yv.x); a0.z = xa.z + bflo(yv.y); a0.w = xa.w + bfhi(yv.y);
                a1.x = xb.x + bflo(yv.z); a1.y = xb.y + bfhi(yv.z); a1.z = xb.z + bflo(yv.w); a1.w = xb.w + bfhi(yv.w);
                ss += ((a0.x * a0.x + a0.y * a0.y) + (a0.z * a0.z + a0.w * a0.w)) + ((a1.x * a1.x + a1.y * a1.y) + (a1.z * a1.z + a1.w * a1.w));
                U4 hv; hv.x = cvtpk(a0.x * na.x, a0.y * na.y); hv.y = cvtpk(a0.z * na.z, a0.w * na.w); hv.z = cvtpk(a1.x * nb.x, a1.y * nb.y); hv.w = cvtpk(a1.z * nb.z, a1.w * nb.w);
                *(U4*)(H2U + ro + 32 * kb2) = hv;
#pragma unroll
                for (int n = 0; n < 3; ++n) { const F4 b0 = WR[((kb2 * 3 + n) * 2 + 0) * 64 + l], b1 = WR[((kb2 * 3 + n) * 2 + 1) * 64 + l];
#pragma unroll
                    for (int j = 0; j < 4; ++j) acc[n] = __builtin_amdgcn_mfma_f32_16x16x4f32(a0[j], b0[j], acc[n], 0, 0, 0);
#pragma unroll
                    for (int j = 0; j < 4; ++j) acc[n] = __builtin_amdgcn_mfma_f32_16x16x4f32(a1[j], b1[j], acc[n], 0, 0, 0); }
            }
            ss += __shfl_xor(ss, 16); ss += __shfl_xor(ss, 32);
            const float rstd = rsqrtf(ss * (1.f / DM) + EPS);
#pragma unroll
            for (int n = 0; n < 3; ++n)
#pragma unroll
                for (int r = 0; r < 4; ++r) scr[(4 * kk + r) * 49 + 16 * n + l15] = acc[n][r];
            if (kk == 0) scr[16 * 49 + l15] = rstd;
            asm volatile("s_waitcnt lgkmcnt(0)" ::: "memory");
            e0[tt] = 0; e1[tt] = 0; w0[tt] = 0.f; w1[tt] = 0.f; rs[tt] = 0.f; rk0[tt] = 0u; rk1[tt] = 0u;
            if (l < 16) {
                const LAS float* lr = scr + l * 49; const float rr = scr[16 * 49 + l];
                float g0 = lr[0] * rr + bg[0], g1 = lr[1] * rr + bg[1], g2 = lr[2] * rr + bg[2], g3 = lr[3] * rr + bg[3];
                int gi = 0; float gmx = g0; if (g1 > gmx) { gmx = g1; gi = 1; } if (g2 > gmx) { gmx = g2; gi = 2; } if (g3 > gmx) { gmx = g3; gi = 3; }
                const float gw = __builtin_amdgcn_rcpf(__expf(g0 - gmx) + __expf(g1 - gmx) + __expf(g2 - gmx) + __expf(g3 - gmx));
                float m1 = -INFINITY, m2 = -INFINITY; int i1 = 0, i2 = 0;
#pragma unroll
                for (int i = 0; i < 8; ++i) { const float v = lr[4 + gi * 8 + i] * rr + be[gi * 8 + i];
                    if (v > m1) { m2 = m1; i2 = i1; m1 = v; i1 = i; } else if (v > m2) { m2 = v; i2 = i; } }
                const float ex = __expf(m2 - m1), wa = __builtin_amdgcn_rcpf(1.f + ex);
                e0[tt] = gi * 8 + i1; e1[tt] = gi * 8 + i2; w0[tt] = gw * wa; w1[tt] = gw * ex * wa; rs[tt] = rr;
                rk0[tt] = atomicAdd((unsigned*)(lcnt + e0[tt]), 1u); rk1[tt] = atomicAdd((unsigned*)(lcnt + e1[tt]), 1u);
            }
            asm volatile("s_waitcnt lgkmcnt(0)" ::: "memory");
        }
        __syncthreads();
        if (C.tid < 32) lbase[C.tid] = atomicAdd(gcnt + C.tid, lcnt[C.tid]);
        __syncthreads();
#pragma unroll
        for (int tt = 0; tt < 2; ++tt) if (l < 16) {
            const int t = blkid * 256 + C.wave * 32 + tt * 16 + l;
            TokInfo ti; ti.e0 = e0[tt]; ti.p0 = (int)(lbase[e0[tt]] + rk0[tt]); ti.e1 = e1[tt]; ti.p1 = (int)(lbase[e1[tt]] + rk1[tt]); ti.w0 = w0[tt]; ti.w1 = w1[tt]; ti.rstd = rs[tt]; ti.pad = 0.f;
            TI[t] = ti;
            TM[ti.e0 * 65536 + ti.p0] = t; SR[ti.e0 * 65536 + ti.p0] = rs[tt];
            TM[ti.e1 * 65536 + ti.p1] = t; SR[ti.e1 * 65536 + ti.p1] = rs[tt]; }
    }
}

__device__ __forceinline__ int build_rowbase(const Ctx& C, unsigned char* ws) {
    LAS int* rb = (LAS int*)(C.lds + LDS_MISC);
    LAS unsigned char* t2e = (LAS unsigned char*)(C.lds + LDS_MISC + 256);
    const unsigned* gcnt = (const unsigned*)(ws + WS_CTL);
    __syncthreads();
    if (C.tid == 0) { int acc = 0; for (int e = 0; e < NEXP; ++e) { rb[e] = acc; const int n = (int)__hip_atomic_load(gcnt + e, __ATOMIC_RELAXED, __HIP_MEMORY_SCOPE_AGENT); acc += (n + 255) & ~255; } rb[NEXP] = acc; }
    __syncthreads();
    for (int e = C.tid >> 4; e < NEXP; e += NTHR >> 4) for (int t = (rb[e] >> 8) + (C.tid & 15); t < (rb[e + 1] >> 8); t += 16) t2e[t] = (unsigned char)e;
    __syncthreads();
    return rb[NEXP] >> 8;
}

__device__ __forceinline__ void phase12(const Ctx& C, const float* const* in, float* out, unsigned char* ws) {
    (void)build_rowbase(C, ws);
    const LAS int* rb = (const LAS int*)(C.lds + LDS_MISC);
    const float* x = in[0]; const float* fw = in[20]; const TokInfo* TI = (const TokInfo*)(ws + WS_TOK); const bf16* Y = (const bf16*)(ws + WS_Y); const bf16* YO = (const bf16*)(ws + WS_YO);
    const int gw = C.vcu * NWAVES + C.wave, NGW = C.G * NWAVES;
    F4 wv[4];
#pragma unroll
    for (int j = 0; j < 4; ++j) wv[j] = *(const F4*)(fw + 4 * C.lane + 256 * j);
    for (int m = gw; m < NTOK; m += NGW) {
        const TokInfo ti = TI[m];
        const F4* xr = (const F4*)(x + (size_t)m * DM) + C.lane;
        const U2* yo = (const U2*)(YO + (size_t)m * DM) + C.lane;
        const U2* y0 = (const U2*)(Y + (size_t)(rb[ti.e0] + ti.p0) * DM) + C.lane;
        const U2* y1 = (const U2*)(Y + (size_t)(rb[ti.e1] + ti.p1) * DM) + C.lane;
        F4 v[4]; float s = 0.f;
#pragma unroll
        for (int j = 0; j < 4; ++j) { const U2 a = y0[64 * j], bq = y1[64 * j], c = yo[64 * j]; v[j] = xr[64 * j];
            v[j].x += bflo(c.x) + ti.w0 * bflo(a.x) + ti.w1 * bflo(bq.x); v[j].y += bfhi(c.x) + ti.w0 * bfhi(a.x) + ti.w1 * bfhi(bq.x);
            v[j].z += bflo(c.y) + ti.w0 * bflo(a.y) + ti.w1 * bflo(bq.y); v[j].w += bfhi(c.y) + ti.w0 * bfhi(a.y) + ti.w1 * bfhi(bq.y);
            s += (v[j].x * v[j].x + v[j].y * v[j].y) + (v[j].z * v[j].z + v[j].w * v[j].w); }
        const float rstd = rsqrtf(wave_sum(s) * (1.f / DM) + EPS);
        F4* xw = (F4*)(out + (size_t)m * DM) + C.lane;
#pragma unroll
        for (int j = 0; j < 4; ++j) xw[64 * j] = v[j] * rstd * wv[j];
    }
}

constexpr int NPHASE = 13;
struct Args { const float* in[21]; float* out; unsigned char* ws; int ph_lo, ph_hi; };
__global__ void __launch_bounds__(NTHR, 2) fwd_kernel(Args args) {
    extern __shared__ __attribute__((aligned(16))) unsigned char lds_raw[];
    cg::grid_group grid = cg::this_grid();
    Ctx C; C.lds = (LAS unsigned char*)lds_raw; C.tid = threadIdx.x; C.lane = C.tid & 63; C.wave = __builtin_amdgcn_readfirstlane(C.tid >> 6);
    C.G = gridDim.x; { const int bx = blockIdx.x; C.vcu = (C.G % 8 == 0) ? (bx % 8) * (C.G / 8) + bx / 8 : bx; }
    unsigned char* ws = args.ws; unsigned char* ob = (unsigned char*)args.out;
    const int lo = args.ph_lo, hi = args.ph_hi;
#ifndef PHMASK
#define PHMASK 0x1fff
#endif
#define IN(k) (((PHMASK >> (k)) & 1) && lo <= (k) && (k) < hi)
    if (C.tid < 2) ((LAS unsigned*)(C.lds + LDS_MISC + 4096))[C.tid] = 0u;
    __syncthreads();
    const XcdBarrier bar = xcd_barrier_post((unsigned*)(ws + WS_CTL) + CW_BAR, (volatile LAS unsigned*)(C.lds + LDS_MISC + 4096));
#define SEAM(k) do { if (IN(k) && IN((k) + 1)) { if ((k) == 0) grid.sync(); else xcd_barrier(bar); } } while (0)
#ifndef DUP_MASK
#define DUP_MASK 0
#endif
#define REP(k) for (int rep_ = 0; rep_ < (((DUP_MASK >> (k)) & 1) ? 2 : 1); ++rep_)
    if (IN(0)) { REP(0) phase0(C, args.in, ws); } SEAM(0);
    if (IN(1)) { pg8::Gemm g{(const pg8::bf16_t*)(ws + WS_H), (const pg8::bf16_t*)(ws + WS_WIN), NTOK, NPROJ, DM}; pg8::StaticOrder S; S.init(NTOK, NPROJ, C.G, (int)blockIdx.x);
        pg8::EpiProj E{ws, ob}; REP(1) pg8::gemm_phase<pg8::EpiProj, pg8::StaticOrder, true, true>(C.lds, g, S, E); } SEAM(1);
    if (IN(2)) { phase2(C, args.in, ws); } SEAM(2);
    if (IN(3)) { if ((DUP_MASK >> 3) & 1) phase3(C, ws, true); phase3(C, ws, false); } SEAM(3);
    if (IN(4)) { phase4(C, args.in, ws); } SEAM(4);
    if (IN(5)) { pg8::Gemm g{(const pg8::bf16_t*)(ws + WS_XCAT), (const pg8::bf16_t*)(ws + WS_WCAT), NTOK, DM, 2 * DM}; pg8::StaticOrder S; S.init(NTOK, DM, C.G, (int)blockIdx.x);
        pg8::EpiGateFused E{(const pg8::bf16_t*)(ob + OUT_GR), (const pg8::bf16_t*)(ob + OUT_GM), (pg8::bf16_t*)(ws + WS_MERGED)}; REP(5) pg8::gemm_phase<pg8::EpiGateFused, pg8::StaticOrder, true, true>(C.lds, g, S, E); }
    if (IN(5) && IN(7)) xcd_barrier(bar);
    if (IN(7)) { pg8::Gemm g{(const pg8::bf16_t*)(ws + WS_MERGED), (const pg8::bf16_t*)(ws + WS_WOUT), NTOK, DM, DM}; pg8::StaticOrder S; S.init(NTOK, DM, C.G, (int)blockIdx.x);
        pg8::EpiBf16<0> E{(pg8::bf16_t*)(ws + WS_YO), DM, nullptr, 0, 0, 1.f}; REP(7) pg8::gemm_phase<pg8::EpiBf16<0>, pg8::StaticOrder, true, true>(C.lds, g, S, E); } SEAM(7);
    if (IN(8)) { phase8(C, args.in, ws); }
    if (IN(8) && IN(10)) xcd_barrier(bar);
    if (IN(10)) { const int nt = build_rowbase(C, ws);
        pg8::Gemm g{(const pg8::bf16_t*)(ws + WS_H2U), (const pg8::bf16_t*)(ws + WS_WGU), MAXROWS, NEXP * 1024, DM};
        pg8::GroupedOrder<true> S{nt, C.G, C.vcu, (const LAS unsigned char*)(C.lds + LDS_MISC + 256), (const LAS int*)(C.lds + LDS_MISC), (const int*)(ws + WS_TOKMAP)};
        pg8::EpiSwiglu E{(pg8::bf16_t*)(ws + WS_HMID), (const float*)(ws + WS_SRSTD)}; REP(10) pg8::gemm_phase<pg8::EpiSwiglu, pg8::GroupedOrder<true>, true, true>(C.lds, g, S, E); } SEAM(10);
    if (IN(11)) { const int nt = build_rowbase(C, ws);
        pg8::Gemm g{(const pg8::bf16_t*)(ws + WS_HMID), (const pg8::bf16_t*)(ws + WS_WD), MAXROWS, NEXP * 1024, DEXP};
        pg8::GroupedOrder<false> S{nt, C.G, C.vcu, (const LAS unsigned char*)(C.lds + LDS_MISC + 256), (const LAS int*)(C.lds + LDS_MISC), nullptr};
        pg8::EpiY E{(pg8::bf16_t*)(ws + WS_Y)}; REP(11) pg8::gemm_phase<pg8::EpiY, pg8::GroupedOrder<false>, true, true>(C.lds, g, S, E); } SEAM(11);
    if (IN(12)) { phase12(C, args.in, args.out, ws); }
#undef IN
#undef SEAM
}

#ifndef MK_SPLIT
#define MK_SPLIT 0
#endif
extern "C" void kernel_launch(void* const* d_in, const int* in_sizes, int n_in, void* d_out, int out_size, void* d_ws, size_t ws_size, hipStream_t stream) {
    static int grid = 0;
    if (grid == 0) {
        if (n_in != 21 || out_size != NTOK * DM || ws_size < WS_END) { fprintf(stderr, "kernel_launch: unexpected shapes (n_in %d out %d ws %zu)\n", n_in, out_size, ws_size); grid = -1; return; }
        int dev = 0, cus = 0, per_cu = 0;
        if (hipGetDevice(&dev) != hipSuccess || hipDeviceGetAttribute(&cus, hipDeviceAttributeMultiprocessorCount, dev) != hipSuccess) { grid = -1; return; }
        if (hipFuncSetAttribute((const void*)fwd_kernel, hipFuncAttributeMaxDynamicSharedMemorySize, LDS_BYTES) != hipSuccess) { fprintf(stderr, "kernel_launch: hipFuncSetAttribute failed\n"); grid = -1; return; }
        if (hipOccupancyMaxActiveBlocksPerMultiprocessor(&per_cu, (const void*)fwd_kernel, NTHR, LDS_BYTES) != hipSuccess || per_cu < 1) { fprintf(stderr, "kernel_launch: occupancy query says %d\n", per_cu); per_cu = 1; }
        (void)hipGetLastError();
        grid = cus;
    }
    if (grid < 0) return;
    (void)hipMemsetAsync((char*)d_ws + WS_CTL, 0, CTL_ZERO_BYTES, stream);
    Args a{};
    for (int i = 0; i < 21; ++i) a.in[i] = (const float*)d_in[i];
    a.out = (float*)d_out; a.ws = (unsigned char*)d_ws;
    void* kargs[] = {&a};
#if MK_SPLIT
    for (int p = 0; p < NPHASE; ++p) { a.ph_lo = p; a.ph_hi = p + 1;
        hipError_t e = hipLaunchCooperativeKernel((const void*)fwd_kernel, dim3(grid), dim3(NTHR), kargs, LDS_BYTES, stream);
        if (e != hipSuccess) { fprintf(stderr, "kernel_launch: launch %d failed: %s\n", p, hipGetErrorString(e)); break; } }
#else
    a.ph_lo = 0; a.ph_hi = NPHASE;
    hipError_t e = hipLaunchCooperativeKernel((const void*)fwd_kernel, dim3(grid), dim3(NTHR), kargs, LDS_BYTES, stream);
    if (e != hipSuccess) fprintf(stderr, "kernel_launch: cooperative launch failed: %s (grid %d)\n", hipGetErrorString(e), grid);
#endif
}
```

```cpp
#include <hip/hip_runtime.h>
#include <hip/hip_cooperative_groups.h>
#include <cstdio>
#include <cstdint>
namespace cg = cooperative_groups;
namespace pg8 {
#define PG8_LAS __attribute__((address_space(3)))
typedef unsigned short bf16_t;
typedef short bf16x8 __attribute__((ext_vector_type(8)));
typedef float f32x4 __attribute__((ext_vector_type(4)));
typedef unsigned u32x4 __attribute__((ext_vector_type(4)));
constexpr int BM = 256, BK = 64, HALF = 128, HTB = HALF * BK * 2  , STAGE_BYTES = 8 * HTB, NXCD = 8, WGM = 8;

__host__ __device__ __forceinline__ int lds_byte(int r, int c) { const int st = (r >> 4) * 2 + (c >> 5), rr = r & 15, cc = c & 31, ob = rr * 64 + cc * 2; return st * 1024 + (ob ^ (((ob >> 9) & 1) << 5)); }
__host__ __device__ __forceinline__ void stage_rc(int b, int& R, int& C) { const int st = b / 1024, sb = b % 1024, swz = sb ^ (((sb >> 9) & 1) << 5); R = (st >> 1) * 16 + swz / 64; C = (st & 1) * 32 + (swz % 64) / 2; }
__host__ __device__ __forceinline__ int perm32(int rho) { const int n = rho >> 4, i = rho & 15; return 8 * (i >> 2) + 4 * n + (i & 3); }

struct Unit { int pm, pn, pa; };
struct Gemm { const bf16_t* A; const bf16_t* Bt; int M, N, K; float* probe = nullptr; int lda = 0  ; };

struct StaticOrder {
    static constexpr bool GATHER = false;
    int nM, nN, nwg, G, c;
    __host__ __device__ void init(int M, int N, int G_, int c_) { nM = M / BM; nN = N / BM; nwg = nM * nN; G = G_; c = c_; }
    __host__ __device__ bool next(int i, Unit& u) const {
        const long L = (long)i * G + c; if (L >= nwg) return false;
        int wgid = (int)L; { const int q = nwg / NXCD, r = nwg % NXCD, xcd = wgid % NXCD, off = wgid / NXCD; wgid = (xcd < r ? xcd * (q + 1) : r * (q + 1) + (xcd - r) * q) + off; }
        const int nig = WGM * nN, gid = wgid / nig, fm = gid * WGM, gsz = (nM - fm) < WGM ? (nM - fm) : WGM;
        u.pm = fm + ((wgid % nig) % gsz); u.pn = (wgid % nig) / gsz; u.pa = 0; return true;
    }
    __device__ __forceinline__ void a_ready(const Unit&) const {}
    __device__ __forceinline__ void done(const Unit&) const {}
};

__device__ __forceinline__ unsigned cvt_pk_bf16(float lo, float hi) { unsigned r; asm volatile("v_cvt_pk_bf16_f32 %0, %1, %2" : "=v"(r) : "v"(lo), "v"(hi)); return r; }
typedef float f32x2 __attribute__((ext_vector_type(2)));
__device__ __forceinline__ f32x2 gelu_pk(f32x2 v) {
    const f32x2 av = __builtin_elementwise_abs(v), d = av * 0.2316418882f + 1.0f;
    f32x2 t; t.x = __builtin_amdgcn_rcpf(d.x); t.y = __builtin_amdgcn_rcpf(d.y);
    f32x2 q = t * 0.5307027145f + (-0.7265760135f); q = q * t + 0.7107068705f; q = q * t + (-0.142248368f); q = q * t + 0.127414796f; q = q * t;
    const f32x2 s = (v * v) * (-0.72134752044f);
    f32x2 e; e.x = __builtin_amdgcn_exp2f(s.x); e.y = __builtin_amdgcn_exp2f(s.y);
    const f32x2 m = v * (q * e), r = v - m;
    f32x2 o; o.x = v.x < 0.f ? m.x : r.x; o.y = v.y < 0.f ? m.y : r.y; return o;
}

template <int ACT  > struct EpiBf16 {
    static constexpr bool PERM = true, AFTER_DRAIN = false, MIDK = false; static constexpr int NST = 16  ; static_assert(ACT == 0 || ACT == 1, "EpiBf16: ACT is 0 (none) or 1 (gelu_pk)");
    bf16_t* O; int ldc; const float* bias; int split_cols; size_t split_stride; float scale0;
    __device__ __forceinline__ void operator()(const f32x4 (&acc)[2][2][4][2], const Unit& u, int wr, int wc, int fr, int fq) const {
        const int row0 = u.pm * BM + wr * 64 + fr; int colt = u.pn * BM; bf16_t* base = O;
        float sc = 1.f; if (split_cols) { const int t = colt / split_cols; base += (size_t)t * split_stride; colt -= t * split_cols; if (t == 0) sc = scale0; }
        const int col0 = colt + wc * 32 + 8 * fq, bcol0 = u.pn * BM + wc * 32 + 8 * fq;
        f32x4 bv[2][2];
#pragma unroll
        for (int bj = 0; bj < 2; ++bj)
#pragma unroll
            for (int n = 0; n < 2; ++n) bv[bj][n] = bias ? *(const f32x4*)(bias + bcol0 + bj * HALF + 4 * n) : (f32x4){0.f, 0.f, 0.f, 0.f};
#pragma unroll
        for (int ai = 0; ai < 2; ++ai)
#pragma unroll
            for (int m = 0; m < 4; ++m) { bf16_t* rowp = base + (size_t)(row0 + ai * HALF + m * 16) * ldc + col0;
#pragma unroll
                for (int bj = 0; bj < 2; ++bj) { f32x4 v0 = acc[ai][bj][m][0] + bv[bj][0], v1 = acc[ai][bj][m][1] + bv[bj][1];
                    if (ACT == 1) { f32x2 a = gelu_pk((f32x2){v0[0], v0[1]}), b = gelu_pk((f32x2){v0[2], v0[3]}), c = gelu_pk((f32x2){v1[0], v1[1]}), d = gelu_pk((f32x2){v1[2], v1[3]});
                        v0 = (f32x4){a.x, a.y, b.x, b.y}; v1 = (f32x4){c.x, c.y, d.x, d.y}; }
                    v0 = v0 * sc; v1 = v1 * sc; u32x4 w; w.x = cvt_pk_bf16(v0[0], v0[1]); w.y = cvt_pk_bf16(v0[2], v0[3]); w.z = cvt_pk_bf16(v1[0], v1[1]); w.w = cvt_pk_bf16(v1[2], v1[3]);
                    *(u32x4*)(rowp + bj * HALF) = w; } }
    }
};
#ifndef PG8_RELAX
#define PG8_RELAX 0
#endif
#ifndef PROBE_GEMM_SEL
#define PROBE_GEMM_SEL 0
#endif
#ifndef PROBE_GEMM_BLK
#define PROBE_GEMM_BLK 0
#endif
#define PG8_NOW() (PROBE_GEMM_SEL == 3 ? __builtin_amdgcn_s_memtime() : PROBE_GEMM_SEL ? __builtin_amdgcn_s_memrealtime() : 0ull)
#ifndef ABL_BMASK
#define ABL_BMASK (~0)
#endif
#ifndef ABL_AMASK
#define ABL_AMASK (~0)
#endif
template <class Epi, class Sched, bool ALIGN_EPI = false, bool SP2 = false>
__device__ __forceinline__ void gemm_phase(PG8_LAS unsigned char* lds, const Gemm g, const Sched& S, const Epi& E) {
    const int tid = threadIdx.x, wid = __builtin_amdgcn_readfirstlane(tid >> 6), lane = tid & 63, wr = wid >> 2, wc = wid & 3, fr = lane & 15, fq = lane >> 4;
    const int K = g.K, nt = K / BK;
    unsigned voffA[2], voffB[2]; int Rr[2], Cc[2];
#pragma unroll
    for (int i = 0; i < 2; ++i) { int R, C; stage_rc(tid * 16 + i * 8192, R, C); const int Rb = Epi::PERM ? ((R & ~31) + perm32(R & 31)) : R; Rr[i] = R; Cc[i] = C;
        voffA[i] = (unsigned)(R * K + C) * 2u; voffB[i] = (unsigned)(Rb * K + C) * 2u; }
    const size_t kstep = (size_t)(BK * 2);
    const size_t hstep = (size_t)HALF * K * 2;
    const size_t tstep = 2 * hstep;
    unsigned vAc[2][2], vAn[2][2];
#define PG8_AOFF(dst, un) do { _Pragma("unroll") for (int h_ = 0; h_ < 2; ++h_) _Pragma("unroll") for (int i_ = 0; i_ < 2; ++i_) { \
        if constexpr (Sched::GATHER) (dst)[h_][i_] = (unsigned)S.arow((un), h_ * HALF + Rr[i_]) * (unsigned)((g.lda ? g.lda : K) * 2) + (unsigned)(Cc[i_] * 2); \
        else (dst)[h_][i_] = voffA[i_] + (unsigned)(h_ * (int)hstep); } } while (0)
    const unsigned ldsw = (unsigned)wid * 1024u;
    const int aoff = lds_byte(wr * 64 + fr, fq * 8), boff = lds_byte(wc * 32 + fr, fq * 8);
#define PG8_SA(b, h) (((b) * 2 + (h)) * HTB)
#define PG8_SB(b, h) ((4 + (b) * 2 + (h)) * HTB)
#define PG8_STAGE(bufoff, gbase, voff) do { _Pragma("unroll") for (int _i = 0; _i < 2; ++_i) \
        __builtin_amdgcn_global_load_lds((const unsigned*)((const char*)(gbase) + (voff)[_i]), (PG8_LAS unsigned*)(lds + (bufoff) + ldsw + _i * 8192), 16, 0, 0); } while (0)
#define PG8_LDA(dst, b, h) do { _Pragma("unroll") for (int m = 0; m < 4; ++m) _Pragma("unroll") for (int k = 0; k < 2; ++k) dst[m][k] = *(const PG8_LAS bf16x8*)(lds + PG8_SA(b, h) + aoff + m * 2048 + k * 1024); } while (0)
#define PG8_LDB(dst, b, h) do { _Pragma("unroll") for (int n = 0; n < 2; ++n) _Pragma("unroll") for (int k = 0; k < 2; ++k) dst[n][k] = *(const PG8_LAS bf16x8*)(lds + PG8_SB(b, h) + boff + n * 2048 + k * 1024); } while (0)
#define PG8_MMA(ai, bj, At, Bt) do { __builtin_amdgcn_s_setprio(1); _Pragma("unroll") for (int m = 0; m < 4; ++m) _Pragma("unroll") for (int n = 0; n < 2; ++n) _Pragma("unroll") for (int k = 0; k < 2; ++k) \
        acc[ai][bj][m][n] = __builtin_amdgcn_mfma_f32_16x16x32_bf16(Bt[n][k], At[m][k], acc[ai][bj][m][n], 0, 0, 0); __builtin_amdgcn_s_setprio(0); } while (0)
#define PG8_WAIT_V(n) asm volatile("s_waitcnt vmcnt(" #n ")" ::: "memory")
#if PG8_RELAX
#define PG8_WAIT_VF asm volatile("s_cmp_lg_u32 %0, 0\n\ts_cbranch_scc1 1f\n\ts_waitcnt vmcnt(8)\n1:\n\ts_waitcnt vmcnt(%1)" :: "s"(relax), "n"(8 + (PG8_RELAX ? Epi::NST : 0)) : "scc", "memory")
#else
#define PG8_WAIT_VF PG8_WAIT_V(8)
#endif
#define PG8_WAIT_L(n) asm volatile("s_waitcnt lgkmcnt(" #n ")" ::: "memory")
#define PG8_BAR __builtin_amdgcn_s_barrier()
#define PG8_SCHED __builtin_amdgcn_sched_barrier(0)
    Unit cur, nxt; int ui = 0;
    int relax; asm volatile("s_mov_b32 %0, 0" : "=s"(relax));
    unsigned long long p_t0 = 0, p_t1 = 0, p_k = 0, p_e = 0;
    if (!S.next(0, cur)) return;
    f32x4 acc[2][2][4][2];
#pragma unroll
    for (int a = 0; a < 2; ++a)
#pragma unroll
        for (int b = 0; b < 2; ++b)
#pragma unroll
            for (int m = 0; m < 4; ++m)
#pragma unroll
                for (int n = 0; n < 2; ++n) acc[a][b][m][n] = (f32x4){0.f, 0.f, 0.f, 0.f};
    bf16x8 At[4][2], B0[2][2], B1[2][2];
    const char* cA = (const char*)g.A + (Sched::GATHER ? (size_t)0 : (size_t)(K == 2048 ? (cur.pm & ABL_AMASK) : cur.pm) * tstep); const char* cB = (const char*)g.Bt + (size_t)(K == 2048 ? (cur.pn & ABL_BMASK) : cur.pn) * tstep;
    PG8_AOFF(vAc, cur);
    S.a_ready(cur);
    if constexpr (SP2) {
        PG8_STAGE(PG8_SB(0, 0), cB, voffB); PG8_STAGE(PG8_SB(0, 1), cB + hstep, voffB); PG8_STAGE(PG8_SA(0, 0), cA, vAc[0]); PG8_STAGE(PG8_SA(0, 1), cA, vAc[1]);
        if (wr == 1) PG8_BAR;
        PG8_WAIT_V(2); PG8_BAR;
        PG8_STAGE(PG8_SB(1, 0), cB + kstep, voffB); PG8_STAGE(PG8_SA(1, 0), cA + kstep, vAc[0]); PG8_STAGE(PG8_SB(1, 1), cB + hstep + kstep, voffB); PG8_STAGE(PG8_SA(1, 1), cA + kstep, vAc[1]);
        PG8_WAIT_V(8); PG8_BAR;
    } else {
        PG8_STAGE(PG8_SB(0, 0), cB, voffB); PG8_STAGE(PG8_SA(0, 0), cA, vAc[0]); PG8_STAGE(PG8_SB(0, 1), cB + hstep, voffB); PG8_STAGE(PG8_SA(0, 1), cA, vAc[1]);
        if (wr == 1) PG8_BAR;
        PG8_WAIT_V(4); PG8_BAR;
        PG8_STAGE(PG8_SB(1, 0), cB + kstep, voffB); PG8_STAGE(PG8_SA(1, 0), cA + kstep, vAc[0]); PG8_STAGE(PG8_SB(1, 1), cB + hstep + kstep, voffB);
        PG8_WAIT_V(6); PG8_BAR;
    }
    for (;;) {
        const bool has_next = S.next(ui + 1, nxt);
        const char* nA = has_next ? (const char*)g.A + (Sched::GATHER ? (size_t)0 : (size_t)(K == 2048 ? (nxt.pm & ABL_AMASK) : nxt.pm) * tstep) : cA; const char* nB = has_next ? (const char*)g.Bt + (size_t)(K == 2048 ? (nxt.pn & ABL_BMASK) : nxt.pn) * tstep : cB;
        if (has_next) { PG8_AOFF(vAn, nxt); } else {
#pragma unroll
            for (int h_ = 0; h_ < 2; ++h_)
#pragma unroll
                for (int i_ = 0; i_ < 2; ++i_) vAn[h_][i_] = vAc[h_][i_]; }
        p_t0 = PG8_NOW(); if (ui > 0) p_e += p_t0 - p_t1;
        for (int t = 0; t < nt; t += 2) {
            if constexpr (Epi::MIDK) { if (t == nt / 2) E.midk(acc, cur, wr, wc, fr, fq); }
            const bool last = (t == nt - 2);
            const char* a1 = cA + (size_t)(t + 1) * kstep;
            const char* a2 = last ? nA : cA + (size_t)(t + 2) * kstep; const char* b2 = last ? nB : cB + (size_t)(t + 2) * kstep;
            const char* a3 = a2 + kstep; const char* b3 = b2 + kstep;
            unsigned vA2[2][2];
#pragma unroll
            for (int h_ = 0; h_ < 2; ++h_)
#pragma unroll
                for (int i_ = 0; i_ < 2; ++i_) vA2[h_][i_] = vAc[h_][i_];
            if (last) { asm volatile("" ::: "memory");
#pragma unroll
                for (int h_ = 0; h_ < 2; ++h_)
#pragma unroll
                    for (int i_ = 0; i_ < 2; ++i_) vA2[h_][i_] = vAn[h_][i_]; }
            if (last && has_next) S.a_ready(nxt);
            if constexpr (SP2) {
            PG8_LDB(B0, 0, 0); PG8_LDB(B1, 0, 1); PG8_SCHED; PG8_LDA(At, 0, 0);
            PG8_WAIT_VF; PG8_WAIT_L(0); PG8_BAR; PG8_MMA(0, 0, At, B0); PG8_MMA(0, 1, At, B1); PG8_BAR; PG8_SCHED;
            PG8_LDA(At, 0, 1); PG8_STAGE(PG8_SB(0, 0), b2, voffB); PG8_STAGE(PG8_SB(0, 1), b2 + hstep, voffB); PG8_STAGE(PG8_SA(0, 0), a2, vA2[0]);
            PG8_WAIT_VF; PG8_WAIT_L(0); PG8_BAR; PG8_MMA(1, 0, At, B0); PG8_MMA(1, 1, At, B1); PG8_BAR; PG8_SCHED;
            PG8_LDB(B0, 1, 0); PG8_LDB(B1, 1, 1); PG8_SCHED; PG8_LDA(At, 1, 0); PG8_STAGE(PG8_SA(0, 1), a2, vA2[1]);
            PG8_WAIT_VF; PG8_WAIT_L(0); PG8_BAR; PG8_MMA(0, 0, At, B0); PG8_MMA(0, 1, At, B1); PG8_BAR; PG8_SCHED;
            PG8_LDA(At, 1, 1); PG8_STAGE(PG8_SB(1, 0), b3, voffB); PG8_STAGE(PG8_SB(1, 1), b3 + hstep, voffB); PG8_STAGE(PG8_SA(1, 0), a3, vA2[0]);
            PG8_WAIT_V(8); PG8_WAIT_L(0); PG8_BAR; PG8_MMA(1, 0, At, B0); PG8_MMA(1, 1, At, B1); PG8_BAR; PG8_SCHED;
            PG8_STAGE(PG8_SA(1, 1), a3, vA2[1]);
            asm volatile("s_mov_b32 %0, 0" : "=s"(relax));
            } else {
            PG8_LDB(B0, 0, 0); PG8_SCHED; PG8_LDA(At, 0, 0); PG8_STAGE(PG8_SA(1, 1), a1, vAc[1]);
            PG8_WAIT_L(8); PG8_BAR; PG8_WAIT_L(0); PG8_MMA(0, 0, At, B0); PG8_BAR; PG8_SCHED;
            PG8_LDB(B1, 0, 1); PG8_STAGE(PG8_SB(0, 0), b2, voffB);
            PG8_BAR; PG8_WAIT_L(0); PG8_MMA(0, 1, At, B1); PG8_BAR;
            PG8_LDA(At, 0, 1); PG8_STAGE(PG8_SA(0, 0), a2, vA2[0]);
            PG8_BAR; PG8_WAIT_L(0); PG8_MMA(1, 0, At, B0); PG8_BAR; PG8_SCHED;
            PG8_STAGE(PG8_SB(0, 1), b2 + hstep, voffB);
            PG8_WAIT_V(6); PG8_BAR; PG8_MMA(1, 1, At, B1); PG8_BAR;
            PG8_LDB(B0, 1, 0); PG8_SCHED; PG8_LDA(At, 1, 0); PG8_STAGE(PG8_SA(0, 1), a2, vA2[1]);
            PG8_WAIT_L(8); PG8_BAR; PG8_WAIT_L(0); PG8_MMA(0, 0, At, B0); PG8_BAR; PG8_SCHED;
            PG8_LDB(B1, 1, 1); PG8_STAGE(PG8_SB(1, 0), b3, voffB);
            PG8_BAR; PG8_WAIT_L(0); PG8_MMA(0, 1, At, B1); PG8_BAR;
            PG8_LDA(At, 1, 1); PG8_STAGE(PG8_SA(1, 0), a3, vA2[0]);
            PG8_BAR; PG8_WAIT_L(0); PG8_MMA(1, 0, At, B0); PG8_BAR; PG8_SCHED;
            PG8_STAGE(PG8_SB(1, 1), b3 + hstep, voffB);
            PG8_WAIT_V(6); PG8_BAR; PG8_MMA(1, 1, At, B1); PG8_BAR;
            }
        }
        p_t1 = PG8_NOW(); p_k += p_t1 - p_t0;
        if constexpr (ALIGN_EPI) { if (wr == 0) PG8_BAR; }
        if constexpr (!Epi::AFTER_DRAIN) { E(acc, cur, wr, wc, fr, fq); S.done(cur); }
        if (!has_next) break;
#pragma unroll
        for (int a = 0; a < 2; ++a)
#pragma unroll
            for (int b = 0; b < 2; ++b)
#pragma unroll
                for (int m = 0; m < 4; ++m)
#pragma unroll
                    for (int n = 0; n < 2; ++n) acc[a][b][m][n] = (f32x4){0.f, 0.f, 0.f, 0.f};
        cur = nxt; cA = nA; cB = nB; ++ui;
        asm volatile("s_mov_b32 %0, 1" : "=s"(relax));
#pragma unroll
        for (int h_ = 0; h_ < 2; ++h_)
#pragma unroll
            for (int i_ = 0; i_ < 2; ++i_) vAc[h_][i_] = vAn[h_][i_];
        if constexpr (ALIGN_EPI) { if (wr == 1) PG8_BAR; }
    }
    PG8_WAIT_V(0);
    if constexpr (!ALIGN_EPI) { if (wr == 0) PG8_BAR; }
    PG8_BAR;
    if constexpr (Epi::AFTER_DRAIN) { E.fused(acc, cur, wr, wc, fr, fq, lds, wid, lane); S.done(cur); }
    if (PROBE_GEMM_SEL && g.probe && tid == 0 && blockIdx.x == PROBE_GEMM_BLK) *g.probe = PROBE_GEMM_SEL == 3 ? (float)p_k / (float)((ui + 1) * nt) * 0.01f : (float)(PROBE_GEMM_SEL == 1 ? p_k : p_e) * 0.001f;
#undef PG8_AOFF
#undef PG8_SA
#undef PG8_SB
#undef PG8_STAGE
#undef PG8_LDA
#undef PG8_LDB
#undef PG8_MMA
#undef PG8_WAIT_V
#undef PG8_WAIT_L
#undef PG8_BAR
#undef PG8_SCHED
}
}

#define GAS __attribute__((address_space(1)))
#define LAS __attribute__((address_space(3)))
typedef unsigned short bf16;
typedef unsigned U4 __attribute__((ext_vector_type(4)));
typedef unsigned U2 __attribute__((ext_vector_type(2)));
typedef float F4 __attribute__((ext_vector_type(4)));
typedef float F2 __attribute__((ext_vector_type(2)));
typedef float F16 __attribute__((ext_vector_type(16)));
typedef short B8 __attribute__((ext_vector_type(8)));
typedef short S4 __attribute__((ext_vector_type(4)));
typedef __bf16 bf16x2_t __attribute__((ext_vector_type(2)));

constexpr int NWAVES = 8, NTHR = 512;
constexpr int DM = 1024, BATCH = 8, SEQ = 8192, NTOK = BATCH * SEQ;
constexpr int DIN = 8200, NPROJ = 8192;
constexpr int CHUNK = 128, NCHUNK = SEQ / CHUNK;
constexpr int NEXP = 32, DEXP = 512;
constexpr int MAXTILES = 544, MAXROWS = MAXTILES * 256;
constexpr float EPS = 1e-6f;
constexpr int LDS_BYTES = 159744;
constexpr int LDS_MISC = 151552;

constexpr size_t MiB = 1u << 20;
constexpr size_t WS_CTL = 0, CTL_ZERO_BYTES = 32768; constexpr int CW_BAR = 1024;
constexpr size_t WS_IF = 1 * MiB;
constexpr size_t WS_THR = 3 * MiB;
constexpr size_t WS_CDEC = 4 * MiB;
constexpr size_t WS_ROUT = 4 * MiB + 65536;
constexpr size_t WS_ROPE = 5 * MiB;
constexpr size_t WS_TOK = 9 * MiB;
constexpr size_t WS_WIN = 12 * MiB;
constexpr size_t WS_WCAT = 28 * MiB, WS_WOUT = 32 * MiB;
constexpr size_t WS_H = 34 * MiB;
constexpr size_t WS_MQP = 34 * MiB, WS_MKP = 98 * MiB, WS_WGU = 34 * MiB, WS_WD = 98 * MiB;
constexpr size_t WS_RQ = 162 * MiB, WS_RK = 226 * MiB, WS_MQ = 290 * MiB, WS_MK = 354 * MiB;
constexpr size_t WS_XCAT = 162 * MiB;
constexpr size_t WS_RV = 418 * MiB, WS_RG = 546 * MiB, WS_MV = 674 * MiB, WS_MO = 802 * MiB;
constexpr size_t WS_MERGED = 802 * MiB;
constexpr size_t WS_YO = 162 * MiB;
constexpr size_t WS_XS = 418 * MiB, WS_HMID = 690 * MiB, WS_Y = 418 * MiB;
constexpr size_t WS_TOKMAP = 930 * MiB, WS_SRSTD = 938 * MiB;
constexpr size_t WS_END = 946 * MiB;
constexpr size_t OUT_GR = 0, OUT_GM = 128 * MiB;
static_assert(WS_XS + (size_t)MAXROWS * 1024 * 2 <= WS_HMID && WS_HMID + (size_t)MAXROWS * 512 * 2 <= WS_END, "ws map");

struct TokInfo { int e0, p0, e1, p1; float w0, w1, rstd, pad; };

__device__ __forceinline__ float bflo(unsigned u) { return __uint_as_float(u << 16); }
__device__ __forceinline__ float bfhi(unsigned u) { return __uint_as_float(u & 0xffff0000u); }
__device__ __forceinline__ float bf2f(short s) { return __uint_as_float(((unsigned)(unsigned short)s) << 16); }
__device__ __forceinline__ unsigned cvtpk(float lo, float hi) { F2 v = {lo, hi}; bf16x2_t b = __builtin_convertvector(v, bf16x2_t); return __builtin_bit_cast(unsigned, b); }
__device__ __forceinline__ float wave_sum(float v) {
#pragma unroll
    for (int o = 1; o < 64; o <<= 1) v += __shfl_xor(v, o);
    return v;
}
__device__ __forceinline__ float sigm(float x) { return __builtin_amdgcn_rcpf(1.f + __expf(-x)); }
__device__ __forceinline__ float silu(float x) { return x * __builtin_amdgcn_rcpf(1.f + __expf(-x)); }
__device__ __forceinline__ float dot2bf(unsigned a, unsigned b, float c) { return __builtin_amdgcn_fdot2_f32_bf16(__builtin_bit_cast(bf16x2_t, a), __builtin_bit_cast(bf16x2_t, b), c, false); }
__device__ __forceinline__ float clamp8(float x) { return fminf(fmaxf(x, -448.f), 448.f); }
__device__ __forceinline__ unsigned pk4_fp8(float a, float b, float c, float d) {
    unsigned w = 0u; w = __builtin_amdgcn_cvt_pk_fp8_f32(clamp8(a), clamp8(b), w, false); w = __builtin_amdgcn_cvt_pk_fp8_f32(clamp8(c), clamp8(d), w, true); return w; }
__device__ __forceinline__ unsigned q8(float s) { return (unsigned)fminf(fmaxf(s * 255.f + 0.5f, 1.f), 255.f); }
__device__ __forceinline__ unsigned pk4_q8(float a, float b, float c, float d) { return q8(a) | (q8(b) << 8) | (q8(c) << 16) | (q8(d) << 24); }
__device__ __forceinline__ float b0f(unsigned w) { return (float)(w & 0xffu); }
__device__ __forceinline__ float b1f(unsigned w) { return (float)((w >> 8) & 0xffu); }
__device__ __forceinline__ float b2f(unsigned w) { return (float)((w >> 16) & 0xffu); }
__device__ __forceinline__ float b3f(unsigned w) { return (float)(w >> 24); }
__device__ __forceinline__ int crow(int r, int hi) { return (r & 3) + 8 * (r >> 2) + 4 * hi; }
#define MFMA32(a, b, c) __builtin_amdgcn_mfma_f32_32x32x16_bf16((a), (b), (c), 0, 0, 0)
typedef short v4i16_t __attribute__((ext_vector_type(4)));
__device__ __forceinline__ S4 trrd(LAS const unsigned char* p) { return __builtin_bit_cast(S4, __builtin_amdgcn_ds_read_tr16_b64_v4i16((LAS v4i16_t*)p)); }
__device__ __forceinline__ void glds16(const void* gsrc, unsigned lds_dst) { unsigned keep;
    asm volatile("s_mov_b32 %0, m0\n\ts_mov_b32 m0, %2\n\ts_nop 0\n\tglobal_load_lds_dwordx4 %1, off\n\ts_mov_b32 m0, %0" : "=&s"(keep) : "v"(gsrc), "s"(lds_dst) : "memory"); }
__device__ __forceinline__ unsigned offb(unsigned row, unsigned ch) { return 256u * row + 16u * (ch ^ (((row & 3) << 2) | ((row >> 2) & 3))); }
__device__ __forceinline__ unsigned offv(unsigned row, unsigned ch) { return 128u * row + 16u * (ch ^ (((row >> 1) & 1) << 2)); }

#define XB_TMO      128
#define XB_XCNT(j)  (256  + 64 * (j))
#define XB_XSUB(j)  (1280 + 64 * (j))
#define XB_XGEN(j)  (2304 + 64 * (j))
#define XB_TOP      3328
#define XB_TOPGEN   3392
#define XCD_BAR_WORDS 3456
#define XB_SPIN_CAP (1u << 18)

__device__ __forceinline__ unsigned xb_ld(unsigned* p)              { return __hip_atomic_load(p, __ATOMIC_RELAXED, __HIP_MEMORY_SCOPE_AGENT); }
__device__ __forceinline__ unsigned xb_add(unsigned* p, unsigned v) { return __hip_atomic_fetch_add(p, v, __ATOMIC_RELAXED, __HIP_MEMORY_SCOPE_AGENT); }
__device__ __forceinline__ unsigned xb_xcc_id() { return (unsigned)__builtin_amdgcn_s_getreg((3 << 11) | 20) & 0xFu; }
#define XB_SPIN(cond, bar) do { unsigned _sp = 0; while (cond) { __builtin_amdgcn_s_sleep(1); \
    if ((++_sp & 255u) == 0u) { if (xb_ld(&(bar)[XB_TMO])) break; if (_sp > XB_SPIN_CAP) { atomicAdd(&(bar)[XB_TMO], 1u); break; } } } } while (0)

struct XcdBarrier {
    unsigned* bar; unsigned x;
    volatile LAS unsigned* st;
};

__device__ __forceinline__ XcdBarrier xcd_barrier_post(unsigned* bar, volatile LAS unsigned* st) {
    XcdBarrier b; b.bar = bar; b.x = xb_xcc_id(); b.st = st;
    if (threadIdx.x == 0) (void)xb_add(&bar[XB_XCNT(b.x)], 1u);
    return b;
}
__device__ __forceinline__ void xcd_barrier_complete(unsigned* bar, unsigned x, unsigned& nloc, unsigned& nx) {
    const unsigned G = gridDim.x * gridDim.y * gridDim.z;
    unsigned sum, cnt, mine, sp = 0u;
    for (;;) {
        sum = 0u; cnt = 0u; mine = 0u;
#pragma unroll
        for (unsigned j = 0; j < 16; ++j) { const unsigned c = xb_ld(&bar[XB_XCNT(j)]); sum += c; cnt += (c > 0u) ? 1u : 0u; mine = (j == x) ? c : mine; }
        if (sum == G) break;
        __builtin_amdgcn_s_sleep(1);
        if ((++sp & 255u) == 0u) { if (xb_ld(&bar[XB_TMO])) break; if (sp > XB_SPIN_CAP) { atomicAdd(&bar[XB_TMO], 1u); break; } }
    }
    nloc = mine > 0u ? mine : 1u; nx = cnt > 0u ? cnt : 1u;
}

__device__ __forceinline__ void xcd_barrier(const XcdBarrier& b) {
    asm volatile("s_waitcnt vmcnt(0)" ::: "memory");
    __syncthreads();
    if (threadIdx.x == 0) {
        unsigned* bar = b.bar;
        __builtin_amdgcn_s_waitcnt(0);
        unsigned nloc = b.st[0], nx = b.st[1];
        if (nloc == 0u) { xcd_barrier_complete(bar, b.x, nloc, nx); b.st[0] = nloc; b.st[1] = nx; }
        const unsigned old = xb_add(&bar[XB_XSUB(b.x)], 1u);
        const unsigned gen = old / nloc;
        if (old + 1u == (gen + 1u) * nloc) {
            __builtin_amdgcn_fence(__ATOMIC_RELEASE, "agent");
            asm volatile("s_waitcnt vmcnt(0)" ::: "memory");
            const unsigned og = xb_add(&bar[XB_TOP], 1u);
            const unsigned tg = og / nx;
            if (og + 1u == (tg + 1u) * nx) xb_add(&bar[XB_TOPGEN], 1u);
            else XB_SPIN(xb_ld(&bar[XB_TOPGEN]) == tg, bar);
            __builtin_amdgcn_fence(__ATOMIC_ACQUIRE, "agent");
            xb_add(&bar[XB_XGEN(b.x)], 1u);
            asm volatile("s_waitcnt vmcnt(0)" ::: "memory");
        } else {
            XB_SPIN(xb_ld(&bar[XB_XGEN(b.x)]) == gen, bar);
            __builtin_amdgcn_fence(__ATOMIC_ACQUIRE, "agent");
            asm volatile("s_waitcnt vmcnt(0)" ::: "memory");
        }
    }
    __syncthreads();
}

namespace pg8 {
struct EpiProj {
    static constexpr bool PERM = true, AFTER_DRAIN = false, MIDK = false; static constexpr int NST = 16;
    unsigned char* ws; unsigned char* ob;
    __device__ __forceinline__ void operator()(const f32x4 (&acc)[2][2][4][2], const Unit& u, int wr, int wc, int fr, int fq) const {
        const int pn = u.pn; bf16_t* base; int ld, ct;
        if (pn < 2)       { base = (bf16_t*)(ws + WS_RQ); ld = 512;  ct = pn; }
        else if (pn < 4)  { base = (bf16_t*)(ws + WS_RK); ld = 512;  ct = pn - 2; }
        else if (pn < 8)  { base = (bf16_t*)(ws + WS_RV); ld = 1024; ct = pn - 4; }
        else if (pn < 12) { base = (bf16_t*)(ws + WS_RG); ld = 1024; ct = pn - 8; }
        else if (pn < 14) { base = (bf16_t*)(ws + WS_MQ); ld = 512;  ct = pn - 12; }
        else if (pn < 16) { base = (bf16_t*)(ws + WS_MK); ld = 512;  ct = pn - 14; }
        else if (pn < 20) { base = (bf16_t*)(ws + WS_MV); ld = 1024; ct = pn - 16; }
        else if (pn < 24) { base = (bf16_t*)(ws + WS_MO); ld = 1024; ct = pn - 20; }
        else if (pn < 28) { base = (bf16_t*)(ob + OUT_GR); ld = 1024; ct = pn - 24; }
        else              { base = (bf16_t*)(ob + OUT_GM); ld = 1024; ct = pn - 28; }
        int row0 = u.pm * BM + wr * 64 + fr, col0 = ct * BM + wc * 32 + 8 * fq;
        asm volatile("" : "+v"(row0), "+v"(col0));
        if (pn >= 20) {
            unsigned char* b8 = pn < 24 ? (unsigned char*)(ws + WS_MO) : (pn < 28 ? (unsigned char*)(ob + OUT_GR) : (unsigned char*)(ob + OUT_GM));
#pragma unroll
            for (int ai = 0; ai < 2; ++ai)
#pragma unroll
                for (int m = 0; m < 4; ++m) { unsigned char* rowp = b8 + (size_t)(row0 + ai * HALF + m * 16) * 1024 + col0;
#pragma unroll
                    for (int bj = 0; bj < 2; ++bj) { const f32x4 v0 = acc[ai][bj][m][0], v1 = acc[ai][bj][m][1];
                        U2 w; w.x = pk4_q8(sigm(v0[0]), sigm(v0[1]), sigm(v0[2]), sigm(v0[3])); w.y = pk4_q8(sigm(v1[0]), sigm(v1[1]), sigm(v1[2]), sigm(v1[3]));
                        *(U2*)(rowp + bj * HALF) = w; } }
            return;
        }
        if (pn < 4) {
            const int hd = (pn & 1) * 2 + (wc >> 1), d1 = 32 * (wc & 1) + 8 * fq;
            const float lg = hd == 0 ? -0.04580368961312479f : (hd == 1 ? -0.02272007650008353f : (hd == 2 ? -0.011315313227834146f : -0.005646563141142063f));
            const float2* RT = (const float2*)(ws + WS_ROPE);
#pragma unroll
            for (int ai = 0; ai < 2; ++ai)
#pragma unroll
                for (int m = 0; m < 4; ++m) { const int r = row0 + ai * HALF + m * 16, pos = r & (SEQ - 1), l = r & (CHUNK - 1);
                    const float sc = pn < 2 ? exp2f(lg * (float)l) : exp2f(-lg * (float)l) * 0.08838834764831845f;
                    const f32x4* rt = (const f32x4*)(RT + (size_t)pos * 64 + d1);
                    const f32x4 c0 = rt[0], c1 = rt[1], c2 = rt[2], c3 = rt[3];
                    const f32x4 a0 = acc[ai][0][m][0], a1 = acc[ai][0][m][1], b0 = acc[ai][1][m][0], b1 = acc[ai][1][m][1];
                    u32x4 w1, w2;
                    w1.x = cvt_pk_bf16((a0[0] * c0[0] - b0[0] * c0[1]) * sc, (a0[1] * c0[2] - b0[1] * c0[3]) * sc); w1.y = cvt_pk_bf16((a0[2] * c1[0] - b0[2] * c1[1]) * sc, (a0[3] * c1[2] - b0[3] * c1[3]) * sc);
                    w1.z = cvt_pk_bf16((a1[0] * c2[0] - b1[0] * c2[1]) * sc, (a1[1] * c2[2] - b1[1] * c2[3]) * sc); w1.w = cvt_pk_bf16((a1[2] * c3[0] - b1[2] * c3[1]) * sc, (a1[3] * c3[2] - b1[3] * c3[3]) * sc);
                    w2.x = cvt_pk_bf16((b0[0] * c0[0] + a0[0] * c0[1]) * sc, (b0[1] * c0[2] + a0[1] * c0[3]) * sc); w2.y = cvt_pk_bf16((b0[2] * c1[0] + a0[2] * c1[1]) * sc, (b0[3] * c1[2] + a0[3] * c1[3]) * sc);
                    w2.z = cvt_pk_bf16((b1[0] * c2[0] + a1[0] * c2[1]) * sc, (b1[1] * c2[2] + a1[1] * c2[3]) * sc); w2.w = cvt_pk_bf16((b1[2] * c3[0] + a1[2] * c3[1]) * sc, (b1[3] * c3[2] + a1[3] * c3[3]) * sc);
                    bf16_t* rowp = base + (size_t)r * 512 + hd * 128 + d1;
                    *(u32x4*)rowp = w1; *(u32x4*)(rowp + 64) = w2; }
            return;
        }
#pragma unroll
        for (int ai = 0; ai < 2; ++ai)
#pragma unroll
            for (int m = 0; m < 4; ++m) { bf16_t* rowp = base + (size_t)(row0 + ai * HALF + m * 16) * ld + col0;
#pragma unroll
                for (int bj = 0; bj < 2; ++bj) { f32x4 v0 = acc[ai][bj][m][0], v1 = acc[ai][bj][m][1];
                    u32x4 w; w.x = cvt_pk_bf16(v0[0], v0[1]); w.y = cvt_pk_bf16(v0[2], v0[3]); w.z = cvt_pk_bf16(v1[0], v1[1]); w.w = cvt_pk_bf16(v1[2], v1[3]);
                    *(u32x4*)(rowp + bj * HALF) = w; } }
    }
};
#ifndef ABL_EPI
#define ABL_EPI 0
#endif
struct EpiGateFused {
    static constexpr bool PERM = true, AFTER_DRAIN = false, MIDK = true; static constexpr int NST = 16;
    const unsigned char* GR; const unsigned char* GM; bf16_t* O;
    __device__ __forceinline__ void midk(f32x4 (&acc)[2][2][4][2], const Unit& u, int wr, int wc, int fr, int fq) const {
        if (ABL_EPI & 2) return;
        int row0 = u.pm * BM + wr * 64 + fr, col0 = u.pn * BM + wc * 32 + 8 * fq;
        asm volatile("" : "+v"(row0), "+v"(col0));
#pragma unroll
        for (int ai = 0; ai < 2; ++ai) {
#pragma unroll
            for (int m = 0; m < 4; ++m) { const size_t ro = (size_t)(row0 + ai * HALF + m * 16) * 1024 + col0;
#pragma unroll
                for (int bj = 0; bj < 2; ++bj) {
                    const U2 a = *(const U2*)(GR + ro + bj * HALF), b = *(const U2*)(GM + ro + bj * HALF);
                    f32x4 r0, r1;
                    r0[0] = b0f(a.x) * __builtin_amdgcn_rcpf(b0f(b.x)); r0[1] = b1f(a.x) * __builtin_amdgcn_rcpf(b1f(b.x)); r0[2] = b2f(a.x) * __builtin_amdgcn_rcpf(b2f(b.x)); r0[3] = b3f(a.x) * __builtin_amdgcn_rcpf(b3f(b.x));
                    r1[0] = b0f(a.y) * __builtin_amdgcn_rcpf(b0f(b.y)); r1[1] = b1f(a.y) * __builtin_amdgcn_rcpf(b1f(b.y)); r1[2] = b2f(a.y) * __builtin_amdgcn_rcpf(b2f(b.y)); r1[3] = b3f(a.y) * __builtin_amdgcn_rcpf(b3f(b.y));
                    acc[ai][bj][m][0] *= r0; acc[ai][bj][m][1] *= r1; } }
            asm volatile("" ::: "memory"); }
    }
    __device__ __forceinline__ void operator()(const f32x4 (&acc)[2][2][4][2], const Unit& u, int wr, int wc, int fr, int fq) const {
        int row0 = u.pm * BM + wr * 64 + fr, col0 = u.pn * BM + wc * 32 + 8 * fq;
        asm volatile("" : "+v"(row0), "+v"(col0));
        if (ABL_EPI & 1) { if (acc[0][0][0][0][0] == 1.2345f) O[row0] = 0; return; }
        const float k = 1.f / 255.f;
        U2 gv[2][4][2];
#pragma unroll
        for (int ai = 0; ai < 2; ++ai)
#pragma unroll
            for (int m = 0; m < 4; ++m) { const size_t ro = (size_t)(row0 + ai * HALF + m * 16) * 1024 + col0;
#pragma unroll
                for (int bj = 0; bj < 2; ++bj) { if (ABL_EPI & 4) gv[ai][m][bj] = (U2){0x80808080u + (unsigned)ro, 0x80808080u}; else gv[ai][m][bj] = *(const U2*)(GM + ro + bj * HALF); } }
#pragma unroll
        for (int ai = 0; ai < 2; ++ai)
#pragma unroll
            for (int m = 0; m < 4; ++m) { const size_t ro = (size_t)(row0 + ai * HALF + m * 16) * 1024 + col0;
#pragma unroll
                for (int bj = 0; bj < 2; ++bj) { const f32x4 v0 = acc[ai][bj][m][0] * k, v1 = acc[ai][bj][m][1] * k;
                    const U2 g = gv[ai][m][bj];
                    u32x4 w; w.x = cvt_pk_bf16(v0[0] * b0f(g.x), v0[1] * b1f(g.x)); w.y = cvt_pk_bf16(v0[2] * b2f(g.x), v0[3] * b3f(g.x));
                    w.z = cvt_pk_bf16(v1[0] * b0f(g.y), v1[1] * b1f(g.y)); w.w = cvt_pk_bf16(v1[2] * b2f(g.y), v1[3] * b3f(g.y));
                    if (ABL_EPI & 8) asm volatile("" :: "v"(w.x), "v"(w.y), "v"(w.z), "v"(w.w));
                    else if (ABL_EPI & 16) __builtin_nontemporal_store(w, (u32x4*)(O + ro + bj * HALF));
                    else *(u32x4*)(O + ro + bj * HALF) = w; } }
    }
};
struct EpiX1 {
    static constexpr bool PERM = true, AFTER_DRAIN = false, MIDK = false; static constexpr int NST = 32;
    const float* X; float* O;
    __device__ __forceinline__ void operator()(const f32x4 (&acc)[2][2][4][2], const Unit& u, int wr, int wc, int fr, int fq) const {
        const int row0 = u.pm * BM + wr * 64 + fr, col0 = u.pn * BM + wc * 32 + 8 * fq;
#pragma unroll
        for (int ai = 0; ai < 2; ++ai)
#pragma unroll
            for (int m = 0; m < 4; ++m) { const size_t ro = (size_t)(row0 + ai * HALF + m * 16) * 1024 + col0;
#pragma unroll
                for (int bj = 0; bj < 2; ++bj) {
                    const f32x4 a = *(const f32x4*)(X + ro + bj * HALF), b = *(const f32x4*)(X + ro + bj * HALF + 4);
                    *(f32x4*)(O + ro + bj * HALF) = a + acc[ai][bj][m][0]; *(f32x4*)(O + ro + bj * HALF + 4) = b + acc[ai][bj][m][1]; } }
    }
};
struct EpiSwiglu {
    static constexpr bool PERM = true, AFTER_DRAIN = false, MIDK = false; static constexpr int NST = 8;
    bf16_t* O; const float* srstd;
    __device__ __forceinline__ void operator()(const f32x4 (&acc)[2][2][4][2], const Unit& u, int wr, int wc, int fr, int fq) const {
        const int row0 = u.pm * BM + wr * 64 + fr, col0 = (u.pn & 3) * HALF + wc * 32 + 8 * fq;
        float rs[2][4];
#pragma unroll
        for (int ai = 0; ai < 2; ++ai)
#pragma unroll
            for (int m = 0; m < 4; ++m) rs[ai][m] = srstd[u.pa + wr * 64 + fr + ai * HALF + m * 16];
#pragma unroll
        for (int ai = 0; ai < 2; ++ai)
#pragma unroll
            for (int m = 0; m < 4; ++m) { bf16_t* rowp = O + (size_t)(row0 + ai * HALF + m * 16) * 512 + col0; const float r = rs[ai][m];
                const f32x4 g0 = acc[ai][0][m][0] * r, g1 = acc[ai][0][m][1] * r, u0 = acc[ai][1][m][0] * r, u1 = acc[ai][1][m][1] * r;
                u32x4 w; w.x = cvt_pk_bf16(silu(g0[0]) * u0[0], silu(g0[1]) * u0[1]); w.y = cvt_pk_bf16(silu(g0[2]) * u0[2], silu(g0[3]) * u0[3]);
                w.z = cvt_pk_bf16(silu(g1[0]) * u1[0], silu(g1[1]) * u1[1]); w.w = cvt_pk_bf16(silu(g1[2]) * u1[2], silu(g1[3]) * u1[3]);
                *(u32x4*)rowp = w; }
    }
};
struct EpiY {
    static constexpr bool PERM = true, AFTER_DRAIN = false, MIDK = false; static constexpr int NST = 16;
    unsigned char* O;
    __device__ __forceinline__ void operator()(const f32x4 (&acc)[2][2][4][2], const Unit& u, int wr, int wc, int fr, int fq) const {
        int row0 = u.pm * BM + wr * 64 + fr, col0 = (u.pn & 3) * BM + wc * 32 + 8 * fq;
        asm volatile("" : "+v"(row0), "+v"(col0));
#pragma unroll
        for (int ai = 0; ai < 2; ++ai)
#pragma unroll
            for (int m = 0; m < 4; ++m) { unsigned char* rowp = O + (size_t)(row0 + ai * HALF + m * 16) * 1024 + col0;
#pragma unroll
                for (int bj = 0; bj < 2; ++bj) { const f32x4 v0 = acc[ai][bj][m][0] * 16.f, v1 = acc[ai][bj][m][1] * 16.f;
                    U2 w; w.x = pk4_fp8(v0[0], v0[1], v0[2], v0[3]); w.y = pk4_fp8(v1[0], v1[1], v1[2], v1[3]);
                    *(U2*)(rowp + bj * HALF) = w; } }
    }
};
template <bool GATHER_> struct GroupedOrder {
    static constexpr bool GATHER = GATHER_;
    int ntiles, G, c; const PG8_LAS unsigned char* t2e; const PG8_LAS int* rb; const int* tokmap;
    __device__ __forceinline__ bool next(int i, Unit& u) const {
        const int L = i * G + c; if (L >= ntiles * 4) return false;
        const int rt = L >> 2; const int e = __builtin_amdgcn_readfirstlane((int)t2e[rt]);
        u.pm = rt; u.pn = e * 4 + (L & 3); u.pa = e * 65536 + ((rt - (__builtin_amdgcn_readfirstlane(rb[e]) >> 8)) << 8); return true;
    }
    __device__ __forceinline__ unsigned arow(const Unit& u, int r) const { const unsigned t = (unsigned)tokmap[u.pa + r]; return t < (unsigned)NTOK ? t : (unsigned)(NTOK - 1); }
    __device__ __forceinline__ void a_ready(const Unit&) const {}
    __device__ __forceinline__ void done(const Unit&) const {}
};
}

struct Ctx { LAS unsigned char* lds; int tid, lane, wave, vcu, G; };

#ifndef ABL_TR
#define ABL_TR 0
#endif
struct TrItem { const float* W; int ld, k0, n0; bf16* WT; int K, drow0, kdst; const float* ksc; };
__device__ __forceinline__ void tr_load(const TrItem& t, F4 (&v)[8], int lane) {
#pragma unroll
    for (int i = 0; i < 8; ++i) v[i] = *(const F4*)(t.W + (size_t)(t.k0 + 8 * i + (lane >> 3)) * t.ld + t.n0 + 4 * (lane & 7));
}
__device__ __forceinline__ void tr_store(const TrItem& t, const F4 (&v)[8], LAS float* scr, int lane) {
    if (ABL_TR & 2) { _Pragma("unroll") for (int i = 0; i < 8; ++i) asm volatile("" :: "v"(v[i].x), "v"(v[i].y), "v"(v[i].z), "v"(v[i].w)); return; }
#pragma unroll
    for (int i = 0; i < 8; ++i) { LAS float* d = scr + (8 * i + (lane >> 3)) * 33 + 4 * (lane & 7); d[0] = v[i].x; d[1] = v[i].y; d[2] = v[i].z; d[3] = v[i].w; }
    asm volatile("s_waitcnt lgkmcnt(0)" ::: "memory");
    const int c = lane & 7;
    F4 k0s = (F4){1.f, 1.f, 1.f, 1.f}, k1s = k0s; if (t.ksc) { k0s = *(const F4*)(t.ksc + t.k0 + 8 * c); k1s = *(const F4*)(t.ksc + t.k0 + 8 * c + 4); }
#pragma unroll
    for (int j = 0; j < 4; ++j) { const int n = (lane >> 3) + 8 * j; const LAS float* s = scr + (8 * c) * 33 + n;
        U4 o; o.x = cvtpk(s[0 * 33] * k0s.x, s[1 * 33] * k0s.y); o.y = cvtpk(s[2 * 33] * k0s.z, s[3 * 33] * k0s.w); o.z = cvtpk(s[4 * 33] * k1s.x, s[5 * 33] * k1s.y); o.w = cvtpk(s[6 * 33] * k1s.z, s[7 * 33] * k1s.w);
        if (ABL_TR & 1) asm volatile("" :: "v"(o.x), "v"(o.y), "v"(o.z), "v"(o.w)); else *(U4*)(t.WT + (size_t)(t.drow0 + n) * t.K + t.kdst + t.k0 + 8 * c) = o; }
    asm volatile("s_waitcnt lgkmcnt(0)" ::: "memory");
}
template <class Dec> __device__ __forceinline__ void tr_loop(int first, int step, int nitems, Dec dec, LAS float* scr, int lane) {
    F4 va[8]; int it = first;
    if (it < nitems) { const TrItem t0 = dec(it); tr_load(t0, va, lane); }
    for (; it < nitems; it += step) {
        F4 vb[8]; const bool hn = it + step < nitems;
        if (hn) { const TrItem tn = dec(it + step); tr_load(tn, vb, lane); }
        { const TrItem tc = dec(it); tr_store(tc, va, scr, lane); }
        if (hn) {
#pragma unroll
            for (int i = 0; i < 8; ++i) va[i] = vb[i]; }
    }
}

__device__ __forceinline__ void phase0(const Ctx& C, const float* const* in, unsigned char* ws) {
    const float* x = in[0]; const float* nw = in[1]; const float* w_in = in[2];
    LAS float* scr = (LAS float*)(C.lds + C.wave * 8448);
    LAS float* wif = (LAS float*)(C.lds + 98304);
    LAS double* invf = (LAS double*)(C.lds + 98304 + 32768);
    for (int i = C.tid; i < 8192; i += NTHR) { const int c = i & 3, e = i >> 2, l = e & 63, jj = (e >> 6) & 15, p = e >> 10; const int k = 4 * l + 256 * (jj >> 2) + (jj & 3);
        wif[i] = w_in[(size_t)k * DIN + 6144 + 4 * p + c]; }
    if (C.tid < 64) { double r = 1.0; for (int j = 0; j < C.tid; ++j) r *= 0.8659643233600653; invf[C.tid] = r; }
    __syncthreads();
    const int gw = C.vcu * NWAVES + C.wave, NGW = C.G * NWAVES;
    {
        bf16* H = (bf16*)(ws + WS_H); float* IFP = (float*)(ws + WS_IF);
        F4 wv[4];
#pragma unroll
        for (int j = 0; j < 4; ++j) wv[j] = *(const F4*)(nw + 4 * C.lane + 256 * j);
        for (int m = gw; m < NTOK; m += NGW) {
            const F4* xr = (const F4*)(x + (size_t)m * DM) + C.lane;
            F4 v[4]; float s = 0.f;
#pragma unroll
            for (int j = 0; j < 4; ++j) { v[j] = xr[64 * j]; s += (v[j].x * v[j].x + v[j].y * v[j].y) + (v[j].z * v[j].z + v[j].w * v[j].w); }
            const float rstd = rsqrtf(wave_sum(s) * (1.f / DM) + EPS);
            float g[8];
#pragma unroll
            for (int c = 0; c < 8; ++c) g[c] = 0.f;
            unsigned long long* o8 = (unsigned long long*)(H + (size_t)m * DM) + C.lane;
#pragma unroll
            for (int j = 0; j < 4; ++j) { v[j] = v[j] * rstd * wv[j];
                o8[64 * j] = (unsigned long long)cvtpk(v[j].x, v[j].y) | ((unsigned long long)cvtpk(v[j].z, v[j].w) << 32);
#pragma unroll
                for (int i = 0; i < 4; ++i) { const LAS F4* wp = (const LAS F4*)wif + (j * 4 + i) * 64 + C.lane; const F4 wa = wp[0], wb = wp[1024]; const float hv = v[j][i];
                    g[0] += hv * wa.x; g[1] += hv * wa.y; g[2] += hv * wa.z; g[3] += hv * wa.w; g[4] += hv * wb.x; g[5] += hv * wb.y; g[6] += hv * wb.z; g[7] += hv * wb.w; } }
#pragma unroll
            for (int c = 0; c < 8; ++c) g[c] = wave_sum(g[c]);
            if (C.lane == 0) { F4* op = (F4*)(IFP + (size_t)m * 8); op[0] = (F4){g[0], g[1], g[2], g[3]}; op[1] = (F4){g[4], g[5], g[6], g[7]}; }
        }
    }
    tr_loop(gw, NGW, 4096 + 3 * 512, [=](int it) __attribute__((always_inline)) -> TrItem {
        if (it < 4096) { const int kb = it >> 8, nb = it & 255; int src = nb * 32 + (nb >= 192 ? 8 : 0);
            if (nb < 32) { const int p0 = (nb * 32) & 255, q0 = p0 & 127; src = (nb >> 3) * 256 + (q0 >> 6) * 128 + (q0 & 63) + 64 * (p0 >> 7); }
            return TrItem{w_in, DIN, kb * 64, src, (bf16*)(ws + WS_WIN), 1024, nb * 32, 0, nullptr}; }
        int r = it - 4096; const int mth = r >> 9; r &= 511; const int kb = r >> 5, nb = r & 31;
        const float* W = mth == 0 ? in[4] : (mth == 1 ? in[10] : in[11]);
        if (mth < 2) return TrItem{W, 1024, kb * 64, nb * 32, (bf16*)(ws + WS_WCAT), 2048, nb * 32, mth * 1024, nullptr};
        return TrItem{W, 1024, kb * 64, nb * 32, (bf16*)(ws + WS_WOUT), 1024, nb * 32, 0, nullptr}; }, scr, C.lane);
    { F2* RT = (F2*)(ws + WS_ROPE);
        for (int idx = C.vcu * NTHR + C.tid; idx < SEQ * 64; idx += C.G * NTHR) { const int pos = idx >> 6, j = idx & 63;
            const double rev = (double)pos * invf[j] * 0.15915494309189535; const float fr = (float)(rev - __builtin_floor(rev));
            RT[idx] = (F2){__builtin_amdgcn_cosf(fr), __builtin_amdgcn_sinf(fr)}; } }
    { U4* WRH = (U4*)(ws + WS_ROUT); U4* WRL = (U4*)(ws + WS_ROUT + 98304); const float* nfw = in[12]; const float* wg = in[13]; const float* we = in[15];
        for (int idx = C.vcu * NTHR + C.tid; idx < 32 * 3 * 64; idx += C.G * NTHR) { const int l = idx & 63, nt = (idx >> 6) % 3, kb2 = idx / 192; const int n = 16 * nt + (l & 15);
            float hv[8], lv[8];
#pragma unroll
            for (int j = 0; j < 8; ++j) { const int k = 32 * kb2 + 8 * (l >> 4) + j; float wv = 0.f; if (n < 4) wv = wg[k * 4 + n]; else if (n < 36) wv = we[k * 32 + (n - 4)]; wv *= nfw[k];
                const float h = bflo(cvtpk(wv, 0.f)); hv[j] = h; lv[j] = wv - h; }
            U4 oh, ol; oh.x = cvtpk(hv[0], hv[1]); oh.y = cvtpk(hv[2], hv[3]); oh.z = cvtpk(hv[4], hv[5]); oh.w = cvtpk(hv[6], hv[7]);
            ol.x = cvtpk(lv[0], lv[1]); ol.y = cvtpk(lv[2], lv[3]); ol.z = cvtpk(lv[4], lv[5]); ol.w = cvtpk(lv[6], lv[7]);
            WRH[idx] = oh; WRL[idx] = ol; } }
}

__device__ __forceinline__ float wscan_add(float v, int lane) {
#pragma unroll
    for (int o = 1; o < 64; o <<= 1) { const float t = __shfl_up(v, o); if (lane >= o) v += t; }
    return v;
}
__device__ __forceinline__ float wscan_max(float v, int lane) {
#pragma unroll
    for (int o = 1; o < 64; o <<= 1) { const float t = __shfl_up(v, o); if (lane >= o) v = fmaxf(v, t); }
    return v;
}
__device__ __forceinline__ void phase2(const Ctx& C, const float* const* in, unsigned char* ws) {
    const float* convw = in[5]; const float* convb = in[6]; const float* b_i = in[7]; const float* b_f = in[8];
    LAS float* sQ = (LAS float*)(C.lds);
    LAS float* sK = (LAS float*)(C.lds + 2048);
    const float* IFP = (const float*)(ws + WS_IF); float* THR = (float*)(ws + WS_THR); float* CDEC = (float*)(ws + WS_CDEC);
    const F2* RT = (const F2*)(ws + WS_ROPE);
    for (int it = C.vcu; it < BATCH * NCHUNK; it += C.G) {
        const int b = it >> 6, c = it & 63; const size_t t0 = (size_t)b * SEQ + (size_t)c * CHUNK;
        __syncthreads();
        if (C.wave < 4) { const int hd = C.wave, l = C.lane;
            const float i0 = IFP[(t0 + 2 * l) * 8 + hd] + b_i[hd], i1 = IFP[(t0 + 2 * l + 1) * 8 + hd] + b_i[hd];
            const float f0 = IFP[(t0 + 2 * l) * 8 + 4 + hd] + b_f[hd], f1 = IFP[(t0 + 2 * l + 1) * 8 + 4 + hd] + b_f[hd];
            const float lf0 = fminf(f0, 0.f) - log1pf(__expf(-fabsf(f0))), lf1 = fminf(f1, 0.f) - log1pf(__expf(-fabsf(f1)));
            const float s1 = lf0 + lf1, inc = wscan_add(s1, l), ex = inc - s1;
            const float b0 = ex + lf0, b1 = ex + s1;
            const float u0 = i0 - b0, u1 = i1 - b1, p1 = fmaxf(u0, u1);
            const float pin = wscan_max(p1, l); float pex = __shfl_up(pin, 1); if (l == 0) pex = -INFINITY;
            const float pm0 = fmaxf(pex, u0), pm1 = fmaxf(pex, p1);
            sQ[hd * 128 + 2 * l] = __expf(-pm0); sQ[hd * 128 + 2 * l + 1] = __expf(-pm1);
            sK[hd * 128 + 2 * l] = __expf(u0) * 0.08838834764831845f; sK[hd * 128 + 2 * l + 1] = __expf(u1) * 0.08838834764831845f;
            THR[(t0 + 2 * l) * 4 + hd] = __expf(-b0 - pm0); THR[(t0 + 2 * l + 1) * 4 + hd] = __expf(-b1 - pm1);
            if (l == 63) CDEC[(size_t)it * 4 + hd] = __expf(b1);
        }
        __syncthreads();
        { const int arr = C.wave >> 2, seg = C.wave & 3, g = C.lane, hd = g >> 4, chn = arr * 512 + 8 * g;
          const bf16* src = (const bf16*)(ws + (arr ? WS_MK : WS_MQ)) + (t0 + 32 * seg) * 512 + 8 * g;
          bf16* dst = (bf16*)(ws + (arr ? WS_MKP : WS_MQP)) + (t0 + 32 * seg) * 512 + 8 * g;
          const LAS float* scp = (arr ? sK : sQ) + hd * 128 + 32 * seg;
          float wt[4][8], bs[8];
#pragma unroll
          for (int w = 0; w < 4; ++w) { const F4 w0 = *(const F4*)(convw + w * 1024 + chn), w1 = *(const F4*)(convw + w * 1024 + chn + 4);
              wt[w][0] = w0.x; wt[w][1] = w0.y; wt[w][2] = w0.z; wt[w][3] = w0.w; wt[w][4] = w1.x; wt[w][5] = w1.y; wt[w][6] = w1.z; wt[w][7] = w1.w; }
          { const F4 b0 = *(const F4*)(convb + chn), b1 = *(const F4*)(convb + chn + 4); bs[0] = b0.x; bs[1] = b0.y; bs[2] = b0.z; bs[3] = b0.w; bs[4] = b1.x; bs[5] = b1.y; bs[6] = b1.z; bs[7] = b1.w; }
          const bool has_prev = (c * CHUNK + 32 * seg) > 0;
          U4 win[3];
#pragma unroll
          for (int k = 0; k < 3; ++k) win[k] = has_prev ? *(const U4*)(src - (size_t)(3 - k) * 512) : (U4){0u, 0u, 0u, 0u};
          for (int r0 = 0; r0 < 32; r0 += 8) {
              U4 rows[8];
#pragma unroll
              for (int k = 0; k < 8; ++k) rows[k] = *(const U4*)(src + (size_t)(r0 + k) * 512);
#pragma unroll
              for (int k = 0; k < 8; ++k) {
                  const U4 x0 = win[0], x1 = win[1], x2 = win[2], x3 = rows[k];
                  float y[8];
                  y[0] = bs[0] + bflo(x0.x) * wt[0][0] + bflo(x1.x) * wt[1][0] + bflo(x2.x) * wt[2][0] + bflo(x3.x) * wt[3][0];
                  y[1] = bs[1] + bfhi(x0.x) * wt[0][1] + bfhi(x1.x) * wt[1][1] + bfhi(x2.x) * wt[2][1] + bfhi(x3.x) * wt[3][1];
                  y[2] = bs[2] + bflo(x0.y) * wt[0][2] + bflo(x1.y) * wt[1][2] + bflo(x2.y) * wt[2][2] + bflo(x3.y) * wt[3][2];
                  y[3] = bs[3] + bfhi(x0.y) * wt[0][3] + bfhi(x1.y) * wt[1][3] + bfhi(x2.y) * wt[2][3] + bfhi(x3.y) * wt[3][3];
                  y[4] = bs[4] + bflo(x0.z) * wt[0][4] + bflo(x1.z) * wt[1][4] + bflo(x2.z) * wt[2][4] + bflo(x3.z) * wt[3][4];
                  y[5] = bs[5] + bfhi(x0.z) * wt[0][5] + bfhi(x1.z) * wt[1][5] + bfhi(x2.z) * wt[2][5] + bfhi(x3.z) * wt[3][5];
                  y[6] = bs[6] + bflo(x0.w) * wt[0][6] + bflo(x1.w) * wt[1][6] + bflo(x2.w) * wt[2][6] + bflo(x3.w) * wt[3][6];
                  y[7] = bs[7] + bfhi(x0.w) * wt[0][7] + bfhi(x1.w) * wt[1][7] + bfhi(x2.w) * wt[2][7] + bfhi(x3.w) * wt[3][7];
                  const float sc = scp[r0 + k];
#pragma unroll
                  for (int i = 0; i < 8; ++i) y[i] = silu(y[i]) * sc;
                  U4 o; o.x = cvtpk(y[0], y[1]); o.y = cvtpk(y[2], y[3]); o.z = cvtpk(y[4], y[5]); o.w = cvtpk(y[6], y[7]);
                  *(U4*)(dst + (size_t)(r0 + k) * 512) = o;
                  win[0] = x1; win[1] = x2; win[2] = x3;
              }
          } }
    }
}

template <bool ML, int ABL = 0>
__device__ __forceinline__ void mixer_item(const Ctx& C, const bf16* Qp, const bf16* Kp, bf16* Vp, bf16* Vout, size_t omask, const float* thr, const float* cdec, int b, int hd, int sl) {
    LAS unsigned char* lds = C.lds;
    const int tid = C.tid, lane = C.lane, w = C.wave, l31 = lane & 31, hi = lane >> 5;
    const int lt = (w < 4) ? w : 7 - w, et = w >> 2, dt = w & 3;
    const int q_ = (lane & 15) >> 2, p_ = lane & 3, blk = (lane >> 4) & 1;
    constexpr unsigned KOFF = 0, VOFF = 65536, QOFF = 98304, SOFF = 131072, NOFF = 147456;
    const size_t tok0 = (size_t)b * SEQ;
    const float rdec = hd == 0 ? 0.017183023570817902f : (hd == 1 ? 0.1332151628796484f : (hd == 2 ? 0.3664377159220373f : 0.6059370882290803f));
    __syncthreads();
    for (int i = tid; i < 16384 / 16; i += NTHR) *(LAS U4*)(lds + SOFF + 16 * i) = (U4){0u, 0u, 0u, 0u};
    if (tid < 384) *(LAS float*)(lds + NOFF + 4 * tid) = 0.f;
    F16 St;
#pragma unroll
    for (int r = 0; r < 16; ++r) St[r] = 0.f;
    B8 qf[8];
    const unsigned lds0 = (unsigned)(uintptr_t)lds;
    unsigned ro[8];
#pragma unroll
    for (int s = 0; s < 8; ++s) ro[s] = offb(l31, 2 * s + hi);
    const unsigned kbase = (16 * w + (lane >> 4)) * 512, kx = (lane & 15) ^ ((lane >> 4) << 2);
    const unsigned vbase = (16 * w + (lane >> 3)) * 1024 + ((lane & 7) ^ (((lane >> 4) & 1) << 2)) * 8;
#define ksrc_(i) (kbase + (i) * 2048 + ((kx ^ (i)) * 8))
#define vsrc_(i) (vbase + (i) * 8192)
#define MX_PIECE(cc, buf, i) do { if ((i) < 4) glds16(Kp + (tok0 + (size_t)(cc) * CHUNK) * 512 + hd * 128 + ksrc_(i), (unsigned)__builtin_amdgcn_readfirstlane((int)(lds0 + KOFF + (buf) * 32768 + (w * 4 + (i)) * 1024))); \
        else if ((i) < 6) glds16(Vp + (tok0 + (size_t)(cc) * CHUNK) * 1024 + hd * 256 + sl * 64 + vsrc_((i) - 4), (unsigned)__builtin_amdgcn_readfirstlane((int)(lds0 + VOFF + (buf) * 16384 + (w * 2 + (i) - 4) * 1024))); \
        else glds16(Qp + (tok0 + (size_t)(cc) * CHUNK) * 512 + hd * 128 + ksrc_((i) - 6), (unsigned)__builtin_amdgcn_readfirstlane((int)(lds0 + QOFF + (w * 4 + (i) - 6) * 1024))); } while (0)
#define MX_DMA(cc, buf) do { \
        const bf16* kp_ = Kp + (tok0 + (size_t)(cc) * CHUNK) * 512 + hd * 128; \
        _Pragma("unroll") for (int i = 0; i < 4; ++i) glds16(kp_ + ksrc_(i), (unsigned)__builtin_amdgcn_readfirstlane((int)(lds0 + KOFF + (buf) * 32768 + (w * 4 + i) * 1024))); \
        const bf16* vp_ = Vp + (tok0 + (size_t)(cc) * CHUNK) * 1024 + hd * 256 + sl * 64; \
        _Pragma("unroll") for (int i = 0; i < 2; ++i) glds16(vp_ + vsrc_(i), (unsigned)__builtin_amdgcn_readfirstlane((int)(lds0 + VOFF + (buf) * 16384 + (w * 2 + i) * 1024))); \
        const bf16* qp_ = Qp + (tok0 + (size_t)(cc) * CHUNK) * 512 + hd * 128; \
        _Pragma("unroll") for (int i = 0; i < 4; ++i) glds16(qp_ + ksrc_(i), (unsigned)__builtin_amdgcn_readfirstlane((int)(lds0 + QOFF + (w * 4 + i) * 1024))); \
        } while (0)
    float thn = 1.f, dcn = rdec;
    MX_DMA(0, 0);
    if (ML) { thn = thr[(tok0 + 32 * lt + l31) * 4 + hd]; dcn = cdec[((size_t)b * NCHUNK) * 4 + hd]; }
    asm volatile("s_waitcnt vmcnt(0)" ::: "memory");
    __syncthreads();
    for (int c = 0; c < NCHUNK; ++c) {
        const int cur = c & 1, nxt = cur ^ 1;
        const unsigned KB = KOFF + cur * 32768, VB = VOFF + cur * 16384;
        const float th = thn, decay = dcn;
        B8 af[8];
#pragma unroll
        for (int s = 0; s < 8; ++s) qf[s] = *(const LAS B8*)(lds + (QOFF + 8192 * lt) + ro[s]);
#pragma unroll
        for (int s = 0; s < 8; ++s) af[s] = *(const LAS B8*)(lds + (SOFF + 8192 * et) + ro[s]);
        F16 o;
#pragma unroll
        for (int r = 0; r < 16; ++r) o[r] = 0.f;
#pragma unroll
        for (int s = 0; s < 8; ++s) { o = MFMA32(af[s], qf[s], o); af[s] = *(const LAS B8*)(lds + KB + ro[s]); }
        asm volatile("s_waitcnt lgkmcnt(0)" ::: "memory");
        __syncthreads();
        const bool more = c + 1 < NCHUNK;
        if (more) { if (ML) { thn = thr[(tok0 + (size_t)(c + 1) * CHUNK + 32 * lt + l31) * 4 + hd]; dcn = cdec[((size_t)b * NCHUNK + c + 1) * 4 + hd]; } }
        float csum = 0.f;
        for (int jt = 0; jt <= lt; ++jt) {
            F16 st;
#pragma unroll
            for (int r = 0; r < 16; ++r) st[r] = 0.f;
            S4 vfr[4];
#pragma unroll
            for (int s2 = 0; s2 < 2; ++s2) { const unsigned R0 = 32 * jt + 16 * s2 + 4 * hi + q_, chv = 4 * et + 2 * blk + (p_ >> 1);
                vfr[2 * s2] = trrd(lds + VB + offv(R0, chv) + 8 * (p_ & 1)); vfr[2 * s2 + 1] = trrd(lds + VB + offv(R0 + 8, chv) + 8 * (p_ & 1)); }
#pragma unroll
            for (int s = 0; s < 8; ++s) { st = MFMA32(af[s], qf[s], st); af[s] = *(const LAS B8*)(lds + (KB + 8192 * (jt + 1)) + ro[s]); }
            if (more) { if (jt == 0) { MX_PIECE(c + 1, nxt, 0); MX_PIECE(c + 1, nxt, 1); MX_PIECE(c + 1, nxt, 2); } else if (jt == 1) { MX_PIECE(c + 1, nxt, 3); MX_PIECE(c + 1, nxt, 4); MX_PIECE(c + 1, nxt, 5); }
                        else if (jt == 2) { MX_PIECE(c + 1, nxt, 6); MX_PIECE(c + 1, nxt, 7); MX_PIECE(c + 1, nxt, 8); } else { MX_PIECE(c + 1, nxt, 9); } }
            if (jt == lt) {
#pragma unroll
                for (int r = 0; r < 16; ++r) if (crow(r, hi) > l31) st[r] = 0.f;
            }
            if (ML) {
#pragma unroll
                for (int r = 0; r < 16; ++r) csum += st[r];
            }
#pragma unroll
            for (int s2 = 0; s2 < 2; ++s2) {
                U4 pk; pk.x = cvtpk(st[8 * s2 + 0], st[8 * s2 + 1]); pk.y = cvtpk(st[8 * s2 + 2], st[8 * s2 + 3]); pk.z = cvtpk(st[8 * s2 + 4], st[8 * s2 + 5]); pk.w = cvtpk(st[8 * s2 + 6], st[8 * s2 + 7]);
                const B8 bfr = __builtin_bit_cast(B8, pk);
                const B8 afr = __builtin_shufflevector(vfr[2 * s2], vfr[2 * s2 + 1], 0, 1, 2, 3, 4, 5, 6, 7);
                o = MFMA32(afr, bfr, o);
            }
        }
        if (more) { if (lt < 1) { MX_PIECE(c + 1, nxt, 3); MX_PIECE(c + 1, nxt, 4); MX_PIECE(c + 1, nxt, 5); } if (lt < 2) { MX_PIECE(c + 1, nxt, 6); MX_PIECE(c + 1, nxt, 7); MX_PIECE(c + 1, nxt, 8); } if (lt < 3) { MX_PIECE(c + 1, nxt, 9); } }
        if (ML) {
            float qd = 0.f;
#pragma unroll
            for (int s = 0; s < 8; ++s) { const U4 nv = *(const LAS U4*)(lds + NOFF + 1024 + cur * 256 + (16 * s + 8 * hi) * 2); const U4 qv = __builtin_bit_cast(U4, qf[s]);
                qd = dot2bf(qv.x, nv.x, qd); qd = dot2bf(qv.y, nv.y, qd); qd = dot2bf(qv.z, nv.z, qd); qd = dot2bf(qv.w, nv.w, qd); }
            csum += __shfl_xor(csum, 32); qd += __shfl_xor(qd, 32);
            const float den = csum + qd;
            const float sc = 1.f / fmaxf(fabsf(den), th);
#pragma unroll
            for (int r = 0; r < 16; ++r) o[r] *= sc;
        }
        { unsigned pk[8];
#pragma unroll
            for (int g = 0; g < 4; ++g) { pk[2 * g] = cvtpk(o[4 * g], o[4 * g + 1]); pk[2 * g + 1] = cvtpk(o[4 * g + 2], o[4 * g + 3]); }
            U4 s0, s1;
            { auto ra = __builtin_amdgcn_permlane32_swap(pk[0], pk[2], false, false); auto rb = __builtin_amdgcn_permlane32_swap(pk[1], pk[3], false, false);
              s0.x = ra[0]; s0.y = rb[0]; s0.z = ra[1]; s0.w = rb[1]; }
            { auto ra = __builtin_amdgcn_permlane32_swap(pk[4], pk[6], false, false); auto rb = __builtin_amdgcn_permlane32_swap(pk[5], pk[7], false, false);
              s1.x = ra[0]; s1.y = rb[0]; s1.z = ra[1]; s1.w = rb[1]; }
            bf16* op = Vout + ((tok0 + (size_t)c * CHUNK + 32 * lt + l31) & omask) * 1024 + hd * 256 + sl * 64 + 32 * et + 8 * hi;
            if (ABL & 2) { asm volatile("" :: "v"(s0), "v"(s1)); } else { *(U4*)op = s0; *(U4*)(op + 16) = s1; } }
        float ksum = 0.f;
        { const unsigned chk = 4 * dt + 2 * blk + (p_ >> 1), chv = 4 * et + 2 * blk + (p_ >> 1);
          const unsigned ka0 = KB + offb(8 * hi + q_, chk) + 8 * (p_ & 1), ka1 = KB + offb(8 * hi + q_ + 4, chk) + 8 * (p_ & 1);
          const unsigned va0 = VB + offv(8 * hi + q_, chv) + 8 * (p_ & 1), va1 = VB + offv(8 * hi + q_ + 4, chv) + 8 * (p_ & 1);
          S4 ua[2][2], ub[2][2];
          ua[0][0] = trrd(lds + ka0); ua[0][1] = trrd(lds + ka1); ub[0][0] = trrd(lds + va0); ub[0][1] = trrd(lds + va1);
#pragma unroll
          for (int ks = 0; ks < 8; ++ks) { const int cu = ks & 1, nx = cu ^ 1;
            if (ks < 7) { ua[nx][0] = trrd(lds + ka0 + 4096 * (ks + 1)); ua[nx][1] = trrd(lds + ka1 + 4096 * (ks + 1)); ub[nx][0] = trrd(lds + va0 + 2048 * (ks + 1)); ub[nx][1] = trrd(lds + va1 + 2048 * (ks + 1)); }
            const B8 afr = __builtin_shufflevector(ua[cu][0], ua[cu][1], 0, 1, 2, 3, 4, 5, 6, 7), bfr = __builtin_shufflevector(ub[cu][0], ub[cu][1], 0, 1, 2, 3, 4, 5, 6, 7);
            St = MFMA32(afr, bfr, St);
            if (ML) { const U4 av = __builtin_bit_cast(U4, afr); ksum = dot2bf(av.x, 0x3f803f80u, ksum); ksum = dot2bf(av.y, 0x3f803f80u, ksum); ksum = dot2bf(av.z, 0x3f803f80u, ksum); ksum = dot2bf(av.w, 0x3f803f80u, ksum); }
          } }
#pragma unroll
        for (int r = 0; r < 16; ++r) St[r] *= decay;
#pragma unroll
        for (int g = 0; g < 4; ++g) { U2 pk; pk.x = cvtpk(St[4 * g], St[4 * g + 1]); pk.y = cvtpk(St[4 * g + 2], St[4 * g + 3]);
            *(LAS U2*)(lds + SOFF + offb(32 * et + l31, 4 * dt + g) + 8 * hi) = pk; }
        if (ML) { ksum += __shfl_xor(ksum, 32);
            if (et == 0 && hi == 0) { const LAS float* nv = (const LAS float*)(lds + NOFF + cur * 512); LAS float* nn = (LAS float*)(lds + NOFF + nxt * 512);
                const float nval = decay * (nv[32 * dt + l31] + ksum); nn[32 * dt + l31] = nval;
                *(LAS unsigned short*)(lds + NOFF + 1024 + nxt * 256 + (32 * dt + l31) * 2) = (unsigned short)(cvtpk(nval, 0.f) & 0xffffu); } }
        asm volatile("s_waitcnt vmcnt(2)" ::: "memory");
        __syncthreads();
    }
#undef MX_DMA
#undef MX_PIECE
#undef ksrc_
#undef vsrc_
}
#ifndef PROBE_ITEM_VCU
#define PROBE_ITEM_VCU (-1)
#endif
__device__ __forceinline__ void phase3(const Ctx& C, unsigned char* ws, bool dry) {
    const unsigned long long pt0 = PROBE_ITEM_VCU >= 0 ? __builtin_amdgcn_s_memrealtime() : 0ull;
    for (int it = C.vcu; it < 256; it += C.G) {
        const int mix = it >> 7, b = (it >> 4) & 7, hd = (it >> 2) & 3, sl = it & 3;
        bf16* vr = (bf16*)(ws + WS_RV); bf16* vm = (bf16*)(ws + WS_MV); bf16* dump = (bf16*)(ws + 930 * MiB);
#ifndef DRY_ABL
#define DRY_ABL 0
#endif
        if (dry) {
            if (mix == 0 || (DRY_ABL & 1)) mixer_item<false, DRY_ABL>(C, (const bf16*)(ws + (mix ? WS_MQP : WS_RQ)), (const bf16*)(ws + (mix ? WS_MKP : WS_RK)), mix ? vm : vr, dump, (size_t)0x7fff, nullptr, nullptr, b, hd, sl);
            else mixer_item<true, DRY_ABL>(C, (const bf16*)(ws + WS_MQP), (const bf16*)(ws + WS_MKP), vm, dump, (size_t)0x7fff, (const float*)(ws + WS_THR), (const float*)(ws + WS_CDEC), b, hd, sl);
        } else {
        if (mix == 0) mixer_item<false>(C, (const bf16*)(ws + WS_RQ), (const bf16*)(ws + WS_RK), vr, vr, ~(size_t)0, nullptr, nullptr, b, hd, sl);
        else mixer_item<true>(C, (const bf16*)(ws + WS_MQP), (const bf16*)(ws + WS_MKP), vm, vm, ~(size_t)0, (const float*)(ws + WS_THR), (const float*)(ws + WS_CDEC), b, hd, sl);
        }
    }
    if (PROBE_ITEM_VCU >= 0 && C.vcu == PROBE_ITEM_VCU && C.tid == 0) ((float*)(ws + WS_CTL))[2000] = (float)(__builtin_amdgcn_s_memrealtime() - pt0) * 0.001f;
    if (PROBE_ITEM_VCU == 1000 && C.tid == 0) atomicMax((unsigned*)(ws + WS_CTL) + 2000, __float_as_uint((float)(__builtin_amdgcn_s_memrealtime() - pt0) * 0.001f));
}

__device__ __forceinline__ void phase4(const Ctx& C, const float* const* in, unsigned char* ws) {
    const float* rgn = in[3]; const float* mgn = in[9];
    const int gw = C.vcu * NWAVES + C.wave, NGW = C.G * NWAVES;
    const int col = (C.lane >> 4) * 256 + (C.lane & 15) * 16;
    float gr[16], gm[16];
#pragma unroll
    for (int i = 0; i < 4; ++i) { const F4 a = *(const F4*)(rgn + col + 4 * i), bq = *(const F4*)(mgn + col + 4 * i);
        gr[4 * i] = a.x; gr[4 * i + 1] = a.y; gr[4 * i + 2] = a.z; gr[4 * i + 3] = a.w; gm[4 * i] = bq.x; gm[4 * i + 1] = bq.y; gm[4 * i + 2] = bq.z; gm[4 * i + 3] = bq.w; }
    for (int m = gw; m < NTOK; m += NGW) {
#pragma unroll
        for (int mx = 0; mx < 2; ++mx) {
            const bf16* ip = (const bf16*)(ws + (mx ? WS_MV : WS_RV)) + (size_t)m * 1024 + col;
            bf16* op = (bf16*)(ws + WS_XCAT) + (size_t)m * 2048 + mx * 1024 + col;
            const bf16* gp = (const bf16*)(ws + WS_RG) + (size_t)m * 1024 + col; const unsigned char* gp8 = (const unsigned char*)(ws + WS_MO) + (size_t)m * 1024 + col;
            const U4 o0 = *(const U4*)ip, o1 = *(const U4*)(ip + 8); U4 g0, g1; if (mx) { g0 = *(const U4*)gp8; g1 = g0; } else { g0 = *(const U4*)gp; g1 = *(const U4*)(gp + 8); }
            float v[16], g[16];
            v[0] = bflo(o0.x); v[1] = bfhi(o0.x); v[2] = bflo(o0.y); v[3] = bfhi(o0.y); v[4] = bflo(o0.z); v[5] = bfhi(o0.z); v[6] = bflo(o0.w); v[7] = bfhi(o0.w);
            v[8] = bflo(o1.x); v[9] = bfhi(o1.x); v[10] = bflo(o1.y); v[11] = bfhi(o1.y); v[12] = bflo(o1.z); v[13] = bfhi(o1.z); v[14] = bflo(o1.w); v[15] = bfhi(o1.w);
            g[0] = bflo(g0.x); g[1] = bfhi(g0.x); g[2] = bflo(g0.y); g[3] = bfhi(g0.y); g[4] = bflo(g0.z); g[5] = bfhi(g0.z); g[6] = bflo(g0.w); g[7] = bfhi(g0.w);
            g[8] = bflo(g1.x); g[9] = bfhi(g1.x); g[10] = bflo(g1.y); g[11] = bfhi(g1.y); g[12] = bflo(g1.z); g[13] = bfhi(g1.z); g[14] = bflo(g1.w); g[15] = bfhi(g1.w);
            if (mx) {
                const float k = 1.f / 255.f;
                v[0] *= b0f(g0.x) * k; v[1] *= b1f(g0.x) * k; v[2] *= b2f(g0.x) * k; v[3] *= b3f(g0.x) * k; v[4] *= b0f(g0.y) * k; v[5] *= b1f(g0.y) * k; v[6] *= b2f(g0.y) * k; v[7] *= b3f(g0.y) * k;
                v[8] *= b0f(g0.z) * k; v[9] *= b1f(g0.z) * k; v[10] *= b2f(g0.z) * k; v[11] *= b3f(g0.z) * k; v[12] *= b0f(g0.w) * k; v[13] *= b1f(g0.w) * k; v[14] *= b2f(g0.w) * k; v[15] *= b3f(g0.w) * k;
            }
            float ss = 0.f;
#pragma unroll
            for (int i = 0; i < 16; ++i) ss += v[i] * v[i];
            ss += __shfl_xor(ss, 1); ss += __shfl_xor(ss, 2); ss += __shfl_xor(ss, 4); ss += __shfl_xor(ss, 8);
            const float r = rsqrtf(ss * (1.f / 256.f) + EPS);
            float y[16];
#pragma unroll
            for (int i = 0; i < 16; ++i) y[i] = mx ? v[i] * r * gm[i] : v[i] * r * gr[i] * silu(g[i]);
            U4 w0, w1; w0.x = cvtpk(y[0], y[1]); w0.y = cvtpk(y[2], y[3]); w0.z = cvtpk(y[4], y[5]); w0.w = cvtpk(y[6], y[7]);
            w1.x = cvtpk(y[8], y[9]); w1.y = cvtpk(y[10], y[11]); w1.z = cvtpk(y[12], y[13]); w1.w = cvtpk(y[14], y[15]);
            *(U4*)op = w0; *(U4*)(op + 8) = w1;
        }
    }
    LAS float* scr = (LAS float*)(C.lds + C.wave * 8448);
    const float* wgate = in[17]; const float* wup = in[18]; const float* wdn = in[19];
    const float* nfw = in[12]; const unsigned long long wup_minus_wgate = (unsigned long long)wup - (unsigned long long)wgate;
    tr_loop(gw, NGW, (ABL_EPI & 32) ? 0 : 16384 + 8192, [=](int it) __attribute__((always_inline)) -> TrItem {
        if (it < 16384) { const int e = it >> 9, kb = (it >> 5) & 15, nb = it & 31; const int R0 = nb * 32, tile = R0 >> 8, within = R0 & 255;
            const float* W = (const float*)((unsigned long long)wgate + (within < 128 ? 0ull : wup_minus_wgate)) + (size_t)e * 1024 * 512;
            return TrItem{W, 512, kb * 64, tile * 128 + (within & 127), (bf16*)(ws + WS_WGU), 1024, e * 1024 + R0, 0, nfw}; }
        const int r = it - 16384; const int e = r >> 8, kb = (r >> 5) & 7, nb = r & 31;
        return TrItem{wdn + (size_t)e * 512 * 1024, 1024, kb * 64, nb * 32, (bf16*)(ws + WS_WD), 512, e * 1024 + nb * 32, 0, nullptr}; }, scr, C.lane);
}

__device__ __forceinline__ void phase8(const Ctx& C, const float* const* in, unsigned char* ws, float* out) {
    const float* x = in[0]; const float* nfw = in[12]; const float* bg = in[14]; const float* be = in[16];
    const bf16* YO = (const bf16*)(ws + WS_YO);
    bf16* X1B = (bf16*)out + 1024;
    const U4* WRH = (const U4*)(ws + WS_ROUT); const U4* WRL = (const U4*)(ws + WS_ROUT + 98304); TokInfo* TI = (TokInfo*)(ws + WS_TOK); unsigned* gcnt = (unsigned*)(ws + WS_CTL);
    int* TM = (int*)(ws + WS_TOKMAP); float* SR = (float*)(ws + WS_SRSTD);
    LAS float* scr = (LAS float*)(C.lds + C.wave * 4096);
    LAS unsigned* lcnt = (LAS unsigned*)(C.lds + 65536);
    LAS unsigned* lbase = (LAS unsigned*)(C.lds + 65536 + 128);
    const int l = C.lane, l15 = l & 15, kk = l >> 4;
    for (int blkid = C.vcu; blkid < NTOK / 256; blkid += C.G) {
        __syncthreads();
        if (C.tid < 32) lcnt[C.tid] = 0u;
        __syncthreads();
        int e0[2], e1[2]; float w0[2], w1[2], rs[2]; unsigned rk0[2], rk1[2];
        F4 accs[2][3]; float sss[2];
#pragma unroll
        for (int tt = 0; tt < 2; ++tt) { sss[tt] = 0.f;
#pragma unroll
            for (int n = 0; n < 3; ++n) accs[tt][n] = (F4){0.f, 0.f, 0.f, 0.f}; }
        {
            const size_t roA = (size_t)(blkid * 256 + C.wave * 32 + l15) * DM + 8 * kk, roB = roA + (size_t)16 * DM;
#pragma unroll 2
            for (int kb2 = 0; kb2 < 32; ++kb2) {
                F4 a0[2], a1[2]; B8 ahi[2], alo[2];
#pragma unroll
                for (int tt = 0; tt < 2; ++tt) { const size_t ro = tt ? roB : roA;
                    const F4 xa = *(const F4*)(x + ro + 32 * kb2), xb = *(const F4*)(x + ro + 32 * kb2 + 4);
                    const U4 yv = *(const U4*)(YO + ro + 32 * kb2);
                    a0[tt].x = xa.x + bflo(yv.x); a0[tt].y = xa.y + bfhi(yv.x); a0[tt].z = xa.z + bflo(yv.y); a0[tt].w = xa.w + bfhi(yv.y);
                    a1[tt].x = xb.x + bflo(yv.z); a1[tt].y = xb.y + bfhi(yv.z); a1[tt].z = xb.z + bflo(yv.w); a1[tt].w = xb.w + bfhi(yv.w); }
#pragma unroll
                for (int tt = 0; tt < 2; ++tt) { const size_t ro = tt ? roB : roA;
                    sss[tt] += ((a0[tt].x * a0[tt].x + a0[tt].y * a0[tt].y) + (a0[tt].z * a0[tt].z + a0[tt].w * a0[tt].w)) + ((a1[tt].x * a1[tt].x + a1[tt].y * a1[tt].y) + (a1[tt].z * a1[tt].z + a1[tt].w * a1[tt].w));
                    U4 xv; xv.x = cvtpk(a0[tt].x, a0[tt].y); xv.y = cvtpk(a0[tt].z, a0[tt].w); xv.z = cvtpk(a1[tt].x, a1[tt].y); xv.w = cvtpk(a1[tt].z, a1[tt].w);
                    *(U4*)(X1B + 2 * ro - 8 * kk + 32 * kb2) = xv;
                    U4 lw; lw.x = cvtpk(a0[tt].x - bflo(xv.x), a0[tt].y - bfhi(xv.x)); lw.y = cvtpk(a0[tt].z - bflo(xv.y), a0[tt].w - bfhi(xv.y));
                    lw.z = cvtpk(a1[tt].x - bflo(xv.z), a1[tt].y - bfhi(xv.z)); lw.w = cvtpk(a1[tt].z - bflo(xv.w), a1[tt].w - bfhi(xv.w));
                    ahi[tt] = __builtin_bit_cast(B8, xv); alo[tt] = __builtin_bit_cast(B8, lw); }
#pragma unroll
                for (int n = 0; n < 3; ++n) { const B8 bh = __builtin_bit_cast(B8, WRH[(kb2 * 3 + n) * 64 + l]), bl = __builtin_bit_cast(B8, WRL[(kb2 * 3 + n) * 64 + l]);
#pragma unroll
                    for (int tt = 0; tt < 2; ++tt) {
                        accs[tt][n] = __builtin_amdgcn_mfma_f32_16x16x32_bf16(ahi[tt], bh, accs[tt][n], 0, 0, 0);
                        accs[tt][n] = __builtin_amdgcn_mfma_f32_16x16x32_bf16(alo[tt], bh, accs[tt][n], 0, 0, 0);
                        accs[tt][n] = __builtin_amdgcn_mfma_f32_16x16x32_bf16(ahi[tt], bl, accs[tt][n], 0, 0, 0); } }
            }
        }
#pragma unroll
        for (int tt = 0; tt < 2; ++tt) {
            F4 acc[3];
#pragma unroll
            for (int n = 0; n < 3; ++n) acc[n] = accs[tt][n];
            float ss = sss[tt];
            ss += __shfl_xor(ss, 16); ss += __shfl_xor(ss, 32);
            const float rstd = rsqrtf(ss * (1.f / DM) + EPS);
#pragma unroll
            for (int n = 0; n < 3; ++n)
#pragma unroll
                for (int r = 0; r < 4; ++r) scr[(4 * kk + r) * 49 + 16 * n + l15] = acc[n][r];
            if (kk == 0) scr[16 * 49 + l15] = rstd;
            asm volatile("s_waitcnt lgkmcnt(0)" ::: "memory");
            e0[tt] = 0; e1[tt] = 0; w0[tt] = 0.f; w1[tt] = 0.f; rs[tt] = 0.f; rk0[tt] = 0u; rk1[tt] = 0u;
            if (l < 16) {
                const LAS float* lr = scr + l * 49; const float rr = scr[16 * 49 + l];
                float g0 = lr[0] * rr + bg[0], g1 = lr[1] * rr + bg[1], g2 = lr[2] * rr + bg[2], g3 = lr[3] * rr + bg[3];
                int gi = 0; float gmx = g0; if (g1 > gmx) { gmx = g1; gi = 1; } if (g2 > gmx) { gmx = g2; gi = 2; } if (g3 > gmx) { gmx = g3; gi = 3; }
                const float gw = __builtin_amdgcn_rcpf(__expf(g0 - gmx) + __expf(g1 - gmx) + __expf(g2 - gmx) + __expf(g3 - gmx));
                float m1 = -INFINITY, m2 = -INFINITY; int i1 = 0, i2 = 0;
#pragma unroll
                for (int i = 0; i < 8; ++i) { const float v = lr[4 + gi * 8 + i] * rr + be[gi * 8 + i];
                    if (v > m1) { m2 = m1; i2 = i1; m1 = v; i1 = i; } else if (v > m2) { m2 = v; i2 = i; } }
                const float ex = __expf(m2 - m1), wa = __builtin_amdgcn_rcpf(1.f + ex);
                e0[tt] = gi * 8 + i1; e1[tt] = gi * 8 + i2; w0[tt] = gw * wa; w1[tt] = gw * ex * wa; rs[tt] = rr;
                rk0[tt] = atomicAdd((unsigned*)(lcnt + e0[tt]), 1u); rk1[tt] = atomicAdd((unsigned*)(lcnt + e1[tt]), 1u);
            }
            asm volatile("s_waitcnt lgkmcnt(0)" ::: "memory");
        }
        __syncthreads();
        if (C.tid < 32) lbase[C.tid] = atomicAdd(gcnt + C.tid, lcnt[C.tid]);
        __syncthreads();
#pragma unroll
        for (int tt = 0; tt < 2; ++tt) if (l < 16) {
            const int t = blkid * 256 + C.wave * 32 + tt * 16 + l;
            TokInfo ti; ti.e0 = e0[tt]; ti.p0 = (int)(lbase[e0[tt]] + rk0[tt]); ti.e1 = e1[tt]; ti.p1 = (int)(lbase[e1[tt]] + rk1[tt]); ti.w0 = w0[tt]; ti.w1 = w1[tt]; ti.rstd = rs[tt]; ti.pad = 0.f;
            TI[t] = ti;
            TM[ti.e0 * 65536 + ti.p0] = t; SR[ti.e0 * 65536 + ti.p0] = rs[tt];
            TM[ti.e1 * 65536 + ti.p1] = t; SR[ti.e1 * 65536 + ti.p1] = rs[tt]; }
    }
}

__device__ __forceinline__ int build_rowbase(const Ctx& C, unsigned char* ws) {
    LAS int* rb = (LAS int*)(C.lds + LDS_MISC);
    LAS unsigned char* t2e = (LAS unsigned char*)(C.lds + LDS_MISC + 256);
    const unsigned* gcnt = (const unsigned*)(ws + WS_CTL);
    __syncthreads();
    if (C.tid == 0) { int acc = 0; for (int e = 0; e < NEXP; ++e) { rb[e] = acc; const int n = (int)__hip_atomic_load(gcnt + e, __ATOMIC_RELAXED, __HIP_MEMORY_SCOPE_AGENT); acc += (n + 255) & ~255; } rb[NEXP] = acc; }
    __syncthreads();
    for (int e = C.tid >> 4; e < NEXP; e += NTHR >> 4) for (int t = (rb[e] >> 8) + (C.tid & 15); t < (rb[e + 1] >> 8); t += 16) t2e[t] = (unsigned char)e;
    __syncthreads();
    return rb[NEXP] >> 8;
}

__device__ __forceinline__ void phase12(const Ctx& C, const float* const* in, float* out, unsigned char* ws) {
    (void)build_rowbase(C, ws);
    const LAS int* rb = (const LAS int*)(C.lds + LDS_MISC);
    const float* fw = in[20]; const TokInfo* TI = (const TokInfo*)(ws + WS_TOK); const unsigned char* Y = (const unsigned char*)(ws + WS_Y);
    const int gw = C.vcu * NWAVES + C.wave, NGW = C.G * NWAVES;
    F4 wv[4];
#pragma unroll
    for (int j = 0; j < 4; ++j) wv[j] = *(const F4*)(fw + 4 * C.lane + 256 * j);
    for (int m = gw; m < NTOK; m += NGW) {
        const TokInfo ti = TI[m];
        const U2* xb = (const U2*)((const bf16*)(out + (size_t)m * DM) + 1024) + C.lane;
        const unsigned* y0 = (const unsigned*)(Y + (size_t)(rb[ti.e0] + ti.p0) * DM) + C.lane;
        const unsigned* y1 = (const unsigned*)(Y + (size_t)(rb[ti.e1] + ti.p1) * DM) + C.lane;
        const float w0 = ti.w0 * 0.0625f, w1 = ti.w1 * 0.0625f;
        F4 v[4]; float s = 0.f;
#pragma unroll
        for (int j = 0; j < 4; ++j) { const unsigned a = y0[64 * j], bq = y1[64 * j]; const U2 c = xb[64 * j];
            v[j].x = bflo(c.x) + w0 * __builtin_amdgcn_cvt_f32_fp8(a, 0) + w1 * __builtin_amdgcn_cvt_f32_fp8(bq, 0); v[j].y = bfhi(c.x) + w0 * __builtin_amdgcn_cvt_f32_fp8(a, 1) + w1 * __builtin_amdgcn_cvt_f32_fp8(bq, 1);
            v[j].z = bflo(c.y) + w0 * __builtin_amdgcn_cvt_f32_fp8(a, 2) + w1 * __builtin_amdgcn_cvt_f32_fp8(bq, 2); v[j].w = bfhi(c.y) + w0 * __builtin_amdgcn_cvt_f32_fp8(a, 3) + w1 * __builtin_amdgcn_cvt_f32_fp8(bq, 3);
            s += (v[j].x * v[j].x + v[j].y * v[j].y) + (v[j].z * v[j].z + v[j].w * v[j].w); }
        const float rstd = rsqrtf(wave_sum(s) * (1.f / DM) + EPS);
        F4* xw = (F4*)(out + (size_t)m * DM) + C.lane;
#pragma unroll
        for (int j = 0; j < 4; ++j) xw[64 * j] = v[j] * rstd * wv[j];
    }
}

constexpr int NPHASE = 13;
struct Args { const float* in[21]; float* out; unsigned char* ws; int ph_lo, ph_hi; };
__global__ void __launch_bounds__(NTHR, 2) fwd_kernel(Args args) {
    extern __shared__ __attribute__((aligned(16))) unsigned char lds_raw[];
    cg::grid_group grid = cg::this_grid();
    Ctx C; C.lds = (LAS unsigned char*)lds_raw; C.tid = threadIdx.x; C.lane = C.tid & 63; C.wave = __builtin_amdgcn_readfirstlane(C.tid >> 6);
    C.G = gridDim.x; { const int bx = blockIdx.x; C.vcu = (C.G % 8 == 0) ? (bx % 8) * (C.G / 8) + bx / 8 : bx; }
    unsigned char* ws = args.ws; unsigned char* ob = (unsigned char*)args.out;
    const int lo = args.ph_lo, hi = args.ph_hi;
#ifndef PHMASK
#define PHMASK 0x1fff
#endif
#define IN(k) (((PHMASK >> (k)) & 1) && lo <= (k) && (k) < hi)
    if (C.tid < 2) ((LAS unsigned*)(C.lds + LDS_MISC + 4096))[C.tid] = 0u;
    __syncthreads();
    XcdBarrier bar; bar.bar = (unsigned*)(ws + WS_CTL) + CW_BAR; bar.x = 0; bar.st = (volatile LAS unsigned*)(C.lds + LDS_MISC + 4096);
    const bool whole = IN(0) && IN(1);
    if (!whole) bar = xcd_barrier_post((unsigned*)(ws + WS_CTL) + CW_BAR, (volatile LAS unsigned*)(C.lds + LDS_MISC + 4096));
    else if (blockIdx.x == 0) { for (int i = C.tid; i < (int)(CTL_ZERO_BYTES / 16); i += NTHR) ((U4*)(ws + WS_CTL))[i] = (U4){0u, 0u, 0u, 0u}; }
#define SEAM(k) do { if (IN(k) && IN((k) + 1)) { if ((k) == 0) { grid.sync(); bar = xcd_barrier_post((unsigned*)(ws + WS_CTL) + CW_BAR, (volatile LAS unsigned*)(C.lds + LDS_MISC + 4096)); } else xcd_barrier(bar); } } while (0)
#ifndef DUP_MASK
#define DUP_MASK 0
#endif
#define REP(k) for (int rep_ = 0; rep_ < (((DUP_MASK >> (k)) & 1) ? 2 : 1); ++rep_)
#ifndef PROBE_GEMM_PHASE
#define PROBE_GEMM_PHASE 0
#endif
#ifndef PROBE_PHASE
#define PROBE_PHASE (-1)
#endif
    unsigned long long t_prev = 0ull; float t_probe = 0.f;
#define STAMP(k) do { if (PROBE_PHASE >= 0) { const unsigned long long t_now = __builtin_amdgcn_s_memrealtime(); if ((k) == PROBE_PHASE) t_probe = (float)(t_now - t_prev) * 0.001f; t_prev = t_now; } } while (0)
    STAMP(-2);
    if (IN(0)) { REP(0) phase0(C, args.in, ws); } SEAM(0); STAMP(0);
    if (IN(1)) { pg8::Gemm g{(const pg8::bf16_t*)(ws + WS_H), (const pg8::bf16_t*)(ws + WS_WIN), NTOK, NPROJ, DM}; if (PROBE_GEMM_PHASE == 1) g.probe = (float*)(ws + WS_CTL) + 2000; pg8::StaticOrder S; S.init(NTOK, NPROJ, C.G, (int)blockIdx.x);
        pg8::EpiProj E{ws, ob}; REP(1) pg8::gemm_phase<pg8::EpiProj, pg8::StaticOrder, true, true>(C.lds, g, S, E); } SEAM(1); STAMP(1);
    if (IN(2)) { phase2(C, args.in, ws); } SEAM(2); STAMP(2);
    if (IN(3)) { if ((DUP_MASK >> 3) & 1) phase3(C, ws, true); phase3(C, ws, false); } SEAM(3); STAMP(3);
    if (IN(4)) { phase4(C, args.in, ws); } SEAM(4); STAMP(4);
    if (IN(5)) { pg8::Gemm g{(const pg8::bf16_t*)(ws + WS_XCAT), (const pg8::bf16_t*)(ws + WS_WCAT), NTOK, DM, 2 * DM}; if (PROBE_GEMM_PHASE == 5) g.probe = (float*)(ws + WS_CTL) + 2000; pg8::StaticOrder S; S.init(NTOK, DM, C.G, (int)blockIdx.x);
        pg8::EpiGateFused E{(const unsigned char*)(ob + OUT_GR), (const unsigned char*)(ob + OUT_GM), (pg8::bf16_t*)(ws + WS_MERGED)}; REP(5) pg8::gemm_phase<pg8::EpiGateFused, pg8::StaticOrder, true, true>(C.lds, g, S, E); }
    if (IN(5) && IN(7)) xcd_barrier(bar);
    STAMP(5);
    if (IN(7)) { pg8::Gemm g{(const pg8::bf16_t*)(ws + ((ABL_EPI & 9) ? WS_XCAT : WS_MERGED)), (const pg8::bf16_t*)(ws + WS_WOUT), NTOK, DM, DM}; if (PROBE_GEMM_PHASE == 7) g.probe = (float*)(ws + WS_CTL) + 2000; pg8::StaticOrder S; S.init(NTOK, DM, C.G, (int)blockIdx.x);
        pg8::EpiBf16<0> E{(pg8::bf16_t*)(ws + WS_YO), DM, nullptr, 0, 0, 1.f}; REP(7) pg8::gemm_phase<pg8::EpiBf16<0>, pg8::StaticOrder, true, true>(C.lds, g, S, E); } SEAM(7); STAMP(7);
    if (IN(8)) { phase8(C, args.in, ws, args.out); }
    if (IN(8) && IN(10)) xcd_barrier(bar);
    STAMP(8);
    if (IN(10)) { const int nt = build_rowbase(C, ws);
        pg8::Gemm g{(const pg8::bf16_t*)args.out + 1024, (const pg8::bf16_t*)(ws + WS_WGU), MAXROWS, NEXP * 1024, DM}; g.lda = 2048;
        pg8::GroupedOrder<true> S{nt, C.G, C.vcu, (const LAS unsigned char*)(C.lds + LDS_MISC + 256), (const LAS int*)(C.lds + LDS_MISC), (const int*)(ws + WS_TOKMAP)};
        pg8::EpiSwiglu E{(pg8::bf16_t*)(ws + WS_HMID), (const float*)(ws + WS_SRSTD)}; REP(10) pg8::gemm_phase<pg8::EpiSwiglu, pg8::GroupedOrder<true>, true, true>(C.lds, g, S, E); } SEAM(10); STAMP(10);
    if (IN(11)) { const int nt = build_rowbase(C, ws);
        pg8::Gemm g{(const pg8::bf16_t*)(ws + WS_HMID), (const pg8::bf16_t*)(ws + WS_WD), MAXROWS, NEXP * 1024, DEXP}; if (PROBE_GEMM_PHASE == 11) g.probe = (float*)(ws + WS_CTL) + 2000;
        pg8::GroupedOrder<false> S{nt, C.G, C.vcu, (const LAS unsigned char*)(C.lds + LDS_MISC + 256), (const LAS int*)(C.lds + LDS_MISC), nullptr};
        pg8::EpiY E{(unsigned char*)(ws + WS_Y)}; REP(11) pg8::gemm_phase<pg8::EpiY, pg8::GroupedOrder<false>, true, true>(C.lds, g, S, E); } SEAM(11); STAMP(11);
    if (IN(12)) { phase12(C, args.in, args.out, ws); }
    if (PROBE_PHASE >= 0) { __syncthreads(); STAMP(12); if (blockIdx.x == 0 && C.tid == 0) { asm volatile("s_waitcnt vmcnt(0)" ::: "memory"); args.out[0] += t_probe + (PROBE_GEMM_PHASE ? ((const float*)(ws + WS_CTL))[2000] : 0.f); } }
#undef IN
#undef SEAM
}

#ifndef MK_SPLIT
#define MK_SPLIT 0
#endif
extern "C" void kernel_launch(void* const* d_in, const int* in_sizes, int n_in, void* d_out, int out_size, void* d_ws, size_t ws_size, hipStream_t stream) {
    static int grid = 0;
    if (grid == 0) {
        if (n_in != 21 || out_size != NTOK * DM || ws_size < WS_END) { fprintf(stderr, "kernel_launch: unexpected shapes (n_in %d out %d ws %zu)\n", n_in, out_size, ws_size); grid = -1; return; }
        int dev = 0, cus = 0, per_cu = 0;
        if (hipGetDevice(&dev) != hipSuccess || hipDeviceGetAttribute(&cus, hipDeviceAttributeMultiprocessorCount, dev) != hipSuccess) { grid = -1; return; }
        if (hipFuncSetAttribute((const void*)fwd_kernel, hipFuncAttributeMaxDynamicSharedMemorySize, LDS_BYTES) != hipSuccess) { fprintf(stderr, "kernel_launch: hipFuncSetAttribute failed\n"); grid = -1; return; }
        if (hipOccupancyMaxActiveBlocksPerMultiprocessor(&per_cu, (const void*)fwd_kernel, NTHR, LDS_BYTES) != hipSuccess || per_cu < 1) { fprintf(stderr, "kernel_launch: occupancy query says %d\n", per_cu); per_cu = 1; }
        (void)hipGetLastError();
        grid = cus;
    }
    if (grid < 0) return;
#if MK_SPLIT
    (void)hipMemsetAsync((char*)d_ws + WS_CTL, 0, CTL_ZERO_BYTES, stream);
#endif
    Args a{};
    for (int i = 0; i < 21; ++i) a.in[i] = (const float*)d_in[i];
    a.out = (float*)d_out; a.ws = (unsigned char*)d_ws;
    void* kargs[] = {&a};
#if MK_SPLIT
    for (int p = 0; p < NPHASE; ++p) { a.ph_lo = p; a.ph_hi = p + 1;
        hipError_t e = hipLaunchCooperativeKernel((const void*)fwd_kernel, dim3(grid), dim3(NTHR), kargs, LDS_BYTES, stream);
        if (e != hipSuccess) { fprintf(stderr, "kernel_launch: launch %d failed: %s\n", p, hipGetErrorString(e)); break; } }
#else
    a.ph_lo = 0; a.ph_hi = NPHASE;
    hipError_t e = hipLaunchCooperativeKernel((const void*)fwd_kernel, dim3(grid), dim3(NTHR), kargs, LDS_BYTES, stream);
    if (e != hipSuccess) fprintf(stderr, "kernel_launch: cooperative launch failed: %s (grid %d)\n", hipGetErrorString(e), grid);
#endif
}
```

```cpp
#include <hip/hip_runtime.h>
#include <hip/hip_cooperative_groups.h>
#include <cstdio>
#include <cstdint>
namespace cg = cooperative_groups;
namespace pg8 {
#define PG8_LAS __attribute__((address_space(3)))
typedef unsigned short bf16_t;
typedef short bf16x8 __attribute__((ext_vector_type(8)));
typedef float f32x4 __attribute__((ext_vector_type(4)));
typedef unsigned u32x4 __attribute__((ext_vector_type(4)));
constexpr int BM = 256, BK = 64, HALF = 128, HTB = HALF * BK * 2  , STAGE_BYTES = 8 * HTB, NXCD = 8, WGM = 8;

__host__ __device__ __forceinline__ int lds_byte(int r, int c) { const int st = (r >> 4) * 2 + (c >> 5), rr = r & 15, cc = c & 31, ob = rr * 64 + cc * 2; return st * 1024 + (ob ^ (((ob >> 9) & 1) << 5)); }
__host__ __device__ __forceinline__ void stage_rc(int b, int& R, int& C) { const int st = b / 1024, sb = b % 1024, swz = sb ^ (((sb >> 9) & 1) << 5); R = (st >> 1) * 16 + swz / 64; C = (st & 1) * 32 + (swz % 64) / 2; }
__host__ __device__ __forceinline__ int perm32(int rho) { const int n = rho >> 4, i = rho & 15; return 8 * (i >> 2) + 4 * n + (i & 3); }

struct Unit { int pm, pn, pa; };
struct Gemm { const bf16_t* A; const bf16_t* Bt; int M, N, K; float* probe = nullptr; int lda = 0  ; int ksplit = 1 << 30  ; long long asplit = 0  ; };

struct StaticOrder {
    static constexpr bool GATHER = false;
    int nM, nN, nwg, G, c, wgm;
    __host__ __device__ void init(int M, int N, int G_, int c_, int wgm_ = WGM) { nM = M / BM; nN = N / BM; nwg = nM * nN; G = G_; c = c_; wgm = wgm_; }
    __host__ __device__ bool next(int i, Unit& u) const {
        const long L = (long)i * G + c; if (L >= nwg) return false;
        int wgid = (int)L; { const int q = nwg / NXCD, r = nwg % NXCD, xcd = wgid % NXCD, off = wgid / NXCD; wgid = (xcd < r ? xcd * (q + 1) : r * (q + 1) + (xcd - r) * q) + off; }
        const int nig = wgm * nN, gid = wgid / nig, fm = gid * wgm, gsz = (nM - fm) < wgm ? (nM - fm) : wgm;
        u.pm = fm + ((wgid % nig) % gsz); u.pn = (wgid % nig) / gsz; u.pa = 0; return true;
    }
    __device__ __forceinline__ void a_ready(const Unit&) const {}
    __device__ __forceinline__ void done(const Unit&) const {}
};

__device__ __forceinline__ unsigned cvt_pk_bf16(float lo, float hi) { unsigned r; asm volatile("v_cvt_pk_bf16_f32 %0, %1, %2" : "=v"(r) : "v"(lo), "v"(hi)); return r; }
typedef float f32x2 __attribute__((ext_vector_type(2)));
__device__ __forceinline__ f32x2 gelu_pk(f32x2 v) {
    const f32x2 av = __builtin_elementwise_abs(v), d = av * 0.2316418882f + 1.0f;
    f32x2 t; t.x = __builtin_amdgcn_rcpf(d.x); t.y = __builtin_amdgcn_rcpf(d.y);
    f32x2 q = t * 0.5307027145f + (-0.7265760135f); q = q * t + 0.7107068705f; q = q * t + (-0.142248368f); q = q * t + 0.127414796f; q = q * t;
    const f32x2 s = (v * v) * (-0.72134752044f);
    f32x2 e; e.x = __builtin_amdgcn_exp2f(s.x); e.y = __builtin_amdgcn_exp2f(s.y);
    const f32x2 m = v * (q * e), r = v - m;
    f32x2 o; o.x = v.x < 0.f ? m.x : r.x; o.y = v.y < 0.f ? m.y : r.y; return o;
}

template <int ACT  > struct EpiBf16 {
    static constexpr bool PERM = true, AFTER_DRAIN = false, MIDK = false; static constexpr int NST = 16  ; static_assert(ACT == 0 || ACT == 1, "EpiBf16: ACT is 0 (none) or 1 (gelu_pk)");
    bf16_t* O; int ldc; const float* bias; int split_cols; size_t split_stride; float scale0;
    __device__ __forceinline__ void operator()(const f32x4 (&acc)[2][2][4][2], const Unit& u, int wr, int wc, int fr, int fq) const {
        const int row0 = u.pm * BM + wr * 64 + fr; int colt = u.pn * BM; bf16_t* base = O;
        float sc = 1.f; if (split_cols) { const int t = colt / split_cols; base += (size_t)t * split_stride; colt -= t * split_cols; if (t == 0) sc = scale0; }
        const int col0 = colt + wc * 32 + 8 * fq, bcol0 = u.pn * BM + wc * 32 + 8 * fq;
        f32x4 bv[2][2];
#pragma unroll
        for (int bj = 0; bj < 2; ++bj)
#pragma unroll
            for (int n = 0; n < 2; ++n) bv[bj][n] = bias ? *(const f32x4*)(bias + bcol0 + bj * HALF + 4 * n) : (f32x4){0.f, 0.f, 0.f, 0.f};
#pragma unroll
        for (int ai = 0; ai < 2; ++ai)
#pragma unroll
            for (int m = 0; m < 4; ++m) { bf16_t* rowp = base + (size_t)(row0 + ai * HALF + m * 16) * ldc + col0;
#pragma unroll
                for (int bj = 0; bj < 2; ++bj) { f32x4 v0 = acc[ai][bj][m][0] + bv[bj][0], v1 = acc[ai][bj][m][1] + bv[bj][1];
                    if (ACT == 1) { f32x2 a = gelu_pk((f32x2){v0[0], v0[1]}), b = gelu_pk((f32x2){v0[2], v0[3]}), c = gelu_pk((f32x2){v1[0], v1[1]}), d = gelu_pk((f32x2){v1[2], v1[3]});
                        v0 = (f32x4){a.x, a.y, b.x, b.y}; v1 = (f32x4){c.x, c.y, d.x, d.y}; }
                    v0 = v0 * sc; v1 = v1 * sc; u32x4 w; w.x = cvt_pk_bf16(v0[0], v0[1]); w.y = cvt_pk_bf16(v0[2], v0[3]); w.z = cvt_pk_bf16(v1[0], v1[1]); w.w = cvt_pk_bf16(v1[2], v1[3]);
                    *(u32x4*)(rowp + bj * HALF) = w; } }
    }
};
#ifndef PG8_RELAX
#define PG8_RELAX 0
#endif
#ifndef PROBE_GEMM_SEL
#define PROBE_GEMM_SEL 0
#endif
#ifndef PROBE_GEMM_BLK
#define PROBE_GEMM_BLK 0
#endif
#define PG8_NOW() (PROBE_GEMM_SEL == 3 ? __builtin_amdgcn_s_memtime() : PROBE_GEMM_SEL ? __builtin_amdgcn_s_memrealtime() : 0ull)
#ifndef ABL_BMASK
#define ABL_BMASK (~0)
#endif
#ifndef ABL_AMASK
#define ABL_AMASK (~0)
#endif
template <class Epi, class Sched, bool ALIGN_EPI = false, bool SP2 = false>
__device__ __forceinline__ void gemm_phase(PG8_LAS unsigned char* lds, const Gemm g, const Sched& S, const Epi& E) {
    const int tid = threadIdx.x, wid = __builtin_amdgcn_readfirstlane(tid >> 6), lane = tid & 63, wr = wid >> 2, wc = wid & 3, fr = lane & 15, fq = lane >> 4;
    const int K = g.K, nt = K / BK;
    const int lda = g.lda ? g.lda : K; const int ksplit = g.ksplit; const long long asplit = g.asplit;
    unsigned voffA[2], voffB[2]; int Rr[2], Cc[2];
#pragma unroll
    for (int i = 0; i < 2; ++i) { int R, C; stage_rc(tid * 16 + i * 8192, R, C); const int Rb = Epi::PERM ? ((R & ~31) + perm32(R & 31)) : R; Rr[i] = R; Cc[i] = C;
        voffA[i] = (unsigned)(R * lda + C) * 2u; voffB[i] = (unsigned)(Rb * K + C) * 2u; }
    const size_t kstep = (size_t)(BK * 2);
    const size_t hstep = (size_t)HALF * K * 2;
    const size_t tstep = 2 * hstep;
    const size_t hstepA = (size_t)HALF * lda * 2, tstepA = 2 * hstepA;
    unsigned vAc[2][2], vAn[2][2];
#define PG8_AOFF(dst, un) do { _Pragma("unroll") for (int h_ = 0; h_ < 2; ++h_) _Pragma("unroll") for (int i_ = 0; i_ < 2; ++i_) { \
        if constexpr (Sched::GATHER) (dst)[h_][i_] = (unsigned)S.arow((un), h_ * HALF + Rr[i_]) * (unsigned)((g.lda ? g.lda : K) * 2) + (unsigned)(Cc[i_] * 2); \
        else (dst)[h_][i_] = voffA[i_] + (unsigned)(h_ * (int)hstepA); } } while (0)
    const unsigned ldsw = (unsigned)wid * 1024u;
    const int aoff = lds_byte(wr * 64 + fr, fq * 8), boff = lds_byte(wc * 32 + fr, fq * 8);
#define PG8_SA(b, h) (((b) * 2 + (h)) * HTB)
#define PG8_SB(b, h) ((4 + (b) * 2 + (h)) * HTB)
#define PG8_STAGE(bufoff, gbase, voff) do { _Pragma("unroll") for (int _i = 0; _i < 2; ++_i) \
        __builtin_amdgcn_global_load_lds((const unsigned*)((const char*)(gbase) + (voff)[_i]), (PG8_LAS unsigned*)(lds + (bufoff) + ldsw + _i * 8192), 16, 0, 0); } while (0)
#define PG8_LDA(dst, b, h) do { _Pragma("unroll") for (int m = 0; m < 4; ++m) _Pragma("unroll") for (int k = 0; k < 2; ++k) dst[m][k] = *(const PG8_LAS bf16x8*)(lds + PG8_SA(b, h) + aoff + m * 2048 + k * 1024); } while (0)
#define PG8_LDB(dst, b, h) do { _Pragma("unroll") for (int n = 0; n < 2; ++n) _Pragma("unroll") for (int k = 0; k < 2; ++k) dst[n][k] = *(const PG8_LAS bf16x8*)(lds + PG8_SB(b, h) + boff + n * 2048 + k * 1024); } while (0)
#define PG8_MMA(ai, bj, At, Bt) do { __builtin_amdgcn_s_setprio(1); _Pragma("unroll") for (int m = 0; m < 4; ++m) _Pragma("unroll") for (int n = 0; n < 2; ++n) _Pragma("unroll") for (int k = 0; k < 2; ++k) \
        acc[ai][bj][m][n] = __builtin_amdgcn_mfma_f32_16x16x32_bf16(Bt[n][k], At[m][k], acc[ai][bj][m][n], 0, 0, 0); __builtin_amdgcn_s_setprio(0); } while (0)
#define PG8_WAIT_V(n) asm volatile("s_waitcnt vmcnt(" #n ")" ::: "memory")
#if PG8_RELAX
#define PG8_WAIT_VF asm volatile("s_cmp_lg_u32 %0, 0\n\ts_cbranch_scc1 1f\n\ts_waitcnt vmcnt(8)\n1:\n\ts_waitcnt vmcnt(%1)" :: "s"(relax), "n"(8 + (PG8_RELAX ? Epi::NST : 0)) : "scc", "memory")
#else
#define PG8_WAIT_VF PG8_WAIT_V(8)
#endif
#define PG8_WAIT_L(n) asm volatile("s_waitcnt lgkmcnt(" #n ")" ::: "memory")
#define PG8_BAR __builtin_amdgcn_s_barrier()
#define PG8_SCHED __builtin_amdgcn_sched_barrier(0)
    Unit cur, nxt; int ui = 0;
    int relax; asm volatile("s_mov_b32 %0, 0" : "=s"(relax));
    unsigned long long p_t0 = 0, p_t1 = 0, p_k = 0, p_e = 0;
    if (!S.next(0, cur)) return;
    f32x4 acc[2][2][4][2];
#pragma unroll
    for (int a = 0; a < 2; ++a)
#pragma unroll
        for (int b = 0; b < 2; ++b)
#pragma unroll
            for (int m = 0; m < 4; ++m)
#pragma unroll
                for (int n = 0; n < 2; ++n) acc[a][b][m][n] = (f32x4){0.f, 0.f, 0.f, 0.f};
    bf16x8 At[4][2], B0[2][2], B1[2][2];
    const char* cA = (const char*)g.A + (Sched::GATHER ? (size_t)0 : (size_t)cur.pm * tstepA); const char* cB = (const char*)g.Bt + (size_t)cur.pn * tstep;
    PG8_AOFF(vAc, cur);
    S.a_ready(cur);
    if constexpr (Epi::MIDK) E.stage(cur, 0);
    if constexpr (SP2) {
        PG8_STAGE(PG8_SB(0, 0), cB, voffB); PG8_STAGE(PG8_SB(0, 1), cB + hstep, voffB); PG8_STAGE(PG8_SA(0, 0), cA, vAc[0]); PG8_STAGE(PG8_SA(0, 1), cA, vAc[1]);
        if (wr == 1) PG8_BAR;
        PG8_WAIT_V(2); PG8_BAR;
        PG8_STAGE(PG8_SB(1, 0), cB + kstep, voffB); PG8_STAGE(PG8_SA(1, 0), cA + kstep, vAc[0]); PG8_STAGE(PG8_SB(1, 1), cB + hstep + kstep, voffB); PG8_STAGE(PG8_SA(1, 1), cA + kstep, vAc[1]);
        PG8_WAIT_V(8); PG8_BAR;
    } else {
        PG8_STAGE(PG8_SB(0, 0), cB, voffB); PG8_STAGE(PG8_SA(0, 0), cA, vAc[0]); PG8_STAGE(PG8_SB(0, 1), cB + hstep, voffB); PG8_STAGE(PG8_SA(0, 1), cA, vAc[1]);
        if (wr == 1) PG8_BAR;
        PG8_WAIT_V(4); PG8_BAR;
        PG8_STAGE(PG8_SB(1, 0), cB + kstep, voffB); PG8_STAGE(PG8_SA(1, 0), cA + kstep, vAc[0]); PG8_STAGE(PG8_SB(1, 1), cB + hstep + kstep, voffB);
        PG8_WAIT_V(6); PG8_BAR;
    }
    for (;;) {
        const bool has_next = S.next(ui + 1, nxt);
        const char* nA = has_next ? (const char*)g.A + (Sched::GATHER ? (size_t)0 : (size_t)nxt.pm * tstepA) : cA; const char* nB = has_next ? (const char*)g.Bt + (size_t)nxt.pn * tstep : cB;
        if (has_next) { PG8_AOFF(vAn, nxt); } else {
#pragma unroll
            for (int h_ = 0; h_ < 2; ++h_)
#pragma unroll
                for (int i_ = 0; i_ < 2; ++i_) vAn[h_][i_] = vAc[h_][i_]; }
        p_t0 = PG8_NOW(); if (ui > 0) p_e += p_t0 - p_t1;
        for (int t = 0; t < nt; t += 2) {
            if constexpr (Epi::MIDK) { if (t > 0 && (t & 3) == 0) E.midk(acc, cur, t, ui, wr, wc, fr, fq); }
            const bool last = (t == nt - 2);
            const char* a1 = cA + (size_t)(t + 1) * kstep + (t >= ksplit ? asplit : 0ll);
            const char* a2 = last ? nA : cA + (size_t)(t + 2) * kstep + (t + 2 >= ksplit ? asplit : 0ll); const char* b2 = last ? nB : cB + (size_t)(t + 2) * kstep;
            const char* a3 = a2 + kstep; const char* b3 = b2 + kstep;
            unsigned vA2[2][2];
#pragma unroll
            for (int h_ = 0; h_ < 2; ++h_)
#pragma unroll
                for (int i_ = 0; i_ < 2; ++i_) vA2[h_][i_] = vAc[h_][i_];
            if (last) { asm volatile("" ::: "memory");
#pragma unroll
                for (int h_ = 0; h_ < 2; ++h_)
#pragma unroll
                    for (int i_ = 0; i_ < 2; ++i_) vA2[h_][i_] = vAn[h_][i_]; }
            if (last && has_next) S.a_ready(nxt);
            if constexpr (SP2) {
            PG8_LDB(B0, 0, 0); PG8_LDB(B1, 0, 1); PG8_SCHED; PG8_LDA(At, 0, 0);
            PG8_WAIT_VF; PG8_WAIT_L(0); PG8_BAR; PG8_MMA(0, 0, At, B0); PG8_MMA(0, 1, At, B1); PG8_BAR; PG8_SCHED;
            PG8_LDA(At, 0, 1); PG8_STAGE(PG8_SB(0, 0), b2, voffB); PG8_STAGE(PG8_SB(0, 1), b2 + hstep, voffB); PG8_STAGE(PG8_SA(0, 0), a2, vA2[0]);
            PG8_WAIT_VF; PG8_WAIT_L(0); PG8_BAR; PG8_MMA(1, 0, At, B0); PG8_MMA(1, 1, At, B1); PG8_BAR; PG8_SCHED;
            PG8_LDB(B0, 1, 0); PG8_LDB(B1, 1, 1); PG8_SCHED; PG8_LDA(At, 1, 0); PG8_STAGE(PG8_SA(0, 1), a2, vA2[1]);
            PG8_WAIT_VF; PG8_WAIT_L(0); PG8_BAR; PG8_MMA(0, 0, At, B0); PG8_MMA(0, 1, At, B1); PG8_BAR; PG8_SCHED;
            PG8_LDA(At, 1, 1); PG8_STAGE(PG8_SB(1, 0), b3, voffB); PG8_STAGE(PG8_SB(1, 1), b3 + hstep, voffB); PG8_STAGE(PG8_SA(1, 0), a3, vA2[0]);
            PG8_WAIT_V(8); PG8_WAIT_L(0); PG8_BAR; PG8_MMA(1, 0, At, B0); PG8_MMA(1, 1, At, B1); PG8_BAR; PG8_SCHED;
            PG8_STAGE(PG8_SA(1, 1), a3, vA2[1]);
            asm volatile("s_mov_b32 %0, 0" : "=s"(relax));
            } else {
            PG8_LDB(B0, 0, 0); PG8_SCHED; PG8_LDA(At, 0, 0); PG8_STAGE(PG8_SA(1, 1), a1, vAc[1]);
            PG8_WAIT_L(8); PG8_BAR; PG8_WAIT_L(0); PG8_MMA(0, 0, At, B0); PG8_BAR; PG8_SCHED;
            PG8_LDB(B1, 0, 1); PG8_STAGE(PG8_SB(0, 0), b2, voffB);
            PG8_BAR; PG8_WAIT_L(0); PG8_MMA(0, 1, At, B1); PG8_BAR;
            PG8_LDA(At, 0, 1); PG8_STAGE(PG8_SA(0, 0), a2, vA2[0]);
            PG8_BAR; PG8_WAIT_L(0); PG8_MMA(1, 0, At, B0); PG8_BAR; PG8_SCHED;
            PG8_STAGE(PG8_SB(0, 1), b2 + hstep, voffB);
            PG8_WAIT_V(6); PG8_BAR; PG8_MMA(1, 1, At, B1); PG8_BAR;
            PG8_LDB(B0, 1, 0); PG8_SCHED; PG8_LDA(At, 1, 0); PG8_STAGE(PG8_SA(0, 1), a2, vA2[1]);
            PG8_WAIT_L(8); PG8_BAR; PG8_WAIT_L(0); PG8_MMA(0, 0, At, B0); PG8_BAR; PG8_SCHED;
            PG8_LDB(B1, 1, 1); PG8_STAGE(PG8_SB(1, 0), b3, voffB);
            PG8_BAR; PG8_WAIT_L(0); PG8_MMA(0, 1, At, B1); PG8_BAR;
            PG8_LDA(At, 1, 1); PG8_STAGE(PG8_SA(1, 0), a3, vA2[0]);
            PG8_BAR; PG8_WAIT_L(0); PG8_MMA(1, 0, At, B0); PG8_BAR; PG8_SCHED;
            PG8_STAGE(PG8_SB(1, 1), b3 + hstep, voffB);
            PG8_WAIT_V(6); PG8_BAR; PG8_MMA(1, 1, At, B1); PG8_BAR;
            }
        }
        p_t1 = PG8_NOW(); p_k += p_t1 - p_t0;
        if constexpr (ALIGN_EPI) { if (wr == 0) PG8_BAR; }
        if constexpr (!Epi::AFTER_DRAIN) { if constexpr (Epi::MIDK) { if (has_next) E.stage(nxt, ui + 1); E.epi(acc, cur, ui, wr, wc, fr, fq); } else E(acc, cur, wr, wc, fr, fq); S.done(cur); }
        if (!has_next) break;
#pragma unroll
        for (int a = 0; a < 2; ++a)
#pragma unroll
            for (int b = 0; b < 2; ++b)
#pragma unroll
                for (int m = 0; m < 4; ++m)
#pragma unroll
                    for (int n = 0; n < 2; ++n) acc[a][b][m][n] = (f32x4){0.f, 0.f, 0.f, 0.f};
        cur = nxt; cA = nA; cB = nB; ++ui;
        asm volatile("s_mov_b32 %0, 1" : "=s"(relax));
#pragma unroll
        for (int h_ = 0; h_ < 2; ++h_)
#pragma unroll
            for (int i_ = 0; i_ < 2; ++i_) vAc[h_][i_] = vAn[h_][i_];
        if constexpr (ALIGN_EPI) { if (wr == 1) PG8_BAR; }
    }
    PG8_WAIT_V(0);
    if constexpr (!ALIGN_EPI) { if (wr == 0) PG8_BAR; }
    PG8_BAR;
    if constexpr (Epi::AFTER_DRAIN) { E.fused(acc, cur, wr, wc, fr, fq, lds, wid, lane); S.done(cur); }
    if (PROBE_GEMM_SEL && g.probe && tid == 0 && blockIdx.x == PROBE_GEMM_BLK) *g.probe = PROBE_GEMM_SEL == 3 ? (float)p_k / (float)((ui + 1) * nt) * 0.01f : (float)(PROBE_GEMM_SEL == 1 ? p_k : p_e) * 0.001f;
#undef PG8_AOFF
#undef PG8_SA
#undef PG8_SB
#undef PG8_STAGE
#undef PG8_LDA
#undef PG8_LDB
#undef PG8_MMA
#undef PG8_WAIT_V
#undef PG8_WAIT_L
#undef PG8_BAR
#undef PG8_SCHED
}
}

#define GAS __attribute__((address_space(1)))
#define LAS __attribute__((address_space(3)))
typedef unsigned short bf16;
typedef unsigned U4 __attribute__((ext_vector_type(4)));
typedef unsigned U2 __attribute__((ext_vector_type(2)));
typedef float F4 __attribute__((ext_vector_type(4)));
typedef float F2 __attribute__((ext_vector_type(2)));
typedef float F16 __attribute__((ext_vector_type(16)));
typedef short B8 __attribute__((ext_vector_type(8)));
typedef short S4 __attribute__((ext_vector_type(4)));
typedef __bf16 bf16x2_t __attribute__((ext_vector_type(2)));

constexpr int NWAVES = 8, NTHR = 512;
constexpr int DM = 1024, BATCH = 8, SEQ = 8192, NTOK = BATCH * SEQ;
constexpr int DIN = 8200, NPROJ = 8192;
constexpr int CHUNK = 128, NCHUNK = SEQ / CHUNK;
constexpr int NEXP = 32, DEXP = 512;
constexpr int MAXTILES = 544, MAXROWS = MAXTILES * 256;
constexpr float EPS = 1e-6f;
constexpr int LDS_BYTES = 159744;
constexpr int LDS_MISC = 151552;

constexpr size_t MiB = 1u << 20;
constexpr size_t WS_CTL = 0, CTL_ZERO_BYTES = 32768; constexpr int CW_BAR = 1024;
constexpr size_t WS_IF = 1 * MiB;
constexpr size_t WS_THR = 3 * MiB;
constexpr size_t WS_CDEC = 4 * MiB;
constexpr size_t WS_ROUT = 4 * MiB + 65536;
constexpr size_t WS_ROPE = 5 * MiB;
constexpr size_t WS_TOK = 9 * MiB;
constexpr size_t WS_WIN = 12 * MiB;
constexpr size_t WS_WCAT = 28 * MiB, WS_WOUT = 32 * MiB;
constexpr size_t WS_H = 34 * MiB;
constexpr size_t WS_MQP = 34 * MiB, WS_MKP = 98 * MiB;
constexpr size_t WS_WGU = 290 * MiB, WS_WD = 354 * MiB;
constexpr size_t WS_RQ = 162 * MiB, WS_RK = 226 * MiB, WS_MQ = 290 * MiB, WS_MK = 354 * MiB;
constexpr size_t WS_XCAT = 162 * MiB;
constexpr size_t WS_RV = 418 * MiB, WS_RG = 546 * MiB, WS_MV = 674 * MiB, WS_MO = 802 * MiB;
constexpr size_t WS_MERGED = 802 * MiB;
constexpr size_t WS_RS = 930 * MiB;
constexpr size_t WS_YO = 162 * MiB;
constexpr size_t WS_XS = 418 * MiB, WS_HMID = 690 * MiB, WS_Y = 418 * MiB;
constexpr size_t WS_TOKMAP = 930 * MiB, WS_SRSTD = 938 * MiB;
constexpr size_t WS_END = 946 * MiB;
constexpr size_t OUT_GR = 0, OUT_GM = 128 * MiB;
static_assert(WS_XS + (size_t)MAXROWS * 1024 * 2 <= WS_HMID && WS_HMID + (size_t)MAXROWS * 512 * 2 <= WS_END, "ws map");

struct TokInfo { int e0, p0, e1, p1; float w0, w1, rstd, pad; };

__device__ __forceinline__ float bflo(unsigned u) { return __uint_as_float(u << 16); }
__device__ __forceinline__ float bfhi(unsigned u) { return __uint_as_float(u & 0xffff0000u); }
__device__ __forceinline__ float bf2f(short s) { return __uint_as_float(((unsigned)(unsigned short)s) << 16); }
__device__ __forceinline__ unsigned cvtpk(float lo, float hi) { F2 v = {lo, hi}; bf16x2_t b = __builtin_convertvector(v, bf16x2_t); return __builtin_bit_cast(unsigned, b); }
__device__ __forceinline__ float wave_sum(float v) {
#pragma unroll
    for (int o = 1; o < 64; o <<= 1) v += __shfl_xor(v, o);
    return v;
}
__device__ __forceinline__ float sigm(float x) { return __builtin_amdgcn_rcpf(1.f + __expf(-x)); }
__device__ __forceinline__ float silu(float x) { return x * __builtin_amdgcn_rcpf(1.f + __expf(-x)); }
__device__ __forceinline__ float dot2bf(unsigned a, unsigned b, float c) { return __builtin_amdgcn_fdot2_f32_bf16(__builtin_bit_cast(bf16x2_t, a), __builtin_bit_cast(bf16x2_t, b), c, false); }
__device__ __forceinline__ float clamp8(float x) { return fminf(fmaxf(x, -448.f), 448.f); }
__device__ __forceinline__ unsigned pk4_fp8(float a, float b, float c, float d) {
    unsigned w = 0u; w = __builtin_amdgcn_cvt_pk_fp8_f32(clamp8(a), clamp8(b), w, false); w = __builtin_amdgcn_cvt_pk_fp8_f32(clamp8(c), clamp8(d), w, true); return w; }
__device__ __forceinline__ unsigned q8(float s) { return (unsigned)fminf(fmaxf(s * 255.f + 0.5f, 1.f), 255.f); }
__device__ __forceinline__ unsigned pk4_q8(float a, float b, float c, float d) { return q8(a) | (q8(b) << 8) | (q8(c) << 16) | (q8(d) << 24); }
__device__ __forceinline__ unsigned ql8(float s) { return (unsigned)fminf(fmaxf((s + 0.3f) * (1.f / 0.03f) + 0.5f, 0.f), 255.f); }
__device__ __forceinline__ unsigned pk4_ql8(float a, float b, float c, float d) { return ql8(a) | (ql8(b) << 8) | (ql8(c) << 16) | (ql8(d) << 24); }
__device__ __forceinline__ float b0f(unsigned w) { return (float)(w & 0xffu); }
__device__ __forceinline__ float b1f(unsigned w) { return (float)((w >> 8) & 0xffu); }
__device__ __forceinline__ float b2f(unsigned w) { return (float)((w >> 16) & 0xffu); }
__device__ __forceinline__ float b3f(unsigned w) { return (float)(w >> 24); }
__device__ __forceinline__ int crow(int r, int hi) { return (r & 3) + 8 * (r >> 2) + 4 * hi; }
#define MFMA32(a, b, c) __builtin_amdgcn_mfma_f32_32x32x16_bf16((a), (b), (c), 0, 0, 0)
typedef short v4i16_t __attribute__((ext_vector_type(4)));
__device__ __forceinline__ S4 trrd(LAS const unsigned char* p) { return __builtin_bit_cast(S4, __builtin_amdgcn_ds_read_tr16_b64_v4i16((LAS v4i16_t*)p)); }
__device__ __forceinline__ void glds16(const void* gsrc, unsigned lds_dst) { unsigned keep;
    asm volatile("s_mov_b32 %0, m0\n\ts_mov_b32 m0, %2\n\ts_nop 0\n\tglobal_load_lds_dwordx4 %1, off\n\ts_mov_b32 m0, %0" : "=&s"(keep) : "v"(gsrc), "s"(lds_dst) : "memory"); }
__device__ __forceinline__ unsigned offb(unsigned row, unsigned ch) { return 256u * row + 16u * (ch ^ (((row & 3) << 2) | ((row >> 2) & 3))); }
__device__ __forceinline__ unsigned offv(unsigned row, unsigned ch) { return 128u * row + 16u * (ch ^ (((row >> 1) & 1) << 2)); }

#define XB_TMO      128
#define XB_XCNT(j)  (256  + 64 * (j))
#define XB_XSUB(j)  (1280 + 64 * (j))
#define XB_XGEN(j)  (2304 + 64 * (j))
#define XB_TOP      3328
#define XB_TOPGEN   3392
#define XCD_BAR_WORDS 3456
#define XB_SPIN_CAP (1u << 18)

__device__ __forceinline__ unsigned xb_ld(unsigned* p)              { return __hip_atomic_load(p, __ATOMIC_RELAXED, __HIP_MEMORY_SCOPE_AGENT); }
__device__ __forceinline__ unsigned xb_add(unsigned* p, unsigned v) { return __hip_atomic_fetch_add(p, v, __ATOMIC_RELAXED, __HIP_MEMORY_SCOPE_AGENT); }
__device__ __forceinline__ unsigned xb_xcc_id() { return (unsigned)__builtin_amdgcn_s_getreg((3 << 11) | 20) & 0xFu; }
#define XB_SPIN(cond, bar) do { unsigned _sp = 0; while (cond) { __builtin_amdgcn_s_sleep(1); \
    if ((++_sp & 255u) == 0u) { if (xb_ld(&(bar)[XB_TMO])) break; if (_sp > XB_SPIN_CAP) { atomicAdd(&(bar)[XB_TMO], 1u); break; } } } } while (0)

struct XcdBarrier {
    unsigned* bar; unsigned x;
    volatile LAS unsigned* st;
};

__device__ __forceinline__ XcdBarrier xcd_barrier_post(unsigned* bar, volatile LAS unsigned* st) {
    XcdBarrier b; b.bar = bar; b.x = xb_xcc_id(); b.st = st;
    if (threadIdx.x == 0) (void)xb_add(&bar[XB_XCNT(b.x)], 1u);
    return b;
}
__device__ __forceinline__ void xcd_barrier_complete(unsigned* bar, unsigned x, unsigned& nloc, unsigned& nx) {
    const unsigned G = gridDim.x * gridDim.y * gridDim.z;
    unsigned sum, cnt, mine, sp = 0u;
    for (;;) {
        sum = 0u; cnt = 0u; mine = 0u;
#pragma unroll
        for (unsigned j = 0; j < 16; ++j) { const unsigned c = xb_ld(&bar[XB_XCNT(j)]); sum += c; cnt += (c > 0u) ? 1u : 0u; mine = (j == x) ? c : mine; }
        if (sum == G) break;
        __builtin_amdgcn_s_sleep(1);
        if ((++sp & 255u) == 0u) { if (xb_ld(&bar[XB_TMO])) break; if (sp > XB_SPIN_CAP) { atomicAdd(&bar[XB_TMO], 1u); break; } }
    }
    nloc = mine > 0u ? mine : 1u; nx = cnt > 0u ? cnt : 1u;
}

__device__ __forceinline__ void xcd_barrier(const XcdBarrier& b) {
    asm volatile("s_waitcnt vmcnt(0)" ::: "memory");
    __syncthreads();
    if (threadIdx.x == 0) {
        unsigned* bar = b.bar;
        __builtin_amdgcn_s_waitcnt(0);
        unsigned nloc = b.st[0], nx = b.st[1];
        if (nloc == 0u) { xcd_barrier_complete(bar, b.x, nloc, nx); b.st[0] = nloc; b.st[1] = nx; }
        const unsigned old = xb_add(&bar[XB_XSUB(b.x)], 1u);
        const unsigned gen = old / nloc;
        if (old + 1u == (gen + 1u) * nloc) {
            __builtin_amdgcn_fence(__ATOMIC_RELEASE, "agent");
            asm volatile("s_waitcnt vmcnt(0)" ::: "memory");
            const unsigned og = xb_add(&bar[XB_TOP], 1u);
            const unsigned tg = og / nx;
            if (og + 1u == (tg + 1u) * nx) xb_add(&bar[XB_TOPGEN], 1u);
            else XB_SPIN(xb_ld(&bar[XB_TOPGEN]) == tg, bar);
            __builtin_amdgcn_fence(__ATOMIC_ACQUIRE, "agent");
            xb_add(&bar[XB_XGEN(b.x)], 1u);
            asm volatile("s_waitcnt vmcnt(0)" ::: "memory");
        } else {
            __builtin_amdgcn_fence(__ATOMIC_ACQUIRE, "agent");
            XB_SPIN(xb_ld(&bar[XB_XGEN(b.x)]) == gen, bar);
            asm volatile("" ::: "memory");
            asm volatile("s_waitcnt vmcnt(0)" ::: "memory");
        }
    }
    __syncthreads();
}

namespace pg8 {
struct EpiProj {
    static constexpr bool PERM = true, AFTER_DRAIN = false, MIDK = false; static constexpr int NST = 16;
    unsigned char* ws; unsigned char* ob;
    __device__ __forceinline__ void operator()(const f32x4 (&acc)[2][2][4][2], const Unit& u, int wr, int wc, int fr, int fq) const {
        const int pn = u.pn; bf16_t* base; int ld, ct;
        if (pn < 2)       { base = (bf16_t*)(ws + WS_RQ); ld = 512;  ct = pn; }
        else if (pn < 4)  { base = (bf16_t*)(ws + WS_RK); ld = 512;  ct = pn - 2; }
        else if (pn < 8)  { base = (bf16_t*)(ws + WS_RV); ld = 1024; ct = pn - 4; }
        else if (pn < 12) { base = (bf16_t*)(ws + WS_RG); ld = 1024; ct = pn - 8; }
        else if (pn < 14) { base = (bf16_t*)(ws + WS_MQ); ld = 512;  ct = pn - 12; }
        else if (pn < 16) { base = (bf16_t*)(ws + WS_MK); ld = 512;  ct = pn - 14; }
        else if (pn < 20) { base = (bf16_t*)(ws + WS_MV); ld = 1024; ct = pn - 16; }
        else if (pn < 24) { base = (bf16_t*)(ws + WS_MO); ld = 1024; ct = pn - 20; }
        else if (pn < 28) { base = (bf16_t*)(ob + OUT_GR); ld = 1024; ct = pn - 24; }
        else              { base = (bf16_t*)(ob + OUT_GM); ld = 1024; ct = pn - 28; }
        int row0 = u.pm * BM + wr * 64 + fr, col0 = ct * BM + wc * 32 + 8 * fq;
        asm volatile("" : "+v"(row0), "+v"(col0));
        if (pn >= 8 && pn < 12) {
            unsigned char* b8 = (unsigned char*)(ws + WS_RG);
#pragma unroll
            for (int ai = 0; ai < 2; ++ai)
#pragma unroll
                for (int m = 0; m < 4; ++m) { unsigned char* rowp = b8 + (size_t)(row0 + ai * HALF + m * 16) * 1024 + col0;
#pragma unroll
                    for (int bj = 0; bj < 2; ++bj) { const f32x4 v0 = acc[ai][bj][m][0], v1 = acc[ai][bj][m][1];
                        U2 w; w.x = pk4_ql8(silu(v0[0]), silu(v0[1]), silu(v0[2]), silu(v0[3])); w.y = pk4_ql8(silu(v1[0]), silu(v1[1]), silu(v1[2]), silu(v1[3]));
                        *(U2*)(rowp + bj * HALF) = w; } }
            return;
        }
        if (pn >= 20) {
            unsigned char* b8 = pn < 24 ? (unsigned char*)(ws + WS_MO) : (pn < 28 ? (unsigned char*)(ob + OUT_GR) : (unsigned char*)(ob + OUT_GM));
#pragma unroll
            for (int ai = 0; ai < 2; ++ai)
#pragma unroll
                for (int m = 0; m < 4; ++m) { unsigned char* rowp = b8 + (size_t)(row0 + ai * HALF + m * 16) * 1024 + col0;
#pragma unroll
                    for (int bj = 0; bj < 2; ++bj) { const f32x4 v0 = acc[ai][bj][m][0], v1 = acc[ai][bj][m][1];
                        U2 w; w.x = pk4_q8(sigm(v0[0]), sigm(v0[1]), sigm(v0[2]), sigm(v0[3])); w.y = pk4_q8(sigm(v1[0]), sigm(v1[1]), sigm(v1[2]), sigm(v1[3]));
                        *(U2*)(rowp + bj * HALF) = w; } }
            return;
        }
        if (pn < 4) {
            const int hd = (pn & 1) * 2 + (wc >> 1), d1 = 32 * (wc & 1) + 8 * fq;
            const float lg = hd == 0 ? -0.04580368961312479f : (hd == 1 ? -0.02272007650008353f : (hd == 2 ? -0.011315313227834146f : -0.005646563141142063f));
            const float2* RT = (const float2*)(ws + WS_ROPE);
#pragma unroll
            for (int ai = 0; ai < 2; ++ai)
#pragma unroll
                for (int m = 0; m < 4; ++m) { const int r = row0 + ai * HALF + m * 16, pos = r & (SEQ - 1), l = r & (CHUNK - 1);
                    const float sc = pn < 2 ? exp2f(lg * (float)l) : exp2f(-lg * (float)l) * 0.08838834764831845f;
                    const f32x4* rt = (const f32x4*)(RT + (size_t)pos * 64 + d1);
                    const f32x4 c0 = rt[0], c1 = rt[1], c2 = rt[2], c3 = rt[3];
                    const f32x4 a0 = acc[ai][0][m][0], a1 = acc[ai][0][m][1], b0 = acc[ai][1][m][0], b1 = acc[ai][1][m][1];
                    u32x4 w1, w2;
                    w1.x = cvt_pk_bf16((a0[0] * c0[0] - b0[0] * c0[1]) * sc, (a0[1] * c0[2] - b0[1] * c0[3]) * sc); w1.y = cvt_pk_bf16((a0[2] * c1[0] - b0[2] * c1[1]) * sc, (a0[3] * c1[2] - b0[3] * c1[3]) * sc);
                    w1.z = cvt_pk_bf16((a1[0] * c2[0] - b1[0] * c2[1]) * sc, (a1[1] * c2[2] - b1[1] * c2[3]) * sc); w1.w = cvt_pk_bf16((a1[2] * c3[0] - b1[2] * c3[1]) * sc, (a1[3] * c3[2] - b1[3] * c3[3]) * sc);
                    w2.x = cvt_pk_bf16((b0[0] * c0[0] + a0[0] * c0[1]) * sc, (b0[1] * c0[2] + a0[1] * c0[3]) * sc); w2.y = cvt_pk_bf16((b0[2] * c1[0] + a0[2] * c1[1]) * sc, (b0[3] * c1[2] + a0[3] * c1[3]) * sc);
                    w2.z = cvt_pk_bf16((b1[0] * c2[0] + a1[0] * c2[1]) * sc, (b1[1] * c2[2] + a1[1] * c2[3]) * sc); w2.w = cvt_pk_bf16((b1[2] * c3[0] + a1[2] * c3[1]) * sc, (b1[3] * c3[2] + a1[3] * c3[3]) * sc);
                    bf16_t* rowp = base + (size_t)r * 512 + hd * 128 + d1;
                    *(u32x4*)rowp = w1; *(u32x4*)(rowp + 64) = w2; }
            return;
        }
#pragma unroll
        for (int ai = 0; ai < 2; ++ai)
#pragma unroll
            for (int m = 0; m < 4; ++m) { bf16_t* rowp = base + (size_t)(row0 + ai * HALF + m * 16) * ld + col0;
#pragma unroll
                for (int bj = 0; bj < 2; ++bj) { f32x4 v0 = acc[ai][bj][m][0], v1 = acc[ai][bj][m][1];
                    u32x4 w; w.x = cvt_pk_bf16(v0[0], v0[1]); w.y = cvt_pk_bf16(v0[2], v0[3]); w.z = cvt_pk_bf16(v1[0], v1[1]); w.w = cvt_pk_bf16(v1[2], v1[3]);
                    *(u32x4*)(rowp + bj * HALF) = w; } }
    }
};
#ifndef ABL_EPI
#define ABL_EPI 0
#endif
struct EpiGateFused {
    static constexpr bool PERM = true, AFTER_DRAIN = false, MIDK = true; static constexpr int NST = 16;
    const unsigned char* GR; const unsigned char* GM; bf16_t* O; const float* RS; PG8_LAS float* T;
    __device__ __forceinline__ void stage(const Unit& u, int ui) const {
        const int tid = (int)threadIdx.x, j = tid >> 6, r4 = (tid & 63) * 4;
        f32x4 q[8];
#pragma unroll
        for (int p8 = 0; p8 < 8; ++p8) q[p8] = *(const f32x4*)(RS + (size_t)(j * 8 + p8) * NTOK + (size_t)u.pm * BM + r4);
        const f32x4 ms = (((q[0] + q[1]) + (q[2] + q[3])) + ((q[4] + q[5]) + (q[6] + q[7]))) * (1.f / 256.f) + EPS;
        f32x4 v; v[0] = rsqrtf(ms[0]); v[1] = rsqrtf(ms[1]); v[2] = rsqrtf(ms[2]); v[3] = rsqrtf(ms[3]);
        *(PG8_LAS f32x4*)(T + (ui & 1) * 2048 + j * 256 + r4) = v;
    }
    __device__ __forceinline__ void midk(f32x4 (&acc)[2][2][4][2], const Unit& u, int t, int ui, int wr, int wc, int fr, int fq) const {
        if (ABL_EPI & 2) return;
        { const PG8_LAS float* tj = T + (ui & 1) * 2048 + (t >> 2) * 256 + wr * 64 + fr;
#pragma unroll
          for (int ai = 0; ai < 2; ++ai)
#pragma unroll
            for (int m = 0; m < 4; ++m) { const float sp = tj[ai * HALF + m * 16 - 256], sn = tj[ai * HALF + m * 16]; const float rt = sp * __builtin_amdgcn_rcpf(sn);
#pragma unroll
                for (int bj = 0; bj < 2; ++bj) { acc[ai][bj][m][0] *= rt; acc[ai][bj][m][1] *= rt; } } }
        if (t != 16) return;
        int row0 = u.pm * BM + wr * 64 + fr, col0 = u.pn * BM + wc * 32 + 8 * fq;
        asm volatile("" : "+v"(row0), "+v"(col0));
#pragma unroll
        for (int ai = 0; ai < 2; ++ai) {
#pragma unroll
            for (int m = 0; m < 4; ++m) { const size_t ro = (size_t)(row0 + ai * HALF + m * 16) * 1024 + col0;
#pragma unroll
                for (int bj = 0; bj < 2; ++bj) {
                    const U2 a = *(const U2*)(GR + ro + bj * HALF), b = *(const U2*)(GM + ro + bj * HALF);
                    f32x4 r0, r1;
                    r0[0] = b0f(a.x) * __builtin_amdgcn_rcpf(b0f(b.x)); r0[1] = b1f(a.x) * __builtin_amdgcn_rcpf(b1f(b.x)); r0[2] = b2f(a.x) * __builtin_amdgcn_rcpf(b2f(b.x)); r0[3] = b3f(a.x) * __builtin_amdgcn_rcpf(b3f(b.x));
                    r1[0] = b0f(a.y) * __builtin_amdgcn_rcpf(b0f(b.y)); r1[1] = b1f(a.y) * __builtin_amdgcn_rcpf(b1f(b.y)); r1[2] = b2f(a.y) * __builtin_amdgcn_rcpf(b2f(b.y)); r1[3] = b3f(a.y) * __builtin_amdgcn_rcpf(b3f(b.y));
                    acc[ai][bj][m][0] *= r0; acc[ai][bj][m][1] *= r1; } }
            asm volatile("" ::: "memory"); }
    }
    __device__ __forceinline__ void epi(const f32x4 (&acc)[2][2][4][2], const Unit& u, int ui, int wr, int wc, int fr, int fq) const {
        int row0 = u.pm * BM + wr * 64 + fr, col0 = u.pn * BM + wc * 32 + 8 * fq;
        asm volatile("" : "+v"(row0), "+v"(col0));
        const float k = 1.f / 255.f;
        const PG8_LAS float* t7 = T + (ui & 1) * 2048 + 7 * 256 + wr * 64 + fr;
#pragma unroll
        for (int ai = 0; ai < 2; ++ai)
#pragma unroll
            for (int m = 0; m < 4; ++m) { const size_t ro = (size_t)(row0 + ai * HALF + m * 16) * 1024 + col0; const float ks = k * t7[ai * HALF + m * 16];
#pragma unroll
                for (int bj = 0; bj < 2; ++bj) { const f32x4 v0 = acc[ai][bj][m][0] * ks, v1 = acc[ai][bj][m][1] * ks;
                    const U2 g = *(const U2*)(GM + ro + bj * HALF);
                    u32x4 w; w.x = cvt_pk_bf16(v0[0] * b0f(g.x), v0[1] * b1f(g.x)); w.y = cvt_pk_bf16(v0[2] * b2f(g.x), v0[3] * b3f(g.x));
                    w.z = cvt_pk_bf16(v1[0] * b0f(g.y), v1[1] * b1f(g.y)); w.w = cvt_pk_bf16(v1[2] * b2f(g.y), v1[3] * b3f(g.y));
                    *(u32x4*)(O + ro + bj * HALF) = w; } }
    }
};
struct EpiX1 {
    static constexpr bool PERM = true, AFTER_DRAIN = false, MIDK = false; static constexpr int NST = 32;
    const float* X; float* O;
    __device__ __forceinline__ void operator()(const f32x4 (&acc)[2][2][4][2], const Unit& u, int wr, int wc, int fr, int fq) const {
        const int row0 = u.pm * BM + wr * 64 + fr, col0 = u.pn * BM + wc * 32 + 8 * fq;
#pragma unroll
        for (int ai = 0; ai < 2; ++ai)
#pragma unroll
            for (int m = 0; m < 4; ++m) { const size_t ro = (size_t)(row0 + ai * HALF + m * 16) * 1024 + col0;
#pragma unroll
                for (int bj = 0; bj < 2; ++bj) {
                    const f32x4 a = *(const f32x4*)(X + ro + bj * HALF), b = *(const f32x4*)(X + ro + bj * HALF + 4);
                    *(f32x4*)(O + ro + bj * HALF) = a + acc[ai][bj][m][0]; *(f32x4*)(O + ro + bj * HALF + 4) = b + acc[ai][bj][m][1]; } }
    }
};
struct EpiSwiglu {
    static constexpr bool PERM = true, AFTER_DRAIN = false, MIDK = false; static constexpr int NST = 8;
    bf16_t* O; const float* srstd;
    __device__ __forceinline__ void operator()(const f32x4 (&acc)[2][2][4][2], const Unit& u, int wr, int wc, int fr, int fq) const {
        const int row0 = u.pm * BM + wr * 64 + fr, col0 = (u.pn & 3) * HALF + wc * 32 + 8 * fq;
        float rs[2][4];
#pragma unroll
        for (int ai = 0; ai < 2; ++ai)
#pragma unroll
            for (int m = 0; m < 4; ++m) rs[ai][m] = srstd[u.pa + wr * 64 + fr + ai * HALF + m * 16];
#pragma unroll
        for (int ai = 0; ai < 2; ++ai)
#pragma unroll
            for (int m = 0; m < 4; ++m) { bf16_t* rowp = O + (size_t)(row0 + ai * HALF + m * 16) * 512 + col0; const float r = rs[ai][m];
                const f32x4 g0 = acc[ai][0][m][0] * r, g1 = acc[ai][0][m][1] * r, u0 = acc[ai][1][m][0] * r, u1 = acc[ai][1][m][1] * r;
                u32x4 w; w.x = cvt_pk_bf16(silu(g0[0]) * u0[0], silu(g0[1]) * u0[1]); w.y = cvt_pk_bf16(silu(g0[2]) * u0[2], silu(g0[3]) * u0[3]);
                w.z = cvt_pk_bf16(silu(g1[0]) * u1[0], silu(g1[1]) * u1[1]); w.w = cvt_pk_bf16(silu(g1[2]) * u1[2], silu(g1[3]) * u1[3]);
                *(u32x4*)rowp = w; }
    }
};
struct EpiY {
    static constexpr bool PERM = true, AFTER_DRAIN = false, MIDK = false; static constexpr int NST = 16;
    unsigned char* O;
    __device__ __forceinline__ void operator()(const f32x4 (&acc)[2][2][4][2], const Unit& u, int wr, int wc, int fr, int fq) const {
        int row0 = u.pm * BM + wr * 64 + fr, col0 = (u.pn & 3) * BM + wc * 32 + 8 * fq;
        asm volatile("" : "+v"(row0), "+v"(col0));
#pragma unroll
        for (int ai = 0; ai < 2; ++ai)
#pragma unroll
            for (int m = 0; m < 4; ++m) { unsigned char* rowp = O + (size_t)(row0 + ai * HALF + m * 16) * 1024 + col0;
#pragma unroll
                for (int bj = 0; bj < 2; ++bj) { const f32x4 v0 = acc[ai][bj][m][0] * 16.f, v1 = acc[ai][bj][m][1] * 16.f;
                    U2 w; w.x = pk4_fp8(v0[0], v0[1], v0[2], v0[3]); w.y = pk4_fp8(v1[0], v1[1], v1[2], v1[3]);
                    *(U2*)(rowp + bj * HALF) = w; } }
    }
};
template <bool GATHER_> struct GroupedOrder {
    static constexpr bool GATHER = GATHER_;
    int ntiles, G, c; const PG8_LAS unsigned char* t2e; const PG8_LAS int* rb; const int* tokmap;
    __device__ __forceinline__ bool next(int i, Unit& u) const {
        int L;
        if (!GATHER_ && (G & 7) == 0) { const int per = (G >> 3), x = c / per, sl_ = c - x * per, q = (((ntiles * 4 + 7) >> 3) + 3) & ~3; L = x * q + i * per + sl_; if (i * per + sl_ >= q || L >= ntiles * 4) return false; }
        else { L = i * G + c; if (L >= ntiles * 4) return false; }
        const int rt = L >> 2; const int e = __builtin_amdgcn_readfirstlane((int)t2e[rt]);
        u.pm = rt; u.pn = e * 4 + (L & 3); u.pa = e * 65536 + ((rt - (__builtin_amdgcn_readfirstlane(rb[e]) >> 8)) << 8); return true;
    }
    __device__ __forceinline__ unsigned arow(const Unit& u, int r) const { const unsigned t = (unsigned)tokmap[u.pa + r]; return t < (unsigned)NTOK ? t : (unsigned)(NTOK - 1); }
    __device__ __forceinline__ void a_ready(const Unit&) const {}
    __device__ __forceinline__ void done(const Unit&) const {}
};
}

struct Ctx { LAS unsigned char* lds; int tid, lane, wave, vcu, G; };

__device__ __forceinline__ void transpose_item(const float* W, int ld, int k0, int n0, bf16* WT, int K, int drow0, LAS float* scr, int lane, int kdst = 0, const float* ksc = nullptr  ) {
#pragma unroll 8
    for (int i = 0; i < 32; ++i) { const int kk = 2 * i + (lane >> 5); scr[kk * 33 + (lane & 31)] = W[(size_t)(k0 + kk) * ld + n0 + (lane & 31)]; }
    asm volatile("s_waitcnt lgkmcnt(0)" ::: "memory");
    const int c = lane & 7;
    F4 k0s = (F4){1.f, 1.f, 1.f, 1.f}, k1s = k0s; if (ksc) { k0s = *(const F4*)(ksc + k0 + 8 * c); k1s = *(const F4*)(ksc + k0 + 8 * c + 4); }
#pragma unroll
    for (int j = 0; j < 4; ++j) { const int n = (lane >> 3) + 8 * j; const LAS float* s = scr + (8 * c) * 33 + n;
        U4 o; o.x = cvtpk(s[0 * 33] * k0s.x, s[1 * 33] * k0s.y); o.y = cvtpk(s[2 * 33] * k0s.z, s[3 * 33] * k0s.w); o.z = cvtpk(s[4 * 33] * k1s.x, s[5 * 33] * k1s.y); o.w = cvtpk(s[6 * 33] * k1s.z, s[7 * 33] * k1s.w);
        *(U4*)(WT + (size_t)(drow0 + n) * K + kdst + k0 + 8 * c) = o; }
    asm volatile("s_waitcnt lgkmcnt(0)" ::: "memory");
}

__device__ __forceinline__ void phase0(const Ctx& C, const float* const* in, unsigned char* ws) {
    const float* x = in[0]; const float* nw = in[1]; const float* w_in = in[2];
    LAS float* scr = (LAS float*)(C.lds + C.wave * 8448);
    LAS float* wif = (LAS float*)(C.lds + 98304);
    LAS double* invf = (LAS double*)(C.lds + 98304 + 32768);
    for (int i = C.tid; i < 8192; i += NTHR) { const int c = i & 3, e = i >> 2, l = e & 63, jj = (e >> 6) & 15, p = e >> 10; const int k = 4 * l + 256 * (jj >> 2) + (jj & 3);
        wif[i] = w_in[(size_t)k * DIN + 6144 + 4 * p + c]; }
    if (C.tid < 64) { double r = 1.0; for (int j = 0; j < C.tid; ++j) r *= 0.8659643233600653; invf[C.tid] = r; }
    __syncthreads();
    const int gw = C.vcu * NWAVES + C.wave, NGW = C.G * NWAVES;
    {
        bf16* H = (bf16*)(ws + WS_H); float* IFP = (float*)(ws + WS_IF);
        F4 wv[4];
#pragma unroll
        for (int j = 0; j < 4; ++j) wv[j] = *(const F4*)(nw + 4 * C.lane + 256 * j);
        for (int m = gw; m < NTOK; m += NGW) {
            const F4* xr = (const F4*)(x + (size_t)m * DM) + C.lane;
            F4 v[4]; float s = 0.f;
#pragma unroll
            for (int j = 0; j < 4; ++j) { v[j] = xr[64 * j]; s += (v[j].x * v[j].x + v[j].y * v[j].y) + (v[j].z * v[j].z + v[j].w * v[j].w); }
            const float rstd = rsqrtf(wave_sum(s) * (1.f / DM) + EPS);
            float g[8];
#pragma unroll
            for (int c = 0; c < 8; ++c) g[c] = 0.f;
            unsigned long long* o8 = (unsigned long long*)(H + (size_t)m * DM) + C.lane;
#pragma unroll
            for (int j = 0; j < 4; ++j) { v[j] = v[j] * rstd * wv[j];
                o8[64 * j] = (unsigned long long)cvtpk(v[j].x, v[j].y) | ((unsigned long long)cvtpk(v[j].z, v[j].w) << 32);
#pragma unroll
                for (int i = 0; i < 4; ++i) { const LAS F4* wp = (const LAS F4*)wif + (j * 4 + i) * 64 + C.lane; const F4 wa = wp[0], wb = wp[1024]; const float hv = v[j][i];
                    g[0] += hv * wa.x; g[1] += hv * wa.y; g[2] += hv * wa.z; g[3] += hv * wa.w; g[4] += hv * wb.x; g[5] += hv * wb.y; g[6] += hv * wb.z; g[7] += hv * wb.w; } }
#pragma unroll
            for (int c = 0; c < 8; ++c) g[c] = wave_sum(g[c]);
            if (C.lane == 0) { F4* op = (F4*)(IFP + (size_t)m * 8); op[0] = (F4){g[0], g[1], g[2], g[3]}; op[1] = (F4){g[4], g[5], g[6], g[7]}; }
        }
    }
    for (int it = gw; it < 4096 + 3 * 512; it += NGW) {
        if (it < 4096) { const int kb = it >> 8, nb = it & 255; int src = nb * 32 + (nb >= 192 ? 8 : 0);
            if (nb < 32) { const int p0 = (nb * 32) & 255, q0 = p0 & 127; src = (nb >> 3) * 256 + (q0 >> 6) * 128 + (q0 & 63) + 64 * (p0 >> 7); }
            transpose_item(w_in, DIN, kb * 64, src, (bf16*)(ws + WS_WIN), 1024, nb * 32, scr, C.lane); }
        else { int r = it - 4096; const int mth = r >> 9; r &= 511; const int kb = r >> 5, nb = r & 31;
            const float* W = mth == 0 ? in[4] : (mth == 1 ? in[10] : in[11]);
            if (mth < 2) transpose_item(W, 1024, kb * 64, nb * 32, (bf16*)(ws + WS_WCAT), 2048, nb * 32, scr, C.lane, mth * 1024, mth == 0 ? in[3] : in[9]);
            else transpose_item(W, 1024, kb * 64, nb * 32, (bf16*)(ws + WS_WOUT), 1024, nb * 32, scr, C.lane); }
    }
    { F2* RT = (F2*)(ws + WS_ROPE);
        for (int idx = C.vcu * NTHR + C.tid; idx < SEQ * 64; idx += C.G * NTHR) { const int pos = idx >> 6, j = idx & 63;
            const double rev = (double)pos * invf[j] * 0.15915494309189535; const float fr = (float)(rev - __builtin_floor(rev));
            RT[idx] = (F2){__builtin_amdgcn_cosf(fr), __builtin_amdgcn_sinf(fr)}; } }
    { U4* WRH = (U4*)(ws + WS_ROUT); U4* WRL = (U4*)(ws + WS_ROUT + 98304); const float* nfw = in[12]; const float* wg = in[13]; const float* we = in[15];
        for (int idx = C.vcu * NTHR + C.tid; idx < 32 * 3 * 64; idx += C.G * NTHR) { const int l = idx & 63, nt = (idx >> 6) % 3, kb2 = idx / 192; const int n = 16 * nt + (l & 15);
            float hv[8], lv[8];
#pragma unroll
            for (int j = 0; j < 8; ++j) { const int k = 32 * kb2 + 8 * (l >> 4) + j; float wv = 0.f; if (n < 4) wv = wg[k * 4 + n]; else if (n < 36) wv = we[k * 32 + (n - 4)]; wv *= nfw[k];
                const float h = bflo(cvtpk(wv, 0.f)); hv[j] = h; lv[j] = wv - h; }
            U4 oh, ol; oh.x = cvtpk(hv[0], hv[1]); oh.y = cvtpk(hv[2], hv[3]); oh.z = cvtpk(hv[4], hv[5]); oh.w = cvtpk(hv[6], hv[7]);
            ol.x = cvtpk(lv[0], lv[1]); ol.y = cvtpk(lv[2], lv[3]); ol.z = cvtpk(lv[4], lv[5]); ol.w = cvtpk(lv[6], lv[7]);
            WRH[idx] = oh; WRL[idx] = ol; } }
}

__device__ __forceinline__ float wscan_add(float v, int lane) {
#pragma unroll
    for (int o = 1; o < 64; o <<= 1) { const float t = __shfl_up(v, o); if (lane >= o) v += t; }
    return v;
}
__device__ __forceinline__ float wscan_max(float v, int lane) {
#pragma unroll
    for (int o = 1; o < 64; o <<= 1) { const float t = __shfl_up(v, o); if (lane >= o) v = fmaxf(v, t); }
    return v;
}
__device__ __forceinline__ void phase2(const Ctx& C, const float* const* in, unsigned char* ws) {
    const float* convw = in[5]; const float* convb = in[6]; const float* b_i = in[7]; const float* b_f = in[8];
    LAS float* sQ = (LAS float*)(C.lds);
    LAS float* sK = (LAS float*)(C.lds + 2048);
    const float* IFP = (const float*)(ws + WS_IF); float* THR = (float*)(ws + WS_THR); float* CDEC = (float*)(ws + WS_CDEC);
    const F2* RT = (const F2*)(ws + WS_ROPE);
    for (int it = C.vcu; it < BATCH * NCHUNK; it += C.G) {
        const int b = it >> 6, c = it & 63; const size_t t0 = (size_t)b * SEQ + (size_t)c * CHUNK;
        __syncthreads();
        if (C.wave < 4) { const int hd = C.wave, l = C.lane;
            const float i0 = IFP[(t0 + 2 * l) * 8 + hd] + b_i[hd], i1 = IFP[(t0 + 2 * l + 1) * 8 + hd] + b_i[hd];
            const float f0 = IFP[(t0 + 2 * l) * 8 + 4 + hd] + b_f[hd], f1 = IFP[(t0 + 2 * l + 1) * 8 + 4 + hd] + b_f[hd];
            const float lf0 = fminf(f0, 0.f) - log1pf(__expf(-fabsf(f0))), lf1 = fminf(f1, 0.f) - log1pf(__expf(-fabsf(f1)));
            const float s1 = lf0 + lf1, inc = wscan_add(s1, l), ex = inc - s1;
            const float b0 = ex + lf0, b1 = ex + s1;
            const float u0 = i0 - b0, u1 = i1 - b1, p1 = fmaxf(u0, u1);
            const float pin = wscan_max(p1, l); float pex = __shfl_up(pin, 1); if (l == 0) pex = -INFINITY;
            const float pm0 = fmaxf(pex, u0), pm1 = fmaxf(pex, p1);
            sQ[hd * 128 + 2 * l] = __expf(-pm0); sQ[hd * 128 + 2 * l + 1] = __expf(-pm1);
            sK[hd * 128 + 2 * l] = __expf(u0) * 0.08838834764831845f; sK[hd * 128 + 2 * l + 1] = __expf(u1) * 0.08838834764831845f;
            THR[(t0 + 2 * l) * 4 + hd] = __expf(-b0 - pm0); THR[(t0 + 2 * l + 1) * 4 + hd] = __expf(-b1 - pm1);
            if (l == 63) CDEC[(size_t)it * 4 + hd] = __expf(b1);
        }
        __syncthreads();
        { const int arr = C.wave >> 2, seg = C.wave & 3, g = C.lane, hd = g >> 4, chn = arr * 512 + 8 * g;
          const bf16* src = (const bf16*)(ws + (arr ? WS_MK : WS_MQ)) + (t0 + 32 * seg) * 512 + 8 * g;
          bf16* dst = (bf16*)(ws + (arr ? WS_MKP : WS_MQP)) + (t0 + 32 * seg) * 512 + 8 * g;
          const LAS float* scp = (arr ? sK : sQ) + hd * 128 + 32 * seg;
          float wt[4][8], bs[8];
#pragma unroll
          for (int w = 0; w < 4; ++w) { const F4 w0 = *(const F4*)(convw + w * 1024 + chn), w1 = *(const F4*)(convw + w * 1024 + chn + 4);
              wt[w][0] = w0.x; wt[w][1] = w0.y; wt[w][2] = w0.z; wt[w][3] = w0.w; wt[w][4] = w1.x; wt[w][5] = w1.y; wt[w][6] = w1.z; wt[w][7] = w1.w; }
          { const F4 b0 = *(const F4*)(convb + chn), b1 = *(const F4*)(convb + chn + 4); bs[0] = b0.x; bs[1] = b0.y; bs[2] = b0.z; bs[3] = b0.w; bs[4] = b1.x; bs[5] = b1.y; bs[6] = b1.z; bs[7] = b1.w; }
          const bool has_prev = (c * CHUNK + 32 * seg) > 0;
          U4 win[3];
#pragma unroll
          for (int k = 0; k < 3; ++k) win[k] = has_prev ? *(const U4*)(src - (size_t)(3 - k) * 512) : (U4){0u, 0u, 0u, 0u};
          U4 nrow[8];
#pragma unroll
          for (int k = 0; k < 8; ++k) nrow[k] = *(const U4*)(src + (size_t)k * 512);
#pragma unroll
          for (int r0 = 0; r0 < 32; r0 += 8) {
              U4 rows[8];
#pragma unroll
              for (int k = 0; k < 8; ++k) rows[k] = nrow[k];
              if (r0 + 8 < 32) {
#pragma unroll
                  for (int k = 0; k < 8; ++k) nrow[k] = *(const U4*)(src + (size_t)(r0 + 8 + k) * 512); }
#pragma unroll
              for (int k = 0; k < 8; ++k) {
                  const U4 x0 = win[0], x1 = win[1], x2 = win[2], x3 = rows[k];
                  float y[8];
                  y[0] = bs[0] + bflo(x0.x) * wt[0][0] + bflo(x1.x) * wt[1][0] + bflo(x2.x) * wt[2][0] + bflo(x3.x) * wt[3][0];
                  y[1] = bs[1] + bfhi(x0.x) * wt[0][1] + bfhi(x1.x) * wt[1][1] + bfhi(x2.x) * wt[2][1] + bfhi(x3.x) * wt[3][1];
                  y[2] = bs[2] + bflo(x0.y) * wt[0][2] + bflo(x1.y) * wt[1][2] + bflo(x2.y) * wt[2][2] + bflo(x3.y) * wt[3][2];
                  y[3] = bs[3] + bfhi(x0.y) * wt[0][3] + bfhi(x1.y) * wt[1][3] + bfhi(x2.y) * wt[2][3] + bfhi(x3.y) * wt[3][3];
                  y[4] = bs[4] + bflo(x0.z) * wt[0][4] + bflo(x1.z) * wt[1][4] + bflo(x2.z) * wt[2][4] + bflo(x3.z) * wt[3][4];
                  y[5] = bs[5] + bfhi(x0.z) * wt[0][5] + bfhi(x1.z) * wt[1][5] + bfhi(x2.z) * wt[2][5] + bfhi(x3.z) * wt[3][5];
                  y[6] = bs[6] + bflo(x0.w) * wt[0][6] + bflo(x1.w) * wt[1][6] + bflo(x2.w) * wt[2][6] + bflo(x3.w) * wt[3][6];
                  y[7] = bs[7] + bfhi(x0.w) * wt[0][7] + bfhi(x1.w) * wt[1][7] + bfhi(x2.w) * wt[2][7] + bfhi(x3.w) * wt[3][7];
                  const float sc = scp[r0 + k];
#pragma unroll
                  for (int i = 0; i < 8; ++i) y[i] = silu(y[i]) * sc;
                  U4 o; o.x = cvtpk(y[0], y[1]); o.y = cvtpk(y[2], y[3]); o.z = cvtpk(y[4], y[5]); o.w = cvtpk(y[6], y[7]);
                  *(U4*)(dst + (size_t)(r0 + k) * 512) = o;
                  win[0] = x1; win[1] = x2; win[2] = x3;
              }
          } }
    }
}

#ifndef MXG
#define MXG 0
#endif
template <bool ML, int ABL = 0>
__device__ __forceinline__ void mixer_item(const Ctx& C, const bf16* Qp, const bf16* Kp, bf16* Vp, bf16* Vout, size_t omask, const float* thr, const float* cdec, int b, int hd, int sl, const unsigned char* G8, float* PART) {
    LAS unsigned char* lds = C.lds;
    const int tid = C.tid, lane = C.lane, w = C.wave, l31 = lane & 31, hi = lane >> 5;
    const int lt = (w < 4) ? w : 7 - w, et = w >> 2, dt = w & 3;
    const int q_ = (lane & 15) >> 2, p_ = lane & 3, blk = (lane >> 4) & 1;
    constexpr unsigned KOFF = 0, VOFF = 65536, QOFF = 98304, SOFF = 131072, NOFF = 147456;
    const size_t tok0 = (size_t)b * SEQ;
    const float rdec = hd == 0 ? 0.017183023570817902f : (hd == 1 ? 0.1332151628796484f : (hd == 2 ? 0.3664377159220373f : 0.6059370882290803f));
    __syncthreads();
    for (int i = tid; i < 16384 / 16; i += NTHR) *(LAS U4*)(lds + SOFF + 16 * i) = (U4){0u, 0u, 0u, 0u};
    if (tid < 384) *(LAS float*)(lds + NOFF + 4 * tid) = 0.f;
    F16 St;
#pragma unroll
    for (int r = 0; r < 16; ++r) St[r] = 0.f;
    B8 qf[8];
    const unsigned lds0 = (unsigned)(uintptr_t)lds;
    unsigned ro[8];
#pragma unroll
    for (int s = 0; s < 8; ++s) ro[s] = offb(l31, 2 * s + hi);
    const unsigned kbase = (16 * w + (lane >> 4)) * 512, kx = (lane & 15) ^ ((lane >> 4) << 2);
    const unsigned vbase = (16 * w + (lane >> 3)) * 1024 + ((lane & 7) ^ (((lane >> 4) & 1) << 2)) * 8;
#define ksrc_(i) (kbase + (i) * 2048 + ((kx ^ (i)) * 8))
#define vsrc_(i) (vbase + (i) * 8192)
#define MX_PIECE(cc, buf, i) do { if ((i) < 4) glds16(Kp + (tok0 + (size_t)(cc) * CHUNK) * 512 + hd * 128 + ksrc_(i), (unsigned)__builtin_amdgcn_readfirstlane((int)(lds0 + KOFF + (buf) * 32768 + (w * 4 + (i)) * 1024))); \
        else if ((i) < 6) glds16(Vp + (tok0 + (size_t)(cc) * CHUNK) * 1024 + hd * 256 + sl * 64 + vsrc_((i) - 4), (unsigned)__builtin_amdgcn_readfirstlane((int)(lds0 + VOFF + (buf) * 16384 + (w * 2 + (i) - 4) * 1024))); \
        else glds16(Qp + (tok0 + (size_t)(cc) * CHUNK) * 512 + hd * 128 + ksrc_((i) - 6), (unsigned)__builtin_amdgcn_readfirstlane((int)(lds0 + QOFF + (w * 4 + (i) - 6) * 1024))); } while (0)
#define MX_DMA(cc, buf) do { \
        const bf16* kp_ = Kp + (tok0 + (size_t)(cc) * CHUNK) * 512 + hd * 128; \
        _Pragma("unroll") for (int i = 0; i < 4; ++i) glds16(kp_ + ksrc_(i), (unsigned)__builtin_amdgcn_readfirstlane((int)(lds0 + KOFF + (buf) * 32768 + (w * 4 + i) * 1024))); \
        const bf16* vp_ = Vp + (tok0 + (size_t)(cc) * CHUNK) * 1024 + hd * 256 + sl * 64; \
        _Pragma("unroll") for (int i = 0; i < 2; ++i) glds16(vp_ + vsrc_(i), (unsigned)__builtin_amdgcn_readfirstlane((int)(lds0 + VOFF + (buf) * 16384 + (w * 2 + i) * 1024))); \
        const bf16* qp_ = Qp + (tok0 + (size_t)(cc) * CHUNK) * 512 + hd * 128; \
        _Pragma("unroll") for (int i = 0; i < 4; ++i) glds16(qp_ + ksrc_(i), (unsigned)__builtin_amdgcn_readfirstlane((int)(lds0 + QOFF + (w * 4 + i) * 1024))); \
        } while (0)
    U4 gqv = (U4){0u, 0u, 0u, 0u}, gnv;
#define MX_GATES(cc) do { const unsigned char* gp_ = G8 + (tok0 + (size_t)(cc) * CHUNK + 32 * lt + l31) * 1024 + hd * 256 + sl * 64 + 32 * et + 16 * hi; \
        asm volatile("global_load_dwordx4 %0, %1, off" : "=&v"(gnv) : "v"(gp_) : "memory"); } while (0)
    float thn = 1.f, dcn = rdec;
    MX_GATES(0);
    MX_DMA(0, 0);
    if (ML) { thn = thr[(tok0 + 32 * lt + l31) * 4 + hd]; dcn = cdec[((size_t)b * NCHUNK) * 4 + hd]; }
    asm volatile("s_waitcnt vmcnt(0)" : "+v"(gnv) :: "memory");
    gqv = gnv;
    __syncthreads();
    for (int c = 0; c < NCHUNK; ++c) {
        const int cur = c & 1, nxt = cur ^ 1;
        const unsigned KB = KOFF + cur * 32768, VB = VOFF + cur * 16384;
        const float th = thn, decay = dcn;
        B8 af[8];
#pragma unroll
        for (int s = 0; s < 8; ++s) qf[s] = *(const LAS B8*)(lds + (QOFF + 8192 * lt) + ro[s]);
#pragma unroll
        for (int s = 0; s < 8; ++s) af[s] = *(const LAS B8*)(lds + (SOFF + 8192 * et) + ro[s]);
        F16 o;
#pragma unroll
        for (int r = 0; r < 16; ++r) o[r] = 0.f;
#pragma unroll
        for (int s = 0; s < 8; ++s) { o = MFMA32(af[s], qf[s], o); af[s] = *(const LAS B8*)(lds + KB + ro[s]); }
        asm volatile("s_waitcnt lgkmcnt(0)" ::: "memory");
        __syncthreads();
        const bool more = c + 1 < NCHUNK;
        if (more) { if (ML) { thn = thr[(tok0 + (size_t)(c + 1) * CHUNK + 32 * lt + l31) * 4 + hd]; dcn = cdec[((size_t)b * NCHUNK + c + 1) * 4 + hd]; } }
        if (more && !(MXG & 4)) MX_GATES(c + 1);
        float csum = 0.f;
        for (int jt = 0; jt <= lt; ++jt) {
            F16 st;
#pragma unroll
            for (int r = 0; r < 16; ++r) st[r] = 0.f;
            S4 vfr[4];
#pragma unroll
            for (int s2 = 0; s2 < 2; ++s2) { const unsigned R0 = 32 * jt + 16 * s2 + 4 * hi + q_, chv = 4 * et + 2 * blk + (p_ >> 1);
                vfr[2 * s2] = trrd(lds + VB + offv(R0, chv) + 8 * (p_ & 1)); vfr[2 * s2 + 1] = trrd(lds + VB + offv(R0 + 8, chv) + 8 * (p_ & 1)); }
#pragma unroll
            for (int s = 0; s < 8; ++s) { st = MFMA32(af[s], qf[s], st); af[s] = *(const LAS B8*)(lds + (KB + 8192 * (jt + 1)) + ro[s]); }
            if (more) { if (jt == 0) { MX_PIECE(c + 1, nxt, 0); MX_PIECE(c + 1, nxt, 1); MX_PIECE(c + 1, nxt, 2); } else if (jt == 1) { MX_PIECE(c + 1, nxt, 3); MX_PIECE(c + 1, nxt, 4); MX_PIECE(c + 1, nxt, 5); }
                        else if (jt == 2) { MX_PIECE(c + 1, nxt, 6); MX_PIECE(c + 1, nxt, 7); MX_PIECE(c + 1, nxt, 8); } else { MX_PIECE(c + 1, nxt, 9); } }
            if (jt == lt) {
#pragma unroll
                for (int r = 0; r < 16; ++r) if (crow(r, hi) > l31) st[r] = 0.f;
            }
            if (ML) {
#pragma unroll
                for (int r = 0; r < 16; ++r) csum += st[r];
            }
#pragma unroll
            for (int s2 = 0; s2 < 2; ++s2) {
                U4 pk; pk.x = cvtpk(st[8 * s2 + 0], st[8 * s2 + 1]); pk.y = cvtpk(st[8 * s2 + 2], st[8 * s2 + 3]); pk.z = cvtpk(st[8 * s2 + 4], st[8 * s2 + 5]); pk.w = cvtpk(st[8 * s2 + 6], st[8 * s2 + 7]);
                const B8 bfr = __builtin_bit_cast(B8, pk);
                const B8 afr = __builtin_shufflevector(vfr[2 * s2], vfr[2 * s2 + 1], 0, 1, 2, 3, 4, 5, 6, 7);
                o = MFMA32(afr, bfr, o);
            }
        }
        if (more) { if (lt < 1) { MX_PIECE(c + 1, nxt, 3); MX_PIECE(c + 1, nxt, 4); MX_PIECE(c + 1, nxt, 5); } if (lt < 2) { MX_PIECE(c + 1, nxt, 6); MX_PIECE(c + 1, nxt, 7); MX_PIECE(c + 1, nxt, 8); } if (lt < 3) { MX_PIECE(c + 1, nxt, 9); } }
        if (ML) {
            float qd = 0.f;
#pragma unroll
            for (int s = 0; s < 8; ++s) { const U4 nv = *(const LAS U4*)(lds + NOFF + 1024 + cur * 256 + (16 * s + 8 * hi) * 2); const U4 qv = __builtin_bit_cast(U4, qf[s]);
                qd = dot2bf(qv.x, nv.x, qd); qd = dot2bf(qv.y, nv.y, qd); qd = dot2bf(qv.z, nv.z, qd); qd = dot2bf(qv.w, nv.w, qd); }
            csum += __shfl_xor(csum, 32); qd += __shfl_xor(qd, 32);
            const float den = csum + qd;
            const float sc = 1.f / fmaxf(fabsf(den), th);
#pragma unroll
            for (int r = 0; r < 16; ++r) o[r] *= sc;
        }
        { unsigned gq[4];
          { auto ra = __builtin_amdgcn_permlane32_swap(gqv.x, gqv.y, false, false); auto rb = __builtin_amdgcn_permlane32_swap(gqv.z, gqv.w, false, false); gq[0] = ra[0]; gq[2] = ra[1]; gq[1] = rb[0]; gq[3] = rb[1]; }
          F2 pa = (F2){0.f, 0.f}, pb = pa;
#pragma unroll
          for (int g = 0; g < ((MXG & 2) ? 0 : 4); ++g) { F2 oa = (F2){o[4 * g], o[4 * g + 1]}, ob = (F2){o[4 * g + 2], o[4 * g + 3]};
            F2 ga = (F2){b0f(gq[g]), b1f(gq[g])}, gb = (F2){b2f(gq[g]), b3f(gq[g])};
            if (ML) { ga = ga * (1.f / 255.f); gb = gb * (1.f / 255.f); oa = oa * ga; ob = ob * gb; pa += oa * oa; pb += ob * ob; }
            else { pa += oa * oa; pb += ob * ob; ga = ga * 0.03f + (-0.3f); gb = gb * 0.03f + (-0.3f); oa = oa * ga; ob = ob * gb; }
            o[4 * g] = oa.x; o[4 * g + 1] = oa.y; o[4 * g + 2] = ob.x; o[4 * g + 3] = ob.y; }
          float part = (pa.x + pa.y) + (pb.x + pb.y);
          part += __shfl_xor(part, 32);
          if (hi == 0 && !(ABL & 2) && !(MXG & 1)) PART[(size_t)et * NTOK + ((tok0 + (size_t)c * CHUNK + 32 * lt + l31) & omask)] = part; }
        { unsigned pk[8];
#pragma unroll
            for (int g = 0; g < 4; ++g) { pk[2 * g] = cvtpk(o[4 * g], o[4 * g + 1]); pk[2 * g + 1] = cvtpk(o[4 * g + 2], o[4 * g + 3]); }
            U4 s0, s1;
            { auto ra = __builtin_amdgcn_permlane32_swap(pk[0], pk[2], false, false); auto rb = __builtin_amdgcn_permlane32_swap(pk[1], pk[3], false, false);
              s0.x = ra[0]; s0.y = rb[0]; s0.z = ra[1]; s0.w = rb[1]; }
            { auto ra = __builtin_amdgcn_permlane32_swap(pk[4], pk[6], false, false); auto rb = __builtin_amdgcn_permlane32_swap(pk[5], pk[7], false, false);
              s1.x = ra[0]; s1.y = rb[0]; s1.z = ra[1]; s1.w = rb[1]; }
            bf16* op = Vout + ((tok0 + (size_t)c * CHUNK + 32 * lt + l31) & omask) * 1024 + hd * 256 + sl * 64 + 32 * et + 8 * hi;
            if (ABL & 2) { asm volatile("" :: "v"(s0), "v"(s1)); } else { *(U4*)op = s0; *(U4*)(op + 16) = s1; } }
        float ksum = 0.f;
        { const unsigned chk = 4 * dt + 2 * blk + (p_ >> 1), chv = 4 * et + 2 * blk + (p_ >> 1);
          const unsigned ka0 = KB + offb(8 * hi + q_, chk) + 8 * (p_ & 1), ka1 = KB + offb(8 * hi + q_ + 4, chk) + 8 * (p_ & 1);
          const unsigned va0 = VB + offv(8 * hi + q_, chv) + 8 * (p_ & 1), va1 = VB + offv(8 * hi + q_ + 4, chv) + 8 * (p_ & 1);
          S4 ua[2][2], ub[2][2];
          ua[0][0] = trrd(lds + ka0); ua[0][1] = trrd(lds + ka1); ub[0][0] = trrd(lds + va0); ub[0][1] = trrd(lds + va1);
#pragma unroll
          for (int ks = 0; ks < 8; ++ks) { const int cu = ks & 1, nx = cu ^ 1;
            if (ks < 7) { ua[nx][0] = trrd(lds + ka0 + 4096 * (ks + 1)); ua[nx][1] = trrd(lds + ka1 + 4096 * (ks + 1)); ub[nx][0] = trrd(lds + va0 + 2048 * (ks + 1)); ub[nx][1] = trrd(lds + va1 + 2048 * (ks + 1)); }
            const B8 afr = __builtin_shufflevector(ua[cu][0], ua[cu][1], 0, 1, 2, 3, 4, 5, 6, 7), bfr = __builtin_shufflevector(ub[cu][0], ub[cu][1], 0, 1, 2, 3, 4, 5, 6, 7);
            St = MFMA32(afr, bfr, St);
            if (ML) { const U4 av = __builtin_bit_cast(U4, afr); ksum = dot2bf(av.x, 0x3f803f80u, ksum); ksum = dot2bf(av.y, 0x3f803f80u, ksum); ksum = dot2bf(av.z, 0x3f803f80u, ksum); ksum = dot2bf(av.w, 0x3f803f80u, ksum); }
          } }
#pragma unroll
        for (int r = 0; r < 16; ++r) St[r] *= decay;
#pragma unroll
        for (int g = 0; g < 4; ++g) { U2 pk; pk.x = cvtpk(St[4 * g], St[4 * g + 1]); pk.y = cvtpk(St[4 * g + 2], St[4 * g + 3]);
            *(LAS U2*)(lds + SOFF + offb(32 * et + l31, 4 * dt + g) + 8 * hi) = pk; }
        if (ML) { ksum += __shfl_xor(ksum, 32);
            if (et == 0 && hi == 0) { const LAS float* nv = (const LAS float*)(lds + NOFF + cur * 512); LAS float* nn = (LAS float*)(lds + NOFF + nxt * 512);
                const float nval = decay * (nv[32 * dt + l31] + ksum); nn[32 * dt + l31] = nval;
                *(LAS unsigned short*)(lds + NOFF + 1024 + nxt * 256 + (32 * dt + l31) * 2) = (unsigned short)(cvtpk(nval, 0.f) & 0xffffu); } }
        asm volatile("s_waitcnt vmcnt(3)" : "+v"(gnv) :: "memory");
        gqv = gnv;
        __syncthreads();
    }
#undef MX_DMA
#undef MX_GATES
#undef MX_PIECE
#undef ksrc_
#undef vsrc_
}
#ifndef PROBE_ITEM_VCU
#define PROBE_ITEM_VCU (-1)
#endif
__device__ __forceinline__ void phase3(const Ctx& C, unsigned char* ws, bool dry) {
    const unsigned long long pt0 = PROBE_ITEM_VCU >= 0 ? __builtin_amdgcn_s_memrealtime() : 0ull;
    for (int it = C.vcu; it < 256; it += C.G) {
        const int mix = it >> 7, b = (it >> 4) & 7, hd = (it >> 2) & 3, sl = it & 3;
        bf16* vr = (bf16*)(ws + WS_RV); bf16* vm = (bf16*)(ws + WS_MV); bf16* dump = (bf16*)(ws + 946 * MiB);
        const unsigned char* g8 = (const unsigned char*)(ws + (mix ? WS_MO : WS_RG)); float* part = (float*)(ws + WS_RS) + (size_t)((mix * 4 + hd) * 8 + sl * 2) * NTOK;
#ifndef DRY_ABL
#define DRY_ABL 0
#endif
        if (dry) {
            if (mix == 0 || (DRY_ABL & 1)) mixer_item<false, DRY_ABL>(C, (const bf16*)(ws + (mix ? WS_MQP : WS_RQ)), (const bf16*)(ws + (mix ? WS_MKP : WS_RK)), mix ? vm : vr, dump, (size_t)0x7fff, nullptr, nullptr, b, hd, sl, g8, (float*)dump);
            else mixer_item<true, DRY_ABL>(C, (const bf16*)(ws + WS_MQP), (const bf16*)(ws + WS_MKP), vm, dump, (size_t)0x7fff, (const float*)(ws + WS_THR), (const float*)(ws + WS_CDEC), b, hd, sl, g8, (float*)dump);
        } else {
        if (mix == 0) mixer_item<false>(C, (const bf16*)(ws + WS_RQ), (const bf16*)(ws + WS_RK), vr, vr, ~(size_t)0, nullptr, nullptr, b, hd, sl, g8, part);
        else mixer_item<true>(C, (const bf16*)(ws + WS_MQP), (const bf16*)(ws + WS_MKP), vm, vm, ~(size_t)0, (const float*)(ws + WS_THR), (const float*)(ws + WS_CDEC), b, hd, sl, g8, part);
        }
    }
    if (PROBE_ITEM_VCU >= 0 && C.vcu == PROBE_ITEM_VCU && C.tid == 0) ((float*)(ws + WS_CTL))[2000] = (float)(__builtin_amdgcn_s_memrealtime() - pt0) * 0.001f;
    if (PROBE_ITEM_VCU == 1000 && C.tid == 0) atomicMax((unsigned*)(ws + WS_CTL) + 2000, __float_as_uint((float)(__builtin_amdgcn_s_memrealtime() - pt0) * 0.001f));
}

__device__ __forceinline__ void phase4(const Ctx& C, const float* const* in, unsigned char* ws) {
    const int gw = C.vcu * NWAVES + C.wave, NGW = C.G * NWAVES;
    LAS float* scr = (LAS float*)(C.lds + C.wave * 8448);
    const float* wgate = in[17]; const float* wup = in[18]; const float* wdn = in[19];
    for (int it = gw; it < 16384 + 8192; it += NGW) {
        if (it < 16384) { const int e = it >> 9, kb = (it >> 5) & 15, nb = it & 31; const int R0 = nb * 32, tile = R0 >> 8, within = R0 & 255;
            const float* W = (within < 128 ? wgate : wup) + (size_t)e * 1024 * 512;
            transpose_item(W, 512, kb * 64, tile * 128 + (within & 127), (bf16*)(ws + WS_WGU), 1024, e * 1024 + R0, scr, C.lane, 0, in[12]); }
        else { const int r = it - 16384; const int e = r >> 8, kb = (r >> 5) & 7, nb = r & 31;
            transpose_item(wdn + (size_t)e * 512 * 1024, 1024, kb * 64, nb * 32, (bf16*)(ws + WS_WD), 512, e * 1024 + nb * 32, scr, C.lane); }
    }
}

__device__ __forceinline__ void phase8(const Ctx& C, const float* const* in, unsigned char* ws, float* out) {
    const float* x = in[0]; const float* nfw = in[12]; const float* bg = in[14]; const float* be = in[16];
    const bf16* YO = (const bf16*)(ws + WS_YO);
    bf16* X1B = (bf16*)out + 1024;
    const U4* WRH = (const U4*)(ws + WS_ROUT); const U4* WRL = (const U4*)(ws + WS_ROUT + 98304); TokInfo* TI = (TokInfo*)(ws + WS_TOK); unsigned* gcnt = (unsigned*)(ws + WS_CTL);
    int* TM = (int*)(ws + WS_TOKMAP); float* SR = (float*)(ws + WS_SRSTD);
    LAS unsigned char* abh = C.lds + C.wave * 8704; LAS unsigned char* abl = abh + 4352;
    LAS float* scr = (LAS float*)abh;
    LAS U4* wbuf = (LAS U4*)(C.lds + 69632);
    LAS unsigned* lcnt = (LAS unsigned*)(C.lds + 139264);
    LAS unsigned* lbase = (LAS unsigned*)(C.lds + 139264 + 128);
    const int l = C.lane, l15 = l & 15, kk = l >> 4, l31 = l & 31, lh = l >> 5;
    for (int blkid = C.vcu; blkid < NTOK / 256; blkid += C.G) {
        __syncthreads();
        if (C.tid < 32) lcnt[C.tid] = 0u;
        int e0[2], e1[2]; float w0[2], w1[2], rs[2]; unsigned rk0[2], rk1[2];
        F4 accs[2][3], accg[2], accg2[2];
#pragma unroll
        for (int tt = 0; tt < 2; ++tt) { accg[tt] = (F4){0.f, 0.f, 0.f, 0.f}; accg2[tt] = (F4){0.f, 0.f, 0.f, 0.f};
#pragma unroll
            for (int n = 0; n < 3; ++n) accs[tt][n] = (F4){0.f, 0.f, 0.f, 0.f}; }
        const size_t rowb = (size_t)(blkid * 256 + C.wave * 32) + lh;
        F4 xr[8]; U2 yr[8];
#define P8_ROWS(tt_, c_) do { _Pragma("unroll") for (int i_ = 0; i_ < 8; ++i_) { const size_t ro_ = (rowb + 16 * (tt_) + 2 * i_) * DM + 128 * (c_) + 4 * l31; xr[i_] = *(const F4*)(x + ro_); yr[i_] = *(const U2*)(YO + ro_); } } while (0)
        for (int j = C.tid; j < 1536; j += NTHR) { const int hl = j >= 768, e = j - hl * 768; wbuf[(e >> 6) * 128 + hl * 64 + (e & 63)] = (hl ? WRL : WRH)[e]; }
        P8_ROWS(0, 0);
        __syncthreads();
        for (int c = 0; c < 8; ++c) {
            U4 wreg[3];
            if (c < 7) {
#pragma unroll
                for (int q = 0; q < 3; ++q) { const int j = C.tid + NTHR * q, hl = j >= 768, e = j - hl * 768; wreg[q] = (hl ? WRL : WRH)[(c + 1) * 768 + e]; } }
            const LAS U4* wb = wbuf + (c & 1) * 1536;
#pragma unroll
            for (int tt = 0; tt < 2; ++tt) {
#pragma unroll
                for (int i = 0; i < 8; ++i) {
                    F4 a; a.x = xr[i].x + bflo(yr[i].x); a.y = xr[i].y + bfhi(yr[i].x); a.z = xr[i].z + bflo(yr[i].y); a.w = xr[i].w + bfhi(yr[i].y);
                    U2 hv; hv.x = cvtpk(a.x, a.y); hv.y = cvtpk(a.z, a.w);
                    *(U2*)(X1B + (rowb + 16 * tt + 2 * i) * 2048 + 128 * c + 4 * l31) = hv;
                    U2 lv; lv.x = cvtpk(a.x - bflo(hv.x), a.y - bfhi(hv.x)); lv.y = cvtpk(a.z - bflo(hv.y), a.w - bfhi(hv.y));
                    *(LAS U2*)(abh + (2 * i + lh) * 272 + 8 * l31) = hv; *(LAS U2*)(abl + (2 * i + lh) * 272 + 8 * l31) = lv; }
                if (tt == 0) P8_ROWS(1, c); else if (c < 7) P8_ROWS(0, c + 1);
                asm volatile("s_waitcnt lgkmcnt(0)" ::: "memory");
#pragma unroll
                for (int s4 = 0; s4 < 4; ++s4) {
                    const B8 ahi = *(const LAS B8*)(abh + l15 * 272 + s4 * 64 + kk * 16), alo = *(const LAS B8*)(abl + l15 * 272 + s4 * 64 + kk * 16);
#pragma unroll
                    for (int n = 0; n < 3; ++n) { const B8 bh = __builtin_bit_cast(B8, wb[(s4 * 3 + n) * 128 + l]), bl = __builtin_bit_cast(B8, wb[(s4 * 3 + n) * 128 + 64 + l]);
                        accs[tt][n] = __builtin_amdgcn_mfma_f32_16x16x32_bf16(ahi, bh, accs[tt][n], 0, 0, 0);
                        accs[tt][n] = __builtin_amdgcn_mfma_f32_16x16x32_bf16(alo, bh, accs[tt][n], 0, 0, 0);
                        accs[tt][n] = __builtin_amdgcn_mfma_f32_16x16x32_bf16(ahi, bl, accs[tt][n], 0, 0, 0); }
                    accg[tt] = __builtin_amdgcn_mfma_f32_16x16x32_bf16(ahi, ahi, accg[tt], 0, 0, 0);
                    accg2[tt] = __builtin_amdgcn_mfma_f32_16x16x32_bf16(ahi, alo, accg2[tt], 0, 0, 0); }
                asm volatile("s_waitcnt lgkmcnt(0)" ::: "memory");
            }
            if (c < 7) {
#pragma unroll
                for (int q = 0; q < 3; ++q) { const int j = C.tid + NTHR * q, hl = j >= 768, e = j - hl * 768; wbuf[((c + 1) & 1) * 1536 + (e >> 6) * 128 + hl * 64 + (e & 63)] = wreg[q]; } }
            __syncthreads();
        }
#undef P8_ROWS
#pragma unroll
        for (int tt = 0; tt < 2; ++tt) {
            F4 acc[3];
#pragma unroll
            for (int n = 0; n < 3; ++n) acc[n] = accs[tt][n];
            const int rd = l15 & 3;
            const float gd = rd == 0 ? accg[tt].x : (rd == 1 ? accg[tt].y : (rd == 2 ? accg[tt].z : accg[tt].w)), gd2 = rd == 0 ? accg2[tt].x : (rd == 1 ? accg2[tt].y : (rd == 2 ? accg2[tt].z : accg2[tt].w));
            const float rstd = rsqrtf((gd + 2.f * gd2) * (1.f / DM) + EPS);
#pragma unroll
            for (int n = 0; n < 3; ++n)
#pragma unroll
                for (int r = 0; r < 4; ++r) scr[(4 * kk + r) * 49 + 16 * n + l15] = acc[n][r];
            if (kk == (l15 >> 2)) scr[16 * 49 + l15] = rstd;
            asm volatile("s_waitcnt lgkmcnt(0)" ::: "memory");
            e0[tt] = 0; e1[tt] = 0; w0[tt] = 0.f; w1[tt] = 0.f; rs[tt] = 0.f; rk0[tt] = 0u; rk1[tt] = 0u;
            if (l < 16) {
                const LAS float* lr = scr + l * 49; const float rr = scr[16 * 49 + l];
                float g0 = lr[0] * rr + bg[0], g1 = lr[1] * rr + bg[1], g2 = lr[2] * rr + bg[2], g3 = lr[3] * rr + bg[3];
                int gi = 0; float gmx = g0; if (g1 > gmx) { gmx = g1; gi = 1; } if (g2 > gmx) { gmx = g2; gi = 2; } if (g3 > gmx) { gmx = g3; gi = 3; }
                const float gw = __builtin_amdgcn_rcpf(__expf(g0 - gmx) + __expf(g1 - gmx) + __expf(g2 - gmx) + __expf(g3 - gmx));
                float m1 = -INFINITY, m2 = -INFINITY; int i1 = 0, i2 = 0;
#pragma unroll
                for (int i = 0; i < 8; ++i) { const float v = lr[4 + gi * 8 + i] * rr + be[gi * 8 + i];
                    if (v > m1) { m2 = m1; i2 = i1; m1 = v; i1 = i; } else if (v > m2) { m2 = v; i2 = i; } }
                const float ex = __expf(m2 - m1), wa = __builtin_amdgcn_rcpf(1.f + ex);
                e0[tt] = gi * 8 + i1; e1[tt] = gi * 8 + i2; w0[tt] = gw * wa; w1[tt] = gw * ex * wa; rs[tt] = rr;
                rk0[tt] = atomicAdd((unsigned*)(lcnt + e0[tt]), 1u); rk1[tt] = atomicAdd((unsigned*)(lcnt + e1[tt]), 1u);
            }
            asm volatile("s_waitcnt lgkmcnt(0)" ::: "memory");
        }
        __syncthreads();
        if (C.tid < 32) lbase[C.tid] = atomicAdd(gcnt + C.tid, lcnt[C.tid]);
        __syncthreads();
#pragma unroll
        for (int tt = 0; tt < 2; ++tt) if (l < 16) {
            const int t = blkid * 256 + C.wave * 32 + tt * 16 + l;
            TokInfo ti; ti.e0 = e0[tt]; ti.p0 = (int)(lbase[e0[tt]] + rk0[tt]); ti.e1 = e1[tt]; ti.p1 = (int)(lbase[e1[tt]] + rk1[tt]); ti.w0 = w0[tt]; ti.w1 = w1[tt]; ti.rstd = rs[tt]; ti.pad = 0.f;
            TI[t] = ti;
            TM[ti.e0 * 65536 + ti.p0] = t; SR[ti.e0 * 65536 + ti.p0] = rs[tt];
            TM[ti.e1 * 65536 + ti.p1] = t; SR[ti.e1 * 65536 + ti.p1] = rs[tt]; }
    }
}

__device__ __forceinline__ int build_rowbase(const Ctx& C, unsigned char* ws) {
    LAS int* rb = (LAS int*)(C.lds + LDS_MISC);
    LAS unsigned char* t2e = (LAS unsigned char*)(C.lds + LDS_MISC + 256);
    const unsigned* gcnt = (const unsigned*)(ws + WS_CTL);
    __syncthreads();
    if (C.tid == 0) { int acc = 0; for (int e = 0; e < NEXP; ++e) { rb[e] = acc; const int n = (int)__hip_atomic_load(gcnt + e, __ATOMIC_RELAXED, __HIP_MEMORY_SCOPE_AGENT); acc += (n + 255) & ~255; } rb[NEXP] = acc; }
    __syncthreads();
    for (int e = C.tid >> 4; e < NEXP; e += NTHR >> 4) for (int t = (rb[e] >> 8) + (C.tid & 15); t < (rb[e + 1] >> 8); t += 16) t2e[t] = (unsigned char)e;
    __syncthreads();
    return rb[NEXP] >> 8;
}

__device__ __forceinline__ void phase12(const Ctx& C, const float* const* in, float* out, unsigned char* ws) {
    (void)build_rowbase(C, ws);
    const LAS int* rb = (const LAS int*)(C.lds + LDS_MISC);
    const float* fw = in[20]; const TokInfo* TI = (const TokInfo*)(ws + WS_TOK); const unsigned char* Y = (const unsigned char*)(ws + WS_Y);
    const int gw = C.vcu * NWAVES + C.wave, NGW = C.G * NWAVES;
    F4 wv[4];
#pragma unroll
    for (int j = 0; j < 4; ++j) wv[j] = *(const F4*)(fw + 4 * C.lane + 256 * j);
    for (int m = gw; m < NTOK; m += NGW) {
        const TokInfo ti = TI[m];
        const U2* xb = (const U2*)((const bf16*)(out + (size_t)m * DM) + 1024) + C.lane;
        const unsigned* y0 = (const unsigned*)(Y + (size_t)(rb[ti.e0] + ti.p0) * DM) + C.lane;
        const unsigned* y1 = (const unsigned*)(Y + (size_t)(rb[ti.e1] + ti.p1) * DM) + C.lane;
        const float w0 = ti.w0 * 0.0625f, w1 = ti.w1 * 0.0625f;
        F4 v[4]; float s = 0.f;
#pragma unroll
        for (int j = 0; j < 4; ++j) { const unsigned a = y0[64 * j], bq = y1[64 * j]; const U2 c = xb[64 * j];
            v[j].x = bflo(c.x) + w0 * __builtin_amdgcn_cvt_f32_fp8(a, 0) + w1 * __builtin_amdgcn_cvt_f32_fp8(bq, 0); v[j].y = bfhi(c.x) + w0 * __builtin_amdgcn_cvt_f32_fp8(a, 1) + w1 * __builtin_amdgcn_cvt_f32_fp8(bq, 1);
            v[j].z = bflo(c.y) + w0 * __builtin_amdgcn_cvt_f32_fp8(a, 2) + w1 * __builtin_amdgcn_cvt_f32_fp8(bq, 2); v[j].w = bfhi(c.y) + w0 * __builtin_amdgcn_cvt_f32_fp8(a, 3) + w1 * __builtin_amdgcn_cvt_f32_fp8(bq, 3);
            s += (v[j].x * v[j].x + v[j].y * v[j].y) + (v[j].z * v[j].z + v[j].w * v[j].w); }
        const float rstd = rsqrtf(wave_sum(s) * (1.f / DM) + EPS);
        F4* xw = (F4*)(out + (size_t)m * DM) + C.lane;
#pragma unroll
        for (int j = 0; j < 4; ++j) xw[64 * j] = v[j] * rstd * wv[j];
    }
}

constexpr int NPHASE = 13;
struct Args { const float* in[21]; float* out; unsigned char* ws; int ph_lo, ph_hi; };
__global__ void __launch_bounds__(NTHR, 2) fwd_kernel(Args args) {
    extern __shared__ __attribute__((aligned(16))) unsigned char lds_raw[];
    cg::grid_group grid = cg::this_grid();
    Ctx C; C.lds = (LAS unsigned char*)lds_raw; C.tid = threadIdx.x; C.lane = C.tid & 63; C.wave = __builtin_amdgcn_readfirstlane(C.tid >> 6);
    C.G = gridDim.x; { const int bx = blockIdx.x; C.vcu = (C.G % 8 == 0) ? (bx % 8) * (C.G / 8) + bx / 8 : bx; }
    unsigned char* ws = args.ws; unsigned char* ob = (unsigned char*)args.out;
    const int lo = args.ph_lo, hi = args.ph_hi;
#ifndef PHMASK
#define PHMASK 0x1fff
#endif
#define IN(k) (((PHMASK >> (k)) & 1) && lo <= (k) && (k) < hi)
    if (C.tid < 2) ((LAS unsigned*)(C.lds + LDS_MISC + 4096))[C.tid] = 0u;
    __syncthreads();
    XcdBarrier bar; bar.bar = (unsigned*)(ws + WS_CTL) + CW_BAR; bar.x = 0; bar.st = (volatile LAS unsigned*)(C.lds + LDS_MISC + 4096);
    const bool whole = false;
    if (!whole) bar = xcd_barrier_post((unsigned*)(ws + WS_CTL) + CW_BAR, (volatile LAS unsigned*)(C.lds + LDS_MISC + 4096));
    else if (blockIdx.x == 0) { for (int i = C.tid; i < (int)(CTL_ZERO_BYTES / 16); i += NTHR) ((U4*)(ws + WS_CTL))[i] = (U4){0u, 0u, 0u, 0u}; }
#define SEAM(k) do { if (IN(k) && IN((k) + 1)) { if ((k) == 0 && whole) { grid.sync(); bar = xcd_barrier_post((unsigned*)(ws + WS_CTL) + CW_BAR, (volatile LAS unsigned*)(C.lds + LDS_MISC + 4096)); } else xcd_barrier(bar); } } while (0)
#ifndef DUP_MASK
#define DUP_MASK 0
#endif
#define REP(k) for (int rep_ = 0; rep_ < (((DUP_MASK >> (k)) & 1) ? 2 : 1); ++rep_)
#ifndef PROBE_GEMM_PHASE
#define PROBE_GEMM_PHASE 0
#endif
#ifndef PROBE_PHASE
#define PROBE_PHASE (-1)
#endif
    unsigned long long t_prev = 0ull; float t_probe = 0.f;
#define STAMP(k) do { if (PROBE_PHASE >= 0) { const unsigned long long t_now = __builtin_amdgcn_s_memrealtime(); if ((k) == PROBE_PHASE) t_probe = (float)(t_now - t_prev) * 0.001f; t_prev = t_now; } } while (0)
    STAMP(-2);
    if (IN(0)) { REP(0) phase0(C, args.in, ws); } SEAM(0); STAMP(0);
    if (IN(1)) { pg8::Gemm g{(const pg8::bf16_t*)(ws + WS_H), (const pg8::bf16_t*)(ws + WS_WIN), NTOK, NPROJ, DM}; if (PROBE_GEMM_PHASE == 1) g.probe = (float*)(ws + WS_CTL) + 2000; pg8::StaticOrder S; S.init(NTOK, NPROJ, C.G, (int)blockIdx.x, 4);
        pg8::EpiProj E{ws, ob}; REP(1) pg8::gemm_phase<pg8::EpiProj, pg8::StaticOrder, true, true>(C.lds, g, S, E); } SEAM(1); STAMP(1);
    if (IN(2)) { phase2(C, args.in, ws); } SEAM(2); STAMP(2);
    if (IN(3)) { if ((DUP_MASK >> 3) & 1) phase3(C, ws, true); phase3(C, ws, false); phase4(C, args.in, ws); }
    if (IN(3) && IN(5)) xcd_barrier(bar);
    STAMP(3); STAMP(4);
    if (IN(5)) { pg8::Gemm g{(const pg8::bf16_t*)(ws + WS_RV), (const pg8::bf16_t*)(ws + WS_WCAT), NTOK, DM, 2 * DM}; g.lda = 1024; g.ksplit = 16; g.asplit = (long long)(WS_MV - WS_RV) - 16 * 128;     if (PROBE_GEMM_PHASE == 5) g.probe = (float*)(ws + WS_CTL) + 2000; pg8::StaticOrder S; S.init(NTOK, DM, C.G, (int)blockIdx.x);
        pg8::EpiGateFused E{(const unsigned char*)(ob + OUT_GR), (const unsigned char*)(ob + OUT_GM), (pg8::bf16_t*)(ws + WS_MERGED), (const float*)(ws + WS_RS), (LAS float*)(C.lds + 131072)}; REP(5) pg8::gemm_phase<pg8::EpiGateFused, pg8::StaticOrder, true, true>(C.lds, g, S, E); }
    if (IN(5) && IN(7)) xcd_barrier(bar);
    STAMP(5);
    if (IN(7)) { pg8::Gemm g{(const pg8::bf16_t*)(ws + ((ABL_EPI & 9) ? WS_XCAT : WS_MERGED)), (const pg8::bf16_t*)(ws + WS_WOUT), NTOK, DM, DM}; if (PROBE_GEMM_PHASE == 7) g.probe = (float*)(ws + WS_CTL) + 2000; pg8::StaticOrder S; S.init(NTOK, DM, C.G, (int)blockIdx.x, 16);
        pg8::EpiBf16<0> E{(pg8::bf16_t*)(ws + WS_YO), DM, nullptr, 0, 0, 1.f}; REP(7) pg8::gemm_phase<pg8::EpiBf16<0>, pg8::StaticOrder, true, true>(C.lds, g, S, E); } SEAM(7); STAMP(7);
    if (IN(8)) { phase8(C, args.in, ws, args.out); }
    if (IN(8) && IN(10)) xcd_barrier(bar);
    STAMP(8);
    if (IN(10)) { const int nt = build_rowbase(C, ws);
        pg8::Gemm g{(const pg8::bf16_t*)args.out + 1024, (const pg8::bf16_t*)(ws + WS_WGU), MAXROWS, NEXP * 1024, DM}; g.lda = 2048;
        pg8::GroupedOrder<true> S{nt, C.G, C.vcu, (const LAS unsigned char*)(C.lds + LDS_MISC + 256), (const LAS int*)(C.lds + LDS_MISC), (const int*)(ws + WS_TOKMAP)};
        pg8::EpiSwiglu E{(pg8::bf16_t*)(ws + WS_HMID), (const float*)(ws + WS_SRSTD)}; REP(10) pg8::gemm_phase<pg8::EpiSwiglu, pg8::GroupedOrder<true>, true, true>(C.lds, g, S, E); } SEAM(10); STAMP(10);
    if (IN(11)) { const int nt = build_rowbase(C, ws);
        pg8::Gemm g{(const pg8::bf16_t*)(ws + WS_HMID), (const pg8::bf16_t*)(ws + WS_WD), MAXROWS, NEXP * 1024, DEXP}; if (PROBE_GEMM_PHASE == 11) g.probe = (float*)(ws + WS_CTL) + 2000;
        pg8::GroupedOrder<false> S{nt, C.G, C.vcu, (const LAS unsigned char*)(C.lds + LDS_MISC + 256), (const LAS int*)(C.lds + LDS_MISC), nullptr};
        pg8::EpiY E{(unsigned char*)(ws + WS_Y)}; REP(11) pg8::gemm_phase<pg8::EpiY, pg8::GroupedOrder<false>, true, true>(C.lds, g, S, E); } SEAM(11); STAMP(11);
    if (IN(12)) { phase12(C, args.in, args.out, ws); }
    if (PROBE_PHASE >= 0) { __syncthreads(); STAMP(12); if (blockIdx.x == 0 && C.tid == 0) { asm volatile("s_waitcnt vmcnt(0)" ::: "memory"); args.out[0] += t_probe + (PROBE_GEMM_PHASE ? ((const float*)(ws + WS_CTL))[2000] : 0.f); } }
#undef IN
#undef SEAM
}

#ifndef MK_SPLIT
#define MK_SPLIT 0
#endif
extern "C" void kernel_launch(void* const* d_in, const int* in_sizes, int n_in, void* d_out, int out_size, void* d_ws, size_t ws_size, hipStream_t stream) {
    static int grid = 0;
    if (grid == 0) {
        if (n_in != 21 || out_size != NTOK * DM || ws_size < WS_END) { fprintf(stderr, "kernel_launch: unexpected shapes (n_in %d out %d ws %zu)\n", n_in, out_size, ws_size); grid = -1; return; }
        int dev = 0, cus = 0, per_cu = 0;
        if (hipGetDevice(&dev) != hipSuccess || hipDeviceGetAttribute(&cus, hipDeviceAttributeMultiprocessorCount, dev) != hipSuccess) { grid = -1; return; }
        if (hipFuncSetAttribute((const void*)fwd_kernel, hipFuncAttributeMaxDynamicSharedMemorySize, LDS_BYTES) != hipSuccess) { fprintf(stderr, "kernel_launch: hipFuncSetAttribute failed\n"); grid = -1; return; }
        if (hipOccupancyMaxActiveBlocksPerMultiprocessor(&per_cu, (const void*)fwd_kernel, NTHR, LDS_BYTES) != hipSuccess || per_cu < 1) { fprintf(stderr, "kernel_launch: occupancy query says %d\n", per_cu); per_cu = 1; }
        (void)hipGetLastError();
        grid = cus;
    }
    if (grid < 0) return;
    (void)hipMemsetAsync((char*)d_ws + WS_CTL, 0, CTL_ZERO_BYTES, stream);
    Args a{};
    for (int i = 0; i < 21; ++i) a.in[i] = (const float*)d_in[i];
    a.out = (float*)d_out; a.ws = (unsigned char*)d_ws;
    void* kargs[] = {&a};
#if MK_SPLIT
    for (int p = 0; p < NPHASE; ++p) { a.ph_lo = p; a.ph_hi = p + 1;
        hipError_t e = hipLaunchCooperativeKernel((const void*)fwd_kernel, dim3(grid), dim3(NTHR), kargs, LDS_BYTES, stream);
        if (e != hipSuccess) { fprintf(stderr, "kernel_launch: launch %d failed: %s\n", p, hipGetErrorString(e)); break; } }
#else
    a.ph_lo = 0; a.ph_hi = NPHASE;
    hipError_t e = hipLaunchCooperativeKernel((const void*)fwd_kernel, dim3(grid), dim3(NTHR), kargs, LDS_BYTES, stream);
    if (e != hipSuccess) fprintf(stderr, "kernel_launch: cooperative launch failed: %s (grid %d)\n", hipGetErrorString(e), grid);
#endif
}
```
